# Optimizing an MI355X kernel written in HIP

```python
import math, functools
import jax, jax.numpy as jnp
from jax import lax
import numpy as np

D_MODEL = 1024
BATCH = 1
SEQ = 16384
DEPTH = 2

GRID_W = 64
CTX_LEN = 256
HEAD_DIM = 64
N_FOURIER_GROUPS = 4
FOURIER_GROUP_DIM = 64
FOURIER_WIDTH = N_FOURIER_GROUPS * FOURIER_GROUP_DIM
N_DIFF_HEADS = 6
DIFF_QK_DIM = HEAD_DIM // 2
DIFF_V_DIM = HEAD_DIM
DIFF_WIDTH = N_DIFF_HEADS * DIFF_V_DIM
N_GQA_Q_HEADS = 6
N_GQA_KV_HEADS = 2
GQA_GROUP = N_GQA_Q_HEADS // N_GQA_KV_HEADS
GQA_WIDTH = N_GQA_Q_HEADS * HEAD_DIM
MIX_WIDTH = FOURIER_WIDTH + DIFF_WIDTH + GQA_WIDTH
IN_SPLITS = (FOURIER_WIDTH, 2 * N_DIFF_HEADS * DIFF_QK_DIM, 2 * N_DIFF_HEADS * DIFF_QK_DIM, DIFF_WIDTH, GQA_WIDTH, N_GQA_KV_HEADS * HEAD_DIM, N_GQA_KV_HEADS * HEAD_DIM)
IN_WIDTH = 2048
N_EXPERTS = 32
TOP_K = 4
EXPERT_FF = 1024
SWIGLU_ALPHA = 1.702
SWIGLU_LIMIT = 7.0
EXPERT_BLOCK = 128
Q_BLOCK = 128
ROPE_THETA = 10000.0
NORM_EPS = 1e-6
SUBLN_EPS = 1e-5
DIFF_SCALE = DIFF_QK_DIM ** -0.5
GQA_SCALE = HEAD_DIM ** -0.5

kernel_name = 'hybrid_fourier_diffattn_gqa_moe_prefix_dit'


def rms_norm(x, g, eps=NORM_EPS):
    xf = x.astype(jnp.float32)
    y = xf * lax.rsqrt(jnp.mean(xf * xf, axis=-1, keepdims=True) + eps)
    return (y * g.astype(jnp.float32)).astype(x.dtype)


def modulate(h, shift, scale):
    return h * (1 + scale) + shift


def axial_rope_tables(row, col, rot_dim):
    n = rot_dim // 4
    inv = ROPE_THETA ** (-jnp.arange(n, dtype=jnp.float32) / n)
    ang = jnp.concatenate([row[:, None] * inv, col[:, None] * inv], axis=-1)
    return jnp.cos(ang), jnp.sin(ang)


def apply_rope(x, cos, sin):
    xf = x.astype(jnp.float32)
    half = x.shape[-1] // 2
    x1, x2 = xf[..., :half], xf[..., half:]
    cs, sn = cos[None, :, None, :], sin[None, :, None, :]
    return jnp.concatenate([x1 * cs - x2 * sn, x2 * cs + x1 * sn], axis=-1).astype(x.dtype)


def diff_attention_core(q, k, v, lam, g_subln, lam_init):
    s = jnp.einsum('bqhtd,bkhtd->bhtqk', q, k).astype(jnp.float32) * DIFF_SCALE
    p = jax.nn.softmax(s, axis=-1)
    a = (p[:, :, 0] - lam * p[:, :, 1]).astype(v.dtype)
    o = jnp.einsum('bhqk,bkhe->bqhe', a, v)
    o = rms_norm(o, g_subln, eps=SUBLN_EPS) * (1.0 - lam_init)
    return o.reshape(q.shape[0], q.shape[1], -1)


def gqa_core(q, k, v):
    s = jnp.einsum('bqhgd,bkhd->bhgqk', q, k).astype(jnp.float32) * GQA_SCALE
    p = jax.nn.softmax(s, axis=-1).astype(v.dtype)
    o = jnp.einsum('bhgqk,bkhd->bqhgd', p, v)
    return o.reshape(q.shape[0], q.shape[1], -1)


def sweep_query_blocks(core, q):
    B, L = q.shape[0], q.shape[1]
    nb = L // Q_BLOCK
    qb = jnp.moveaxis(q.reshape((B, nb, Q_BLOCK) + q.shape[2:]), 1, 0)
    ob = lax.map(core, qb)
    return jnp.moveaxis(ob, 0, 1).reshape(B, L, ob.shape[-1])


def fourier_mix(u, w_fnet):
    B, L, _ = u.shape
    ug = u.reshape(B, L, N_FOURIER_GROUPS, FOURIER_GROUP_DIM).astype(jnp.float32)
    f = jnp.fft.fft2(ug, axes=(1, 3), norm='ortho').real.astype(u.dtype)
    y = jnp.einsum('blgc,gce->blge', f, w_fnet)
    return y.reshape(B, L, FOURIER_WIDTH)


def token_mixers(h, hc, need_ctx, w_in, w_out, w_fnet, lam, lam_init, g_subln, g_q, g_k, rope_d, rope_g):
    B, L, _ = h.shape
    C = hc.shape[1]
    pts = [int(v) for v in np.cumsum(IN_SPLITS)[:-1]]
    f, dq, dk, dv, gq, gk, gv = jnp.split(h @ w_in, pts, axis=-1)
    fc, dqc, dkc, dvc, gqc, gkc, gvc = jnp.split(hc @ w_in, pts, axis=-1)
    cos_d, sin_d = rope_d
    dq = apply_rope(dq.reshape(B, L, 2 * N_DIFF_HEADS, DIFF_QK_DIM), cos_d, sin_d).reshape(B, L, N_DIFF_HEADS, 2, DIFF_QK_DIM)
    dk = apply_rope(dk.reshape(B, L, 2 * N_DIFF_HEADS, DIFF_QK_DIM), cos_d, sin_d).reshape(B, L, N_DIFF_HEADS, 2, DIFF_QK_DIM)
    dv = dv.reshape(B, L, N_DIFF_HEADS, DIFF_V_DIM)
    dkc = dkc.reshape(B, C, N_DIFF_HEADS, 2, DIFF_QK_DIM)
    dvc = dvc.reshape(B, C, N_DIFF_HEADS, DIFF_V_DIM)
    dk_all = jnp.concatenate([dkc, dk], axis=1)
    dv_all = jnp.concatenate([dvc, dv], axis=1)
    d_out = sweep_query_blocks(lambda qi: diff_attention_core(qi, dk_all, dv_all, lam, g_subln, lam_init), dq)
    cos_g, sin_g = rope_g
    gq = apply_rope(rms_norm(gq.reshape(B, L, N_GQA_Q_HEADS, HEAD_DIM), g_q), cos_g, sin_g).reshape(B, L, N_GQA_KV_HEADS, GQA_GROUP, HEAD_DIM)
    gk = apply_rope(rms_norm(gk.reshape(B, L, N_GQA_KV_HEADS, HEAD_DIM), g_k), cos_g, sin_g)
    gv = gv.reshape(B, L, N_GQA_KV_HEADS, HEAD_DIM)
    gkc = rms_norm(gkc.reshape(B, C, N_GQA_KV_HEADS, HEAD_DIM), g_k)
    gvc = gvc.reshape(B, C, N_GQA_KV_HEADS, HEAD_DIM)
    gk_all = jnp.concatenate([gkc, gk], axis=1)
    gv_all = jnp.concatenate([gvc, gv], axis=1)
    g_out = sweep_query_blocks(lambda qi: gqa_core(qi, gk_all, gv_all), gq)
    f_out = fourier_mix(f, w_fnet)
    o = jnp.concatenate([f_out, d_out, g_out], axis=-1) @ w_out
    if not need_ctx:
        return o, None
    dqc = dqc.reshape(B, C, N_DIFF_HEADS, 2, DIFF_QK_DIM)
    gqc = rms_norm(gqc.reshape(B, C, N_GQA_Q_HEADS, HEAD_DIM), g_q).reshape(B, C, N_GQA_KV_HEADS, GQA_GROUP, HEAD_DIM)
    d_out_c = diff_attention_core(dqc, dkc, dvc, lam, g_subln, lam_init)
    g_out_c = gqa_core(gqc, gkc, gvc)
    f_out_c = fourier_mix(fc, w_fnet)
    oc = jnp.concatenate([f_out_c, d_out_c, g_out_c], axis=-1) @ w_out
    return o, oc


def moe_ffn(h, w_router, b_router, w_gate_up, b_gate_up, w_down, b_down):
    N, D = h.shape
    NK = N * TOP_K
    logits = (h @ w_router + b_router).astype(jnp.float32)
    top_v, top_i = lax.top_k(logits, TOP_K)
    gates = jax.nn.softmax(top_v, axis=-1)
    flat_e = top_i.reshape(-1).astype(jnp.int32)
    flat_t = jnp.arange(NK, dtype=jnp.int32) // TOP_K
    flat_g = gates.reshape(-1)
    se, order = lax.sort((flat_e, jnp.arange(NK, dtype=jnp.int32)), num_keys=1, is_stable=True)
    counts = jax.ops.segment_sum(jnp.ones_like(flat_e), flat_e, num_segments=N_EXPERTS)
    padded = (counts + EXPERT_BLOCK - 1) // EXPERT_BLOCK * EXPERT_BLOCK
    start_sorted = jnp.cumsum(counts) - counts
    ends_pad = jnp.cumsum(padded)
    start_pad = ends_pad - padded
    dest = start_pad[se] + jnp.arange(NK, dtype=jnp.int32) - start_sorted[se]
    P = (NK + EXPERT_BLOCK - 1) // EXPERT_BLOCK * EXPERT_BLOCK + N_EXPERTS * EXPERT_BLOCK
    nb = P // EXPERT_BLOCK
    buf_t = jnp.zeros((P,), jnp.int32).at[dest].set(flat_t[order])
    buf_g = jnp.zeros((P,), jnp.float32).at[dest].set(flat_g[order])
    blk_e = jnp.minimum(jnp.searchsorted(ends_pad, jnp.arange(nb, dtype=jnp.int32) * EXPERT_BLOCK, side='right'), N_EXPERTS - 1)
    xb = h[buf_t].reshape(nb, EXPERT_BLOCK, D)

    def expert_block(args):
        xi, e = args
        gu = xi @ w_gate_up[e] + b_gate_up[e]
        glu, lin = gu[:, :EXPERT_FF], gu[:, EXPERT_FF:]
        glu = jnp.minimum(glu, SWIGLU_LIMIT)
        lin = jnp.clip(lin, -SWIGLU_LIMIT, SWIGLU_LIMIT)
        act = glu * jax.nn.sigmoid(SWIGLU_ALPHA * glu) * (lin + 1)
        return act @ w_down[e] + b_down[e]

    yb = lax.map(expert_block, (xb, blk_e)).reshape(P, D)
    return jnp.zeros((N, D), h.dtype).at[buf_t].add(yb * buf_g[:, None].astype(yb.dtype))


def setup_inputs(seed: int = 0) -> dict:
    key = jax.random.key(seed)
    ks = jax.random.split(key, 26)
    D = D_MODEL

    def nrm(k, shape, scale):
        return jax.random.normal(k, shape, jnp.float32) * scale

    return {
        'x': nrm(ks[0], (BATCH, SEQ, D), 1.0),
        'c': nrm(ks[1], (BATCH, D), 1.0),
        'ctx': nrm(ks[2], (BATCH, CTX_LEN, D), 1.0),
        'c_ctx': nrm(ks[3], (D,), 1.0),
        'w_mod': nrm(ks[4], (DEPTH, D, 6 * D), 0.5 * D ** -0.5),
        'b_mod': nrm(ks[5], (DEPTH, 6 * D), 0.02),
        'g_norm1': 1.0 + nrm(ks[6], (DEPTH, D), 0.02),
        'g_norm2': 1.0 + nrm(ks[7], (DEPTH, D), 0.02),
        'w_in': nrm(ks[8], (DEPTH, D, IN_WIDTH), D ** -0.5),
        'w_out': nrm(ks[9], (DEPTH, MIX_WIDTH, D), MIX_WIDTH ** -0.5),
        'w_fnet': nrm(ks[10], (DEPTH, N_FOURIER_GROUPS, FOURIER_GROUP_DIM, FOURIER_GROUP_DIM), FOURIER_GROUP_DIM ** -0.5),
        'lambda_q1': nrm(ks[11], (DEPTH, DIFF_QK_DIM), 0.1),
        'lambda_k1': nrm(ks[12], (DEPTH, DIFF_QK_DIM), 0.1),
        'lambda_q2': nrm(ks[13], (DEPTH, DIFF_QK_DIM), 0.1),
        'lambda_k2': nrm(ks[14], (DEPTH, DIFF_QK_DIM), 0.1),
        'g_subln': 1.0 + nrm(ks[15], (DEPTH, DIFF_V_DIM), 0.02),
        'g_qnorm': 1.0 + nrm(ks[16], (DEPTH, HEAD_DIM), 0.02),
        'g_knorm': 1.0 + nrm(ks[17], (DEPTH, HEAD_DIM), 0.02),
        'w_router': nrm(ks[18], (DEPTH, D, N_EXPERTS), D ** -0.5),
        'b_router': nrm(ks[19], (DEPTH, N_EXPERTS), 0.01),
        'w_gate_up': nrm(ks[20], (DEPTH, N_EXPERTS, D, 2 * EXPERT_FF), D ** -0.5),
        'b_gate_up': nrm(ks[21], (DEPTH, N_EXPERTS, 2 * EXPERT_FF), 0.02),
        'w_down': nrm(ks[22], (DEPTH, N_EXPERTS, EXPERT_FF, D), EXPERT_FF ** -0.5),
        'b_down': nrm(ks[23], (DEPTH, N_EXPERTS, D), 0.02),
        'g_final': 1.0 + nrm(ks[24], (D,), 0.02),
    }


def reference(x, c, ctx, c_ctx, w_mod, b_mod, g_norm1, g_norm2, w_in, w_out, w_fnet, lambda_q1, lambda_k1, lambda_q2, lambda_k2, g_subln, g_qnorm, g_knorm, w_router, b_router, w_gate_up, b_gate_up, w_down, b_down, g_final):
    B, L, D = x.shape
    rows = L // GRID_W
    row_ids = jnp.repeat(jnp.arange(rows, dtype=jnp.float32), GRID_W)
    col_ids = jnp.tile(jnp.arange(GRID_W, dtype=jnp.float32), rows)
    rope_d = axial_rope_tables(row_ids, col_ids, DIFF_QK_DIM)
    rope_g = axial_rope_tables(row_ids, col_ids, HEAD_DIM)
    xc = ctx
    for l in range(DEPTH):
        need_ctx = l < DEPTH - 1
        mod = jax.nn.silu(c) @ w_mod[l] + b_mod[l]
        modc = jax.nn.silu(c_ctx) @ w_mod[l] + b_mod[l]
        sh1, sc1, gt1, sh2, sc2, gt2 = jnp.split(mod[:, None, :], 6, axis=-1)
        sh1c, sc1c, gt1c, sh2c, sc2c, gt2c = jnp.split(modc, 6, axis=-1)
        lam_init = 0.8 - 0.6 * math.exp(-0.3 * l)
        lam = (jnp.exp(jnp.sum(lambda_q1[l].astype(jnp.float32) * lambda_k1[l].astype(jnp.float32)))
               - jnp.exp(jnp.sum(lambda_q2[l].astype(jnp.float32) * lambda_k2[l].astype(jnp.float32))) + lam_init)
        h = modulate(rms_norm(x, g_norm1[l]), sh1, sc1)
        hc = modulate(rms_norm(xc, g_norm1[l]), sh1c, sc1c)
        o, oc = token_mixers(h, hc, need_ctx, w_in[l], w_out[l], w_fnet[l], lam, lam_init, g_subln[l], g_qnorm[l], g_knorm[l], rope_d, rope_g)
        x = x + gt1 * o
        h2 = modulate(rms_norm(x, g_norm2[l]), sh2, sc2)
        if need_ctx:
            xc = xc + gt1c * oc
            h2c = modulate(rms_norm(xc, g_norm2[l]), sh2c, sc2c)
            n_ctx = B * xc.shape[1]
            tokens = jnp.concatenate([h2c.reshape(-1, D), h2.reshape(-1, D)], axis=0)
            y = moe_ffn(tokens, w_router[l], b_router[l], w_gate_up[l], b_gate_up[l], w_down[l], b_down[l])
            xc = xc + gt2c * y[:n_ctx].reshape(xc.shape)
            x = x + gt2 * y[n_ctx:].reshape(x.shape)
        else:
            y = moe_ffn(h2.reshape(-1, D), w_router[l], b_router[l], w_gate_up[l], b_gate_up[l], w_down[l], b_down[l])
            x = x + gt2 * y.reshape(x.shape)
    return rms_norm(x, g_final)
```

```cpp
#include <hip/hip_runtime.h>
#include <cstdio>
#include <cstdint>

#ifndef MK_PROBE
#define MK_PROBE -1
#endif
#ifndef MK_ONE_LAUNCH
#define MK_ONE_LAUNCH 1
#endif

#define LAS __attribute__((address_space(3)))
typedef unsigned short bf16_t;
typedef short bf16x8 __attribute__((ext_vector_type(8)));
typedef short s16x4 __attribute__((ext_vector_type(4)));
typedef float f32x16 __attribute__((ext_vector_type(16)));
typedef float f32x4 __attribute__((ext_vector_type(4)));
typedef float f32x2 __attribute__((ext_vector_type(2)));
typedef unsigned u32x4 __attribute__((ext_vector_type(4)));
typedef unsigned u32x2 __attribute__((ext_vector_type(2)));
typedef __bf16 bf16x2_t __attribute__((ext_vector_type(2)));
typedef short v4i16_t __attribute__((ext_vector_type(4)));

constexpr int DM = 1024, LSEQ = 16384, NCTX = 256, NT = LSEQ + NCTX, INW = 2048, NEXP = 32, FFD = 1024, MIXK = 1280;
constexpr int NKT = NT / 64;
constexpr int NQB = NT / 32;
constexpr float LOG2E = 1.4426950408889634f;
constexpr int NTHREADS = 512;
constexpr int LDS_BYTES = 155648;
constexpr int LDS_CTL = 151552;

constexpr size_t al256(size_t x) { return (x + 255) & ~(size_t)255; }
constexpr size_t WS_CTL = 0, CTL_BYTES = 1u << 20;
constexpr size_t WS_MOD = CTL_BYTES;
constexpr size_t WS_ROPE = WS_MOD + 131072;
constexpr size_t WS_TW = WS_ROPE + 65536;
constexpr size_t WS_A1F = WS_TW + 131072;
constexpr size_t WS_A2F = WS_A1F + 65536;
constexpr size_t WS_ACF = WS_A2F + 131072;
constexpr size_t WS_WIN = WS_ACF + 262144;
constexpr size_t WS_WOUT = WS_WIN + (size_t)2 * INW * DM * 2;
constexpr size_t WS_WGU = WS_WOUT + (size_t)2 * DM * MIXK * 2;
constexpr size_t WS_WDN = WS_WGU + (size_t)2 * NEXP * 2048 * DM * 2;
constexpr size_t WS_HB = WS_WDN + (size_t)2 * NEXP * DM * FFD * 2;
constexpr size_t WS_QD = WS_HB + (size_t)NT * DM * 2;
constexpr size_t WS_KD = WS_QD + (size_t)6 * NQB * 2048 * 2;
constexpr size_t WS_VD = WS_KD + (size_t)6 * NKT * 4096 * 2;
constexpr size_t WS_QG = WS_VD + (size_t)6 * NKT * 4096 * 2;
constexpr size_t WS_KG = WS_QG + (size_t)6 * NQB * 2048 * 2;
constexpr size_t WS_VG = WS_KG + (size_t)2 * NKT * 4096 * 2;
constexpr size_t WS_FT = WS_VG + (size_t)2 * NKT * 4096 * 2;
constexpr size_t WS_FC = WS_FT + (size_t)128 * 2 * 4 * 4096 * 2;
constexpr size_t WS_T2 = WS_FC + (size_t)2 * 4 * 8192 * 2;
constexpr size_t WS_MIX = WS_T2 + (size_t)128 * 2 * 4 * 8192 * 2;
constexpr size_t WS_XS = WS_MIX + (size_t)NT * MIXK * 2;
constexpr size_t WS_LIST = WS_XS + (size_t)NT * DM * 4;
constexpr size_t WS_SLOT = WS_LIST + (size_t)NEXP * NT * 4;
constexpr size_t WS_GATE = WS_SLOT + (size_t)NT * 16;
constexpr size_t WS_ACT = WS_GATE + (size_t)NT * 16;
constexpr size_t WS_YB = WS_ACT + (size_t)NT * 4 * FFD * 2;
constexpr size_t WS_PART = WS_YB + (size_t)NT * 4 * DM * 2;
constexpr size_t WS_PL = WS_PART + (size_t)36 * NT * 64 * 2;
constexpr size_t WS_KP = WS_PL + (size_t)36 * NT * 4;
constexpr size_t WS_END = WS_KP + (size_t)2 * 12 * 1024 * 4;

constexpr int CW_BAR = 4096;
constexpr int CW_CNT = 8192;
constexpr int CW_KMAX = 8320;
constexpr int CW_QH = 8448;

constexpr int RD_RC = 0, RD_RS = 2048, RD_CC = 4096, RD_CS = 4608, RG_RC = 5120, RG_RS = 9216, RG_CC = 13312, RG_CS = 14336, ROPE_N = 15360;

struct Params { const float* in[25]; float* out; unsigned char* ws; };
enum { I_X = 0, I_C, I_CTX, I_CCTX, I_WMOD, I_BMOD, I_GN1, I_GN2, I_WIN, I_WOUT, I_WFNET, I_LQ1, I_LK1, I_LQ2, I_LK2, I_GSUB, I_GQ, I_GK, I_WR, I_BR, I_WGU, I_BGU, I_WDN, I_BDN, I_GFIN };

__device__ __forceinline__ unsigned pk2(float lo, float hi) { f32x2 v = {lo, hi}; bf16x2_t b = __builtin_convertvector(v, bf16x2_t); return __builtin_bit_cast(unsigned, b); }
__device__ __forceinline__ float bf2f(unsigned short u) { return __builtin_bit_cast(float, (unsigned)u << 16); }
__device__ __forceinline__ float bflo(unsigned u) { return __builtin_bit_cast(float, u << 16); }
__device__ __forceinline__ float bfhi(unsigned u) { return __builtin_bit_cast(float, u & 0xffff0000u); }
#define WAITV(n) asm volatile("s_waitcnt vmcnt(" #n ")" ::: "memory")
#define BAR_SYNC() do { asm volatile("s_waitcnt lgkmcnt(0)" ::: "memory"); __builtin_amdgcn_s_barrier(); asm volatile("" ::: "memory"); } while (0)
__device__ __forceinline__ void dma16(const void* g, LAS void* l) { __builtin_amdgcn_global_load_lds((const unsigned*)g, (LAS unsigned*)l, 16, 0, 0); }
__device__ __forceinline__ void glds16(const void* gsrc, unsigned lds_dst) { unsigned keep;
    asm volatile("s_mov_b32 %0, m0\n\ts_mov_b32 m0, %2\n\ts_nop 0\n\tglobal_load_lds_dwordx4 %1, off\n\ts_mov_b32 m0, %0" : "=&s"(keep) : "v"(gsrc), "s"(lds_dst) : "memory"); }
__device__ __forceinline__ s16x4 vtr(LAS const char* p) { return __builtin_bit_cast(s16x4, __builtin_amdgcn_ds_read_tr16_b64_v4i16((LAS v4i16_t*)p)); }
__device__ __forceinline__ int lane_now() { unsigned z = 0u; asm volatile("" : "+v"(z)); return (int)__builtin_amdgcn_mbcnt_hi(~0u, __builtin_amdgcn_mbcnt_lo(~0u, z)); }
template <int M> __device__ __forceinline__ float shxc(float v) { return __builtin_bit_cast(float, __builtin_amdgcn_ds_bpermute((lane_now() ^ M) << 2, __builtin_bit_cast(int, v))); }
__device__ __forceinline__ float add32(float v) { return v + shxc<32>(v); }
__device__ __forceinline__ float max32(float v) { return fmaxf(v, shxc<32>(v)); }
__device__ __forceinline__ float partner32(float v, bool upper) { return shxc<32>(v); }
__device__ __forceinline__ float wave_sum(float v) { v = add32(v); v += shxc<16>(v); v += shxc<8>(v); v += shxc<4>(v); v += shxc<2>(v); v += shxc<1>(v); return v; }
__device__ __forceinline__ float wave_max(float v) { v = max32(v); v = fmaxf(v, shxc<16>(v)); v = fmaxf(v, shxc<8>(v)); v = fmaxf(v, shxc<4>(v)); v = fmaxf(v, shxc<2>(v)); v = fmaxf(v, shxc<1>(v)); return v; }
__device__ __forceinline__ bf16x8 pack8(float a0, float a1, float a2, float a3, float a4, float a5, float a6, float a7) {
    u32x4 w = {pk2(a0, a1), pk2(a2, a3), pk2(a4, a5), pk2(a6, a7)}; return __builtin_bit_cast(bf16x8, w); }
#define MFMA(a, b, c) __builtin_amdgcn_mfma_f32_32x32x16_bf16((a), (b), (c), 0, 0, 0)

#define XB_TMO      128
#define XB_XCNT(j)  (256  + 64 * (j))
#define XB_XSUB(j)  (1280 + 64 * (j))
#define XB_XGEN(j)  (2304 + 64 * (j))
#define XB_TOP      3328
#define XB_TOPGEN   3392
#define XCD_BAR_WORDS 3456
#define XB_SPIN_CAP (1u << 22)
__device__ __forceinline__ unsigned xb_ld(unsigned* p)              { return __hip_atomic_load(p, __ATOMIC_RELAXED, __HIP_MEMORY_SCOPE_AGENT); }
__device__ __forceinline__ unsigned xb_add(unsigned* p, unsigned v) { return __hip_atomic_fetch_add(p, v, __ATOMIC_RELAXED, __HIP_MEMORY_SCOPE_AGENT); }
__device__ __forceinline__ unsigned xb_xcc_id() { return (unsigned)__builtin_amdgcn_s_getreg((3 << 11) | 20) & 0xFu; }
#define XB_SPIN(cond, bar) do { unsigned _sp = 0; while (cond) { __builtin_amdgcn_s_sleep(1); \
    if ((++_sp & 255u) == 0u) { if (xb_ld(&(bar)[XB_TMO])) break; if (_sp > XB_SPIN_CAP) { atomicAdd(&(bar)[XB_TMO], 1u); break; } } } } while (0)
struct XcdBarrier { unsigned* bar; unsigned x; volatile LAS unsigned* st; int wid; };
__device__ __forceinline__ bool xb_leader(int wid) { unsigned z = 0u; asm volatile("" : "+v"(z)); return wid == 0 && __builtin_amdgcn_mbcnt_hi(~0u, __builtin_amdgcn_mbcnt_lo(~0u, z)) == 0u; }
__device__ __forceinline__ XcdBarrier xcd_barrier_post(unsigned* bar, volatile LAS unsigned* st, int wid) {
    XcdBarrier b; b.bar = bar; b.x = xb_xcc_id(); b.st = st; b.wid = wid;
    if (xb_leader(wid)) (void)xb_add(&bar[XB_XCNT(b.x)], 1u);
    return b;
}
__device__ __forceinline__ void xcd_barrier_complete(unsigned* bar, unsigned x, unsigned& nloc, unsigned& nx) {
    const unsigned G = gridDim.x * gridDim.y * gridDim.z;
    unsigned sum, cnt, mine, sp = 0u;
    for (;;) {
        sum = 0u; cnt = 0u; mine = 0u;
#pragma unroll
        for (unsigned j = 0; j < 16; ++j) { const unsigned c = xb_ld(&bar[XB_XCNT(j)]); sum += c; cnt += (c > 0u) ? 1u : 0u; }
        mine = xb_ld(&bar[XB_XCNT(x)]);
        if (sum == G) break;
        __builtin_amdgcn_s_sleep(1);
        if ((++sp & 255u) == 0u) { if (xb_ld(&bar[XB_TMO])) break; if (sp > XB_SPIN_CAP) { atomicAdd(&bar[XB_TMO], 1u); break; } }
    }
    nloc = mine > 0u ? mine : 1u; nx = cnt > 0u ? cnt : 1u;
}
__device__ __forceinline__ void xcd_barrier(const XcdBarrier& b) {
    asm volatile("s_waitcnt vmcnt(0)" ::: "memory");
    __syncthreads();
    if (xb_leader(b.wid)) {
        unsigned* bar = b.bar;
        __builtin_amdgcn_s_waitcnt(0);
        unsigned nloc = b.st[0], nx = b.st[1];
        if (nloc == 0u) { xcd_barrier_complete(bar, b.x, nloc, nx); b.st[0] = nloc; b.st[1] = nx; }
        const unsigned old = xb_add(&bar[XB_XSUB(b.x)], 1u);
        const unsigned gen = old / nloc;
        if (old + 1u == (gen + 1u) * nloc) {
            __builtin_amdgcn_fence(__ATOMIC_RELEASE, "agent");
            asm volatile("s_waitcnt vmcnt(0)" ::: "memory");
            const unsigned og = xb_add(&bar[XB_TOP], 1u);
            const unsigned tg = og / nx;
            if (og + 1u == (tg + 1u) * nx) xb_add(&bar[XB_TOPGEN], 1u);
            else XB_SPIN(xb_ld(&bar[XB_TOPGEN]) == tg, bar);
            __builtin_amdgcn_fence(__ATOMIC_ACQUIRE, "agent");
            xb_add(&bar[XB_XGEN(b.x)], 1u);
            asm volatile("s_waitcnt vmcnt(0)" ::: "memory");
        } else {
            XB_SPIN(xb_ld(&bar[XB_XGEN(b.x)]) == gen, bar);
            __builtin_amdgcn_fence(__ATOMIC_ACQUIRE, "agent");
            asm volatile("s_waitcnt vmcnt(0)" ::: "memory");
        }
    }
    __syncthreads();
}

struct Frame {
    const __attribute__((address_space(4))) Params* pp; unsigned char* wsb; LAS char* lds; int tid, lane, wid, G, bid;
    unsigned* ctl;
    __device__ __forceinline__ const float* in(int i) const { return pp->in[i]; }
    __device__ __forceinline__ float* outp() const { return pp->out; }
    template <class T> __device__ __forceinline__ T* ws(size_t off) const { return (T*)(wsb + off); }
};

template <class RowMap>
__device__ __forceinline__ void transpose_tile(const Frame& F, const float* __restrict__ src, int ldn, int k0, int n0, bf16_t* dst, int ldk, int kdst0, const RowMap& rm) {
    LAS float* tile = (LAS float*)F.lds;
    const int t = F.tid;
    f32x4 v[8];
#pragma unroll
    for (int i = 0; i < 8; ++i) { const int idx = t + 512 * i, k = idx >> 6, c4 = idx & 63; v[i] = *(const f32x4*)(src + (size_t)(k0 + k) * ldn + n0 + 4 * c4); }
#pragma unroll
    for (int i = 0; i < 8; ++i) { const int idx = t + 512 * i, k = idx >> 6, c4 = idx & 63; *(LAS f32x4*)(tile + k * 260 + 4 * c4) = v[i]; }
    __syncthreads();
    { const int n = t >> 1, kh = t & 1; bf16_t* d = dst + (size_t)rm(n0 + n) * ldk + kdst0 + 32 * kh;
#pragma unroll
      for (int q = 0; q < 4; ++q) { float a[8];
#pragma unroll
          for (int j = 0; j < 8; ++j) a[j] = tile[(32 * kh + 8 * q + j) * 260 + n];
          u32x4 w = {pk2(a[0], a[1]), pk2(a[2], a[3]), pk2(a[4], a[5]), pk2(a[6], a[7])}; *(u32x4*)(d + 8 * q) = w; } }
    __syncthreads();
}
struct RowId { __device__ __forceinline__ int operator()(int n) const { return n; } };
struct RowGU { __device__ __forceinline__ int operator()(int n) const { const int ri = n >> 10, j = n & 1023; return 64 * (j >> 5) + 32 * ri + (j & 31); } };

constexpr int P0_GEMV = 192, P0_FOLD = 128, P0_TAB = 16;
constexpr int P0_TWIN = 2 * 16 * 8, P0_TWOUT = 2 * 12 * 4, P0_TWGU = 2 * 32 * 16 * 8, P0_TWDN = 2 * 32 * 16 * 4;
constexpr int P0_ITEMS = P0_GEMV + P0_FOLD + P0_TAB + P0_TWIN + P0_TWOUT + P0_TWGU + P0_TWDN;

__device__ __forceinline__ void p0_gemv(const Frame& F, int item) {
    const int l = item / 96, cc = item % 96, t = F.tid, lane = F.lane, w = F.wid;
    LAS float* sc = (LAS float*)F.lds;
    LAS float* red = sc + 2048;
    const float* c = F.in(I_C); const float* cx = F.in(I_CCTX);
#pragma unroll
    for (int i = 0; i < 2; ++i) { const int k = t + 512 * i; const float a = c[k], b = cx[k]; sc[k] = a / (1.f + __expf(-a)); sc[1024 + k] = b / (1.f + __expf(-b)); }
    __syncthreads();
    const int col = 64 * cc + lane; const float* wm = F.in(I_WMOD) + (size_t)l * 1024 * 6144 + col;
    float a1 = 0.f, a2 = 0.f;
#pragma unroll 8
    for (int k = 128 * w; k < 128 * w + 128; ++k) { const float wv = wm[(size_t)k * 6144]; a1 += sc[k] * wv; a2 += sc[1024 + k] * wv; }
    red[w * 64 + lane] = a1; red[512 + w * 64 + lane] = a2;
    __syncthreads();
    if (w == 0) { float s1 = 0.f, s2 = 0.f;
#pragma unroll
        for (int j = 0; j < 8; ++j) { s1 += red[j * 64 + lane]; s2 += red[512 + j * 64 + lane]; }
        const float b = F.in(I_BMOD)[l * 6144 + col]; float* mod = F.ws<float>(WS_MOD) + (size_t)l * 2 * 6144;
        mod[col] = s1 + b; mod[6144 + col] = s2 + b; }
    __syncthreads();
}
__device__ __forceinline__ void p0_fold(const Frame& F, int item) {
    const int nch = item & 7, g = (item >> 3) & 3, ri = (item >> 5) & 1, l = item >> 6, t = F.tid;
    LAS float* Mx = (LAS float*)F.lds;
    LAS float* wf = Mx + 64 * 65;
    const float* wfn = F.in(I_WFNET) + (size_t)(l * 4 + g) * 4096;
    for (int i = t; i < 4096; i += 512) wf[(i >> 6) * 65 + (i & 63)] = wfn[i];
    __syncthreads();
    for (int i = t; i < 4096; i += 512) { const int c = i >> 6, e = i & 63; float s = 0.f;
        for (int m = 0; m < 64; ++m) { float sn, cs; sincospif(2.f * (float)((m * c) & 63) / 64.f, &sn, &cs); s += (ri ? sn : cs) * wf[m * 65 + e]; }
        Mx[c * 65 + e] = s; }
    __syncthreads();
    const float* wo = F.in(I_WOUT) + (size_t)l * 1024 * 1024 + (size_t)(64 * g) * 1024;
    bf16_t* dst = F.ws<bf16_t>(WS_WOUT) + (size_t)l * DM * MIXK;
    { const int n = nch * 128 + (t & 127), c0 = (t >> 7) * 16; float acc[16];
#pragma unroll
      for (int j = 0; j < 16; ++j) acc[j] = 0.f;
      for (int e = 0; e < 64; ++e) { const float wv = wo[(size_t)e * 1024 + n];
#pragma unroll
          for (int j = 0; j < 16; ++j) acc[j] += Mx[(c0 + j) * 65 + e] * wv; }
      u32x4 w0 = {pk2(acc[0], acc[1]), pk2(acc[2], acc[3]), pk2(acc[4], acc[5]), pk2(acc[6], acc[7])};
      u32x4 w1 = {pk2(acc[8], acc[9]), pk2(acc[10], acc[11]), pk2(acc[12], acc[13]), pk2(acc[14], acc[15])};
      bf16_t* d = dst + (size_t)n * MIXK + 256 * ri + 64 * g + c0; *(u32x4*)d = w0; *(u32x4*)(d + 8) = w1; }
    __syncthreads();
}
__device__ __forceinline__ void p0_tables(const Frame& F, int item) {
    constexpr int N0 = ROPE_N, N1 = N0 + 16384, N2 = N1 + 32768, N3 = N2 + 65536, N4 = N3 + 131072;
    float* rope = F.ws<float>(WS_ROPE); f32x2* tw = F.ws<f32x2>(WS_TW);
    bf16_t* a1 = F.ws<bf16_t>(WS_A1F); bf16_t* a2 = F.ws<bf16_t>(WS_A2F); bf16_t* ac = F.ws<bf16_t>(WS_ACF);
    for (int idx = item * 512 + F.tid; idx < N4; idx += P0_TAB * 512) {
        if (idx < N0) {
            int i = idx; bool isg = false; if (i >= RG_RC) { isg = true; i -= RG_RC; }
            const int n = isg ? 16 : 8, rowsz = 256 * n, colsz = 64 * n;
            int which, pos, fi;
            if (i < rowsz) { which = 0; pos = i / n; fi = i % n; } else if (i < 2 * rowsz) { which = 1; i -= rowsz; pos = i / n; fi = i % n; }
            else if (i < 2 * rowsz + colsz) { which = 2; i -= 2 * rowsz; pos = i / n; fi = i % n; } else { which = 3; i -= 2 * rowsz + colsz; pos = i / n; fi = i % n; }
            const float inv = powf(10000.f, -(float)fi / (float)n); const float ang = (float)pos * inv;
            rope[idx] = (which & 1) ? sinf(ang) : cosf(ang);
        } else if (idx < N1) { const int j = idx - N0; float sn, cs; sincospif(2.f * (float)j / 16384.f, &sn, &cs); tw[j] = (f32x2){cs, sn};
        } else if (idx < N2) { const int e = idx - N1; const int j = e & 7, ln = (e >> 3) & 63, s = (e >> 9) & 7, fb = (e >> 12) & 1, rg = e >> 13;
            const int k1 = 32 * rg + (ln & 31), l1 = 16 * s + 8 * (ln >> 5) + j; float sn, cs; sincospif(2.f * (float)((k1 * l1) & 127) / 128.f, &sn, &cs);
            a1[e] = (bf16_t)(pk2(fb ? -sn : cs, 0.f) & 0xffff);
        } else if (idx < N3) { const int e = idx - N2; const int j = e & 7, ln = (e >> 3) & 63, s = (e >> 9) & 15, fb = (e >> 13) & 1, rg = e >> 14;
            const int k2 = 32 * rg + (ln & 31), kk = 16 * s + 8 * (ln >> 5) + j, l2 = kk >> 1, rip = kk & 1; float sn, cs; sincospif(2.f * (float)((k2 * l2) & 127) / 128.f, &sn, &cs);
            const float v = fb == 0 ? (rip == 0 ? cs : sn) : (rip == 0 ? -sn : cs);
            a2[e] = (bf16_t)(pk2(v, 0.f) & 0xffff);
        } else { const int e = idx - N3; const int j = e & 7, ln = (e >> 3) & 63, s = (e >> 9) & 15, fb = (e >> 13) & 1, rg = (e >> 14) & 3, pa = e >> 16;
            const int k = 128 * pa + 32 * rg + (ln & 31), li = 16 * s + 8 * (ln >> 5) + j; float sn, cs; sincospif(2.f * (float)((k * li) & 255) / 256.f, &sn, &cs);
            ac[e] = (bf16_t)(pk2(fb ? -sn : cs, 0.f) & 0xffff); }
    }
}
__device__ __forceinline__ void phase_prologue(const Frame& F) {
    LAS unsigned* qw = (LAS unsigned*)(F.lds + LDS_CTL + 64);
    unsigned nxt = 0u; if (F.tid == 0) nxt = xb_add(F.ctl + CW_QH + 32, 1u);
    for (;;) {
        __syncthreads();
        if (F.tid == 0) *qw = nxt;
        __syncthreads();
        const int it = (int)*qw; if (it >= P0_ITEMS) break;
        if (F.tid == 0) nxt = xb_add(F.ctl + CW_QH + 32, 1u);
        int i = it;
        if (i < P0_GEMV) { p0_gemv(F, i); continue; } i -= P0_GEMV;
        if (i < P0_FOLD) { p0_fold(F, i); continue; } i -= P0_FOLD;
        if (i < P0_TAB) { p0_tables(F, i); continue; } i -= P0_TAB;
        if (i < P0_TWIN) { const int l = i / 128, r = i % 128, kt = r / 8, nt = r % 8;
            transpose_tile(F, F.in(I_WIN) + (size_t)l * DM * INW, INW, 64 * kt, 256 * nt, F.ws<bf16_t>(WS_WIN) + (size_t)l * INW * DM, DM, 64 * kt, RowId()); continue; } i -= P0_TWIN;
        if (i < P0_TWOUT) { const int l = i / 48, r = i % 48, kt = r / 4, nt = r % 4;
            transpose_tile(F, F.in(I_WOUT) + (size_t)l * DM * DM, DM, 256 + 64 * kt, 256 * nt, F.ws<bf16_t>(WS_WOUT) + (size_t)l * DM * MIXK, MIXK, 512 + 64 * kt, RowId()); continue; } i -= P0_TWOUT;
        if (i < P0_TWGU) { const int le = i / 128, r = i % 128, kt = r / 8, nt = r % 8;
            transpose_tile(F, F.in(I_WGU) + (size_t)le * DM * 2048, 2048, 64 * kt, 256 * nt, F.ws<bf16_t>(WS_WGU) + (size_t)le * 2048 * DM, DM, 64 * kt, RowGU()); continue; } i -= P0_TWGU;
        { const int le = i / 64, r = i % 64, kt = r / 4, nt = r % 4;
            transpose_tile(F, F.in(I_WDN) + (size_t)le * FFD * DM, DM, 64 * kt, 256 * nt, F.ws<bf16_t>(WS_WDN) + (size_t)le * DM * FFD, FFD, 64 * kt, RowId()); }
    }
}

__device__ __forceinline__ void load_row(const float* row, int lane, f32x4 (&x)[4]) {
#pragma unroll
    for (int q = 0; q < 4; ++q) x[q] = *(const f32x4*)(row + 256 * q + 4 * lane);
}
__device__ __forceinline__ float row_rstd(const f32x4 (&x)[4], float eps) {
    float ss = 0.f;
#pragma unroll
    for (int q = 0; q < 4; ++q) ss += x[q][0] * x[q][0] + x[q][1] * x[q][1] + x[q][2] * x[q][2] + x[q][3] * x[q][3];
    ss = wave_sum(ss); return rsqrtf(ss * (1.f / 1024.f) + eps);
}
__device__ __forceinline__ void mod_store_bf16(const f32x4 (&x)[4], float rstd, const float* g, const float* shift, const float* scale, bf16_t* dst, int lane, f32x4 (*hout)[4] = nullptr) {
#pragma unroll
    for (int q = 0; q < 4; ++q) { const int k = 256 * q + 4 * lane;
        const f32x4 gv = *(const f32x4*)(g + k), sh = *(const f32x4*)(shift + k), sc = *(const f32x4*)(scale + k);
        f32x4 hv;
#pragma unroll
        for (int i = 0; i < 4; ++i) hv[i] = (x[q][i] * rstd * gv[i]) * (1.f + sc[i]) + sh[i];
        u32x2 w = {pk2(hv[0], hv[1]), pk2(hv[2], hv[3])}; *(u32x2*)(dst + k) = w;
        if (hout) (*hout)[q] = hv; }
}
__device__ __forceinline__ void phase_norm0(const Frame& F) {
    const float* mod = F.ws<float>(WS_MOD); bf16_t* hb = F.ws<bf16_t>(WS_HB); const float* g1 = F.in(I_GN1);
    const float* xc = F.in(I_CTX); const float* xl = F.in(I_X);
    for (int R = F.bid * 8 + F.wid; R < NT; R += F.G * 8) {
        const float* row = R < NCTX ? xc + (size_t)R * DM : xl + (size_t)(R - NCTX) * DM;
        const float* m = mod + (R < NCTX ? 6144 : 0);
        f32x4 x[4]; load_row(row, F.lane, x); const float rstd = row_rstd(x, 1e-6f);
        mod_store_bf16(x, rstd, g1, m, m + 1024, hb + (size_t)R * DM, F.lane);
    }
}

#define MFMA16(a, b, c) __builtin_amdgcn_mfma_f32_16x16x32_bf16((a), (b), (c), 0, 0, 0)
__device__ __forceinline__ int lds_byte(int r, int c) { const int st = (r >> 4) * 2 + (c >> 5), rr = r & 15, cc = c & 31, ob = rr * 64 + cc * 2; return st * 1024 + (ob ^ (((ob >> 9) & 1) << 5)); }
__device__ __forceinline__ void stage_rc(int b, int& R, int& C) { const int st = b / 1024, sb = b % 1024, swz = sb ^ (((sb >> 9) & 1) << 5); R = (st >> 1) * 16 + swz / 64; C = (st & 1) * 32 + (swz % 64) / 2; }
struct EpiC { f32x4 c[4]; };
struct EpiT { f32x4 t[4]; };
template <class XRow, class Epi>
__device__ __forceinline__ void gemm8(const Frame& F, const bf16_t* __restrict__ A, int K, int brow, const XRow& xrow, const Epi& epi) {
    constexpr int HTB = 16384;
    LAS char* shm = F.lds;
    const int tz = F.tid, wid = F.wid, lane = tz & 63, wr = wid >> 2, wc = wid & 3, fr = lane & 15, fq = lane >> 4;
    unsigned aoff[2]; const bf16_t* xp[2][2];
#pragma unroll
    for (int i = 0; i < 2; ++i) { int r, c; stage_rc(tz * 16 + i * 8192, r, c); aoff[i] = (unsigned)(r * K + c); xp[0][i] = xrow(r) + c; xp[1][i] = xrow(128 + r) + c; }
    const bf16_t* Ab = A + (size_t)brow * K; const size_t hstepA = (size_t)128 * K;
    const int ldsw = wid * 1024;
    const int aoffl = lds_byte(wr * 64 + fr, fq * 8), boffl = lds_byte(wc * 32 + fr, fq * 8);
#define SA(b, h) (shm + ((b) * 2 + (h)) * HTB)
#define SB(b, h) (shm + (4 + (b) * 2 + (h)) * HTB)
#define STAGE_A(b, h, kt) do { _Pragma("unroll") for (int i_ = 0; i_ < 2; ++i_) dma16(Ab + (h) * hstepA + aoff[i_] + (size_t)(kt) * 64, SA(b, h) + ldsw + i_ * 8192); } while (0)
#define STAGE_B(b, h, kt) do { _Pragma("unroll") for (int i_ = 0; i_ < 2; ++i_) dma16(xp[h][i_] + (size_t)(kt) * 64, SB(b, h) + ldsw + i_ * 8192); } while (0)
#define LDA(dst, b, h) do { _Pragma("unroll") for (int m = 0; m < 4; ++m) _Pragma("unroll") for (int k = 0; k < 2; ++k) dst[m][k] = *(LAS const bf16x8*)(SA(b, h) + aoffl + m * 2048 + k * 1024); } while (0)
#define LDB(dst, b, h) do { _Pragma("unroll") for (int n = 0; n < 2; ++n) _Pragma("unroll") for (int k = 0; k < 2; ++k) dst[n][k] = *(LAS const bf16x8*)(SB(b, h) + boffl + n * 2048 + k * 1024); } while (0)
#define MMA(ai, bj, At_, Bt_) do { __builtin_amdgcn_s_setprio(1); _Pragma("unroll") for (int m = 0; m < 4; ++m) _Pragma("unroll") for (int n = 0; n < 2; ++n) _Pragma("unroll") for (int k = 0; k < 2; ++k) \
        acc[ai][bj][m][n] = MFMA16(At_[m][k], Bt_[n][k], acc[ai][bj][m][n]); __builtin_amdgcn_s_setprio(0); } while (0)
#define WAIT_V(n) asm volatile("s_waitcnt vmcnt(" #n ")" ::: "memory")
#define WAIT_L(n) asm volatile("s_waitcnt lgkmcnt(" #n ")" ::: "memory")
#define BAR __builtin_amdgcn_s_barrier()
#define SCHED __builtin_amdgcn_sched_barrier(0)
    f32x4 acc[2][2][4][2];
#pragma unroll
    for (int a = 0; a < 2; ++a)
#pragma unroll
        for (int b = 0; b < 2; ++b)
#pragma unroll
            for (int m = 0; m < 4; ++m)
#pragma unroll
                for (int n = 0; n < 2; ++n) acc[a][b][m][n] = (f32x4){0.f, 0.f, 0.f, 0.f};
    bf16x8 At[4][2], B0[2][2], B1[2][2];
    const int nt = K / 64;
    WAIT_L(0); BAR;
    STAGE_B(0, 0, 0); STAGE_B(0, 1, 0); STAGE_A(0, 0, 0); STAGE_A(0, 1, 0);
    if (wr == 1) BAR;
    WAIT_V(2); BAR;
    STAGE_B(1, 0, 1); STAGE_A(1, 0, 1); STAGE_B(1, 1, 1);
    WAIT_V(6); BAR;
#pragma unroll 1
    for (int t = 0; t < nt; t += 2) {
        const int k2 = (t == nt - 2) ? 0 : t + 2;
        LDB(B0, 0, 0); LDB(B1, 0, 1); SCHED; LDA(At, 0, 0); STAGE_A(1, 1, t + 1);
        WAIT_V(8); WAIT_L(0); BAR; MMA(0, 0, At, B0); MMA(0, 1, At, B1); BAR; SCHED;
        LDA(At, 0, 1); STAGE_B(0, 0, k2); STAGE_B(0, 1, k2); STAGE_A(0, 0, k2);
        WAIT_V(8); WAIT_L(0); BAR; MMA(1, 0, At, B0); MMA(1, 1, At, B1); BAR; SCHED;
        LDB(B0, 1, 0); LDB(B1, 1, 1); SCHED; LDA(At, 1, 0); STAGE_A(0, 1, k2);
        WAIT_V(8); WAIT_L(0); BAR; MMA(0, 0, At, B0); MMA(0, 1, At, B1); BAR; SCHED;
        LDA(At, 1, 1); STAGE_B(1, 0, k2 + 1); STAGE_B(1, 1, k2 + 1); STAGE_A(1, 0, k2 + 1);
        WAIT_V(8); WAIT_L(0); BAR; MMA(1, 0, At, B0); MMA(1, 1, At, B1); BAR; SCHED;
    }
    WAIT_V(0);
    if (wr == 0) BAR;
    BAR;
#undef SA
#undef SB
#undef STAGE_A
#undef STAGE_B
#undef LDA
#undef LDB
#undef MMA
#undef WAIT_V
#undef WAIT_L
#undef BAR
#undef SCHED
    int tq = F.tid; asm volatile("" : "+v"(tq)); const int fr2 = tq & 15, fq2 = (tq >> 4) & 3;
#pragma unroll
    for (int ai = 0; ai < 2; ++ai) { const int cg = (brow >> 6) + 2 * ai + wr;
        const EpiC C = epi.load_c(cg, fq2);
        EpiT T = epi.load_t(cg, wc * 32 + fr2, fq2);
#pragma unroll
        for (int c = 0; c < 4; ++c) { const int bj = c >> 1, n = c & 1; const int tok = bj * 128 + wc * 32 + n * 16 + fr2;
            EpiT Tn = T; if (c < 3) Tn = epi.load_t(cg, ((c + 1) >> 1) * 128 + wc * 32 + ((c + 1) & 1) * 16 + fr2, fq2);
            f32x4 v[4] = {acc[ai][bj][0][n], acc[ai][bj][1][n], acc[ai][bj][2][n], acc[ai][bj][3][n]};
            epi.apply(v, cg, tok, fq2, C, T); T = Tn; } }
}

__device__ __forceinline__ u32x2 pk4(const f32x4& v) { return (u32x2){pk2(v[0], v[1]), pk2(v[2], v[3])}; }
struct EpiInProj {
    const Frame& F; int l, t0;
    __device__ __forceinline__ EpiC load_c(int cg, int fq) const { EpiC C;
#pragma unroll
        for (int m = 0; m < 4; ++m) C.c[m] = (f32x4){0.f, 0.f, 0.f, 0.f};
        if (cg >= 22 && cg < 30) { const float* gw = (cg < 28 ? F.in(I_GQ) : F.in(I_GK)) + 64 * l;
#pragma unroll
            for (int m = 0; m < 4; ++m) C.c[m] = *(const f32x4*)(gw + 16 * m + 4 * fq); }
        return C; }
    __device__ __forceinline__ EpiT load_t(int cg, int tok, int fq) const { EpiT T;
#pragma unroll
        for (int m = 0; m < 4; ++m) T.t[m] = (f32x4){0.f, 0.f, 0.f, 0.f};
        const int R = t0 + tok; const int t = R - NCTX; const int prow = (t >> 6) & 255, pcol = t & 63; const float* const rope = F.ws<float>(WS_ROPE);
        if (R >= NCTX) {
            if (cg >= 4 && cg < 16) { const int ti = fq < 2 ? RD_RC + prow * 8 + 4 * fq : RD_CC + pcol * 8 + 4 * (fq - 2), si = fq < 2 ? RD_RS + prow * 8 + 4 * fq : RD_CS + pcol * 8 + 4 * (fq - 2);
                T.t[0] = *(const f32x4*)(rope + ti); T.t[1] = *(const f32x4*)(rope + si); }
            else if (cg >= 22 && cg < 30) { T.t[0] = *(const f32x4*)(rope + RG_RC + prow * 16 + 4 * fq); T.t[1] = *(const f32x4*)(rope + RG_RS + prow * 16 + 4 * fq);
                T.t[2] = *(const f32x4*)(rope + RG_CC + pcol * 16 + 4 * fq); T.t[3] = *(const f32x4*)(rope + RG_CS + pcol * 16 + 4 * fq); } }
        return T; }
    __device__ __forceinline__ void apply(f32x4 (&v)[4], int cg, int tok, int fq, const EpiC& C, const EpiT& T) const {
        bf16_t* const ft = F.ws<bf16_t>(WS_FT); bf16_t* const fc = F.ws<bf16_t>(WS_FC); bf16_t* const qd = F.ws<bf16_t>(WS_QD); bf16_t* const kd = F.ws<bf16_t>(WS_KD); bf16_t* const vd = F.ws<bf16_t>(WS_VD);
        bf16_t* const qg = F.ws<bf16_t>(WS_QG); bf16_t* const kg = F.ws<bf16_t>(WS_KG); bf16_t* const vg = F.ws<bf16_t>(WS_VG);
        unsigned* const kmax = F.ctl + CW_KMAX + 16 * l;
        const float QSD = 0.17677669529663687f * LOG2E, QSG = 0.125f * LOG2E;
        const int R = t0 + tok; const bool isctx = R < NCTX; const int t = R - NCTX;
        if (cg < 4) {
#pragma unroll
            for (int m = 0; m < 4; ++m) { const int ch = 64 * cg + 16 * m + 4 * fq; const u32x2 w = pk4(v[m]);
                if (isctx) { const size_t a = (size_t)(((ch >> 7) * 4 + ((ch >> 5) & 3)) * 8192 + (R >> 3) * 256 + (R & 7) * 32 + (ch & 31)); *(u32x2*)(fc + a) = w; }
                else { const int l1 = t >> 7, l2 = t & 127; const size_t a = (size_t)((l2 * 2 + (ch >> 7)) * 4 + ((ch >> 5) & 3)) * 4096 + (l1 >> 3) * 256 + (l1 & 7) * 32 + (ch & 31); *(u32x2*)(ft + a) = w; } }
        } else if (cg < 16) {
            const bool isq = cg < 10; const int head = isq ? cg - 4 : cg - 10;
            if (!isctx) { const f32x4 cc = T.t[0], sn = T.t[1];
#pragma unroll
                for (int mp = 0; mp < 2; ++mp)
#pragma unroll
                    for (int j = 0; j < 4; ++j) { const float a = v[2 * mp][j], b = v[2 * mp + 1][j]; v[2 * mp][j] = a * cc[j] - b * sn[j]; v[2 * mp + 1][j] = b * cc[j] + a * sn[j]; } }
            if (isq) {
#pragma unroll
                for (int m = 0; m < 4; ++m) { const f32x4 s = v[m] * QSD;
                    const size_t a = ((((size_t)(head * NQB + (R >> 5)) * 2 + (m >> 1)) * 4 + 2 * (m & 1) + (fq >> 1)) * 32 + (R & 31)) * 8 + 4 * (fq & 1); *(u32x2*)(qd + a) = pk4(s); }
            } else {
                float ss0 = 0.f, ss1 = 0.f;
#pragma unroll
                for (int j = 0; j < 4; ++j) { ss0 += v[0][j] * v[0][j] + v[1][j] * v[1][j]; ss1 += v[2][j] * v[2][j] + v[3][j] * v[3][j]; }
                ss0 += shxc<16>(ss0); ss1 += shxc<16>(ss1); ss0 = add32(ss0); ss1 = add32(ss1);
                ss0 = fmaxf(ss0, shxc<8>(ss0)); ss1 = fmaxf(ss1, shxc<8>(ss1)); ss0 = fmaxf(ss0, shxc<4>(ss0)); ss1 = fmaxf(ss1, shxc<4>(ss1));
                ss0 = fmaxf(ss0, shxc<2>(ss0)); ss1 = fmaxf(ss1, shxc<2>(ss1)); ss0 = fmaxf(ss0, shxc<1>(ss0)); ss1 = fmaxf(ss1, shxc<1>(ss1));
                if ((tok & 15) == 0 && fq == 0) { float* kp = F.ws<float>(WS_KP) + ((size_t)(l * 12 + 2 * head) * 64 + ((t0 >> 8) - 1)) * 16 + (tok >> 4); kp[0] = ss0; kp[1024] = ss1; }
#pragma unroll
                for (int m = 0; m < 4; ++m) {
                    const size_t a = ((((size_t)(head * NKT + (R >> 6)) * 2 + (m >> 1)) * 4 + 2 * (m & 1) + (fq >> 1)) * 64 + (R & 63)) * 8 + 4 * (fq & 1); *(u32x2*)(kd + a) = pk4(v[m]); }
            }
        } else if (cg < 22 || cg >= 30) {
            const bool isd = cg < 22; const int head = isd ? cg - 16 : cg - 30; bf16_t* vb = isd ? vd : vg;
#pragma unroll
            for (int m = 0; m < 4; ++m) {
                const size_t a = ((size_t)(head * NKT + (R >> 6)) * 2 + (m >> 1)) * 2048 + ((R & 63) >> 3) * 256 + (R & 7) * 32 + 16 * (m & 1) + 4 * fq; *(u32x2*)(vb + a) = pk4(v[m]); }
        } else {
            const bool isq = cg < 28; const int head = isq ? cg - 22 : cg - 28;
            float ss = 0.f;
#pragma unroll
            for (int m = 0; m < 4; ++m)
#pragma unroll
                for (int j = 0; j < 4; ++j) ss += v[m][j] * v[m][j];
            ss += shxc<16>(ss); ss = add32(ss); const float rs = rsqrtf(ss * (1.f / 64.f) + 1e-6f);
#pragma unroll
            for (int m = 0; m < 4; ++m) v[m] = v[m] * C.c[m] * rs;
            if (!isctx) { const f32x4 cr = T.t[0], sr = T.t[1], cc = T.t[2], sc = T.t[3];
#pragma unroll
                for (int j = 0; j < 4; ++j) { { const float a = v[0][j], b = v[2][j]; v[0][j] = a * cr[j] - b * sr[j]; v[2][j] = b * cr[j] + a * sr[j]; }
                    { const float a = v[1][j], b = v[3][j]; v[1][j] = a * cc[j] - b * sc[j]; v[3][j] = b * cc[j] + a * sc[j]; } } }
#pragma unroll
            for (int m = 0; m < 4; ++m) { const f32x4 s = isq ? v[m] * QSG : v[m]; const int c = 2 * m + (fq >> 1);
                if (isq) { const size_t a = (((size_t)(head * NQB + (R >> 5)) * 8 + c) * 32 + (R & 31)) * 8 + 4 * (fq & 1); *(u32x2*)(qg + a) = pk4(s); }
                else { const size_t a = (((size_t)(head * NKT + (R >> 6)) * 8 + c) * 64 + (R & 63)) * 8 + 4 * (fq & 1); *(u32x2*)(kg + a) = pk4(s); } }
        }
    }
};
struct EpiOutProj {
    const Frame& F; int l, t0;
    __device__ __forceinline__ const float* src_row(int R) const { return l == 0 ? (R < NCTX ? F.in(I_CTX) + (size_t)R * DM : F.in(I_X) + (size_t)(R - NCTX) * DM) : F.ws<float>(WS_XS) + (size_t)R * DM; }
    __device__ __forceinline__ EpiC load_c(int cg, int fq) const { EpiC C; const float* gt = F.ws<float>(WS_MOD) + (size_t)l * 2 * 6144 + (t0 < NCTX ? 6144 : 0) + 2048;
#pragma unroll
        for (int m = 0; m < 4; ++m) C.c[m] = *(const f32x4*)(gt + 64 * cg + 16 * m + 4 * fq);
        return C; }
    __device__ __forceinline__ EpiT load_t(int cg, int tok, int fq) const { EpiT T; const float* src = src_row(t0 + tok);
#pragma unroll
        for (int m = 0; m < 4; ++m) T.t[m] = *(const f32x4*)(src + 64 * cg + 16 * m + 4 * fq);
        return T; }
    __device__ __forceinline__ void apply(f32x4 (&v)[4], int cg, int tok, int fq, const EpiC& C, const EpiT& T) const {
        float* xs = F.ws<float>(WS_XS) + (size_t)(t0 + tok) * DM;
#pragma unroll
        for (int m = 0; m < 4; ++m) *(f32x4*)(xs + 64 * cg + 16 * m + 4 * fq) = T.t[m] + C.c[m] * v[m];
    }
};
struct EpiGateUp {
    const Frame& F; int le, m0, cnt, offs;
    __device__ __forceinline__ EpiC load_c(int cg, int fq) const { EpiC C; const float* bias = F.in(I_BGU) + (size_t)le * 2048 + 32 * cg + 4 * fq;
        C.c[0] = *(const f32x4*)(bias); C.c[1] = *(const f32x4*)(bias + 16); C.c[2] = *(const f32x4*)(bias + 1024); C.c[3] = *(const f32x4*)(bias + 1024 + 16); return C; }
    __device__ __forceinline__ EpiT load_t(int, int, int) const { EpiT T;
#pragma unroll
        for (int m = 0; m < 4; ++m) T.t[m] = (f32x4){0.f, 0.f, 0.f, 0.f};
        return T; }
    __device__ __forceinline__ void apply(f32x4 (&v)[4], int cg, int tok, int fq, const EpiC& C, const EpiT&) const {
        const int mt = m0 + tok; if (mt >= cnt) return;
        bf16_t* dst = F.ws<bf16_t>(WS_ACT) + (size_t)(offs + mt) * FFD;
#pragma unroll
        for (int m = 0; m < 2; ++m) { const int jj = 32 * cg + 16 * m + 4 * fq; f32x4 o;
#pragma unroll
            for (int j = 0; j < 4; ++j) { float gl = v[m][j] + C.c[m][j], li = v[m + 2][j] + C.c[2 + m][j]; gl = fminf(gl, 7.f); li = fminf(fmaxf(li, -7.f), 7.f);
                o[j] = gl * (1.f / (1.f + __expf(-1.702f * gl))) * (li + 1.f); }
            *(u32x2*)(dst + jj) = pk4(o); }
    }
};
struct EpiDown {
    const Frame& F; int le, m0, cnt, offs;
    __device__ __forceinline__ EpiC load_c(int cg, int fq) const { EpiC C; const float* bias = F.in(I_BDN) + (size_t)le * DM + 64 * cg + 4 * fq;
#pragma unroll
        for (int m = 0; m < 4; ++m) C.c[m] = *(const f32x4*)(bias + 16 * m);
        return C; }
    __device__ __forceinline__ EpiT load_t(int, int, int) const { EpiT T;
#pragma unroll
        for (int m = 0; m < 4; ++m) T.t[m] = (f32x4){0.f, 0.f, 0.f, 0.f};
        return T; }
    __device__ __forceinline__ void apply(f32x4 (&v)[4], int cg, int tok, int fq, const EpiC& C, const EpiT&) const {
        const int mt = m0 + tok; if (mt >= cnt) return;
        bf16_t* dst = F.ws<bf16_t>(WS_YB) + (size_t)(offs + mt) * DM;
#pragma unroll
        for (int m = 0; m < 4; ++m) *(u32x2*)(dst + 64 * cg + 16 * m + 4 * fq) = pk4(v[m] + C.c[m]);
    }
};
struct XDense { const bf16_t* X; int ld; int t0; __device__ __forceinline__ const bf16_t* operator()(int row) const { return X + (size_t)(t0 + row) * ld; } };
struct XGather { const bf16_t* X; const unsigned* list; int m0, cnt; __device__ __forceinline__ const bf16_t* operator()(int row) const { int m = m0 + row; m = m < cnt ? m : cnt - 1; return X + (size_t)list[m] * DM; } };
struct XAct { const bf16_t* X; int base, m0, cnt; __device__ __forceinline__ const bf16_t* operator()(int row) const { int m = m0 + row; m = m < cnt ? m : cnt - 1; return X + (size_t)(base + m) * FFD; } };

template <class Epi>
__device__ __forceinline__ void mini_unit(const Frame& F, const bf16_t* W, int ldw, int f0, const bf16_t* X, int ldx, int t0, int K, const Epi& epi) {
    const int lane = F.lane, wid = F.wid, r = lane & 31, h = lane >> 5; const int kw = K >> 3;
    const bf16_t* wp = W + (size_t)(f0 + r) * ldw + wid * kw + 8 * h; const bf16_t* xp = X + (size_t)(t0 + r) * ldx + wid * kw + 8 * h;
    f32x16 acc0, acc1;
#pragma unroll
    for (int i = 0; i < 16; ++i) { acc0[i] = 0.f; acc1[i] = 0.f; }
#pragma unroll
    for (int s = 0; s < (kw >> 4); ++s) { const bf16x8 w0 = *(const bf16x8*)(wp + 16 * s), w1 = *(const bf16x8*)(wp + (size_t)32 * ldw + 16 * s), xv = *(const bf16x8*)(xp + 16 * s);
        acc0 = MFMA(w0, xv, acc0); acc1 = MFMA(w1, xv, acc1); }
    BAR_SYNC();
    LAS float* red = (LAS float*)F.lds;
#pragma unroll
    for (int i = 0; i < 16; ++i) { red[(wid * 32 + i) * 64 + lane] = acc0[i]; red[(wid * 32 + 16 + i) * 64 + lane] = acc1[i]; }
    __syncthreads();
    LAS float* out = red + 8 * 32 * 64;
#pragma unroll
    for (int j = 0; j < 4; ++j) { const int rg = 4 * wid + j; float s = 0.f;
#pragma unroll
        for (int w = 0; w < 8; ++w) s += red[(w * 32 + rg) * 64 + lane];
        out[rg * 64 + lane] = s; }
    __syncthreads();
    if (wid == 0) {
#pragma unroll
        for (int i = 0; i < 16; ++i) { acc0[i] = out[i * 64 + lane]; acc1[i] = out[(16 + i) * 64 + lane]; }
        epi(acc0, acc1, f0 >> 6, t0 + r, h);
    }
}
struct EpiInProjCtx {
    const Frame& F; int l;
    __device__ __forceinline__ void operator()(f32x16& v0, f32x16& v1, int cg, int R, int h) const {
        const float QSD = 0.17677669529663687f * LOG2E, QSG = 0.125f * LOG2E;
        if (cg < 4) { bf16_t* fc = F.ws<bf16_t>(WS_FC);
#pragma unroll
            for (int fb = 0; fb < 2; ++fb)
#pragma unroll
                for (int g = 0; g < 4; ++g) { const f32x16& v = fb ? v1 : v0; const int ch = 64 * cg + 32 * fb + 8 * g + 4 * h;
                    const size_t a = (size_t)(((ch >> 7) * 4 + ((ch >> 5) & 3)) * 8192 + (R >> 3) * 256 + (R & 7) * 32 + (ch & 31)); *(u32x2*)(fc + a) = (u32x2){pk2(v[4 * g], v[4 * g + 1]), pk2(v[4 * g + 2], v[4 * g + 3])}; }
        } else if (cg < 16) { const bool isq = cg < 10; const int head = isq ? cg - 4 : cg - 10;
            if (isq) { bf16_t* qd = F.ws<bf16_t>(WS_QD);
#pragma unroll
                for (int fb = 0; fb < 2; ++fb)
#pragma unroll
                    for (int g = 0; g < 4; ++g) { const f32x16& v = fb ? v1 : v0;
                        const size_t a = ((((size_t)(head * NQB + (R >> 5)) * 2 + fb) * 4 + g) * 32 + (R & 31)) * 8 + 4 * h;
                        *(u32x2*)(qd + a) = (u32x2){pk2(v[4 * g] * QSD, v[4 * g + 1] * QSD), pk2(v[4 * g + 2] * QSD, v[4 * g + 3] * QSD)}; }
            } else { bf16_t* kd = F.ws<bf16_t>(WS_KD); unsigned* kmax = F.ctl + CW_KMAX + 16 * l;
                float ss0 = 0.f, ss1 = 0.f;
#pragma unroll
                for (int i = 0; i < 16; ++i) { ss0 += v0[i] * v0[i]; ss1 += v1[i] * v1[i]; }
                ss0 = add32(ss0); ss1 = add32(ss1); ss0 = wave_max(ss0); ss1 = wave_max(ss1);
                if (F.lane == 0) { atomicMax(kmax + 2 * head, __float_as_uint(ss0)); atomicMax(kmax + 2 * head + 1, __float_as_uint(ss1)); }
#pragma unroll
                for (int fb = 0; fb < 2; ++fb)
#pragma unroll
                    for (int g = 0; g < 4; ++g) { const f32x16& v = fb ? v1 : v0;
                        const size_t a = ((((size_t)(head * NKT + (R >> 6)) * 2 + fb) * 4 + g) * 64 + (R & 63)) * 8 + 4 * h;
                        *(u32x2*)(kd + a) = (u32x2){pk2(v[4 * g], v[4 * g + 1]), pk2(v[4 * g + 2], v[4 * g + 3])}; } }
        } else if (cg < 22 || cg >= 30) { const bool isd = cg < 22; const int head = isd ? cg - 16 : cg - 30; bf16_t* vb = isd ? F.ws<bf16_t>(WS_VD) : F.ws<bf16_t>(WS_VG);
#pragma unroll
            for (int fb = 0; fb < 2; ++fb)
#pragma unroll
                for (int g = 0; g < 4; ++g) { const f32x16& v = fb ? v1 : v0;
                    const size_t a = ((size_t)(head * NKT + (R >> 6)) * 2 + fb) * 2048 + ((R & 63) >> 3) * 256 + (R & 7) * 32 + 8 * g + 4 * h;
                    *(u32x2*)(vb + a) = (u32x2){pk2(v[4 * g], v[4 * g + 1]), pk2(v[4 * g + 2], v[4 * g + 3])}; }
        } else { const bool isq = cg < 28; const int head = isq ? cg - 22 : cg - 28; const float* gw = (isq ? F.in(I_GQ) : F.in(I_GK)) + 64 * l;
            float ss = 0.f;
#pragma unroll
            for (int i = 0; i < 16; ++i) ss += v0[i] * v0[i] + v1[i] * v1[i];
            ss = add32(ss); const float rs = rsqrtf(ss * (1.f / 64.f) + 1e-6f) * (isq ? QSG : 1.f);
#pragma unroll
            for (int fb = 0; fb < 2; ++fb)
#pragma unroll
                for (int g = 0; g < 4; ++g) { const f32x16& v = fb ? v1 : v0; const f32x4 gv = *(const f32x4*)(gw + 32 * fb + 8 * g + 4 * h);
                    const u32x2 w = {pk2(v[4 * g] * rs * gv[0], v[4 * g + 1] * rs * gv[1]), pk2(v[4 * g + 2] * rs * gv[2], v[4 * g + 3] * rs * gv[3])};
                    if (isq) { const size_t a = (((size_t)(head * NQB + (R >> 5)) * 8 + 4 * fb + g) * 32 + (R & 31)) * 8 + 4 * h; *(u32x2*)(F.ws<bf16_t>(WS_QG) + a) = w; }
                    else { const size_t a = (((size_t)(head * NKT + (R >> 6)) * 8 + 4 * fb + g) * 64 + (R & 63)) * 8 + 4 * h; *(u32x2*)(F.ws<bf16_t>(WS_KG) + a) = w; } }
        }
    }
};
struct EpiOutProjCtx {
    const Frame& F;
    __device__ __forceinline__ void operator()(f32x16& v0, f32x16& v1, int cg, int R, int h) const {
        const float* src = F.in(I_CTX) + (size_t)R * DM; const float* gt = F.ws<float>(WS_MOD) + 6144 + 2048; float* xs = F.ws<float>(WS_XS) + (size_t)R * DM;
#pragma unroll
        for (int fb = 0; fb < 2; ++fb)
#pragma unroll
            for (int g = 0; g < 4; ++g) { const f32x16& v = fb ? v1 : v0; const int n = 64 * cg + 32 * fb + 8 * g + 4 * h;
                const f32x4 x = *(const f32x4*)(src + n), gv = *(const f32x4*)(gt + n);
                *(f32x4*)(xs + n) = (f32x4){x[0] + gv[0] * v[4 * g], x[1] + gv[1] * v[4 * g + 1], x[2] + gv[2] * v[4 * g + 2], x[3] + gv[3] * v[4 * g + 3]}; }
    }
};
__device__ __forceinline__ void phase_inproj(const Frame& F, int l) {
    const bf16_t* Wt = F.ws<bf16_t>(WS_WIN) + (size_t)l * INW * DM; const bf16_t* hb = F.ws<bf16_t>(WS_HB);
    const bool xcd = F.G == 256; const int x = F.bid & 7;
    const int first = xcd ? (F.bid >> 3) : F.bid, stride = xcd ? 32 : F.G, total = xcd ? 64 : 8 * 64;
    for (int i = first; i < total; i += stride) { const int ft = xcd ? 4 * (x & 1) + (i & 3) : (i & 7), tt = 1 + (xcd ? 4 * (i >> 2) + (x >> 1) : (i >> 3));
        EpiInProj E{F, l, 256 * tt}; XDense X{hb, DM, 256 * tt}; gemm8(F, Wt, DM, 256 * ft, X, E); }
    EpiInProjCtx EC{F, l};
    for (int u = F.bid; u < 256; u += F.G) { const int cg = u & 31, tb = u >> 5;
        if (l == 1 && !((cg >= 10 && cg < 22) || cg >= 28)) continue;
        mini_unit(F, Wt, DM, 64 * cg, hb, DM, 32 * tb, DM, EC); }
}
__device__ __forceinline__ void phase_outproj(const Frame& F, int l) {
    const bf16_t* Wt = F.ws<bf16_t>(WS_WOUT) + (size_t)l * DM * MIXK; const bf16_t* mix = F.ws<bf16_t>(WS_MIX);
    const bool xcd = F.G == 256; const int x = F.bid & 7;
    const int first = xcd ? (F.bid >> 3) : F.bid, stride = xcd ? 32 : F.G, total = xcd ? 32 : 4 * 64;
    for (int i = first; i < total; i += stride) { const int ft = i & 3, tt = 1 + (xcd ? 8 * (i >> 2) + x : (i >> 2));
        EpiOutProj E{F, l, 256 * tt}; XDense X{mix, MIXK, 256 * tt}; gemm8(F, Wt, MIXK, 256 * ft, X, E); }
    if (l == 0) { EpiOutProjCtx EC{F};
        for (int u = F.bid; u < 128; u += F.G) { const int cg = u & 15, tb = u >> 4; mini_unit(F, Wt, MIXK, 64 * cg, mix, MIXK, 32 * tb, MIXK, EC); } }
}
__device__ __forceinline__ void moe_tables(const Frame& F, int l, int nf, bool xcd, LAS int*& s_cnt, LAS int*& s_offs, LAS int*& s_t0) {
    LAS int* base = (LAS int*)(F.lds + LDS_CTL + 256); s_cnt = base; s_offs = base + 32; s_t0 = base + 72;
    __syncthreads();
    if (F.tid < NEXP) s_cnt[F.tid] = (int)__hip_atomic_load(F.ctl + CW_CNT + 64 * l + F.tid, __ATOMIC_RELAXED, __HIP_MEMORY_SCOPE_AGENT);
    __syncthreads();
    if (F.tid == 0) { const int g = (F.bid & 7) >> 1; int o = 0, t = 0; for (int e = 0; e < NEXP; ++e) { const int c = s_cnt[e];
            const int ntt = (c + 255) >> 8; int nu = ntt * nf;
            if (xcd) { const int fst = (g - e) & 3; nu = (fst < ntt ? (ntt - fst + 3) >> 2 : 0) * (nf >> 1); }
            s_cnt[e] = c; s_offs[e] = o; s_t0[e] = t; o += c; t += nu; } s_offs[32] = o; s_t0[32] = t; }
    __syncthreads();
}
__device__ __forceinline__ void moe_decode(const Frame& F, bool xcd, int nf, int i, LAS const int* s_t0, int& e, int& ft, int& tt) {
    e = 0; while (e < NEXP - 1 && i >= s_t0[e + 1]) ++e;
    const int j = i - s_t0[e];
    if (xcd) { const int x = F.bid & 7, hf = nf >> 1; ft = hf * (x & 1) + (j % hf); tt = (((x >> 1) - e) & 3) + 4 * (j / hf); }
    else { ft = j % nf; tt = j / nf; } }
__device__ __forceinline__ void phase_gateup(const Frame& F, int l) {
    const bool xcd = F.G == 256;
    LAS int *s_cnt, *s_offs, *s_t0; moe_tables(F, l, 8, xcd, s_cnt, s_offs, s_t0);
    const int first = xcd ? (F.bid >> 3) : F.bid, stride = xcd ? 32 : F.G, total = s_t0[32];
    for (int i = first; i < total; i += stride) { int e, ft, tt; moe_decode(F, xcd, 8, i, s_t0, e, ft, tt);
        EpiGateUp E{F, l * NEXP + e, 256 * tt, s_cnt[e], s_offs[e]};
        XGather X{F.ws<bf16_t>(WS_HB), F.ws<unsigned>(WS_LIST) + (size_t)e * NT, 256 * tt, s_cnt[e]};
        gemm8(F, F.ws<bf16_t>(WS_WGU) + (size_t)(l * NEXP + e) * 2048 * DM, DM, 256 * ft, X, E); }
}
__device__ __forceinline__ void phase_down(const Frame& F, int l) {
    const bool xcd = F.G == 256;
    LAS int *s_cnt, *s_offs, *s_t0; moe_tables(F, l, 4, xcd, s_cnt, s_offs, s_t0);
    const int first = xcd ? (F.bid >> 3) : F.bid, stride = xcd ? 32 : F.G, total = s_t0[32];
    for (int i = first; i < total; i += stride) { int e, ft, tt; moe_decode(F, xcd, 4, i, s_t0, e, ft, tt);
        EpiDown E{F, l * NEXP + e, 256 * tt, s_cnt[e], s_offs[e]};
        XAct X{F.ws<bf16_t>(WS_ACT), s_offs[e], 256 * tt, s_cnt[e]};
        gemm8(F, F.ws<bf16_t>(WS_WDN) + (size_t)(l * NEXP + e) * DM * FFD, FFD, 256 * ft, X, E); }
}

template <int KD, int MODE>
__device__ __forceinline__ void dft_unit(const Frame& F, const bf16_t* AF, const bf16_t* Bsrc, int p0, int colhalf, int pa) {
    constexpr int NS = KD / 16, TILE_B = 4 * KD * 64;
    const int lane = F.lane, wid = F.wid, r = lane & 31, h = lane >> 5, rg = wid & 3, cg2 = wid >> 2;
    LAS char* lds = F.lds;
    BAR_SYNC();
    for (int pc = wid; pc < TILE_B / 1024; pc += 8) dma16((const char*)Bsrc + (size_t)pc * 1024 + lane * 16, lds + pc * 1024);
    WAITV(0); BAR_SYNC();
    f32x16 acc[2][2];
#pragma unroll
    for (int a = 0; a < 2; ++a)
#pragma unroll
        for (int b = 0; b < 2; ++b)
#pragma unroll
            for (int i = 0; i < 16; ++i) acc[a][b][i] = 0.f;
    const bf16_t* af = AF + (size_t)(rg * 2) * NS * 512 + lane * 8;
    const int bl = h * 512 + ((lane & 15) >> 2) * 64 + ((lane >> 4) & 1) * 32 + (lane & 3) * 8;
#pragma unroll 4
    for (int s = 0; s < NS; ++s) {
        const bf16x8 a0 = *(const bf16x8*)(af + (size_t)s * 512), a1 = *(const bf16x8*)(af + (size_t)(NS + s) * 512);
#pragma unroll
        for (int cb = 0; cb < 2; ++cb) { LAS const char* bp = lds + (2 * cg2 + cb) * (KD * 64) + s * 1024 + bl;
            const s16x4 lo = vtr(bp), hi = vtr(bp + 256);
            const bf16x8 bf = {lo[0], lo[1], lo[2], lo[3], hi[0], hi[1], hi[2], hi[3]};
            acc[0][cb] = MFMA(a0, bf, acc[0][cb]); acc[1][cb] = MFMA(a1, bf, acc[1][cb]); }
    }
#pragma unroll
    for (int cb = 0; cb < 2; ++cb) { const int c = 128 * colhalf + 32 * (2 * cg2 + cb) + r;
#pragma unroll
        for (int rho = 0; rho < 16; ++rho) { const int kk = 32 * rg + (rho & 3) + 8 * (rho >> 2) + 4 * h; const float re = acc[0][cb][rho], im = acc[1][cb][rho];
            if (MODE == 0) { const int l2 = p0; const f32x2 tw = F.ws<f32x2>(WS_TW)[(kk * l2) & 16383]; const float o_re = re * tw[0] + im * tw[1], o_im = im * tw[0] - re * tw[1];
                bf16_t* T2 = F.ws<bf16_t>(WS_T2); const size_t a = ((size_t)(kk * 2 + (c >> 7)) * 4 + ((c >> 5) & 3)) * 8192 + (l2 >> 2) * 256 + (2 * (l2 & 3)) * 32 + (c & 31);
                T2[a] = (bf16_t)(pk2(o_re, 0.f) & 0xffff); T2[a + 32] = (bf16_t)(pk2(o_im, 0.f) & 0xffff);
            } else if (MODE == 1) { const int k1 = p0; bf16_t* mr = F.ws<bf16_t>(WS_MIX) + (size_t)(NCTX + k1 + 128 * kk) * MIXK;
                mr[c] = (bf16_t)(pk2(re * (1.f / 1024.f), 0.f) & 0xffff); mr[256 + c] = (bf16_t)(pk2(im * (1.f / 1024.f), 0.f) & 0xffff);
            } else { bf16_t* mr = F.ws<bf16_t>(WS_MIX) + (size_t)(128 * pa + kk) * MIXK;
                mr[c] = (bf16_t)(pk2(re * (1.f / 128.f), 0.f) & 0xffff); mr[256 + c] = (bf16_t)(pk2(im * (1.f / 128.f), 0.f) & 0xffff); } } }
}

constexpr int A_SLOT = 16384;
constexpr int N_PSLOT = 18;
constexpr int A_KRING = 0, A_VRING = 32768;
template <int NQ, int NKS, bool SEPK, bool BIAS>
__device__ __forceinline__ void attn_sweep(const Frame& F, const bf16x8 (&qf)[NQ][NKS], const bf16_t* Kt, const bf16_t* Vt, int ntiles, const f32x16& negm, f32x16 (&o)[NQ][2], float (&lsum)[NQ]) {
    constexpr int NKF = (SEPK ? NQ : 1) * NKS;
    const int lane = F.lane, wid = F.wid, r = lane & 31, h = lane >> 5;
    LAS char* lds = F.lds; const unsigned lds0 = (unsigned)(size_t)F.lds;
    const bf16_t* ksrc = Kt + wid * 512 + lane * 8; const bf16_t* vsrc = Vt + wid * 512 + lane * 8;
#define A_K(t) glds16(ksrc + (size_t)(t) * 4096, (unsigned)__builtin_amdgcn_readfirstlane((int)(lds0 + A_KRING + ((t) & 3) * 8192 + wid * 1024)))
#define A_V(t) glds16(vsrc + (size_t)(t) * 4096, (unsigned)__builtin_amdgcn_readfirstlane((int)(lds0 + A_VRING + ((t) & 3) * 8192 + wid * 1024)))
#define SB() __builtin_amdgcn_sched_barrier(0)
    BAR_SYNC();
    A_K(0); A_V(0); A_K(1); A_K(2); A_V(1);
    float l0[NQ]; f32x16 scA[NQ], scB[NQ]; bf16x8 kf[NKF], vf[4], pa[NQ][2];
#pragma unroll
    for (int qi = 0; qi < NQ; ++qi) { l0[qi] = 0.f;
#pragma unroll
        for (int i = 0; i < 16; ++i) { o[qi][0][i] = 0.f; o[qi][1][i] = 0.f; scB[qi][i] = 0.f; } }
    const int vb = ((lane >> 4) & 1) * 32 + (lane & 3) * 8 + (4 * h + ((lane & 15) >> 2)) * 64;
    const int kbo = h * 1024 + r * 16;
#define LOADK(tile, kb) do { LAS const char* kp_ = lds + A_KRING + ((tile) & 3) * 8192 + kbo + (kb) * 512; \
        _Pragma("unroll") for (int f_ = 0; f_ < NKF; ++f_) kf[f_] = *(LAS const bf16x8*)(kp_ + (SEPK ? (f_ / NKS) * 4096 : 0) + (f_ % NKS) * 2048); } while (0)
#define LOADV(tile, kb) do { LAS const char* vp_ = lds + A_VRING + ((tile) & 3) * 8192 + vb + (kb) * 2048; \
        _Pragma("unroll") for (int j_ = 0; j_ < 2; ++j_) _Pragma("unroll") for (int d_ = 0; d_ < 2; ++d_) { const s16x4 lo_ = vtr(vp_ + d_ * 4096 + j_ * 1024), hi_ = vtr(vp_ + d_ * 4096 + j_ * 1024 + 512); \
            vf[j_ * 2 + d_] = (bf16x8){lo_[0], lo_[1], lo_[2], lo_[3], hi_[0], hi_[1], hi_[2], hi_[3]}; } } while (0)
#define HALF(SN, SO, vtile, vkb, DOK, ktile, kkb) do { \
        LOADV(vtile, vkb); SB(); \
          \
        _Pragma("unroll") for (int m_ = 0; m_ < NQ * NKS; ++m_) { const int qi_ = m_ / NKS, s_ = m_ % NKS; \
            if (s_ == 0) { if (BIAS) SN[qi_] = MFMA(kf[(SEPK ? qi_ : 0) * NKS], qf[qi_][0], negm); else { f32x16 z_; _Pragma("unroll") for (int i_ = 0; i_ < 16; ++i_) z_[i_] = 0.f; SN[qi_] = MFMA(kf[(SEPK ? qi_ : 0) * NKS], qf[qi_][0], z_); } } \
            else SN[qi_] = MFMA(kf[(SEPK ? qi_ : 0) * NKS + s_], qf[qi_][s_], SN[qi_]); \
              \
            _Pragma("unroll") for (int g_ = m_ * 4 / NKS; g_ < (m_ + 1) * 4 / NKS; ++g_) { const int fq_ = g_ >> 2, gg_ = g_ & 3; \
                l0[fq_] += SO[fq_][4 * gg_]; l0[fq_] += SO[fq_][4 * gg_ + 1]; l0[fq_] += SO[fq_][4 * gg_ + 2]; l0[fq_] += SO[fq_][4 * gg_ + 3]; \
                { u32x4 w_ = __builtin_bit_cast(u32x4, pa[fq_][gg_ >> 1]); w_[(gg_ & 1) * 2] = pk2(SO[fq_][4 * gg_], SO[fq_][4 * gg_ + 1]); w_[(gg_ & 1) * 2 + 1] = pk2(SO[fq_][4 * gg_ + 2], SO[fq_][4 * gg_ + 3]); pa[fq_][gg_ >> 1] = __builtin_bit_cast(bf16x8, w_); } } \
            SB(); } \
          \
        _Pragma("unroll") for (int m_ = 0; m_ < NQ * 4; ++m_) { const int j_ = m_ / (2 * NQ), d_ = (m_ / NQ) & 1, qi_ = m_ % NQ; \
            o[qi_][d_] = MFMA(vf[j_ * 2 + d_], pa[qi_][j_], o[qi_][d_]); \
            { const int eq_ = m_ >> 2, eg_ = m_ & 3; \
              SN[eq_][4 * eg_] = __builtin_amdgcn_exp2f(SN[eq_][4 * eg_]); SN[eq_][4 * eg_ + 1] = __builtin_amdgcn_exp2f(SN[eq_][4 * eg_ + 1]); \
              SN[eq_][4 * eg_ + 2] = __builtin_amdgcn_exp2f(SN[eq_][4 * eg_ + 2]); SN[eq_][4 * eg_ + 3] = __builtin_amdgcn_exp2f(SN[eq_][4 * eg_ + 3]); } \
            if (m_ == 0) { if (DOK) LOADK(ktile, kkb); }   \
            SB(); } \
    } while (0)
    WAITV(2); BAR_SYNC();
    A_K(3); if (ntiles > 2) A_V(2);
    LOADK(0, 0);
    for (int t = 0; t < ntiles; ++t) {
        if (t > 0) {
            if (t + 2 < ntiles) { WAITV(2); } else if (t + 1 < ntiles) { WAITV(1); } else { WAITV(0); }
            BAR_SYNC();
            if (t + 3 < ntiles) A_K(t + 3);
            if (t + 2 < ntiles) A_V(t + 2);
        }
        HALF(scA, scB, (t > 0 ? t - 1 : 0), 1, true, t, 1);
        HALF(scB, scA, t, 0, (t + 1 < ntiles), t + 1, 0);
    }
    LOADV(ntiles - 1, 1);
#pragma unroll
    for (int qi = 0; qi < NQ; ++qi) {
#pragma unroll
        for (int i = 0; i < 16; ++i) l0[qi] += scB[qi][i];
        pa[qi][0] = pack8(scB[qi][0], scB[qi][1], scB[qi][2], scB[qi][3], scB[qi][4], scB[qi][5], scB[qi][6], scB[qi][7]);
        pa[qi][1] = pack8(scB[qi][8], scB[qi][9], scB[qi][10], scB[qi][11], scB[qi][12], scB[qi][13], scB[qi][14], scB[qi][15]); }
#pragma unroll
    for (int j = 0; j < 2; ++j)
#pragma unroll
        for (int d0 = 0; d0 < 2; ++d0)
#pragma unroll
            for (int qi = 0; qi < NQ; ++qi) o[qi][d0] = MFMA(vf[j * 2 + d0], pa[qi][j], o[qi][d0]);
#undef A_K
#undef A_V
#undef SB
#undef LOADK
#undef LOADV
#undef HALF
#pragma unroll
    for (int qi = 0; qi < NQ; ++qi) lsum[qi] = add32(l0[qi]);
}
constexpr int PREC = 1152;
__device__ __forceinline__ void store_partial(const Frame& F, int kh, int slot, int R, const f32x16 (&o)[2], float l, int r, int h) {
    bf16_t* rec = F.ws<bf16_t>(WS_PART) + ((size_t)R * 2 + kh) * PREC; const float inv = 1.f / l;
#pragma unroll
    for (int d0 = 0; d0 < 2; ++d0)
#pragma unroll
        for (int g = 0; g < 4; ++g) { u32x2 w = {pk2(o[d0][4 * g] * inv, o[d0][4 * g + 1] * inv), pk2(o[d0][4 * g + 2] * inv, o[d0][4 * g + 3] * inv)};
            const int off = slot < 12 ? (((slot >> 1) * 8 + 4 * d0 + g) * 2 + (slot & 1)) * 8 + 4 * h : 768 + (slot - 12) * 64 + 32 * d0 + 8 * g + 4 * h;
            *(u32x2*)(rec + off) = w; }
    if (h == 0) F.ws<float>(WS_PL)[((size_t)R * 2 + kh) * N_PSLOT + slot] = l;
}
__device__ __forceinline__ void attn_diff_unit(const Frame& F, int l, int head, int R0, int t0, int ntiles, int khalf) {
    const int lane = F.lane, wid = F.wid, r = lane & 31, h = lane >> 5;
    const bf16_t* qp = F.ws<bf16_t>(WS_QD) + (size_t)(head * NQB + (R0 >> 5) + wid) * 2048;
    bf16x8 qf[2][2]; float mi[2];
#pragma unroll
    for (int mp = 0; mp < 2; ++mp) {
#pragma unroll
        for (int s = 0; s < 2; ++s) qf[mp][s] = *(const bf16x8*)(qp + ((4 * mp + 2 * s + h) * 32 + r) * 8);
        float qq = 0.f;
#pragma unroll
        for (int j = 0; j < 8; ++j) { const float a = bf2f((unsigned short)qf[mp][0][j]), b = bf2f((unsigned short)qf[mp][1][j]); qq += a * a + b * b; }
        qq = add32(qq);
        const float km = ((LAS const float*)(F.lds + LDS_CTL + 1024))[2 * head + mp];
        mi[mp] = -sqrtf(qq * km) * 1.01f; }
    f32x16 negm; { const float mm = fminf(mi[0], mi[1]);
#pragma unroll
        for (int i = 0; i < 16; ++i) negm[i] = mm; asm volatile("" : "+v"(negm)); }
    f32x16 o[2][2]; float ls[2];
    attn_sweep<2, 2, true, true>(F, qf, F.ws<bf16_t>(WS_KD) + (size_t)(head * NKT + t0) * 4096, F.ws<bf16_t>(WS_VD) + (size_t)(head * NKT + t0) * 4096, ntiles, negm, o, ls);
    { const int ln = lane_now(), r2 = ln & 31, h2 = ln >> 5, R = R0 + 32 * wid + r2;
#pragma unroll
      for (int mp = 0; mp < 2; ++mp) store_partial(F, khalf, 2 * head + mp, R, o[mp], ls[mp], r2, h2); }
}
template <int NH>
__device__ __forceinline__ void attn_gqa_unit(const Frame& F, int qh0, int kvh, int R0, int t0, int ntiles, int khalf, float bound) {
    const int lane = F.lane, wid = F.wid, r = lane & 31, h = lane >> 5;
    bf16x8 qf[NH][4];
#pragma unroll
    for (int hh = 0; hh < NH; ++hh) { const bf16_t* qp = F.ws<bf16_t>(WS_QG) + (size_t)((qh0 + hh) * NQB + (R0 >> 5) + wid) * 2048;
#pragma unroll
        for (int s = 0; s < 4; ++s) qf[hh][s] = *(const bf16x8*)(qp + ((2 * s + h) * 32 + r) * 8); }
    f32x16 o[NH][2]; float ls[NH]; f32x16 negm;
#pragma unroll
    for (int i = 0; i < 16; ++i) negm[i] = 0.f;
    attn_sweep<NH, 4, false, false>(F, qf, F.ws<bf16_t>(WS_KG) + (size_t)(kvh * NKT + t0) * 4096, F.ws<bf16_t>(WS_VG) + (size_t)(kvh * NKT + t0) * 4096, ntiles, negm, o, ls);
    { const int ln = lane_now(), r2 = ln & 31, h2 = ln >> 5, R = R0 + 32 * wid + r2;
#pragma unroll
      for (int hh = 0; hh < NH; ++hh) store_partial(F, khalf, 12 + qh0 + hh, R, o[hh], ls[hh], r2, h2); }
}

__device__ __forceinline__ void phase_attn(const Frame& F, int l, int rep) {
    if (F.wid >= 4) __builtin_amdgcn_s_setprio(1);
    float gqm = 0.f, gkm = 0.f; { const float* gq = F.in(I_GQ) + 64 * l; const float* gk = F.in(I_GK) + 64 * l; for (int i = 0; i < 64; ++i) { gqm = fmaxf(gqm, fabsf(gq[i])); gkm = fmaxf(gkm, fabsf(gk[i])); } }
    const float bg = fminf(8.f * gqm * gkm * LOG2E * 1.01f, 100.f);
    for (int mp = F.wid; mp < 12; mp += 8) { const float* kp = F.ws<float>(WS_KP) + (size_t)(l * 12 + mp) * 1024; float mx = 0.f;
#pragma unroll
        for (int q = 0; q < 4; ++q) { const f32x4 v = *(const f32x4*)(kp + 256 * q + 4 * F.lane); mx = fmaxf(fmaxf(mx, fmaxf(v[0], v[1])), fmaxf(v[2], v[3])); }
        mx = wave_max(mx); mx = fmaxf(mx, __uint_as_float(__hip_atomic_load(F.ctl + CW_KMAX + 16 * l + mp, __ATOMIC_RELAXED, __HIP_MEMORY_SCOPE_AGENT)));
        if (F.lane == 0) ((LAS float*)(F.lds + LDS_CTL + 1024))[mp] = mx; }
    __syncthreads();
    constexpr int HT = NKT / 2;
    for (int u = F.bid; u < 256; u += F.G) { const int cb = (u & 7) >> 1, rb = ((u >> 3) << 1) | (u & 1), R0 = NCTX + 256 * rb; const int kvh = cb >> 1, kh = cb & 1;
        attn_gqa_unit<2>(F, 3 * kvh, kvh, R0, kh * HT, HT, kh, bg); }
    for (int u = F.bid; u < 768; u += F.G) { const int j = u >> 8, v = u & 255, cb = 4 * j + ((v & 7) >> 1), rb = ((v >> 3) << 1) | (v & 1), R0 = NCTX + 256 * rb; const int head = cb >> 1, kh = cb & 1;
        attn_diff_unit(F, l, head, R0, kh * HT, HT, kh); }
    for (int u = F.bid; u < 256; u += F.G) { const int cb = (u & 7) >> 1, rb = ((u >> 3) << 1) | (u & 1), R0 = NCTX + 256 * rb; const int kvh = cb >> 1, kh = cb & 1;
        attn_gqa_unit<1>(F, 3 * kvh + 2, kvh, R0, kh * HT, HT, kh, bg); }
    for (int u = F.bid; u < 256; u += F.G) { const int l2 = u >> 1, ch = u & 1;
        dft_unit<128, 0>(F, F.ws<bf16_t>(WS_A1F), F.ws<bf16_t>(WS_FT) + (size_t)(l2 * 2 + ch) * 4 * 4096, l2, ch, 0); }
    if (l == 0) {
        for (int u = F.bid; u < 14; u += F.G) {
            if (u < 4) { const int pa = u >> 1, ch = u & 1; dft_unit<256, 2>(F, F.ws<bf16_t>(WS_ACF) + (size_t)pa * 65536, F.ws<bf16_t>(WS_FC) + (size_t)ch * 4 * 8192, 0, ch, pa); }
            else if (u < 10) attn_diff_unit(F, l, u - 4, 0, 0, NCTX / 64, 0);
            else if (u < 12) attn_gqa_unit<2>(F, 3 * (u - 10), u - 10, 0, 0, NCTX / 64, 0, bg);
            else attn_gqa_unit<1>(F, 3 * (u - 12) + 2, u - 12, 0, 0, NCTX / 64, 0, bg);
        }
    }
    __builtin_amdgcn_s_setprio(0);
}
__device__ __forceinline__ void unpack8(const u32x4& w, float (&f)[8]) { f[0] = bflo(w[0]); f[1] = bfhi(w[0]); f[2] = bflo(w[1]); f[3] = bfhi(w[1]); f[4] = bflo(w[2]); f[5] = bfhi(w[2]); f[6] = bflo(w[3]); f[7] = bfhi(w[3]); }
__device__ __forceinline__ void attn_merge(const Frame& F, int l) {
    const int lane = F.lane, un = lane >> 3, dc = lane & 7; const bool act = lane < 48;
    const float* lq1 = F.in(I_LQ1) + 32 * l; const float* lk1 = F.in(I_LK1) + 32 * l; const float* lq2 = F.in(I_LQ2) + 32 * l; const float* lk2 = F.in(I_LK2) + 32 * l;
    float d1 = 0.f, d2 = 0.f; for (int i = 0; i < 32; ++i) { d1 += lq1[i] * lk1[i]; d2 += lq2[i] * lk2[i]; }
    const float lam_init = 0.8f - 0.6f * expf(-0.3f * (float)l); const float lam = expf(d1) - expf(d2) + lam_init, post = 1.f - lam_init;
    float gs[8]; { const float* g = F.in(I_GSUB) + 64 * l + 8 * dc; for (int j = 0; j < 8; ++j) gs[j] = g[j]; }
    const bf16_t* part = F.ws<bf16_t>(WS_PART); const float* pl = F.ws<float>(WS_PL); bf16_t* mix = F.ws<bf16_t>(WS_MIX);
    const int Rbeg = l == 0 ? 0 : NCTX; const int u6 = act ? un : 0;
    for (int R = Rbeg + F.bid * 8 + F.wid; R < NT; R += F.G * 8) {
        const bool two = R >= NCTX; bf16_t* mr = mix + (size_t)R * MIXK;
        const bf16_t* ra = part + (size_t)R * 2 * PREC; const bf16_t* rb = ra + PREC; const float* la = pl + (size_t)R * 2 * N_PSLOT; const float* lb = la + N_PSLOT;
        { const u32x4 a0 = *(const u32x4*)(ra + (u6 * 8 + dc) * 16), a1 = *(const u32x4*)(ra + (u6 * 8 + dc) * 16 + 8);
          u32x4 b0 = {0u, 0u, 0u, 0u}, b1 = b0; float lb0 = 0.f, lb1 = 0.f;
          if (two) { b0 = *(const u32x4*)(rb + (u6 * 8 + dc) * 16); b1 = *(const u32x4*)(rb + (u6 * 8 + dc) * 16 + 8); lb0 = lb[2 * u6]; lb1 = lb[2 * u6 + 1]; }
          const float la0 = la[2 * u6], la1 = la[2 * u6 + 1]; const float i0 = 1.f / (la0 + lb0), i1 = lam / (la1 + lb1);
          float fa0[8], fa1[8], fb0[8], fb1[8], v[8]; unpack8(a0, fa0); unpack8(a1, fa1); unpack8(b0, fb0); unpack8(b1, fb1);
          float ss = 0.f;
#pragma unroll
          for (int j = 0; j < 8; ++j) { v[j] = (la0 * fa0[j] + lb0 * fb0[j]) * i0 - (la1 * fa1[j] + lb1 * fb1[j]) * i1; ss += v[j] * v[j]; }
          ss += shxc<1>(ss); ss += shxc<2>(ss); ss += shxc<4>(ss);
          const float rs = rsqrtf(ss * (1.f / 64.f) + 1e-5f) * post;
          if (act) { u32x4 w = {pk2(v[0] * rs * gs[0], v[1] * rs * gs[1]), pk2(v[2] * rs * gs[2], v[3] * rs * gs[3]), pk2(v[4] * rs * gs[4], v[5] * rs * gs[5]), pk2(v[6] * rs * gs[6], v[7] * rs * gs[7])};
              *(u32x4*)(mr + 512 + 64 * un + 8 * dc) = w; } }
        { const u32x4 a0 = *(const u32x4*)(ra + 768 + u6 * 64 + dc * 8); u32x4 b0 = {0u, 0u, 0u, 0u}; float lbq = 0.f;
          if (two) { b0 = *(const u32x4*)(rb + 768 + u6 * 64 + dc * 8); lbq = lb[12 + u6]; }
          const float laq = la[12 + u6], iq = 1.f / (laq + lbq); float fa[8], fb[8]; unpack8(a0, fa); unpack8(b0, fb);
          if (act) { float o[8];
#pragma unroll
              for (int j = 0; j < 8; ++j) o[j] = (laq * fa[j] + lbq * fb[j]) * iq;
              u32x4 w = {pk2(o[0], o[1]), pk2(o[2], o[3]), pk2(o[4], o[5]), pk2(o[6], o[7])}; *(u32x4*)(mr + 896 + 64 * un + 8 * dc) = w; } }
    }
}
__device__ __forceinline__ void phase_fft2(const Frame& F, int l) {
    for (int u = F.bid; u < 256; u += F.G) { const int k1 = u >> 1, ch = u & 1;
        dft_unit<256, 1>(F, F.ws<bf16_t>(WS_A2F), F.ws<bf16_t>(WS_T2) + (size_t)(k1 * 2 + ch) * 4 * 8192, k1, ch, 0); }
    attn_merge(F, l);
}

__device__ __forceinline__ void phase_router(const Frame& F, int l) {
    LAS float* wl = (LAS float*)F.lds;
    LAS unsigned* hist = (LAS unsigned*)(F.lds + 131072);
    LAS unsigned* recs = hist + 64;
    const int lane = F.lane, wid = F.wid, t = F.tid;
    const float* wr = F.in(I_WR) + (size_t)l * 1024 * 32;
    __syncthreads();
    for (int i = t; i < 8192; i += 512) { const int k = i >> 3, c = i & 7; const f32x4 v = *(const f32x4*)(wr + k * 32 + 4 * c); *(LAS f32x4*)(wl + k * 32 + 4 * (c ^ ((k >> 2) & 7))) = v; }
    if (t < 64) hist[t] = 0u;
    __syncthreads();
    const int Rbeg = l == 0 ? 0 : NCTX, ntok = NT - Rbeg, per = (ntok + F.G - 1) / F.G;
    const int r0 = Rbeg + F.bid * per, r1 = min(r0 + per, NT);
    const float* mod = F.ws<float>(WS_MOD) + (size_t)l * 2 * 6144; const float* g2 = F.in(I_GN2) + 1024 * l; const float* br = F.in(I_BR) + 32 * l;
    const float* xs = F.ws<float>(WS_XS); bf16_t* hb = F.ws<bf16_t>(WS_HB);
    unsigned* slot = F.ws<unsigned>(WS_SLOT); float* gate = F.ws<float>(WS_GATE);
    for (int R = r0 + wid; R < r1; R += 8) {
        const float* m = mod + (R < NCTX ? 6144 : 0);
        f32x4 x[4], hv[4]; load_row(xs + (size_t)R * DM, lane, x); const float rstd = row_rstd(x, 1e-6f);
        mod_store_bf16(x, rstd, g2, m + 3072, m + 4096, hb + (size_t)R * DM, lane, &hv);
        float acc[32];
#pragma unroll
        for (int e = 0; e < 32; ++e) acc[e] = 0.f;
#pragma unroll
        for (int q = 0; q < 4; ++q)
#pragma unroll
            for (int i = 0; i < 4; ++i) { const int k = 256 * q + 4 * lane + i; const float hx = hv[q][i]; const int sw = (k >> 2) & 7;
#pragma unroll
                for (int c = 0; c < 8; ++c) { const f32x4 w = *(LAS const f32x4*)(wl + k * 32 + 4 * (c ^ sw));
                    acc[4 * c] += hx * w[0]; acc[4 * c + 1] += hx * w[1]; acc[4 * c + 2] += hx * w[2]; acc[4 * c + 3] += hx * w[3]; } }
        float a16[16], a8[8], a4[4], a2[2], a1;
        { const bool b = lane & 32;
#pragma unroll
          for (int j = 0; j < 16; ++j) { const float keep = b ? acc[16 + j] : acc[j], send = b ? acc[j] : acc[16 + j]; a16[j] = keep + partner32(send, b); } }
        { const bool b = lane & 16;
#pragma unroll
          for (int j = 0; j < 8; ++j) { const float keep = b ? a16[8 + j] : a16[j], send = b ? a16[j] : a16[8 + j]; a8[j] = keep + shxc<16>(send); } }
        { const bool b = lane & 8;
#pragma unroll
          for (int j = 0; j < 4; ++j) { const float keep = b ? a8[4 + j] : a8[j], send = b ? a8[j] : a8[4 + j]; a4[j] = keep + shxc<8>(send); } }
        { const bool b = lane & 4;
#pragma unroll
          for (int j = 0; j < 2; ++j) { const float keep = b ? a4[2 + j] : a4[j], send = b ? a4[j] : a4[2 + j]; a2[j] = keep + shxc<4>(send); } }
        { const bool b = lane & 2; const float keep = b ? a2[1] : a2[0], send = b ? a2[0] : a2[1]; a1 = keep + shxc<2>(send); }
        a1 += shxc<1>(a1);
        const int e = lane >> 1; float v = a1 + br[e];
        float tv[4]; int te[4];
#pragma unroll
        for (int kk = 0; kk < 4; ++kk) { const float mx = wave_max(v); const unsigned long long bal = __ballot(v == mx); const int ln = __ffsll((long long)bal) - 1; te[kk] = ln >> 1; tv[kk] = mx; if (e == te[kk]) v = -INFINITY; }
        const float e1 = __expf(tv[1] - tv[0]), e2 = __expf(tv[2] - tv[0]), e3 = __expf(tv[3] - tv[0]); const float inv = 1.f / (1.f + e1 + e2 + e3);
        if (lane < 4) { const int ee = lane == 0 ? te[0] : lane == 1 ? te[1] : lane == 2 ? te[2] : te[3]; const float gg = (lane == 0 ? 1.f : lane == 1 ? e1 : lane == 2 ? e2 : e3) * inv;
            const unsigned lr = atomicAdd((unsigned*)(hist + ee), 1u);
            const int ti = R - r0; recs[ti * 4 + lane] = ((unsigned)ee << 24) | lr; gate[(size_t)R * 4 + lane] = gg; }
    }
    __syncthreads();
    if (t < 32) { const unsigned c = hist[t]; hist[32 + t] = c ? xb_add(F.ctl + CW_CNT + 64 * l + t, c) : 0u; }
    __syncthreads();
    unsigned* list = F.ws<unsigned>(WS_LIST);
    for (int i = t; i < (r1 - r0) * 4; i += 512) { const unsigned rec = recs[i]; const unsigned ee = rec >> 24, rk = (rec & 0xffffffu) + hist[32 + ee]; const int R = r0 + (i >> 2);
        slot[(size_t)R * 4 + (i & 3)] = (ee << 24) | rk; list[(size_t)ee * NT + rk] = (unsigned)R; }
    __syncthreads();
}

__device__ __forceinline__ void phase_combine(const Frame& F, int l) {
    const int lane = F.lane; const float* mod = F.ws<float>(WS_MOD) + (size_t)l * 2 * 6144; const float* modn = F.ws<float>(WS_MOD) + (size_t)(l + 1) * 2 * 6144;
    float* xs = F.ws<float>(WS_XS); const bf16_t* yb = F.ws<bf16_t>(WS_YB); const unsigned* slot = F.ws<unsigned>(WS_SLOT); const float* gate = F.ws<float>(WS_GATE); bf16_t* hb = F.ws<bf16_t>(WS_HB);
    int offs = 0;
    { const int ce = lane < NEXP ? (int)__hip_atomic_load(F.ctl + CW_CNT + 64 * l + lane, __ATOMIC_RELAXED, __HIP_MEMORY_SCOPE_AGENT) : 0;
      int inc = ce;
#pragma unroll
      for (int d = 1; d < 32; d <<= 1) { const int up = __builtin_amdgcn_ds_bpermute(((lane - d) & 63) << 2, inc); if (lane >= d) inc += up; }
      offs = inc - ce; }
    const int Rbeg = l == 0 ? 0 : NCTX; float* outb = F.outp(); const float* gn1 = F.in(I_GN1) + 1024; const float* gf = F.in(I_GFIN);
    for (int R = Rbeg + F.bid * 8 + F.wid; R < NT; R += F.G * 8) {
        const float* m = mod + (R < NCTX ? 6144 : 0);
        f32x4 x[4], a[4]; load_row(xs + (size_t)R * DM, lane, x);
#pragma unroll
        for (int q = 0; q < 4; ++q) a[q] = (f32x4){0.f, 0.f, 0.f, 0.f};
#pragma unroll
        for (int s = 0; s < 4; ++s) { const unsigned rec = slot[(size_t)R * 4 + s]; const float g = gate[(size_t)R * 4 + s]; const int pos = __builtin_amdgcn_ds_bpermute((int)((rec >> 24) << 2), offs) + (int)(rec & 0xffffffu);
            const bf16_t* yr = yb + (size_t)pos * DM;
#pragma unroll
            for (int q = 0; q < 4; ++q) { const u32x2 w = *(const u32x2*)(yr + 256 * q + 4 * lane); a[q][0] += g * bflo(w[0]); a[q][1] += g * bfhi(w[0]); a[q][2] += g * bflo(w[1]); a[q][3] += g * bfhi(w[1]); } }
#pragma unroll
        for (int q = 0; q < 4; ++q) { const f32x4 gt = *(const f32x4*)(m + 5120 + 256 * q + 4 * lane);
#pragma unroll
            for (int i = 0; i < 4; ++i) x[q][i] += gt[i] * a[q][i]; }
        const float rstd = row_rstd(x, 1e-6f);
        if (l == 0) {
#pragma unroll
            for (int q = 0; q < 4; ++q) *(f32x4*)(xs + (size_t)R * DM + 256 * q + 4 * lane) = x[q];
            const float* mn = modn + (R < NCTX ? 6144 : 0);
            mod_store_bf16(x, rstd, gn1, mn, mn + 1024, hb + (size_t)R * DM, lane);
        } else {
            float* orow = outb + (size_t)(R - NCTX) * DM;
#pragma unroll
            for (int q = 0; q < 4; ++q) { const f32x4 gv = *(const f32x4*)(gf + 256 * q + 4 * lane); f32x4 o;
#pragma unroll
                for (int i = 0; i < 4; ++i) o[i] = x[q][i] * rstd * gv[i];
                *(f32x4*)(orow + 256 * q + 4 * lane) = o; }
        }
    }
}

__device__ __forceinline__ int opaque_i32(int v) { asm volatile("" : "+s"(v)); return __builtin_amdgcn_readfirstlane(v); }
__device__ __forceinline__ unsigned long long opaque_u64(unsigned long long w) { int lo = (int)(unsigned)w, hi = (int)(unsigned)(w >> 32); lo = opaque_i32(lo); hi = opaque_i32(hi);
    return ((unsigned long long)(unsigned)hi << 32) | (unsigned)lo; }
__device__ __forceinline__ Frame fresh(const Frame& F) { Frame G = F;
    G.wsb = (unsigned char*)opaque_u64((unsigned long long)F.wsb); G.ctl = (unsigned*)opaque_u64((unsigned long long)F.ctl);
    G.pp = (const __attribute__((address_space(4))) Params*)opaque_u64((unsigned long long)F.pp);
    G.wid = opaque_i32(F.wid); G.bid = opaque_i32(F.bid); G.G = opaque_i32(F.G);
    G.lane = lane_now(); G.tid = G.wid * 64 + G.lane; return G; }
constexpr int N_PHASES = 18;
__global__ void __launch_bounds__(NTHREADS, 2) mk_fwd(Params P, int ph_lo, int ph_hi, int probe) {
    extern __shared__ __attribute__((aligned(16))) unsigned char smem_raw[];
    Frame F; F.pp = (const __attribute__((address_space(4))) Params*)__builtin_amdgcn_kernarg_segment_ptr(); F.wsb = P.ws; F.lds = (LAS char*)smem_raw; F.tid = threadIdx.x; F.lane = F.tid & 63; F.wid = __builtin_amdgcn_readfirstlane(F.tid >> 6); F.G = gridDim.x; F.bid = blockIdx.x;
    F.ctl = (unsigned*)(P.ws + WS_CTL);
    LAS unsigned* bw = (LAS unsigned*)(F.lds + LDS_CTL);
    if (F.tid < 4) bw[F.tid] = 0u;
    __syncthreads();
    XcdBarrier bar;
    if (MK_ONE_LAUNCH) bar = xcd_barrier_post(F.ctl + CW_BAR, (volatile LAS unsigned*)bw, F.wid);
#ifndef PHASE_MASK
#define PHASE_MASK 0xFFFFFFFFu
#endif
#if MK_ONE_LAUNCH
#define IN(k) (((PHASE_MASK >> ((k) >= 10 ? (k) - 8 : (k))) & 1u) != 0u)
#else
#define IN(k) (((PHASE_MASK >> ((k) >= 10 ? (k) - 8 : (k))) & 1u) && ph_lo <= (k) && (k) < ph_hi)
#endif
#define SEAM(k) do { if (MK_ONE_LAUNCH && IN(k) && IN((k) + 1)) xcd_barrier(bar); } while (0)
#define RUN(k, code, body) do { if (IN(k)) { const int nr_ = (opaque_i32(probe) == (code)) ? 2 : 1; _Pragma("unroll 1") for (int rep = 0; rep < nr_; ++rep) { body; if (MK_ONE_LAUNCH && rep + 1 < nr_) xcd_barrier(bar); } } SEAM(k); } while (0)
    RUN(0, 100, phase_prologue(fresh(F)));
    RUN(1, 101, phase_norm0(fresh(F)));
#pragma unroll 1
    for (int l = 0; l < 2; ++l) {
        const int b = 2 + 8 * l;
        RUN(b + 0, 0, phase_inproj(fresh(F), l));
        RUN(b + 1, 1, phase_attn(fresh(F), l, rep));
        RUN(b + 2, 2, phase_fft2(fresh(F), l));
        RUN(b + 3, 3 + 10 * l, phase_outproj(fresh(F), l));
        RUN(b + 4, 104, phase_router(fresh(F), l));
        RUN(b + 5, 5, phase_gateup(fresh(F), l));
        RUN(b + 6, 6, phase_down(fresh(F), l));
        RUN(b + 7, 17 - 10 * l, phase_combine(fresh(F), l));
    }
}

extern "C" void kernel_launch(void* const* d_in, const int* in_sizes, int n_in, void* d_out, int out_size, void* d_ws, size_t ws_size, hipStream_t stream) {
    static int grid = 0;
    if (!grid) {
        int dev = 0, cus = 0, per_cu = 0;
        hipGetDevice(&dev);
        hipDeviceGetAttribute(&cus, hipDeviceAttributeMultiprocessorCount, dev);
        hipFuncSetAttribute((const void*)mk_fwd, hipFuncAttributeMaxDynamicSharedMemorySize, LDS_BYTES);
        hipOccupancyMaxActiveBlocksPerMultiprocessor(&per_cu, (const void*)mk_fwd, NTHREADS, LDS_BYTES);
        if (per_cu < 1) { fprintf(stderr, "mk_fwd: occupancy query says %d blocks per CU\n", per_cu); per_cu = 1; }
        grid = cus * 1;
        if (ws_size < WS_END) fprintf(stderr, "mk_fwd: workspace too small (%zu < %zu)\n", ws_size, (size_t)WS_END);
    }
    hipMemsetAsync(d_ws, 0, CTL_BYTES, stream);
    Params p{};
    for (int i = 0; i < 25; ++i) p.in[i] = (const float*)d_in[i];
    p.out = (float*)d_out; p.ws = (unsigned char*)d_ws;
#if MK_ONE_LAUNCH
    hipLaunchKernelGGL(mk_fwd, dim3(grid), dim3(NTHREADS), LDS_BYTES, stream, p, 0, N_PHASES, MK_PROBE);
#else
    for (int k = 0; k < N_PHASES; ++k) hipLaunchKernelGGL(mk_fwd, dim3(grid), dim3(NTHREADS), LDS_BYTES, stream, p, k, k + 1, -1);
#endif
}
```

```cpp
#include <hip/hip_runtime.h>
#include <cstdio>
#include <cstdint>

#ifndef MK_PROBE
#define MK_PROBE -1
#endif
#ifndef MK_ONE_LAUNCH
#define MK_ONE_LAUNCH 1
#endif

#define LAS __attribute__((address_space(3)))
typedef unsigned short bf16_t;
typedef short bf16x8 __attribute__((ext_vector_type(8)));
typedef short s16x4 __attribute__((ext_vector_type(4)));
typedef float f32x16 __attribute__((ext_vector_type(16)));
typedef float f32x4 __attribute__((ext_vector_type(4)));
typedef float f32x2 __attribute__((ext_vector_type(2)));
typedef unsigned u32x4 __attribute__((ext_vector_type(4)));
typedef unsigned u32x2 __attribute__((ext_vector_type(2)));
typedef __bf16 bf16x2_t __attribute__((ext_vector_type(2)));
typedef short v4i16_t __attribute__((ext_vector_type(4)));

constexpr int DM = 1024, LSEQ = 16384, NCTX = 256, NT = LSEQ + NCTX, INW = 2048, NEXP = 32, FFD = 1024, MIXK = 1280;
constexpr int NKT = NT / 64;
constexpr int NQB = NT / 32;
constexpr float LOG2E = 1.4426950408889634f;
constexpr int NTHREADS = 512;
constexpr int LDS_BYTES = 155648;
constexpr int LDS_CTL = 151552;

constexpr size_t al256(size_t x) { return (x + 255) & ~(size_t)255; }
constexpr size_t WS_CTL = 0, CTL_BYTES = 1u << 20;
constexpr size_t WS_MOD = CTL_BYTES;
constexpr size_t WS_ROPE = WS_MOD + 131072;
constexpr size_t WS_TW = WS_ROPE + 65536;
constexpr size_t WS_A1F = WS_TW + 131072;
constexpr size_t WS_A2F = WS_A1F + 65536;
constexpr size_t WS_ACF = WS_A2F + 131072;
constexpr size_t WS_WIN = WS_ACF + 262144;
constexpr size_t WS_WOUT = WS_WIN + (size_t)2 * INW * DM * 2;
constexpr size_t WS_WGU = WS_WOUT + (size_t)2 * DM * MIXK * 2;
constexpr size_t WS_WDN = WS_WGU + (size_t)2 * NEXP * 2048 * DM * 2;
constexpr size_t WS_HB = WS_WDN + (size_t)2 * NEXP * DM * FFD * 2;
constexpr size_t WS_QD = WS_HB + (size_t)NT * DM * 2;
constexpr size_t WS_KD = WS_QD + (size_t)6 * NQB * 2048 * 2;
constexpr size_t WS_VD = WS_KD + (size_t)6 * NKT * 4096 * 2;
constexpr size_t WS_QG = WS_VD + (size_t)6 * NKT * 4096 * 2;
constexpr size_t WS_KG = WS_QG + (size_t)6 * NQB * 2048 * 2;
constexpr size_t WS_VG = WS_KG + (size_t)2 * NKT * 4096 * 2;
constexpr size_t WS_FT = WS_VG + (size_t)2 * NKT * 4096 * 2;
constexpr size_t WS_FC = WS_FT + (size_t)128 * 2 * 4 * 4096 * 2;
constexpr size_t WS_T2 = WS_FC + (size_t)2 * 4 * 8192 * 2;
constexpr size_t WS_MIX = WS_T2 + (size_t)128 * 2 * 4 * 8192 * 2;
constexpr size_t WS_XS = WS_MIX + (size_t)NT * MIXK * 2;
constexpr size_t WS_LIST = WS_XS + (size_t)NT * DM * 4;
constexpr size_t WS_SLOT = WS_LIST + (size_t)NEXP * NT * 4;
constexpr size_t WS_GATE = WS_SLOT + (size_t)NT * 16;
constexpr size_t WS_ACT = WS_GATE + (size_t)NT * 16;
constexpr size_t WS_YB = WS_ACT + (size_t)NT * 4 * FFD * 2;
constexpr size_t WS_PART = WS_YB + (size_t)NT * 4 * DM * 2;
constexpr size_t WS_PL = WS_PART + (size_t)36 * NT * 64 * 2;
constexpr size_t WS_KP = WS_PL + (size_t)36 * NT * 4;
constexpr size_t WS_END = WS_KP + (size_t)2 * 12 * 1024 * 4;

constexpr int CW_BAR = 4096;
constexpr int CW_CNT = 8192;
constexpr int CW_KMAX = 8320;
constexpr int CW_QH = 8448;

constexpr int RD_RC = 0, RD_RS = 2048, RD_CC = 4096, RD_CS = 4608, RG_RC = 5120, RG_RS = 9216, RG_CC = 13312, RG_CS = 14336, ROPE_N = 15360;

struct Params { const float* in[25]; float* out; unsigned char* ws; };
enum { I_X = 0, I_C, I_CTX, I_CCTX, I_WMOD, I_BMOD, I_GN1, I_GN2, I_WIN, I_WOUT, I_WFNET, I_LQ1, I_LK1, I_LQ2, I_LK2, I_GSUB, I_GQ, I_GK, I_WR, I_BR, I_WGU, I_BGU, I_WDN, I_BDN, I_GFIN };

__device__ __forceinline__ unsigned pk2(float lo, float hi) { f32x2 v = {lo, hi}; bf16x2_t b = __builtin_convertvector(v, bf16x2_t); return __builtin_bit_cast(unsigned, b); }
__device__ __forceinline__ float bf2f(unsigned short u) { return __builtin_bit_cast(float, (unsigned)u << 16); }
__device__ __forceinline__ float bflo(unsigned u) { return __builtin_bit_cast(float, u << 16); }
__device__ __forceinline__ float bfhi(unsigned u) { return __builtin_bit_cast(float, u & 0xffff0000u); }
#define WAITV(n) asm volatile("s_waitcnt vmcnt(" #n ")" ::: "memory")
#define BAR_SYNC() do { asm volatile("s_waitcnt lgkmcnt(0)" ::: "memory"); __builtin_amdgcn_s_barrier(); asm volatile("" ::: "memory"); } while (0)
__device__ __forceinline__ void dma16(const void* g, LAS void* l) { __builtin_amdgcn_global_load_lds((const unsigned*)g, (LAS unsigned*)l, 16, 0, 0); }
__device__ __forceinline__ void glds16(const void* gsrc, unsigned lds_dst) { unsigned keep;
    asm volatile("s_mov_b32 %0, m0\n\ts_mov_b32 m0, %2\n\ts_nop 0\n\tglobal_load_lds_dwordx4 %1, off\n\ts_mov_b32 m0, %0" : "=&s"(keep) : "v"(gsrc), "s"(lds_dst) : "memory"); }
__device__ __forceinline__ s16x4 vtr(LAS const char* p) { return __builtin_bit_cast(s16x4, __builtin_amdgcn_ds_read_tr16_b64_v4i16((LAS v4i16_t*)p)); }
__device__ __forceinline__ int lane_now() { unsigned z = 0u; asm volatile("" : "+v"(z)); return (int)__builtin_amdgcn_mbcnt_hi(~0u, __builtin_amdgcn_mbcnt_lo(~0u, z)); }
template <int M> __device__ __forceinline__ float shxc(float v) { return __builtin_bit_cast(float, __builtin_amdgcn_ds_bpermute((lane_now() ^ M) << 2, __builtin_bit_cast(int, v))); }
__device__ __forceinline__ float add32(float v) { return v + shxc<32>(v); }
__device__ __forceinline__ float max32(float v) { return fmaxf(v, shxc<32>(v)); }
__device__ __forceinline__ float partner32(float v, bool upper) { return shxc<32>(v); }
__device__ __forceinline__ float wave_sum(float v) { v = add32(v); v += shxc<16>(v); v += shxc<8>(v); v += shxc<4>(v); v += shxc<2>(v); v += shxc<1>(v); return v; }
__device__ __forceinline__ float wave_max(float v) { v = max32(v); v = fmaxf(v, shxc<16>(v)); v = fmaxf(v, shxc<8>(v)); v = fmaxf(v, shxc<4>(v)); v = fmaxf(v, shxc<2>(v)); v = fmaxf(v, shxc<1>(v)); return v; }
__device__ __forceinline__ bf16x8 pack8(float a0, float a1, float a2, float a3, float a4, float a5, float a6, float a7) {
    u32x4 w = {pk2(a0, a1), pk2(a2, a3), pk2(a4, a5), pk2(a6, a7)}; return __builtin_bit_cast(bf16x8, w); }
#define MFMA(a, b, c) __builtin_amdgcn_mfma_f32_32x32x16_bf16((a), (b), (c), 0, 0, 0)

#define XB_TMO      128
#define XB_XCNT(j)  (256  + 64 * (j))
#define XB_XSUB(j)  (1280 + 64 * (j))
#define XB_XGEN(j)  (2304 + 64 * (j))
#define XB_TOP      3328
#define XB_TOPGEN   3392
#define XCD_BAR_WORDS 3456
#define XB_SPIN_CAP (1u << 22)
__device__ __forceinline__ unsigned xb_ld(unsigned* p)              { return __hip_atomic_load(p, __ATOMIC_RELAXED, __HIP_MEMORY_SCOPE_AGENT); }
__device__ __forceinline__ unsigned xb_add(unsigned* p, unsigned v) { return __hip_atomic_fetch_add(p, v, __ATOMIC_RELAXED, __HIP_MEMORY_SCOPE_AGENT); }
__device__ __forceinline__ unsigned xb_xcc_id() { return (unsigned)__builtin_amdgcn_s_getreg((3 << 11) | 20) & 0xFu; }
#define XB_SPIN(cond, bar) do { unsigned _sp = 0; while (cond) { __builtin_amdgcn_s_sleep(1); \
    if ((++_sp & 255u) == 0u) { if (xb_ld(&(bar)[XB_TMO])) break; if (_sp > XB_SPIN_CAP) { atomicAdd(&(bar)[XB_TMO], 1u); break; } } } } while (0)
struct XcdBarrier { unsigned* bar; unsigned x; volatile LAS unsigned* st; int wid; };
__device__ __forceinline__ bool xb_leader(int wid) { unsigned z = 0u; asm volatile("" : "+v"(z)); return wid == 0 && __builtin_amdgcn_mbcnt_hi(~0u, __builtin_amdgcn_mbcnt_lo(~0u, z)) == 0u; }
__device__ __forceinline__ XcdBarrier xcd_barrier_post(unsigned* bar, volatile LAS unsigned* st, int wid) {
    XcdBarrier b; b.bar = bar; b.x = xb_xcc_id(); b.st = st; b.wid = wid;
    if (xb_leader(wid)) (void)xb_add(&bar[XB_XCNT(b.x)], 1u);
    return b;
}
__device__ __forceinline__ void xcd_barrier_complete(unsigned* bar, unsigned x, unsigned& nloc, unsigned& nx) {
    const unsigned G = gridDim.x * gridDim.y * gridDim.z;
    unsigned sum, cnt, mine, sp = 0u;
    for (;;) {
        sum = 0u; cnt = 0u; mine = 0u;
#pragma unroll
        for (unsigned j = 0; j < 16; ++j) { const unsigned c = xb_ld(&bar[XB_XCNT(j)]); sum += c; cnt += (c > 0u) ? 1u : 0u; }
        mine = xb_ld(&bar[XB_XCNT(x)]);
        if (sum == G) break;
        __builtin_amdgcn_s_sleep(1);
        if ((++sp & 255u) == 0u) { if (xb_ld(&bar[XB_TMO])) break; if (sp > XB_SPIN_CAP) { atomicAdd(&bar[XB_TMO], 1u); break; } }
    }
    nloc = mine > 0u ? mine : 1u; nx = cnt > 0u ? cnt : 1u;
}
__device__ __forceinline__ void xcd_barrier(const XcdBarrier& b) {
    asm volatile("s_waitcnt vmcnt(0)" ::: "memory");
    __syncthreads();
    if (xb_leader(b.wid)) {
        unsigned* bar = b.bar;
        __builtin_amdgcn_s_waitcnt(0);
        unsigned nloc = b.st[0], nx = b.st[1];
        if (nloc == 0u) { xcd_barrier_complete(bar, b.x, nloc, nx); b.st[0] = nloc; b.st[1] = nx; }
        const unsigned old = xb_add(&bar[XB_XSUB(b.x)], 1u);
        const unsigned gen = old / nloc;
        if (old + 1u == (gen + 1u) * nloc) {
            __builtin_amdgcn_fence(__ATOMIC_RELEASE, "agent");
            asm volatile("s_waitcnt vmcnt(0)" ::: "memory");
            const unsigned og = xb_add(&bar[XB_TOP], 1u);
            const unsigned tg = og / nx;
            if (og + 1u == (tg + 1u) * nx) xb_add(&bar[XB_TOPGEN], 1u);
            else XB_SPIN(xb_ld(&bar[XB_TOPGEN]) == tg, bar);
            __builtin_amdgcn_fence(__ATOMIC_ACQUIRE, "agent");
            xb_add(&bar[XB_XGEN(b.x)], 1u);
            asm volatile("s_waitcnt vmcnt(0)" ::: "memory");
        } else {
            XB_SPIN(xb_ld(&bar[XB_XGEN(b.x)]) == gen, bar);
            __builtin_amdgcn_fence(__ATOMIC_ACQUIRE, "agent");
            asm volatile("s_waitcnt vmcnt(0)" ::: "memory");
        }
    }
    __syncthreads();
}

struct Frame {
    const __attribute__((address_space(4))) Params* pp; unsigned char* wsb; LAS char* lds; int tid, lane, wid, G, bid;
    unsigned* ctl;
    __device__ __forceinline__ const float* in(int i) const { return pp->in[i]; }
    __device__ __forceinline__ float* outp() const { return pp->out; }
    template <class T> __device__ __forceinline__ T* ws(size_t off) const { return (T*)(wsb + off); }
};

template <class RowMap>
__device__ __forceinline__ void transpose_tile(const Frame& F, const float* __restrict__ src, int ldn, int k0, int n0, bf16_t* dst, int ldk, int kdst0, const RowMap& rm) {
    LAS float* tile = (LAS float*)F.lds;
    const int t = F.tid;
    f32x4 v[8];
#pragma unroll
    for (int i = 0; i < 8; ++i) { const int idx = t + 512 * i, k = idx >> 6, c4 = idx & 63; v[i] = *(const f32x4*)(src + (size_t)(k0 + k) * ldn + n0 + 4 * c4); }
#pragma unroll
    for (int i = 0; i < 8; ++i) { const int idx = t + 512 * i, k = idx >> 6, c4 = idx & 63; *(LAS f32x4*)(tile + k * 260 + 4 * c4) = v[i]; }
    __syncthreads();
    { const int n = t >> 1, kh = t & 1; bf16_t* d = dst + (size_t)rm(n0 + n) * ldk + kdst0 + 32 * kh;
#pragma unroll
      for (int q = 0; q < 4; ++q) { float a[8];
#pragma unroll
          for (int j = 0; j < 8; ++j) a[j] = tile[(32 * kh + 8 * q + j) * 260 + n];
          u32x4 w = {pk2(a[0], a[1]), pk2(a[2], a[3]), pk2(a[4], a[5]), pk2(a[6], a[7])}; *(u32x4*)(d + 8 * q) = w; } }
    __syncthreads();
}
struct RowId { __device__ __forceinline__ int operator()(int n) const { return n; } };
struct RowGU { __device__ __forceinline__ int operator()(int n) const { const int ri = n >> 10, j = n & 1023; return 64 * (j >> 5) + 32 * ri + (j & 31); } };

constexpr int P0_GEMV = 192, P0_FOLD = 128, P0_TAB = 16;
constexpr int P0_TWIN = 2 * 16 * 8, P0_TWOUT = 2 * 12 * 4, P0_TWGU = 2 * 32 * 16 * 8, P0_TWDN = 2 * 32 * 16 * 4;
constexpr int P0_ITEMS = P0_GEMV + P0_FOLD + P0_TAB + P0_TWIN + P0_TWOUT + P0_TWGU + P0_TWDN;

__device__ __forceinline__ void p0_gemv(const Frame& F, int item) {
    const int l = item / 96, cc = item % 96, t = F.tid, lane = F.lane, w = F.wid;
    LAS float* sc = (LAS float*)F.lds;
    LAS float* red = sc + 2048;
    const float* c = F.in(I_C); const float* cx = F.in(I_CCTX);
#pragma unroll
    for (int i = 0; i < 2; ++i) { const int k = t + 512 * i; const float a = c[k], b = cx[k]; sc[k] = a / (1.f + __expf(-a)); sc[1024 + k] = b / (1.f + __expf(-b)); }
    __syncthreads();
    const int col = 64 * cc + lane; const float* wm = F.in(I_WMOD) + (size_t)l * 1024 * 6144 + col;
    float a1 = 0.f, a2 = 0.f;
#pragma unroll 8
    for (int k = 128 * w; k < 128 * w + 128; ++k) { const float wv = wm[(size_t)k * 6144]; a1 += sc[k] * wv; a2 += sc[1024 + k] * wv; }
    red[w * 64 + lane] = a1; red[512 + w * 64 + lane] = a2;
    __syncthreads();
    if (w == 0) { float s1 = 0.f, s2 = 0.f;
#pragma unroll
        for (int j = 0; j < 8; ++j) { s1 += red[j * 64 + lane]; s2 += red[512 + j * 64 + lane]; }
        const float b = F.in(I_BMOD)[l * 6144 + col]; float* mod = F.ws<float>(WS_MOD) + (size_t)l * 2 * 6144;
        mod[col] = s1 + b; mod[6144 + col] = s2 + b; }
    __syncthreads();
}
__device__ __forceinline__ void p0_fold(const Frame& F, int item) {
    const int nch = item & 7, g = (item >> 3) & 3, ri = (item >> 5) & 1, l = item >> 6, t = F.tid;
    LAS float* Mx = (LAS float*)F.lds;
    LAS float* wf = Mx + 64 * 65;
    const float* wfn = F.in(I_WFNET) + (size_t)(l * 4 + g) * 4096;
    for (int i = t; i < 4096; i += 512) wf[(i >> 6) * 65 + (i & 63)] = wfn[i];
    __syncthreads();
    for (int i = t; i < 4096; i += 512) { const int c = i >> 6, e = i & 63; float s = 0.f;
        for (int m = 0; m < 64; ++m) { float sn, cs; sincospif(2.f * (float)((m * c) & 63) / 64.f, &sn, &cs); s += (ri ? sn : cs) * wf[m * 65 + e]; }
        Mx[c * 65 + e] = s; }
    __syncthreads();
    const float* wo = F.in(I_WOUT) + (size_t)l * 1024 * 1024 + (size_t)(64 * g) * 1024;
    bf16_t* dst = F.ws<bf16_t>(WS_WOUT) + (size_t)l * DM * MIXK;
    { const int n = nch * 128 + (t & 127), c0 = (t >> 7) * 16; float acc[16];
#pragma unroll
      for (int j = 0; j < 16; ++j) acc[j] = 0.f;
      for (int e = 0; e < 64; ++e) { const float wv = wo[(size_t)e * 1024 + n];
#pragma unroll
          for (int j = 0; j < 16; ++j) acc[j] += Mx[(c0 + j) * 65 + e] * wv; }
      u32x4 w0 = {pk2(acc[0], acc[1]), pk2(acc[2], acc[3]), pk2(acc[4], acc[5]), pk2(acc[6], acc[7])};
      u32x4 w1 = {pk2(acc[8], acc[9]), pk2(acc[10], acc[11]), pk2(acc[12], acc[13]), pk2(acc[14], acc[15])};
      bf16_t* d = dst + (size_t)n * MIXK + 256 * ri + 64 * g + c0; *(u32x4*)d = w0; *(u32x4*)(d + 8) = w1; }
    __syncthreads();
}
__device__ __forceinline__ void p0_tables(const Frame& F, int item) {
    constexpr int N0 = ROPE_N, N1 = N0 + 16384, N2 = N1 + 32768, N3 = N2 + 65536, N4 = N3 + 131072;
    float* rope = F.ws<float>(WS_ROPE); f32x2* tw = F.ws<f32x2>(WS_TW);
    bf16_t* a1 = F.ws<bf16_t>(WS_A1F); bf16_t* a2 = F.ws<bf16_t>(WS_A2F); bf16_t* ac = F.ws<bf16_t>(WS_ACF);
    for (int idx = item * 512 + F.tid; idx < N4; idx += P0_TAB * 512) {
        if (idx < N0) {
            int i = idx; bool isg = false; if (i >= RG_RC) { isg = true; i -= RG_RC; }
            const int n = isg ? 16 : 8, rowsz = 256 * n, colsz = 64 * n;
            int which, pos, fi;
            if (i < rowsz) { which = 0; pos = i / n; fi = i % n; } else if (i < 2 * rowsz) { which = 1; i -= rowsz; pos = i / n; fi = i % n; }
            else if (i < 2 * rowsz + colsz) { which = 2; i -= 2 * rowsz; pos = i / n; fi = i % n; } else { which = 3; i -= 2 * rowsz + colsz; pos = i / n; fi = i % n; }
            const float inv = powf(10000.f, -(float)fi / (float)n); const float ang = (float)pos * inv;
            rope[idx] = (which & 1) ? sinf(ang) : cosf(ang);
        } else if (idx < N1) { const int j = idx - N0; float sn, cs; sincospif(2.f * (float)j / 16384.f, &sn, &cs); tw[j] = (f32x2){cs, sn};
        } else if (idx < N2) { const int e = idx - N1; const int j = e & 7, ln = (e >> 3) & 63, s = (e >> 9) & 7, fb = (e >> 12) & 1, rg = e >> 13;
            const int k1 = 32 * rg + (ln & 31), l1 = 16 * s + 8 * (ln >> 5) + j; float sn, cs; sincospif(2.f * (float)((k1 * l1) & 127) / 128.f, &sn, &cs);
            a1[e] = (bf16_t)(pk2(fb ? -sn : cs, 0.f) & 0xffff);
        } else if (idx < N3) { const int e = idx - N2; const int j = e & 7, ln = (e >> 3) & 63, s = (e >> 9) & 15, fb = (e >> 13) & 1, rg = e >> 14;
            const int k2 = 32 * rg + (ln & 31), kk = 16 * s + 8 * (ln >> 5) + j, l2 = kk >> 1, rip = kk & 1; float sn, cs; sincospif(2.f * (float)((k2 * l2) & 127) / 128.f, &sn, &cs);
            const float v = fb == 0 ? (rip == 0 ? cs : sn) : (rip == 0 ? -sn : cs);
            a2[e] = (bf16_t)(pk2(v, 0.f) & 0xffff);
        } else { const int e = idx - N3; const int j = e & 7, ln = (e >> 3) & 63, s = (e >> 9) & 15, fb = (e >> 13) & 1, rg = (e >> 14) & 3, pa = e >> 16;
            const int k = 128 * pa + 32 * rg + (ln & 31), li = 16 * s + 8 * (ln >> 5) + j; float sn, cs; sincospif(2.f * (float)((k * li) & 255) / 256.f, &sn, &cs);
            ac[e] = (bf16_t)(pk2(fb ? -sn : cs, 0.f) & 0xffff); }
    }
}
struct TrDesc { const float* src; bf16_t* dst; int ldn, k0, n0, ldk, kdst0, gu; };
__device__ __forceinline__ TrDesc tr_desc(const Frame& F, int i) { TrDesc D;
    if (i < P0_TWIN) { const int l = i / 128, r = i % 128, kt = r / 8, nt = r % 8;
        D = TrDesc{F.in(I_WIN) + (size_t)l * DM * INW, F.ws<bf16_t>(WS_WIN) + (size_t)l * INW * DM, INW, 64 * kt, 256 * nt, DM, 64 * kt, 0}; return D; } i -= P0_TWIN;
    if (i < P0_TWOUT) { const int l = i / 48, r = i % 48, kt = r / 4, nt = r % 4;
        D = TrDesc{F.in(I_WOUT) + (size_t)l * DM * DM, F.ws<bf16_t>(WS_WOUT) + (size_t)l * DM * MIXK, DM, 256 + 64 * kt, 256 * nt, MIXK, 512 + 64 * kt, 0}; return D; } i -= P0_TWOUT;
    if (i < P0_TWGU) { const int le = i / 128, r = i % 128, kt = r / 8, nt = r % 8;
        D = TrDesc{F.in(I_WGU) + (size_t)le * DM * 2048, F.ws<bf16_t>(WS_WGU) + (size_t)le * 2048 * DM, 2048, 64 * kt, 256 * nt, DM, 64 * kt, 1}; return D; } i -= P0_TWGU;
    { const int le = i / 64, r = i % 64, kt = r / 4, nt = r % 4;
        D = TrDesc{F.in(I_WDN) + (size_t)le * FFD * DM, F.ws<bf16_t>(WS_WDN) + (size_t)le * DM * FFD, DM, 64 * kt, 256 * nt, FFD, 64 * kt, 0}; return D; }
}
__device__ __forceinline__ void tr_load(const Frame& F, const TrDesc& D, f32x4 (&v)[8]) {
#pragma unroll
    for (int i = 0; i < 8; ++i) { const int idx = F.tid + 512 * i, k = idx >> 6, c4 = idx & 63; v[i] = *(const f32x4*)(D.src + (size_t)(D.k0 + k) * D.ldn + D.n0 + 4 * c4); }
}
__device__ __forceinline__ void tr_finish(const Frame& F, const TrDesc& D, const f32x4 (&v)[8]) {
    LAS float* tile = (LAS float*)F.lds;
    const int t = F.tid;
#pragma unroll
    for (int i = 0; i < 8; ++i) { const int idx = t + 512 * i, k = idx >> 6, c4 = idx & 63; *(LAS f32x4*)(tile + k * 260 + 4 * c4) = v[i]; }
    __syncthreads();
    { const int n = t >> 1, kh = t & 1, nn = D.n0 + n; const int row = D.gu ? RowGU()(nn) : nn; bf16_t* d = D.dst + (size_t)row * D.ldk + D.kdst0 + 32 * kh;
#pragma unroll
      for (int q = 0; q < 4; ++q) { float a[8];
#pragma unroll
          for (int j = 0; j < 8; ++j) a[j] = tile[(32 * kh + 8 * q + j) * 260 + n];
          u32x4 w = {pk2(a[0], a[1]), pk2(a[2], a[3]), pk2(a[4], a[5]), pk2(a[6], a[7])}; *(u32x4*)(d + 8 * q) = w; } }
    __syncthreads();
}
__device__ __forceinline__ void phase_prologue(const Frame& F) {
    LAS unsigned* qw = (LAS unsigned*)(F.lds + LDS_CTL + 64);
    constexpr int P0_HEAD = P0_GEMV + P0_FOLD + P0_TAB;
    unsigned nxt = 0u; if (F.tid == 0) nxt = xb_add(F.ctl + CW_QH + 32, 1u);
    int it;
    for (;;) {
        __syncthreads();
        if (F.tid == 0) *qw = nxt;
        __syncthreads();
        it = (int)*qw; if (it >= P0_HEAD) break;
        if (F.tid == 0) nxt = xb_add(F.ctl + CW_QH + 32, 1u);
        int i = it;
        if (i < P0_GEMV) { p0_gemv(F, i); continue; } i -= P0_GEMV;
        if (i < P0_FOLD) { p0_fold(F, i); continue; } i -= P0_FOLD;
        p0_tables(F, i);
    }
    if (it >= P0_ITEMS) return;
    if (F.tid == 0) nxt = xb_add(F.ctl + CW_QH + 32, 1u);
    TrDesc dc = tr_desc(F, it - P0_HEAD); f32x4 vc[8]; tr_load(F, dc, vc);
    for (;;) {
        __syncthreads();
        if (F.tid == 0) *qw = nxt;
        __syncthreads();
        const int itn = (int)*qw; const bool hn = itn < P0_ITEMS;
        if (hn && F.tid == 0) nxt = xb_add(F.ctl + CW_QH + 32, 1u);
        const TrDesc dn = tr_desc(F, hn ? itn - P0_HEAD : it - P0_HEAD); f32x4 vn[8];
        if (hn) tr_load(F, dn, vn); else {
#pragma unroll
            for (int i = 0; i < 8; ++i) vn[i] = vc[i]; }
        tr_finish(F, dc, vc);
        if (!hn) break;
        dc = dn;
#pragma unroll
        for (int i = 0; i < 8; ++i) vc[i] = vn[i];
    }
}

__device__ __forceinline__ void load_row(const float* row, int lane, f32x4 (&x)[4]) {
#pragma unroll
    for (int q = 0; q < 4; ++q) x[q] = *(const f32x4*)(row + 256 * q + 4 * lane);
}
__device__ __forceinline__ float row_rstd(const f32x4 (&x)[4], float eps) {
    float ss = 0.f;
#pragma unroll
    for (int q = 0; q < 4; ++q) ss += x[q][0] * x[q][0] + x[q][1] * x[q][1] + x[q][2] * x[q][2] + x[q][3] * x[q][3];
    ss = wave_sum(ss); return rsqrtf(ss * (1.f / 1024.f) + eps);
}
__device__ __forceinline__ void mod_store_bf16(const f32x4 (&x)[4], float rstd, const float* g, const float* shift, const float* scale, bf16_t* dst, int lane, f32x4 (*hout)[4] = nullptr) {
#pragma unroll
    for (int q = 0; q < 4; ++q) { const int k = 256 * q + 4 * lane;
        const f32x4 gv = *(const f32x4*)(g + k), sh = *(const f32x4*)(shift + k), sc = *(const f32x4*)(scale + k);
        f32x4 hv;
#pragma unroll
        for (int i = 0; i < 4; ++i) hv[i] = (x[q][i] * rstd * gv[i]) * (1.f + sc[i]) + sh[i];
        u32x2 w = {pk2(hv[0], hv[1]), pk2(hv[2], hv[3])}; *(u32x2*)(dst + k) = w;
        if (hout) (*hout)[q] = hv; }
}
__device__ __forceinline__ void phase_norm0(const Frame& F) {
    const float* mod = F.ws<float>(WS_MOD); bf16_t* hb = F.ws<bf16_t>(WS_HB); const float* g1 = F.in(I_GN1);
    const float* xc = F.in(I_CTX); const float* xl = F.in(I_X);
    for (int R = F.bid * 8 + F.wid; R < NT; R += F.G * 8) {
        const float* row = R < NCTX ? xc + (size_t)R * DM : xl + (size_t)(R - NCTX) * DM;
        const float* m = mod + (R < NCTX ? 6144 : 0);
        f32x4 x[4]; load_row(row, F.lane, x); const float rstd = row_rstd(x, 1e-6f);
        mod_store_bf16(x, rstd, g1, m, m + 1024, hb + (size_t)R * DM, F.lane);
    }
}

#define MFMA16(a, b, c) __builtin_amdgcn_mfma_f32_16x16x32_bf16((a), (b), (c), 0, 0, 0)
__device__ __forceinline__ int lds_byte(int r, int c) { const int st = (r >> 4) * 2 + (c >> 5), rr = r & 15, cc = c & 31, ob = rr * 64 + cc * 2; return st * 1024 + (ob ^ (((ob >> 9) & 1) << 5)); }
__device__ __forceinline__ void stage_rc(int b, int& R, int& C) { const int st = b / 1024, sb = b % 1024, swz = sb ^ (((sb >> 9) & 1) << 5); R = (st >> 1) * 16 + swz / 64; C = (st & 1) * 32 + (swz % 64) / 2; }
struct EpiC { f32x4 c[4]; };
struct EpiT { f32x4 t[4]; };
template <class XRow, class Epi>
__device__ __forceinline__ void gemm8(const Frame& F, const bf16_t* __restrict__ A, int K, int brow, const XRow& xrow, const Epi& epi) {
    constexpr int HTB = 16384;
    LAS char* shm = F.lds;
    const int tz = F.tid, wid = F.wid, lane = tz & 63, wr = wid >> 2, wc = wid & 3, fr = lane & 15, fq = lane >> 4;
    unsigned aoff[2]; const bf16_t* xp[2][2];
#pragma unroll
    for (int i = 0; i < 2; ++i) { int r, c; stage_rc(tz * 16 + i * 8192, r, c); aoff[i] = (unsigned)(r * K + c); xp[0][i] = xrow(r) + c; xp[1][i] = xrow(128 + r) + c; }
    const bf16_t* Ab = A + (size_t)brow * K; const size_t hstepA = (size_t)128 * K;
    const int ldsw = wid * 1024;
    const int aoffl = lds_byte(wr * 64 + fr, fq * 8), boffl = lds_byte(wc * 32 + fr, fq * 8);
#define SA(b, h) (shm + ((b) * 2 + (h)) * HTB)
#define SB(b, h) (shm + (4 + (b) * 2 + (h)) * HTB)
#define STAGE_A(b, h, kt) do { _Pragma("unroll") for (int i_ = 0; i_ < 2; ++i_) dma16(Ab + (h) * hstepA + aoff[i_] + (size_t)(kt) * 64, SA(b, h) + ldsw + i_ * 8192); } while (0)
#define STAGE_B(b, h, kt) do { _Pragma("unroll") for (int i_ = 0; i_ < 2; ++i_) dma16(xp[h][i_] + (size_t)(kt) * 64, SB(b, h) + ldsw + i_ * 8192); } while (0)
#define LDA(dst, b, h) do { _Pragma("unroll") for (int m = 0; m < 4; ++m) _Pragma("unroll") for (int k = 0; k < 2; ++k) dst[m][k] = *(LAS const bf16x8*)(SA(b, h) + aoffl + m * 2048 + k * 1024); } while (0)
#define LDB(dst, b, h) do { _Pragma("unroll") for (int n = 0; n < 2; ++n) _Pragma("unroll") for (int k = 0; k < 2; ++k) dst[n][k] = *(LAS const bf16x8*)(SB(b, h) + boffl + n * 2048 + k * 1024); } while (0)
#define MMA(ai, bj, At_, Bt_) do { __builtin_amdgcn_s_setprio(1); _Pragma("unroll") for (int m = 0; m < 4; ++m) _Pragma("unroll") for (int n = 0; n < 2; ++n) _Pragma("unroll") for (int k = 0; k < 2; ++k) \
        acc[ai][bj][m][n] = MFMA16(At_[m][k], Bt_[n][k], acc[ai][bj][m][n]); __builtin_amdgcn_s_setprio(0); } while (0)
#define WAIT_V(n) asm volatile("s_waitcnt vmcnt(" #n ")" ::: "memory")
#define WAIT_L(n) asm volatile("s_waitcnt lgkmcnt(" #n ")" ::: "memory")
#define BAR __builtin_amdgcn_s_barrier()
#define SCHED __builtin_amdgcn_sched_barrier(0)
    f32x4 acc[2][2][4][2];
#pragma unroll
    for (int a = 0; a < 2; ++a)
#pragma unroll
        for (int b = 0; b < 2; ++b)
#pragma unroll
            for (int m = 0; m < 4; ++m)
#pragma unroll
                for (int n = 0; n < 2; ++n) acc[a][b][m][n] = (f32x4){0.f, 0.f, 0.f, 0.f};
    bf16x8 At[4][2], B0[2][2], B1[2][2];
    const int nt = K / 64;
    WAIT_L(0); BAR;
    STAGE_B(0, 0, 0); STAGE_B(0, 1, 0); STAGE_A(0, 0, 0); STAGE_A(0, 1, 0);
    if (wr == 1) BAR;
    WAIT_V(2); BAR;
    STAGE_B(1, 0, 1); STAGE_A(1, 0, 1); STAGE_B(1, 1, 1);
    WAIT_V(6); BAR;
#pragma unroll 1
    for (int t = 0; t < nt; t += 2) {
        const int k2 = (t == nt - 2) ? 0 : t + 2;
        LDB(B0, 0, 0); LDB(B1, 0, 1); SCHED; LDA(At, 0, 0); STAGE_A(1, 1, t + 1);
        WAIT_V(8); WAIT_L(0); BAR; MMA(0, 0, At, B0); MMA(0, 1, At, B1); BAR; SCHED;
        LDA(At, 0, 1); STAGE_B(0, 0, k2); STAGE_B(0, 1, k2); STAGE_A(0, 0, k2);
        WAIT_V(8); WAIT_L(0); BAR; MMA(1, 0, At, B0); MMA(1, 1, At, B1); BAR; SCHED;
        LDB(B0, 1, 0); LDB(B1, 1, 1); SCHED; LDA(At, 1, 0); STAGE_A(0, 1, k2);
        WAIT_V(8); WAIT_L(0); BAR; MMA(0, 0, At, B0); MMA(0, 1, At, B1); BAR; SCHED;
        LDA(At, 1, 1); STAGE_B(1, 0, k2 + 1); STAGE_B(1, 1, k2 + 1); STAGE_A(1, 0, k2 + 1);
        WAIT_V(8); WAIT_L(0); BAR; MMA(1, 0, At, B0); MMA(1, 1, At, B1); BAR; SCHED;
    }
    WAIT_V(0);
    if (wr == 0) BAR;
    BAR;
#undef SA
#undef SB
#undef STAGE_A
#undef STAGE_B
#undef LDA
#undef LDB
#undef MMA
#undef WAIT_V
#undef WAIT_L
#undef BAR
#undef SCHED
    int tq = F.tid; asm volatile("" : "+v"(tq)); const int fr2 = tq & 15, fq2 = (tq >> 4) & 3;
#pragma unroll
    for (int ai = 0; ai < 2; ++ai) { const int cg = (brow >> 6) + 2 * ai + wr;
        const EpiC C = epi.load_c(cg, fq2);
        EpiT T = epi.load_t(cg, wc * 32 + fr2, fq2);
#pragma unroll
        for (int c = 0; c < 4; ++c) { const int bj = c >> 1, n = c & 1; const int tok = bj * 128 + wc * 32 + n * 16 + fr2;
            EpiT Tn = T; if (c < 3) Tn = epi.load_t(cg, ((c + 1) >> 1) * 128 + wc * 32 + ((c + 1) & 1) * 16 + fr2, fq2);
            f32x4 v[4] = {acc[ai][bj][0][n], acc[ai][bj][1][n], acc[ai][bj][2][n], acc[ai][bj][3][n]};
            epi.apply(v, cg, tok, fq2, C, T); T = Tn; } }
}

__device__ __forceinline__ u32x2 pk4(const f32x4& v) { return (u32x2){pk2(v[0], v[1]), pk2(v[2], v[3])}; }
struct EpiInProj {
    const Frame& F; int l, t0;
    __device__ __forceinline__ EpiC load_c(int cg, int fq) const { EpiC C;
#pragma unroll
        for (int m = 0; m < 4; ++m) C.c[m] = (f32x4){0.f, 0.f, 0.f, 0.f};
        if (cg >= 22 && cg < 30) { const float* gw = (cg < 28 ? F.in(I_GQ) : F.in(I_GK)) + 64 * l;
#pragma unroll
            for (int m = 0; m < 4; ++m) C.c[m] = *(const f32x4*)(gw + 16 * m + 4 * fq); }
        return C; }
    __device__ __forceinline__ EpiT load_t(int cg, int tok, int fq) const { EpiT T;
#pragma unroll
        for (int m = 0; m < 4; ++m) T.t[m] = (f32x4){0.f, 0.f, 0.f, 0.f};
        const int R = t0 + tok; const int t = R - NCTX; const int prow = (t >> 6) & 255, pcol = t & 63; const float* const rope = F.ws<float>(WS_ROPE);
        if (R >= NCTX) {
            if (cg >= 4 && cg < 16) { const int ti = fq < 2 ? RD_RC + prow * 8 + 4 * fq : RD_CC + pcol * 8 + 4 * (fq - 2), si = fq < 2 ? RD_RS + prow * 8 + 4 * fq : RD_CS + pcol * 8 + 4 * (fq - 2);
                T.t[0] = *(const f32x4*)(rope + ti); T.t[1] = *(const f32x4*)(rope + si); }
            else if (cg >= 22 && cg < 30) { T.t[0] = *(const f32x4*)(rope + RG_RC + prow * 16 + 4 * fq); T.t[1] = *(const f32x4*)(rope + RG_RS + prow * 16 + 4 * fq);
                T.t[2] = *(const f32x4*)(rope + RG_CC + pcol * 16 + 4 * fq); T.t[3] = *(const f32x4*)(rope + RG_CS + pcol * 16 + 4 * fq); } }
        return T; }
    __device__ __forceinline__ void apply(f32x4 (&v)[4], int cg, int tok, int fq, const EpiC& C, const EpiT& T) const {
        bf16_t* const ft = F.ws<bf16_t>(WS_FT); bf16_t* const fc = F.ws<bf16_t>(WS_FC); bf16_t* const qd = F.ws<bf16_t>(WS_QD); bf16_t* const kd = F.ws<bf16_t>(WS_KD); bf16_t* const vd = F.ws<bf16_t>(WS_VD);
        bf16_t* const qg = F.ws<bf16_t>(WS_QG); bf16_t* const kg = F.ws<bf16_t>(WS_KG); bf16_t* const vg = F.ws<bf16_t>(WS_VG);
        unsigned* const kmax = F.ctl + CW_KMAX + 16 * l;
        const float QSD = 0.17677669529663687f * LOG2E, QSG = 0.125f * LOG2E;
        const int R = t0 + tok; const bool isctx = R < NCTX; const int t = R - NCTX;
        if (cg < 4) {
#pragma unroll
            for (int m = 0; m < 4; ++m) { const int ch = 64 * cg + 16 * m + 4 * fq; const u32x2 w = pk4(v[m]);
                if (isctx) { const size_t a = (size_t)(((ch >> 7) * 4 + ((ch >> 5) & 3)) * 8192 + (R >> 3) * 256 + (R & 7) * 32 + (ch & 31)); *(u32x2*)(fc + a) = w; }
                else { const int l1 = t >> 7, l2 = t & 127; const size_t a = (size_t)((l2 * 2 + (ch >> 7)) * 4 + ((ch >> 5) & 3)) * 4096 + (l1 >> 3) * 256 + (l1 & 7) * 32 + (ch & 31); *(u32x2*)(ft + a) = w; } }
        } else if (cg < 16) {
            const bool isq = cg < 10; const int head = isq ? cg - 4 : cg - 10;
            if (!isctx) { const f32x4 cc = T.t[0], sn = T.t[1];
#pragma unroll
                for (int mp = 0; mp < 2; ++mp)
#pragma unroll
                    for (int j = 0; j < 4; ++j) { const float a = v[2 * mp][j], b = v[2 * mp + 1][j]; v[2 * mp][j] = a * cc[j] - b * sn[j]; v[2 * mp + 1][j] = b * cc[j] + a * sn[j]; } }
            if (isq) {
#pragma unroll
                for (int m = 0; m < 4; ++m) { const f32x4 s = v[m] * QSD;
                    const size_t a = ((((size_t)(head * NQB + (R >> 5)) * 2 + (m >> 1)) * 4 + 2 * (m & 1) + (fq >> 1)) * 32 + (R & 31)) * 8 + 4 * (fq & 1); *(u32x2*)(qd + a) = pk4(s); }
            } else {
                float ss0 = 0.f, ss1 = 0.f;
#pragma unroll
                for (int j = 0; j < 4; ++j) { ss0 += v[0][j] * v[0][j] + v[1][j] * v[1][j]; ss1 += v[2][j] * v[2][j] + v[3][j] * v[3][j]; }
                ss0 += shxc<16>(ss0); ss1 += shxc<16>(ss1); ss0 = add32(ss0); ss1 = add32(ss1);
                ss0 = fmaxf(ss0, shxc<8>(ss0)); ss1 = fmaxf(ss1, shxc<8>(ss1)); ss0 = fmaxf(ss0, shxc<4>(ss0)); ss1 = fmaxf(ss1, shxc<4>(ss1));
                ss0 = fmaxf(ss0, shxc<2>(ss0)); ss1 = fmaxf(ss1, shxc<2>(ss1)); ss0 = fmaxf(ss0, shxc<1>(ss0)); ss1 = fmaxf(ss1, shxc<1>(ss1));
                if ((tok & 15) == 0 && fq == 0) { float* kp = F.ws<float>(WS_KP) + ((size_t)(l * 12 + 2 * head) * 64 + ((t0 >> 8) - 1)) * 16 + (tok >> 4); kp[0] = ss0; kp[1024] = ss1; }
#pragma unroll
                for (int m = 0; m < 4; ++m) {
                    const size_t a = ((((size_t)(head * NKT + (R >> 6)) * 2 + (m >> 1)) * 4 + 2 * (m & 1) + (fq >> 1)) * 64 + (R & 63)) * 8 + 4 * (fq & 1); *(u32x2*)(kd + a) = pk4(v[m]); }
            }
        } else if (cg < 22 || cg >= 30) {
            const bool isd = cg < 22; const int head = isd ? cg - 16 : cg - 30; bf16_t* vb = isd ? vd : vg;
#pragma unroll
            for (int m = 0; m < 4; ++m) {
                const size_t a = ((size_t)(head * NKT + (R >> 6)) * 2 + (m >> 1)) * 2048 + ((R & 63) >> 3) * 256 + (R & 7) * 32 + 16 * (m & 1) + 4 * fq; *(u32x2*)(vb + a) = pk4(v[m]); }
        } else {
            const bool isq = cg < 28; const int head = isq ? cg - 22 : cg - 28;
            float ss = 0.f;
#pragma unroll
            for (int m = 0; m < 4; ++m)
#pragma unroll
                for (int j = 0; j < 4; ++j) ss += v[m][j] * v[m][j];
            ss += shxc<16>(ss); ss = add32(ss); const float rs = rsqrtf(ss * (1.f / 64.f) + 1e-6f);
#pragma unroll
            for (int m = 0; m < 4; ++m) v[m] = v[m] * C.c[m] * rs;
            if (!isctx) { const f32x4 cr = T.t[0], sr = T.t[1], cc = T.t[2], sc = T.t[3];
#pragma unroll
                for (int j = 0; j < 4; ++j) { { const float a = v[0][j], b = v[2][j]; v[0][j] = a * cr[j] - b * sr[j]; v[2][j] = b * cr[j] + a * sr[j]; }
                    { const float a = v[1][j], b = v[3][j]; v[1][j] = a * cc[j] - b * sc[j]; v[3][j] = b * cc[j] + a * sc[j]; } } }
#pragma unroll
            for (int m = 0; m < 4; ++m) { const f32x4 s = isq ? v[m] * QSG : v[m]; const int c = 2 * m + (fq >> 1);
                if (isq) { const size_t a = (((size_t)(head * NQB + (R >> 5)) * 8 + c) * 32 + (R & 31)) * 8 + 4 * (fq & 1); *(u32x2*)(qg + a) = pk4(s); }
                else { const size_t a = (((size_t)(head * NKT + (R >> 6)) * 8 + c) * 64 + (R & 63)) * 8 + 4 * (fq & 1); *(u32x2*)(kg + a) = pk4(s); } }
        }
    }
};
struct EpiOutProj {
    const Frame& F; int l, t0;
    __device__ __forceinline__ const float* src_row(int R) const { return l == 0 ? (R < NCTX ? F.in(I_CTX) + (size_t)R * DM : F.in(I_X) + (size_t)(R - NCTX) * DM) : F.ws<float>(WS_XS) + (size_t)R * DM; }
    __device__ __forceinline__ EpiC load_c(int cg, int fq) const { EpiC C; const float* gt = F.ws<float>(WS_MOD) + (size_t)l * 2 * 6144 + (t0 < NCTX ? 6144 : 0) + 2048;
#pragma unroll
        for (int m = 0; m < 4; ++m) C.c[m] = *(const f32x4*)(gt + 64 * cg + 16 * m + 4 * fq);
        return C; }
    __device__ __forceinline__ EpiT load_t(int cg, int tok, int fq) const { EpiT T; const float* src = src_row(t0 + tok);
#pragma unroll
        for (int m = 0; m < 4; ++m) T.t[m] = *(const f32x4*)(src + 64 * cg + 16 * m + 4 * fq);
        return T; }
    __device__ __forceinline__ void apply(f32x4 (&v)[4], int cg, int tok, int fq, const EpiC& C, const EpiT& T) const {
        float* xs = F.ws<float>(WS_XS) + (size_t)(t0 + tok) * DM;
#pragma unroll
        for (int m = 0; m < 4; ++m) *(f32x4*)(xs + 64 * cg + 16 * m + 4 * fq) = T.t[m] + C.c[m] * v[m];
    }
};
struct EpiGateUp {
    const Frame& F; int le, m0, cnt, offs;
    __device__ __forceinline__ EpiC load_c(int cg, int fq) const { EpiC C; const float* bias = F.in(I_BGU) + (size_t)le * 2048 + 32 * cg + 4 * fq;
        C.c[0] = *(const f32x4*)(bias); C.c[1] = *(const f32x4*)(bias + 16); C.c[2] = *(const f32x4*)(bias + 1024); C.c[3] = *(const f32x4*)(bias + 1024 + 16); return C; }
    __device__ __forceinline__ EpiT load_t(int, int, int) const { EpiT T;
#pragma unroll
        for (int m = 0; m < 4; ++m) T.t[m] = (f32x4){0.f, 0.f, 0.f, 0.f};
        return T; }
    __device__ __forceinline__ void apply(f32x4 (&v)[4], int cg, int tok, int fq, const EpiC& C, const EpiT&) const {
        const int mt = m0 + tok; if (mt >= cnt) return;
        bf16_t* dst = F.ws<bf16_t>(WS_ACT) + (size_t)(offs + mt) * FFD;
#pragma unroll
        for (int m = 0; m < 2; ++m) { const int jj = 32 * cg + 16 * m + 4 * fq; f32x4 o;
#pragma unroll
            for (int j = 0; j < 4; ++j) { float gl = v[m][j] + C.c[m][j], li = v[m + 2][j] + C.c[2 + m][j]; gl = fminf(gl, 7.f); li = fminf(fmaxf(li, -7.f), 7.f);
                o[j] = gl * (1.f / (1.f + __expf(-1.702f * gl))) * (li + 1.f); }
            *(u32x2*)(dst + jj) = pk4(o); }
    }
};
struct EpiDown {
    const Frame& F; int le, m0, cnt, offs;
    __device__ __forceinline__ EpiC load_c(int cg, int fq) const { EpiC C; const float* bias = F.in(I_BDN) + (size_t)le * DM + 64 * cg + 4 * fq;
#pragma unroll
        for (int m = 0; m < 4; ++m) C.c[m] = *(const f32x4*)(bias + 16 * m);
        return C; }
    __device__ __forceinline__ EpiT load_t(int, int, int) const { EpiT T;
#pragma unroll
        for (int m = 0; m < 4; ++m) T.t[m] = (f32x4){0.f, 0.f, 0.f, 0.f};
        return T; }
    __device__ __forceinline__ void apply(f32x4 (&v)[4], int cg, int tok, int fq, const EpiC& C, const EpiT&) const {
        const int mt = m0 + tok; if (mt >= cnt) return;
        bf16_t* dst = F.ws<bf16_t>(WS_YB) + (size_t)(offs + mt) * DM;
#pragma unroll
        for (int m = 0; m < 4; ++m) *(u32x2*)(dst + 64 * cg + 16 * m + 4 * fq) = pk4(v[m] + C.c[m]);
    }
};
struct XDense { const bf16_t* X; int ld; int t0; __device__ __forceinline__ const bf16_t* operator()(int row) const { return X + (size_t)(t0 + row) * ld; } };
struct XGather { const bf16_t* X; const unsigned* list; int m0, cnt; __device__ __forceinline__ const bf16_t* operator()(int row) const { int m = m0 + row; m = m < cnt ? m : cnt - 1; return X + (size_t)list[m] * DM; } };
struct XAct { const bf16_t* X; int base, m0, cnt; __device__ __forceinline__ const bf16_t* operator()(int row) const { int m = m0 + row; m = m < cnt ? m : cnt - 1; return X + (size_t)(base + m) * FFD; } };

template <class Epi>
__device__ __forceinline__ void mini_unit(const Frame& F, const bf16_t* W, int ldw, int f0, const bf16_t* X, int ldx, int t0, int K, const Epi& epi) {
    const int lane = F.lane, wid = F.wid, r = lane & 31, h = lane >> 5; const int kw = K >> 3;
    const bf16_t* wp = W + (size_t)(f0 + r) * ldw + wid * kw + 8 * h; const bf16_t* xp = X + (size_t)(t0 + r) * ldx + wid * kw + 8 * h;
    f32x16 acc0, acc1;
#pragma unroll
    for (int i = 0; i < 16; ++i) { acc0[i] = 0.f; acc1[i] = 0.f; }
#pragma unroll 2
    for (int s = 0; s < (kw >> 4); ++s) { const bf16x8 w0 = *(const bf16x8*)(wp + 16 * s), w1 = *(const bf16x8*)(wp + (size_t)32 * ldw + 16 * s), xv = *(const bf16x8*)(xp + 16 * s);
        acc0 = MFMA(w0, xv, acc0); acc1 = MFMA(w1, xv, acc1); }
    BAR_SYNC();
    LAS float* red = (LAS float*)F.lds;
#pragma unroll
    for (int i = 0; i < 16; ++i) { red[(wid * 32 + i) * 64 + lane] = acc0[i]; red[(wid * 32 + 16 + i) * 64 + lane] = acc1[i]; }
    __syncthreads();
    LAS float* out = red + 8 * 32 * 64;
#pragma unroll
    for (int j = 0; j < 4; ++j) { const int rg = 4 * wid + j; float s = 0.f;
#pragma unroll
        for (int w = 0; w < 8; ++w) s += red[(w * 32 + rg) * 64 + lane];
        out[rg * 64 + lane] = s; }
    __syncthreads();
    if (wid == 0) {
#pragma unroll
        for (int i = 0; i < 16; ++i) { acc0[i] = out[i * 64 + lane]; acc1[i] = out[(16 + i) * 64 + lane]; }
        epi(acc0, acc1, f0 >> 6, t0 + r, h);
    }
}
struct EpiInProjCtx {
    const Frame& F; int l;
    __device__ __forceinline__ void operator()(f32x16& v0, f32x16& v1, int cg, int R, int h) const {
        const float QSD = 0.17677669529663687f * LOG2E, QSG = 0.125f * LOG2E;
        if (cg < 4) { bf16_t* fc = F.ws<bf16_t>(WS_FC);
#pragma unroll
            for (int fb = 0; fb < 2; ++fb)
#pragma unroll
                for (int g = 0; g < 4; ++g) { const f32x16& v = fb ? v1 : v0; const int ch = 64 * cg + 32 * fb + 8 * g + 4 * h;
                    const size_t a = (size_t)(((ch >> 7) * 4 + ((ch >> 5) & 3)) * 8192 + (R >> 3) * 256 + (R & 7) * 32 + (ch & 31)); *(u32x2*)(fc + a) = (u32x2){pk2(v[4 * g], v[4 * g + 1]), pk2(v[4 * g + 2], v[4 * g + 3])}; }
        } else if (cg < 16) { const bool isq = cg < 10; const int head = isq ? cg - 4 : cg - 10;
            if (isq) { bf16_t* qd = F.ws<bf16_t>(WS_QD);
#pragma unroll
                for (int fb = 0; fb < 2; ++fb)
#pragma unroll
                    for (int g = 0; g < 4; ++g) { const f32x16& v = fb ? v1 : v0;
                        const size_t a = ((((size_t)(head * NQB + (R >> 5)) * 2 + fb) * 4 + g) * 32 + (R & 31)) * 8 + 4 * h;
                        *(u32x2*)(qd + a) = (u32x2){pk2(v[4 * g] * QSD, v[4 * g + 1] * QSD), pk2(v[4 * g + 2] * QSD, v[4 * g + 3] * QSD)}; }
            } else { bf16_t* kd = F.ws<bf16_t>(WS_KD); unsigned* kmax = F.ctl + CW_KMAX + 16 * l;
                float ss0 = 0.f, ss1 = 0.f;
#pragma unroll
                for (int i = 0; i < 16; ++i) { ss0 += v0[i] * v0[i]; ss1 += v1[i] * v1[i]; }
                ss0 = add32(ss0); ss1 = add32(ss1); ss0 = wave_max(ss0); ss1 = wave_max(ss1);
                if (F.lane == 0) { atomicMax(kmax + 2 * head, __float_as_uint(ss0)); atomicMax(kmax + 2 * head + 1, __float_as_uint(ss1)); }
#pragma unroll
                for (int fb = 0; fb < 2; ++fb)
#pragma unroll
                    for (int g = 0; g < 4; ++g) { const f32x16& v = fb ? v1 : v0;
                        const size_t a = ((((size_t)(head * NKT + (R >> 6)) * 2 + fb) * 4 + g) * 64 + (R & 63)) * 8 + 4 * h;
                        *(u32x2*)(kd + a) = (u32x2){pk2(v[4 * g], v[4 * g + 1]), pk2(v[4 * g + 2], v[4 * g + 3])}; } }
        } else if (cg < 22 || cg >= 30) { const bool isd = cg < 22; const int head = isd ? cg - 16 : cg - 30; bf16_t* vb = isd ? F.ws<bf16_t>(WS_VD) : F.ws<bf16_t>(WS_VG);
#pragma unroll
            for (int fb = 0; fb < 2; ++fb)
#pragma unroll
                for (int g = 0; g < 4; ++g) { const f32x16& v = fb ? v1 : v0;
                    const size_t a = ((size_t)(head * NKT + (R >> 6)) * 2 + fb) * 2048 + ((R & 63) >> 3) * 256 + (R & 7) * 32 + 8 * g + 4 * h;
                    *(u32x2*)(vb + a) = (u32x2){pk2(v[4 * g], v[4 * g + 1]), pk2(v[4 * g + 2], v[4 * g + 3])}; }
        } else { const bool isq = cg < 28; const int head = isq ? cg - 22 : cg - 28; const float* gw = (isq ? F.in(I_GQ) : F.in(I_GK)) + 64 * l;
            float ss = 0.f;
#pragma unroll
            for (int i = 0; i < 16; ++i) ss += v0[i] * v0[i] + v1[i] * v1[i];
            ss = add32(ss); const float rs = rsqrtf(ss * (1.f / 64.f) + 1e-6f) * (isq ? QSG : 1.f);
#pragma unroll
            for (int fb = 0; fb < 2; ++fb)
#pragma unroll
                for (int g = 0; g < 4; ++g) { const f32x16& v = fb ? v1 : v0; const f32x4 gv = *(const f32x4*)(gw + 32 * fb + 8 * g + 4 * h);
                    const u32x2 w = {pk2(v[4 * g] * rs * gv[0], v[4 * g + 1] * rs * gv[1]), pk2(v[4 * g + 2] * rs * gv[2], v[4 * g + 3] * rs * gv[3])};
                    if (isq) { const size_t a = (((size_t)(head * NQB + (R >> 5)) * 8 + 4 * fb + g) * 32 + (R & 31)) * 8 + 4 * h; *(u32x2*)(F.ws<bf16_t>(WS_QG) + a) = w; }
                    else { const size_t a = (((size_t)(head * NKT + (R >> 6)) * 8 + 4 * fb + g) * 64 + (R & 63)) * 8 + 4 * h; *(u32x2*)(F.ws<bf16_t>(WS_KG) + a) = w; } }
        }
    }
};
struct EpiOutProjCtx {
    const Frame& F;
    __device__ __forceinline__ void operator()(f32x16& v0, f32x16& v1, int cg, int R, int h) const {
        const float* src = F.in(I_CTX) + (size_t)R * DM; const float* gt = F.ws<float>(WS_MOD) + 6144 + 2048; float* xs = F.ws<float>(WS_XS) + (size_t)R * DM;
#pragma unroll
        for (int fb = 0; fb < 2; ++fb)
#pragma unroll
            for (int g = 0; g < 4; ++g) { const f32x16& v = fb ? v1 : v0; const int n = 64 * cg + 32 * fb + 8 * g + 4 * h;
                const f32x4 x = *(const f32x4*)(src + n), gv = *(const f32x4*)(gt + n);
                *(f32x4*)(xs + n) = (f32x4){x[0] + gv[0] * v[4 * g], x[1] + gv[1] * v[4 * g + 1], x[2] + gv[2] * v[4 * g + 2], x[3] + gv[3] * v[4 * g + 3]}; }
    }
};
__device__ __forceinline__ void phase_inproj(const Frame& F, int l) {
    const bf16_t* Wt = F.ws<bf16_t>(WS_WIN) + (size_t)l * INW * DM; const bf16_t* hb = F.ws<bf16_t>(WS_HB);
    const bool xcd = F.G == 256; const int x = F.bid & 7;
    const int first = xcd ? (F.bid >> 3) : F.bid, stride = xcd ? 32 : F.G, total = xcd ? 64 : 8 * 64;
    for (int i = first; i < total; i += stride) { const int ft = xcd ? 4 * (x & 1) + (i & 3) : (i & 7), tt = 1 + (xcd ? 4 * (i >> 2) + (x >> 1) : (i >> 3));
        EpiInProj E{F, l, 256 * tt}; XDense X{hb, DM, 256 * tt}; gemm8(F, Wt, DM, 256 * ft, X, E); }
    EpiInProjCtx EC{F, l};
    for (int u = F.bid; u < 256; u += F.G) { const int cg = u & 31, tb = u >> 5;
        if (l == 1 && !((cg >= 10 && cg < 22) || cg >= 28)) continue;
        mini_unit(F, Wt, DM, 64 * cg, hb, DM, 32 * tb, DM, EC); }
}
__device__ __forceinline__ void phase_outproj(const Frame& F, int l) {
    const bf16_t* Wt = F.ws<bf16_t>(WS_WOUT) + (size_t)l * DM * MIXK; const bf16_t* mix = F.ws<bf16_t>(WS_MIX);
    const bool xcd = F.G == 256; const int x = F.bid & 7;
    const int first = xcd ? (F.bid >> 3) : F.bid, stride = xcd ? 32 : F.G, total = xcd ? 32 : 4 * 64;
    for (int i = first; i < total; i += stride) { const int ft = i & 3, tt = 1 + (xcd ? 8 * (i >> 2) + x : (i >> 2));
        EpiOutProj E{F, l, 256 * tt}; XDense X{mix, MIXK, 256 * tt}; gemm8(F, Wt, MIXK, 256 * ft, X, E); }
    if (l == 0) { EpiOutProjCtx EC{F};
        for (int u = F.bid; u < 128; u += F.G) { const int cg = u & 15, tb = u >> 4; mini_unit(F, Wt, MIXK, 64 * cg, mix, MIXK, 32 * tb, MIXK, EC); } }
}
__device__ __forceinline__ void moe_tables(const Frame& F, int l, int nf, bool xcd, LAS int*& s_cnt, LAS int*& s_offs, LAS int*& s_t0) {
    LAS int* base = (LAS int*)(F.lds + LDS_CTL + 256); s_cnt = base; s_offs = base + 32; s_t0 = base + 72;
    __syncthreads();
    if (F.tid < NEXP) s_cnt[F.tid] = (int)__hip_atomic_load(F.ctl + CW_CNT + 64 * l + F.tid, __ATOMIC_RELAXED, __HIP_MEMORY_SCOPE_AGENT);
    __syncthreads();
    if (F.tid == 0) { const int g = (F.bid & 7) >> 1; int o = 0, t = 0; for (int e = 0; e < NEXP; ++e) { const int c = s_cnt[e];
            const int ntt = (c + 255) >> 8; int nu = ntt * nf;
            if (xcd) { const int fst = (g - e) & 3; nu = (fst < ntt ? (ntt - fst + 3) >> 2 : 0) * (nf >> 1); }
            s_cnt[e] = c; s_offs[e] = o; s_t0[e] = t; o += c; t += nu; } s_offs[32] = o; s_t0[32] = t; }
    __syncthreads();
}
__device__ __forceinline__ void moe_decode(const Frame& F, bool xcd, int nf, int i, LAS const int* s_t0, int& e, int& ft, int& tt) {
    e = 0; while (e < NEXP - 1 && i >= s_t0[e + 1]) ++e;
    const int j = i - s_t0[e];
    if (xcd) { const int x = F.bid & 7, hf = nf >> 1; ft = hf * (x & 1) + (j % hf); tt = (((x >> 1) - e) & 3) + 4 * (j / hf); }
    else { ft = j % nf; tt = j / nf; } }
__device__ __forceinline__ void phase_gateup(const Frame& F, int l) {
    const bool xcd = F.G == 256;
    LAS int *s_cnt, *s_offs, *s_t0; moe_tables(F, l, 8, xcd, s_cnt, s_offs, s_t0);
    const int first = xcd ? (F.bid >> 3) : F.bid, stride = xcd ? 32 : F.G, total = s_t0[32];
    for (int i = first; i < total; i += stride) { int e, ft, tt; moe_decode(F, xcd, 8, i, s_t0, e, ft, tt);
        EpiGateUp E{F, l * NEXP + e, 256 * tt, s_cnt[e], s_offs[e]};
        XGather X{F.ws<bf16_t>(WS_HB), F.ws<unsigned>(WS_LIST) + (size_t)e * NT, 256 * tt, s_cnt[e]};
        gemm8(F, F.ws<bf16_t>(WS_WGU) + (size_t)(l * NEXP + e) * 2048 * DM, DM, 256 * ft, X, E); }
}
__device__ __forceinline__ void phase_down(const Frame& F, int l) {
    const bool xcd = F.G == 256;
    LAS int *s_cnt, *s_offs, *s_t0; moe_tables(F, l, 4, xcd, s_cnt, s_offs, s_t0);
    const int first = xcd ? (F.bid >> 3) : F.bid, stride = xcd ? 32 : F.G, total = s_t0[32];
    for (int i = first; i < total; i += stride) { int e, ft, tt; moe_decode(F, xcd, 4, i, s_t0, e, ft, tt);
        EpiDown E{F, l * NEXP + e, 256 * tt, s_cnt[e], s_offs[e]};
        XAct X{F.ws<bf16_t>(WS_ACT), s_offs[e], 256 * tt, s_cnt[e]};
        gemm8(F, F.ws<bf16_t>(WS_WDN) + (size_t)(l * NEXP + e) * DM * FFD, FFD, 256 * ft, X, E); }
}

template <int KD, int MODE>
__device__ __forceinline__ void dft_unit(const Frame& F, const bf16_t* AF, const bf16_t* Bsrc, int p0, int colhalf, int pa) {
    constexpr int NS = KD / 16, TILE_B = 4 * KD * 64;
    const int lane = F.lane, wid = F.wid, r = lane & 31, h = lane >> 5, rg = wid & 3, cg2 = wid >> 2;
    LAS char* lds = F.lds;
    BAR_SYNC();
    for (int pc = wid; pc < TILE_B / 1024; pc += 8) dma16((const char*)Bsrc + (size_t)pc * 1024 + lane * 16, lds + pc * 1024);
    WAITV(0); BAR_SYNC();
    f32x16 acc[2][2];
#pragma unroll
    for (int a = 0; a < 2; ++a)
#pragma unroll
        for (int b = 0; b < 2; ++b)
#pragma unroll
            for (int i = 0; i < 16; ++i) acc[a][b][i] = 0.f;
    const bf16_t* af = AF + (size_t)(rg * 2) * NS * 512 + lane * 8;
    const int bl = h * 512 + ((lane & 15) >> 2) * 64 + ((lane >> 4) & 1) * 32 + (lane & 3) * 8;
#pragma unroll 4
    for (int s = 0; s < NS; ++s) {
        const bf16x8 a0 = *(const bf16x8*)(af + (size_t)s * 512), a1 = *(const bf16x8*)(af + (size_t)(NS + s) * 512);
#pragma unroll
        for (int cb = 0; cb < 2; ++cb) { LAS const char* bp = lds + (2 * cg2 + cb) * (KD * 64) + s * 1024 + bl;
            const s16x4 lo = vtr(bp), hi = vtr(bp + 256);
            const bf16x8 bf = {lo[0], lo[1], lo[2], lo[3], hi[0], hi[1], hi[2], hi[3]};
            acc[0][cb] = MFMA(a0, bf, acc[0][cb]); acc[1][cb] = MFMA(a1, bf, acc[1][cb]); }
    }
#pragma unroll
    for (int cb = 0; cb < 2; ++cb) { const int c = 128 * colhalf + 32 * (2 * cg2 + cb) + r;
#pragma unroll
        for (int rho = 0; rho < 16; ++rho) { const int kk = 32 * rg + (rho & 3) + 8 * (rho >> 2) + 4 * h; const float re = acc[0][cb][rho], im = acc[1][cb][rho];
            if (MODE == 0) { const int l2 = p0; const f32x2 tw = F.ws<f32x2>(WS_TW)[(kk * l2) & 16383]; const float o_re = re * tw[0] + im * tw[1], o_im = im * tw[0] - re * tw[1];
                bf16_t* T2 = F.ws<bf16_t>(WS_T2); const size_t a = ((size_t)(kk * 2 + (c >> 7)) * 4 + ((c >> 5) & 3)) * 8192 + (l2 >> 2) * 256 + (2 * (l2 & 3)) * 32 + (c & 31);
                T2[a] = (bf16_t)(pk2(o_re, 0.f) & 0xffff); T2[a + 32] = (bf16_t)(pk2(o_im, 0.f) & 0xffff);
            } else if (MODE == 1) { const int k1 = p0; bf16_t* mr = F.ws<bf16_t>(WS_MIX) + (size_t)(NCTX + k1 + 128 * kk) * MIXK;
                mr[c] = (bf16_t)(pk2(re * (1.f / 1024.f), 0.f) & 0xffff); mr[256 + c] = (bf16_t)(pk2(im * (1.f / 1024.f), 0.f) & 0xffff);
            } else { bf16_t* mr = F.ws<bf16_t>(WS_MIX) + (size_t)(128 * pa + kk) * MIXK;
                mr[c] = (bf16_t)(pk2(re * (1.f / 128.f), 0.f) & 0xffff); mr[256 + c] = (bf16_t)(pk2(im * (1.f / 128.f), 0.f) & 0xffff); } } }
}

constexpr int A_SLOT = 16384;
constexpr int N_PSLOT = 18;
constexpr int A_KRING = 0, A_VRING = 32768;
template <int NQ, int NKS, bool SEPK, bool BIAS>
__device__ __forceinline__ void attn_sweep(const Frame& F, const bf16x8 (&qf)[NQ][NKS], const bf16_t* Kt, const bf16_t* Vt, int ntiles, const f32x16& negm, f32x16 (&o)[NQ][2], float (&lsum)[NQ]) {
    constexpr int NKF = (SEPK ? NQ : 1) * NKS;
    const int lane = F.lane, wid = F.wid, r = lane & 31, h = lane >> 5;
    LAS char* lds = F.lds; const unsigned lds0 = (unsigned)(size_t)F.lds;
    const bf16_t* ksrc = Kt + wid * 512 + lane * 8; const bf16_t* vsrc = Vt + wid * 512 + lane * 8;
#define A_K(t) glds16(ksrc + (size_t)(t) * 4096, (unsigned)__builtin_amdgcn_readfirstlane((int)(lds0 + A_KRING + ((t) & 3) * 8192 + wid * 1024)))
#define A_V(t) glds16(vsrc + (size_t)(t) * 4096, (unsigned)__builtin_amdgcn_readfirstlane((int)(lds0 + A_VRING + ((t) & 3) * 8192 + wid * 1024)))
#define SB() __builtin_amdgcn_sched_barrier(0)
    BAR_SYNC();
    A_K(0); A_V(0); A_K(1); A_K(2); A_V(1);
    float l0[NQ]; f32x16 scA[NQ], scB[NQ]; bf16x8 kf[NKF], vf[4], pa[NQ][2];
#pragma unroll
    for (int qi = 0; qi < NQ; ++qi) { l0[qi] = 0.f;
#pragma unroll
        for (int i = 0; i < 16; ++i) { o[qi][0][i] = 0.f; o[qi][1][i] = 0.f; scB[qi][i] = 0.f; } }
    const int vb = ((lane >> 4) & 1) * 32 + (lane & 3) * 8 + (4 * h + ((lane & 15) >> 2)) * 64;
    const int kbo = h * 1024 + r * 16;
#define LOADK(tile, kb) do { LAS const char* kp_ = lds + A_KRING + ((tile) & 3) * 8192 + kbo + (kb) * 512; \
        _Pragma("unroll") for (int f_ = 0; f_ < NKF; ++f_) kf[f_] = *(LAS const bf16x8*)(kp_ + (SEPK ? (f_ / NKS) * 4096 : 0) + (f_ % NKS) * 2048); } while (0)
#define LOADV(tile, kb) do { LAS const char* vp_ = lds + A_VRING + ((tile) & 3) * 8192 + vb + (kb) * 2048; \
        _Pragma("unroll") for (int j_ = 0; j_ < 2; ++j_) _Pragma("unroll") for (int d_ = 0; d_ < 2; ++d_) { const s16x4 lo_ = vtr(vp_ + d_ * 4096 + j_ * 1024), hi_ = vtr(vp_ + d_ * 4096 + j_ * 1024 + 512); \
            vf[j_ * 2 + d_] = (bf16x8){lo_[0], lo_[1], lo_[2], lo_[3], hi_[0], hi_[1], hi_[2], hi_[3]}; } } while (0)
#define HALF(SN, SO, vtile, vkb, DOK, ktile, kkb) do { \
        LOADV(vtile, vkb); SB(); \
          \
        _Pragma("unroll") for (int m_ = 0; m_ < NQ * NKS; ++m_) { const int qi_ = m_ / NKS, s_ = m_ % NKS; \
            if (s_ == 0) { if (BIAS) SN[qi_] = MFMA(kf[(SEPK ? qi_ : 0) * NKS], qf[qi_][0], negm); else { f32x16 z_; _Pragma("unroll") for (int i_ = 0; i_ < 16; ++i_) z_[i_] = 0.f; SN[qi_] = MFMA(kf[(SEPK ? qi_ : 0) * NKS], qf[qi_][0], z_); } } \
            else SN[qi_] = MFMA(kf[(SEPK ? qi_ : 0) * NKS + s_], qf[qi_][s_], SN[qi_]); \
              \
            _Pragma("unroll") for (int g_ = m_ * 4 / NKS; g_ < (m_ + 1) * 4 / NKS; ++g_) { const int fq_ = g_ >> 2, gg_ = g_ & 3; \
                l0[fq_] += SO[fq_][4 * gg_]; l0[fq_] += SO[fq_][4 * gg_ + 1]; l0[fq_] += SO[fq_][4 * gg_ + 2]; l0[fq_] += SO[fq_][4 * gg_ + 3]; \
                { u32x4 w_ = __builtin_bit_cast(u32x4, pa[fq_][gg_ >> 1]); w_[(gg_ & 1) * 2] = pk2(SO[fq_][4 * gg_], SO[fq_][4 * gg_ + 1]); w_[(gg_ & 1) * 2 + 1] = pk2(SO[fq_][4 * gg_ + 2], SO[fq_][4 * gg_ + 3]); pa[fq_][gg_ >> 1] = __builtin_bit_cast(bf16x8, w_); } } \
            SB(); } \
          \
        _Pragma("unroll") for (int m_ = 0; m_ < NQ * 4; ++m_) { const int j_ = m_ / (2 * NQ), d_ = (m_ / NQ) & 1, qi_ = m_ % NQ; \
            o[qi_][d_] = MFMA(vf[j_ * 2 + d_], pa[qi_][j_], o[qi_][d_]); \
            { const int eq_ = m_ >> 2, eg_ = m_ & 3; \
              SN[eq_][4 * eg_] = __builtin_amdgcn_exp2f(SN[eq_][4 * eg_]); SN[eq_][4 * eg_ + 1] = __builtin_amdgcn_exp2f(SN[eq_][4 * eg_ + 1]); \
              SN[eq_][4 * eg_ + 2] = __builtin_amdgcn_exp2f(SN[eq_][4 * eg_ + 2]); SN[eq_][4 * eg_ + 3] = __builtin_amdgcn_exp2f(SN[eq_][4 * eg_ + 3]); } \
            if (m_ == 0) { if (DOK) LOADK(ktile, kkb); }   \
            SB(); } \
    } while (0)
    WAITV(2); BAR_SYNC();
    A_K(3); if (ntiles > 2) A_V(2);
    LOADK(0, 0);
    for (int t = 0; t < ntiles; ++t) {
        if (t > 0) {
            if (t + 2 < ntiles) { WAITV(2); } else if (t + 1 < ntiles) { WAITV(1); } else { WAITV(0); }
            BAR_SYNC();
            if (t + 3 < ntiles) A_K(t + 3);
            if (t + 2 < ntiles) A_V(t + 2);
        }
        HALF(scA, scB, (t > 0 ? t - 1 : 0), 1, true, t, 1);
        HALF(scB, scA, t, 0, (t + 1 < ntiles), t + 1, 0);
    }
    LOADV(ntiles - 1, 1);
#pragma unroll
    for (int qi = 0; qi < NQ; ++qi) {
#pragma unroll
        for (int i = 0; i < 16; ++i) l0[qi] += scB[qi][i];
        pa[qi][0] = pack8(scB[qi][0], scB[qi][1], scB[qi][2], scB[qi][3], scB[qi][4], scB[qi][5], scB[qi][6], scB[qi][7]);
        pa[qi][1] = pack8(scB[qi][8], scB[qi][9], scB[qi][10], scB[qi][11], scB[qi][12], scB[qi][13], scB[qi][14], scB[qi][15]); }
#pragma unroll
    for (int j = 0; j < 2; ++j)
#pragma unroll
        for (int d0 = 0; d0 < 2; ++d0)
#pragma unroll
            for (int qi = 0; qi < NQ; ++qi) o[qi][d0] = MFMA(vf[j * 2 + d0], pa[qi][j], o[qi][d0]);
#undef A_K
#undef A_V
#undef SB
#undef LOADK
#undef LOADV
#undef HALF
#pragma unroll
    for (int qi = 0; qi < NQ; ++qi) lsum[qi] = add32(l0[qi]);
}
constexpr int PREC = 1152;
__device__ __forceinline__ void store_partial(const Frame& F, int kh, int slot, int R, const f32x16 (&o)[2], float l, int r, int h) {
    bf16_t* rec = F.ws<bf16_t>(WS_PART) + ((size_t)R * 2 + kh) * PREC; const float inv = 1.f / l;
#pragma unroll
    for (int d0 = 0; d0 < 2; ++d0)
#pragma unroll
        for (int g = 0; g < 4; ++g) { u32x2 w = {pk2(o[d0][4 * g] * inv, o[d0][4 * g + 1] * inv), pk2(o[d0][4 * g + 2] * inv, o[d0][4 * g + 3] * inv)};
            const int off = slot < 12 ? (((slot >> 1) * 8 + 4 * d0 + g) * 2 + (slot & 1)) * 8 + 4 * h : 768 + (slot - 12) * 64 + 32 * d0 + 8 * g + 4 * h;
            *(u32x2*)(rec + off) = w; }
    if (h == 0) F.ws<float>(WS_PL)[((size_t)R * 2 + kh) * N_PSLOT + slot] = l;
}
__device__ __forceinline__ void attn_diff_unit(const Frame& F, int l, int head, int R0, int t0, int ntiles, int khalf) {
    const int lane = F.lane, wid = F.wid, r = lane & 31, h = lane >> 5;
    const bf16_t* qp = F.ws<bf16_t>(WS_QD) + (size_t)(head * NQB + (R0 >> 5) + wid) * 2048;
    bf16x8 qf[2][2]; float mi[2];
#pragma unroll
    for (int mp = 0; mp < 2; ++mp) {
#pragma unroll
        for (int s = 0; s < 2; ++s) qf[mp][s] = *(const bf16x8*)(qp + ((4 * mp + 2 * s + h) * 32 + r) * 8);
        float qq = 0.f;
#pragma unroll
        for (int j = 0; j < 8; ++j) { const float a = bf2f((unsigned short)qf[mp][0][j]), b = bf2f((unsigned short)qf[mp][1][j]); qq += a * a + b * b; }
        qq = add32(qq);
        const float km = ((LAS const float*)(F.lds + LDS_CTL + 1024))[2 * head + mp];
        mi[mp] = -sqrtf(qq * km) * 1.01f; }
    f32x16 negm; { const float mm = fminf(mi[0], mi[1]);
#pragma unroll
        for (int i = 0; i < 16; ++i) negm[i] = mm; asm volatile("" : "+v"(negm)); }
    f32x16 o[2][2]; float ls[2];
    attn_sweep<2, 2, true, true>(F, qf, F.ws<bf16_t>(WS_KD) + (size_t)(head * NKT + t0) * 4096, F.ws<bf16_t>(WS_VD) + (size_t)(head * NKT + t0) * 4096, ntiles, negm, o, ls);
    { const int ln = lane_now(), r2 = ln & 31, h2 = ln >> 5, R = R0 + 32 * wid + r2;
#pragma unroll
      for (int mp = 0; mp < 2; ++mp) store_partial(F, khalf, 2 * head + mp, R, o[mp], ls[mp], r2, h2); }
}
template <int NH>
__device__ __forceinline__ void attn_gqa_unit(const Frame& F, int qh0, int kvh, int R0, int t0, int ntiles, int khalf, float bound) {
    const int lane = F.lane, wid = F.wid, r = lane & 31, h = lane >> 5;
    bf16x8 qf[NH][4];
#pragma unroll
    for (int hh = 0; hh < NH; ++hh) { const bf16_t* qp = F.ws<bf16_t>(WS_QG) + (size_t)((qh0 + hh) * NQB + (R0 >> 5) + wid) * 2048;
#pragma unroll
        for (int s = 0; s < 4; ++s) qf[hh][s] = *(const bf16x8*)(qp + ((2 * s + h) * 32 + r) * 8); }
    f32x16 o[NH][2]; float ls[NH]; f32x16 negm;
#pragma unroll
    for (int i = 0; i < 16; ++i) negm[i] = 0.f;
    attn_sweep<NH, 4, false, false>(F, qf, F.ws<bf16_t>(WS_KG) + (size_t)(kvh * NKT + t0) * 4096, F.ws<bf16_t>(WS_VG) + (size_t)(kvh * NKT + t0) * 4096, ntiles, negm, o, ls);
    { const int ln = lane_now(), r2 = ln & 31, h2 = ln >> 5, R = R0 + 32 * wid + r2;
#pragma unroll
      for (int hh = 0; hh < NH; ++hh) store_partial(F, khalf, 12 + qh0 + hh, R, o[hh], ls[hh], r2, h2); }
}

__device__ __forceinline__ void phase_attn(const Frame& F, int l, int rep) {
    if (F.wid >= 4) __builtin_amdgcn_s_setprio(1);
    float gqm = 0.f, gkm = 0.f; { const float* gq = F.in(I_GQ) + 64 * l; const float* gk = F.in(I_GK) + 64 * l; for (int i = 0; i < 64; ++i) { gqm = fmaxf(gqm, fabsf(gq[i])); gkm = fmaxf(gkm, fabsf(gk[i])); } }
    const float bg = fminf(8.f * gqm * gkm * LOG2E * 1.01f, 100.f);
    for (int mp = F.wid; mp < 12; mp += 8) { const float* kp = F.ws<float>(WS_KP) + (size_t)(l * 12 + mp) * 1024; float mx = 0.f;
#pragma unroll
        for (int q = 0; q < 4; ++q) { const f32x4 v = *(const f32x4*)(kp + 256 * q + 4 * F.lane); mx = fmaxf(fmaxf(mx, fmaxf(v[0], v[1])), fmaxf(v[2], v[3])); }
        mx = wave_max(mx); mx = fmaxf(mx, __uint_as_float(__hip_atomic_load(F.ctl + CW_KMAX + 16 * l + mp, __ATOMIC_RELAXED, __HIP_MEMORY_SCOPE_AGENT)));
        if (F.lane == 0) ((LAS float*)(F.lds + LDS_CTL + 1024))[mp] = mx; }
    __syncthreads();
    constexpr int HT = NKT / 2;
    for (int u = F.bid; u < 256; u += F.G) { const int cb = (u & 7) >> 1, rb = ((u >> 3) << 1) | (u & 1), R0 = NCTX + 256 * rb; const int kvh = cb >> 1, kh = cb & 1;
        attn_gqa_unit<2>(F, 3 * kvh, kvh, R0, kh * HT, HT, kh, bg); }
    for (int u = F.bid; u < 768; u += F.G) { const int j = u >> 8, v = u & 255, cb = 4 * j + ((v & 7) >> 1), rb = ((v >> 3) << 1) | (v & 1), R0 = NCTX + 256 * rb; const int head = cb >> 1, kh = cb & 1;
        attn_diff_unit(F, l, head, R0, kh * HT, HT, kh); }
    for (int u = F.bid; u < 256; u += F.G) { const int cb = (u & 7) >> 1, rb = ((u >> 3) << 1) | (u & 1), R0 = NCTX + 256 * rb; const int kvh = cb >> 1, kh = cb & 1;
        attn_gqa_unit<1>(F, 3 * kvh + 2, kvh, R0, kh * HT, HT, kh, bg); }
    for (int u = F.bid; u < 256; u += F.G) { const int l2 = u >> 1, ch = u & 1;
        dft_unit<128, 0>(F, F.ws<bf16_t>(WS_A1F), F.ws<bf16_t>(WS_FT) + (size_t)(l2 * 2 + ch) * 4 * 4096, l2, ch, 0); }
    if (l == 0) {
        for (int u = F.bid; u < 14; u += F.G) {
            if (u < 4) { const int pa = u >> 1, ch = u & 1; dft_unit<256, 2>(F, F.ws<bf16_t>(WS_ACF) + (size_t)pa * 65536, F.ws<bf16_t>(WS_FC) + (size_t)ch * 4 * 8192, 0, ch, pa); }
            else if (u < 10) attn_diff_unit(F, l, u - 4, 0, 0, NCTX / 64, 0);
            else if (u < 12) attn_gqa_unit<2>(F, 3 * (u - 10), u - 10, 0, 0, NCTX / 64, 0, bg);
            else attn_gqa_unit<1>(F, 3 * (u - 12) + 2, u - 12, 0, 0, NCTX / 64, 0, bg);
        }
    }
    __builtin_amdgcn_s_setprio(0);
}
__device__ __forceinline__ void unpack8(const u32x4& w, float (&f)[8]) { f[0] = bflo(w[0]); f[1] = bfhi(w[0]); f[2] = bflo(w[1]); f[3] = bfhi(w[1]); f[4] = bflo(w[2]); f[5] = bfhi(w[2]); f[6] = bflo(w[3]); f[7] = bfhi(w[3]); }
__device__ __forceinline__ void attn_merge(const Frame& F, int l) {
    const int lane = F.lane, un = lane >> 3, dc = lane & 7; const bool act = lane < 48;
    const float* lq1 = F.in(I_LQ1) + 32 * l; const float* lk1 = F.in(I_LK1) + 32 * l; const float* lq2 = F.in(I_LQ2) + 32 * l; const float* lk2 = F.in(I_LK2) + 32 * l;
    float d1 = 0.f, d2 = 0.f; for (int i = 0; i < 32; ++i) { d1 += lq1[i] * lk1[i]; d2 += lq2[i] * lk2[i]; }
    const float lam_init = 0.8f - 0.6f * expf(-0.3f * (float)l); const float lam = expf(d1) - expf(d2) + lam_init, post = 1.f - lam_init;
    float gs[8]; { const float* g = F.in(I_GSUB) + 64 * l + 8 * dc; for (int j = 0; j < 8; ++j) gs[j] = g[j]; }
    const bf16_t* part = F.ws<bf16_t>(WS_PART); const float* pl = F.ws<float>(WS_PL); bf16_t* mix = F.ws<bf16_t>(WS_MIX);
    const int Rbeg = l == 0 ? 0 : NCTX; const int u6 = act ? un : 0;
    for (int R = Rbeg + F.bid * 8 + F.wid; R < NT; R += F.G * 8) {
        const bool two = R >= NCTX; bf16_t* mr = mix + (size_t)R * MIXK;
        const bf16_t* ra = part + (size_t)R * 2 * PREC; const bf16_t* rb = ra + PREC; const float* la = pl + (size_t)R * 2 * N_PSLOT; const float* lb = la + N_PSLOT;
        { const u32x4 a0 = *(const u32x4*)(ra + (u6 * 8 + dc) * 16), a1 = *(const u32x4*)(ra + (u6 * 8 + dc) * 16 + 8);
          u32x4 b0 = {0u, 0u, 0u, 0u}, b1 = b0; float lb0 = 0.f, lb1 = 0.f;
          if (two) { b0 = *(const u32x4*)(rb + (u6 * 8 + dc) * 16); b1 = *(const u32x4*)(rb + (u6 * 8 + dc) * 16 + 8); lb0 = lb[2 * u6]; lb1 = lb[2 * u6 + 1]; }
          const float la0 = la[2 * u6], la1 = la[2 * u6 + 1]; const float i0 = 1.f / (la0 + lb0), i1 = lam / (la1 + lb1);
          float fa0[8], fa1[8], fb0[8], fb1[8], v[8]; unpack8(a0, fa0); unpack8(a1, fa1); unpack8(b0, fb0); unpack8(b1, fb1);
          float ss = 0.f;
#pragma unroll
          for (int j = 0; j < 8; ++j) { v[j] = (la0 * fa0[j] + lb0 * fb0[j]) * i0 - (la1 * fa1[j] + lb1 * fb1[j]) * i1; ss += v[j] * v[j]; }
          ss += shxc<1>(ss); ss += shxc<2>(ss); ss += shxc<4>(ss);
          const float rs = rsqrtf(ss * (1.f / 64.f) + 1e-5f) * post;
          if (act) { u32x4 w = {pk2(v[0] * rs * gs[0], v[1] * rs * gs[1]), pk2(v[2] * rs * gs[2], v[3] * rs * gs[3]), pk2(v[4] * rs * gs[4], v[5] * rs * gs[5]), pk2(v[6] * rs * gs[6], v[7] * rs * gs[7])};
              *(u32x4*)(mr + 512 + 64 * un + 8 * dc) = w; } }
        { const u32x4 a0 = *(const u32x4*)(ra + 768 + u6 * 64 + dc * 8); u32x4 b0 = {0u, 0u, 0u, 0u}; float lbq = 0.f;
          if (two) { b0 = *(const u32x4*)(rb + 768 + u6 * 64 + dc * 8); lbq = lb[12 + u6]; }
          const float laq = la[12 + u6], iq = 1.f / (laq + lbq); float fa[8], fb[8]; unpack8(a0, fa); unpack8(b0, fb);
          if (act) { float o[8];
#pragma unroll
              for (int j = 0; j < 8; ++j) o[j] = (laq * fa[j] + lbq * fb[j]) * iq;
              u32x4 w = {pk2(o[0], o[1]), pk2(o[2], o[3]), pk2(o[4], o[5]), pk2(o[6], o[7])}; *(u32x4*)(mr + 896 + 64 * un + 8 * dc) = w; } }
    }
}
__device__ __forceinline__ void phase_fft2(const Frame& F, int l) {
    for (int u = F.bid; u < 256; u += F.G) { const int k1 = u >> 1, ch = u & 1;
        dft_unit<256, 1>(F, F.ws<bf16_t>(WS_A2F), F.ws<bf16_t>(WS_T2) + (size_t)(k1 * 2 + ch) * 4 * 8192, k1, ch, 0); }
    attn_merge(F, l);
}

__device__ __forceinline__ void phase_router(const Frame& F, int l) {
    LAS float* wl = (LAS float*)F.lds;
    LAS unsigned* hist = (LAS unsigned*)(F.lds + 131072);
    LAS unsigned* recs = hist + 64;
    const int lane = F.lane, wid = F.wid, t = F.tid;
    const float* wr = F.in(I_WR) + (size_t)l * 1024 * 32;
    __syncthreads();
    for (int i = t; i < 8192; i += 512) { const int k = i >> 3, c = i & 7; const f32x4 v = *(const f32x4*)(wr + k * 32 + 4 * c); *(LAS f32x4*)(wl + k * 32 + 4 * (c ^ ((k >> 2) & 7))) = v; }
    if (t < 64) hist[t] = 0u;
    __syncthreads();
    const int Rbeg = l == 0 ? 0 : NCTX, ntok = NT - Rbeg, per = (ntok + F.G - 1) / F.G;
    const int r0 = Rbeg + F.bid * per, r1 = min(r0 + per, NT);
    const float* mod = F.ws<float>(WS_MOD) + (size_t)l * 2 * 6144; const float* g2 = F.in(I_GN2) + 1024 * l; const float* br = F.in(I_BR) + 32 * l;
    const float* xs = F.ws<float>(WS_XS); bf16_t* hb = F.ws<bf16_t>(WS_HB);
    unsigned* slot = F.ws<unsigned>(WS_SLOT); float* gate = F.ws<float>(WS_GATE);
    for (int R = r0 + wid; R < r1; R += 8) {
        const float* m = mod + (R < NCTX ? 6144 : 0);
        f32x4 x[4], hv[4]; load_row(xs + (size_t)R * DM, lane, x); const float rstd = row_rstd(x, 1e-6f);
        mod_store_bf16(x, rstd, g2, m + 3072, m + 4096, hb + (size_t)R * DM, lane, &hv);
        float acc[32];
#pragma unroll
        for (int e = 0; e < 32; ++e) acc[e] = 0.f;
#pragma unroll
        for (int q = 0; q < 4; ++q)
#pragma unroll
            for (int i = 0; i < 4; ++i) { const int k = 256 * q + 4 * lane + i; const float hx = hv[q][i]; const int sw = (k >> 2) & 7;
#pragma unroll
                for (int c = 0; c < 8; ++c) { const f32x4 w = *(LAS const f32x4*)(wl + k * 32 + 4 * (c ^ sw));
                    acc[4 * c] += hx * w[0]; acc[4 * c + 1] += hx * w[1]; acc[4 * c + 2] += hx * w[2]; acc[4 * c + 3] += hx * w[3]; } }
        float a16[16], a8[8], a4[4], a2[2], a1;
        { const bool b = lane & 32;
#pragma unroll
          for (int j = 0; j < 16; ++j) { const float keep = b ? acc[16 + j] : acc[j], send = b ? acc[j] : acc[16 + j]; a16[j] = keep + partner32(send, b); } }
        { const bool b = lane & 16;
#pragma unroll
          for (int j = 0; j < 8; ++j) { const float keep = b ? a16[8 + j] : a16[j], send = b ? a16[j] : a16[8 + j]; a8[j] = keep + shxc<16>(send); } }
        { const bool b = lane & 8;
#pragma unroll
          for (int j = 0; j < 4; ++j) { const float keep = b ? a8[4 + j] : a8[j], send = b ? a8[j] : a8[4 + j]; a4[j] = keep + shxc<8>(send); } }
        { const bool b = lane & 4;
#pragma unroll
          for (int j = 0; j < 2; ++j) { const float keep = b ? a4[2 + j] : a4[j], send = b ? a4[j] : a4[2 + j]; a2[j] = keep + shxc<4>(send); } }
        { const bool b = lane & 2; const float keep = b ? a2[1] : a2[0], send = b ? a2[0] : a2[1]; a1 = keep + shxc<2>(send); }
        a1 += shxc<1>(a1);
        const int e = lane >> 1; float v = a1 + br[e];
        float tv[4]; int te[4];
#pragma unroll
        for (int kk = 0; kk < 4; ++kk) { const float mx = wave_max(v); const unsigned long long bal = __ballot(v == mx); const int ln = __ffsll((long long)bal) - 1; te[kk] = ln >> 1; tv[kk] = mx; if (e == te[kk]) v = -INFINITY; }
        const float e1 = __expf(tv[1] - tv[0]), e2 = __expf(tv[2] - tv[0]), e3 = __expf(tv[3] - tv[0]); const float inv = 1.f / (1.f + e1 + e2 + e3);
        if (lane < 4) { const int ee = lane == 0 ? te[0] : lane == 1 ? te[1] : lane == 2 ? te[2] : te[3]; const float gg = (lane == 0 ? 1.f : lane == 1 ? e1 : lane == 2 ? e2 : e3) * inv;
            const unsigned lr = atomicAdd((unsigned*)(hist + ee), 1u);
            const int ti = R - r0; recs[ti * 4 + lane] = ((unsigned)ee << 24) | lr; gate[(size_t)R * 4 + lane] = gg; }
    }
    __syncthreads();
    if (t < 32) { const unsigned c = hist[t]; hist[32 + t] = c ? xb_add(F.ctl + CW_CNT + 64 * l + t, c) : 0u; }
    __syncthreads();
    unsigned* list = F.ws<unsigned>(WS_LIST);
    for (int i = t; i < (r1 - r0) * 4; i += 512) { const unsigned rec = recs[i]; const unsigned ee = rec >> 24, rk = (rec & 0xffffffu) + hist[32 + ee]; const int R = r0 + (i >> 2);
        slot[(size_t)R * 4 + (i & 3)] = (ee << 24) | rk; list[(size_t)ee * NT + rk] = (unsigned)R; }
    __syncthreads();
}

__device__ __forceinline__ void phase_combine(const Frame& F, int l) {
    const int lane = F.lane; const float* mod = F.ws<float>(WS_MOD) + (size_t)l * 2 * 6144; const float* modn = F.ws<float>(WS_MOD) + (size_t)(l + 1) * 2 * 6144;
    float* xs = F.ws<float>(WS_XS); const bf16_t* yb = F.ws<bf16_t>(WS_YB); const unsigned* slot = F.ws<unsigned>(WS_SLOT); const float* gate = F.ws<float>(WS_GATE); bf16_t* hb = F.ws<bf16_t>(WS_HB);
    int offs = 0;
    { const int ce = lane < NEXP ? (int)__hip_atomic_load(F.ctl + CW_CNT + 64 * l + lane, __ATOMIC_RELAXED, __HIP_MEMORY_SCOPE_AGENT) : 0;
      int inc = ce;
#pragma unroll
      for (int d = 1; d < 32; d <<= 1) { const int up = __builtin_amdgcn_ds_bpermute(((lane - d) & 63) << 2, inc); if (lane >= d) inc += up; }
      offs = inc - ce; }
    const int Rbeg = l == 0 ? 0 : NCTX; float* outb = F.outp(); const float* gn1 = F.in(I_GN1) + 1024; const float* gf = F.in(I_GFIN);
    for (int R = Rbeg + F.bid * 8 + F.wid; R < NT; R += F.G * 8) {
        const float* m = mod + (R < NCTX ? 6144 : 0);
        f32x4 x[4], a[4]; load_row(xs + (size_t)R * DM, lane, x);
#pragma unroll
        for (int q = 0; q < 4; ++q) a[q] = (f32x4){0.f, 0.f, 0.f, 0.f};
#pragma unroll
        for (int s = 0; s < 4; ++s) { const unsigned rec = slot[(size_t)R * 4 + s]; const float g = gate[(size_t)R * 4 + s]; const int pos = __builtin_amdgcn_ds_bpermute((int)((rec >> 24) << 2), offs) + (int)(rec & 0xffffffu);
            const bf16_t* yr = yb + (size_t)pos * DM;
#pragma unroll
            for (int q = 0; q < 4; ++q) { const u32x2 w = *(const u32x2*)(yr + 256 * q + 4 * lane); a[q][0] += g * bflo(w[0]); a[q][1] += g * bfhi(w[0]); a[q][2] += g * bflo(w[1]); a[q][3] += g * bfhi(w[1]); } }
#pragma unroll
        for (int q = 0; q < 4; ++q) { const f32x4 gt = *(const f32x4*)(m + 5120 + 256 * q + 4 * lane);
#pragma unroll
            for (int i = 0; i < 4; ++i) x[q][i] += gt[i] * a[q][i]; }
        const float rstd = row_rstd(x, 1e-6f);
        if (l == 0) {
#pragma unroll
            for (int q = 0; q < 4; ++q) *(f32x4*)(xs + (size_t)R * DM + 256 * q + 4 * lane) = x[q];
            const float* mn = modn + (R < NCTX ? 6144 : 0);
            mod_store_bf16(x, rstd, gn1, mn, mn + 1024, hb + (size_t)R * DM, lane);
        } else {
            float* orow = outb + (size_t)(R - NCTX) * DM;
#pragma unroll
            for (int q = 0; q < 4; ++q) { const f32x4 gv = *(const f32x4*)(gf + 256 * q + 4 * lane); f32x4 o;
#pragma unroll
                for (int i = 0; i < 4; ++i) o[i] = x[q][i] * rstd * gv[i];
                *(f32x4*)(orow + 256 * q + 4 * lane) = o; }
        }
    }
}

__device__ __forceinline__ int opaque_i32(int v) { asm volatile("" : "+s"(v)); return __builtin_amdgcn_readfirstlane(v); }
__device__ __forceinline__ unsigned long long opaque_u64(unsigned long long w) { int lo = (int)(unsigned)w, hi = (int)(unsigned)(w >> 32); lo = opaque_i32(lo); hi = opaque_i32(hi);
    return ((unsigned long long)(unsigned)hi << 32) | (unsigned)lo; }
__device__ __forceinline__ Frame fresh(const Frame& F) { Frame G = F;
    G.wsb = (unsigned char*)opaque_u64((unsigned long long)F.wsb); G.ctl = (unsigned*)opaque_u64((unsigned long long)F.ctl);
    G.pp = (const __attribute__((address_space(4))) Params*)opaque_u64((unsigned long long)F.pp);
    G.wid = opaque_i32(F.wid); G.bid = opaque_i32(F.bid); G.G = opaque_i32(F.G);
    G.lane = lane_now(); G.tid = G.wid * 64 + G.lane; return G; }
constexpr int N_PHASES = 18;
__global__ void __launch_bounds__(NTHREADS, 2) mk_fwd(Params P, int ph_lo, int ph_hi, int probe) {
    extern __shared__ __attribute__((aligned(16))) unsigned char smem_raw[];
    Frame F; F.pp = (const __attribute__((address_space(4))) Params*)__builtin_amdgcn_kernarg_segment_ptr(); F.wsb = P.ws; F.lds = (LAS char*)smem_raw; F.tid = threadIdx.x; F.lane = F.tid & 63; F.wid = __builtin_amdgcn_readfirstlane(F.tid >> 6); F.G = gridDim.x; F.bid = blockIdx.x;
    F.ctl = (unsigned*)(P.ws + WS_CTL);
    LAS unsigned* bw = (LAS unsigned*)(F.lds + LDS_CTL);
    if (F.tid < 4) bw[F.tid] = 0u;
    __syncthreads();
    XcdBarrier bar;
    if (MK_ONE_LAUNCH) bar = xcd_barrier_post(F.ctl + CW_BAR, (volatile LAS unsigned*)bw, F.wid);
#ifndef PHASE_MASK
#define PHASE_MASK 0xFFFFFFFFu
#endif
#if MK_ONE_LAUNCH
#define IN(k) (((PHASE_MASK >> ((k) >= 10 ? (k) - 8 : (k))) & 1u) != 0u)
#else
#define IN(k) (((PHASE_MASK >> ((k) >= 10 ? (k) - 8 : (k))) & 1u) && ph_lo <= (k) && (k) < ph_hi)
#endif
#define SEAM(k) do { if (MK_ONE_LAUNCH && IN(k) && IN((k) + 1)) xcd_barrier(bar); } while (0)
#define RUN(k, code, body) do { if (IN(k)) { const int nr_ = (opaque_i32(probe) == (code)) ? 2 : 1; _Pragma("unroll 1") for (int rep = 0; rep < nr_; ++rep) { body; if (MK_ONE_LAUNCH && rep + 1 < nr_) xcd_barrier(bar); } } SEAM(k); } while (0)
    RUN(0, 100, phase_prologue(fresh(F)));
    RUN(1, 101, phase_norm0(fresh(F)));
#pragma unroll 1
    for (int l = 0; l < 2; ++l) {
        const int b = 2 + 8 * l;
        RUN(b + 0, 0, phase_inproj(fresh(F), l));
        RUN(b + 1, 1, phase_attn(fresh(F), l, rep));
        RUN(b + 2, 2, phase_fft2(fresh(F), l));
        RUN(b + 3, 3 + 10 * l, phase_outproj(fresh(F), l));
        RUN(b + 4, 104, phase_router(fresh(F), l));
        RUN(b + 5, 5, phase_gateup(fresh(F), l));
        RUN(b + 6, 6, phase_down(fresh(F), l));
        RUN(b + 7, 17 - 10 * l, phase_combine(fresh(F), l));
    }
}

extern "C" void kernel_launch(void* const* d_in, const int* in_sizes, int n_in, void* d_out, int out_size, void* d_ws, size_t ws_size, hipStream_t stream) {
    static int grid = 0;
    if (!grid) {
        int dev = 0, cus = 0, per_cu = 0;
        hipGetDevice(&dev);
        hipDeviceGetAttribute(&cus, hipDeviceAttributeMultiprocessorCount, dev);
        hipFuncSetAttribute((const void*)mk_fwd, hipFuncAttributeMaxDynamicSharedMemorySize, LDS_BYTES);
        hipOccupancyMaxActiveBlocksPerMultiprocessor(&per_cu, (const void*)mk_fwd, NTHREADS, LDS_BYTES);
        if (per_cu < 1) { fprintf(stderr, "mk_fwd: occupancy query says %d blocks per CU\n", per_cu); per_cu = 1; }
        grid = cus * 1;
        if (ws_size < WS_END) fprintf(stderr, "mk_fwd: workspace too small (%zu < %zu)\n", ws_size, (size_t)WS_END);
    }
    hipMemsetAsync(d_ws, 0, CTL_BYTES, stream);
    Params p{};
    for (int i = 0; i < 25; ++i) p.in[i] = (const float*)d_in[i];
    p.out = (float*)d_out; p.ws = (unsigned char*)d_ws;
#if MK_ONE_LAUNCH
    hipLaunchKernelGGL(mk_fwd, dim3(grid), dim3(NTHREADS), LDS_BYTES, stream, p, 0, N_PHASES, MK_PROBE);
#else
    for (int k = 0; k < N_PHASES; ++k) hipLaunchKernelGGL(mk_fwd, dim3(grid), dim3(NTHREADS), LDS_BYTES, stream, p, k, k + 1, -1);
#endif
}
```

```cpp
#include <hip/hip_runtime.h>
#include <cstdio>
#include <cstdint>

#ifndef MK_PROBE
#define MK_PROBE -1
#endif
#ifndef MK_ONE_LAUNCH
#define MK_ONE_LAUNCH 1
#endif

#define LAS __attribute__((address_space(3)))
typedef unsigned short bf16_t;
typedef short bf16x8 __attribute__((ext_vector_type(8)));
typedef short s16x4 __attribute__((ext_vector_type(4)));
typedef float f32x16 __attribute__((ext_vector_type(16)));
typedef float f32x4 __attribute__((ext_vector_type(4)));
typedef float f32x2 __attribute__((ext_vector_type(2)));
typedef unsigned u32x4 __attribute__((ext_vector_type(4)));
typedef unsigned u32x2 __attribute__((ext_vector_type(2)));
typedef __bf16 bf16x2_t __attribute__((ext_vector_type(2)));
typedef short v4i16_t __attribute__((ext_vector_type(4)));

constexpr int DM = 1024, LSEQ = 16384, NCTX = 256, NT = LSEQ + NCTX, INW = 2048, NEXP = 32, FFD = 1024, MIXK = 1280;
constexpr int NKT = NT / 64;
constexpr int NQB = NT / 32;
constexpr float LOG2E = 1.4426950408889634f;
constexpr int NTHREADS = 512;
constexpr int LDS_BYTES = 155648;
constexpr int LDS_CTL = 151552;

constexpr size_t al256(size_t x) { return (x + 255) & ~(size_t)255; }
constexpr size_t WS_CTL = 0, CTL_BYTES = 1u << 20;
constexpr size_t WS_MOD = CTL_BYTES;
constexpr size_t WS_ROPE = WS_MOD + 131072;
constexpr size_t WS_TW = WS_ROPE + 65536;
constexpr size_t WS_A1F = WS_TW + 131072;
constexpr size_t WS_A2F = WS_A1F + 65536;
constexpr size_t WS_ACF = WS_A2F + 131072;
constexpr size_t WS_WIN = WS_ACF + 262144;
constexpr size_t WS_WOUT = WS_WIN + (size_t)2 * INW * DM * 2;
constexpr size_t WS_WGU = WS_WOUT + (size_t)2 * DM * MIXK * 2;
constexpr size_t WS_WDN = WS_WGU + (size_t)2 * NEXP * 2048 * DM * 2;
constexpr size_t WS_HB = WS_WDN + (size_t)2 * NEXP * DM * FFD * 2;
constexpr size_t WS_QD = WS_HB + (size_t)NT * DM * 2;
constexpr size_t WS_KD = WS_QD + (size_t)6 * NQB * 2048 * 2;
constexpr size_t WS_VD = WS_KD + (size_t)6 * NKT * 4096 * 2;
constexpr size_t WS_QG = WS_VD + (size_t)6 * NKT * 4096 * 2;
constexpr size_t WS_KG = WS_QG + (size_t)6 * NQB * 2048 * 2;
constexpr size_t WS_VG = WS_KG + (size_t)2 * NKT * 4096 * 2;
constexpr size_t WS_FT = WS_VG + (size_t)2 * NKT * 4096 * 2;
constexpr size_t WS_FC = WS_FT + (size_t)128 * 2 * 4 * 4096 * 2;
constexpr size_t WS_T2 = WS_FC + (size_t)2 * 4 * 8192 * 2;
constexpr size_t WS_MIX = WS_T2 + (size_t)128 * 2 * 4 * 8192 * 2;
constexpr size_t WS_XS = WS_MIX + (size_t)NT * MIXK * 2;
constexpr size_t WS_LIST = WS_XS + (size_t)NT * DM * 4;
constexpr size_t WS_SLOT = WS_LIST + (size_t)NEXP * NT * 4;
constexpr size_t WS_GATE = WS_SLOT + (size_t)NT * 16;
constexpr size_t WS_ACT = WS_GATE + (size_t)NT * 16;
constexpr size_t WS_YB = WS_ACT + (size_t)NT * 4 * FFD * 2;
constexpr size_t WS_PART = WS_YB + (size_t)NT * 4 * DM * 2;
constexpr size_t WS_PL = WS_PART + (size_t)36 * NT * 64 * 2;
constexpr size_t WS_KP = WS_PL + (size_t)36 * NT * 4;
constexpr size_t WS_END = WS_KP + (size_t)2 * 12 * 1024 * 4;

constexpr int CW_BAR = 4096;
constexpr int CW_CNT = 8192;
constexpr int CW_KMAX = 8320;
constexpr int CW_QH = 8448;

constexpr int RD_RC = 0, RD_RS = 2048, RD_CC = 4096, RD_CS = 4608, RG_RC = 5120, RG_RS = 9216, RG_CC = 13312, RG_CS = 14336, ROPE_N = 15360;

struct Params { const float* in[25]; float* out; unsigned char* ws; };
enum { I_X = 0, I_C, I_CTX, I_CCTX, I_WMOD, I_BMOD, I_GN1, I_GN2, I_WIN, I_WOUT, I_WFNET, I_LQ1, I_LK1, I_LQ2, I_LK2, I_GSUB, I_GQ, I_GK, I_WR, I_BR, I_WGU, I_BGU, I_WDN, I_BDN, I_GFIN };

__device__ __forceinline__ unsigned pk2(float lo, float hi) { f32x2 v = {lo, hi}; bf16x2_t b = __builtin_convertvector(v, bf16x2_t); return __builtin_bit_cast(unsigned, b); }
__device__ __forceinline__ float bf2f(unsigned short u) { return __builtin_bit_cast(float, (unsigned)u << 16); }
__device__ __forceinline__ float bflo(unsigned u) { return __builtin_bit_cast(float, u << 16); }
__device__ __forceinline__ float bfhi(unsigned u) { return __builtin_bit_cast(float, u & 0xffff0000u); }
#define WAITV(n) asm volatile("s_waitcnt vmcnt(" #n ")" ::: "memory")
#define BAR_SYNC() do { asm volatile("s_waitcnt lgkmcnt(0)" ::: "memory"); __builtin_amdgcn_s_barrier(); asm volatile("" ::: "memory"); } while (0)
__device__ __forceinline__ void dma16(const void* g, LAS void* l) { __builtin_amdgcn_global_load_lds((const unsigned*)g, (LAS unsigned*)l, 16, 0, 0); }
__device__ __forceinline__ void glds16(const void* gsrc, unsigned lds_dst) { unsigned keep;
    asm volatile("s_mov_b32 %0, m0\n\ts_mov_b32 m0, %2\n\ts_nop 0\n\tglobal_load_lds_dwordx4 %1, off\n\ts_mov_b32 m0, %0" : "=&s"(keep) : "v"(gsrc), "s"(lds_dst) : "memory"); }
__device__ __forceinline__ s16x4 vtr(LAS const char* p) { return __builtin_bit_cast(s16x4, __builtin_amdgcn_ds_read_tr16_b64_v4i16((LAS v4i16_t*)p)); }
__device__ __forceinline__ int lane_now() { unsigned z = 0u; asm volatile("" : "+v"(z)); return (int)__builtin_amdgcn_mbcnt_hi(~0u, __builtin_amdgcn_mbcnt_lo(~0u, z)); }
template <int M> __device__ __forceinline__ float shxc(float v) { return __builtin_bit_cast(float, __builtin_amdgcn_ds_bpermute((lane_now() ^ M) << 2, __builtin_bit_cast(int, v))); }
__device__ __forceinline__ float add32(float v) { return v + shxc<32>(v); }
__device__ __forceinline__ float max32(float v) { return fmaxf(v, shxc<32>(v)); }
__device__ __forceinline__ float partner32(float v, bool upper) { return shxc<32>(v); }
template <int CTRL, int ROWMASK, bool BC> __device__ __forceinline__ float dppf(float old, float src) {
    return __builtin_bit_cast(float, __builtin_amdgcn_update_dpp(__builtin_bit_cast(int, old), __builtin_bit_cast(int, src), CTRL, ROWMASK, 0xf, BC)); }
__device__ __forceinline__ float wave_sum(float v) {
    v += dppf<0x111, 0xf, true>(0.f, v); v += dppf<0x112, 0xf, true>(0.f, v); v += dppf<0x114, 0xf, true>(0.f, v); v += dppf<0x118, 0xf, true>(0.f, v);
    v += dppf<0x142, 0xa, false>(0.f, v); v += dppf<0x143, 0xc, false>(0.f, v);
    return __builtin_bit_cast(float, __builtin_amdgcn_readlane(__builtin_bit_cast(int, v), 63)); }
__device__ __forceinline__ float wave_max(float v) {
    v = fmaxf(v, dppf<0x111, 0xf, false>(v, v)); v = fmaxf(v, dppf<0x112, 0xf, false>(v, v)); v = fmaxf(v, dppf<0x114, 0xf, false>(v, v)); v = fmaxf(v, dppf<0x118, 0xf, false>(v, v));
    v = fmaxf(v, dppf<0x142, 0xa, false>(v, v)); v = fmaxf(v, dppf<0x143, 0xc, false>(v, v));
    return __builtin_bit_cast(float, __builtin_amdgcn_readlane(__builtin_bit_cast(int, v), 63)); }
__device__ __forceinline__ bf16x8 pack8(float a0, float a1, float a2, float a3, float a4, float a5, float a6, float a7) {
    u32x4 w = {pk2(a0, a1), pk2(a2, a3), pk2(a4, a5), pk2(a6, a7)}; return __builtin_bit_cast(bf16x8, w); }
#define MFMA(a, b, c) __builtin_amdgcn_mfma_f32_32x32x16_bf16((a), (b), (c), 0, 0, 0)

#define XB_TMO      128
#define XB_XCNT(j)  (256  + 64 * (j))
#define XB_XSUB(j)  (1280 + 64 * (j))
#define XB_XGEN(j)  (2304 + 64 * (j))
#define XB_TOP      3328
#define XB_TOPGEN   3392
#define XCD_BAR_WORDS 3456
#define XB_SPIN_CAP (1u << 22)
__device__ __forceinline__ unsigned xb_ld(unsigned* p)              { return __hip_atomic_load(p, __ATOMIC_RELAXED, __HIP_MEMORY_SCOPE_AGENT); }
__device__ __forceinline__ unsigned xb_add(unsigned* p, unsigned v) { return __hip_atomic_fetch_add(p, v, __ATOMIC_RELAXED, __HIP_MEMORY_SCOPE_AGENT); }
__device__ __forceinline__ unsigned xb_xcc_id() { return (unsigned)__builtin_amdgcn_s_getreg((3 << 11) | 20) & 0xFu; }
#define XB_SPIN(cond, bar) do { unsigned _sp = 0; while (cond) { __builtin_amdgcn_s_sleep(1); \
    if ((++_sp & 255u) == 0u) { if (xb_ld(&(bar)[XB_TMO])) break; if (_sp > XB_SPIN_CAP) { atomicAdd(&(bar)[XB_TMO], 1u); break; } } } } while (0)
struct XcdBarrier { unsigned* bar; unsigned x; volatile LAS unsigned* st; int wid; };
__device__ __forceinline__ bool xb_leader(int wid) { unsigned z = 0u; asm volatile("" : "+v"(z)); return wid == 0 && __builtin_amdgcn_mbcnt_hi(~0u, __builtin_amdgcn_mbcnt_lo(~0u, z)) == 0u; }
__device__ __forceinline__ XcdBarrier xcd_barrier_post(unsigned* bar, volatile LAS unsigned* st, int wid) {
    XcdBarrier b; b.bar = bar; b.x = xb_xcc_id(); b.st = st; b.wid = wid;
    if (xb_leader(wid)) (void)xb_add(&bar[XB_XCNT(b.x)], 1u);
    return b;
}
__device__ __forceinline__ void xcd_barrier_complete(unsigned* bar, unsigned x, unsigned& nloc, unsigned& nx) {
    const unsigned G = gridDim.x * gridDim.y * gridDim.z;
    unsigned sum, cnt, mine, sp = 0u;
    for (;;) {
        sum = 0u; cnt = 0u; mine = 0u;
#pragma unroll
        for (unsigned j = 0; j < 16; ++j) { const unsigned c = xb_ld(&bar[XB_XCNT(j)]); sum += c; cnt += (c > 0u) ? 1u : 0u; }
        mine = xb_ld(&bar[XB_XCNT(x)]);
        if (sum == G) break;
        __builtin_amdgcn_s_sleep(1);
        if ((++sp & 255u) == 0u) { if (xb_ld(&bar[XB_TMO])) break; if (sp > XB_SPIN_CAP) { atomicAdd(&bar[XB_TMO], 1u); break; } }
    }
    nloc = mine > 0u ? mine : 1u; nx = cnt > 0u ? cnt : 1u;
}
__device__ __forceinline__ void xcd_barrier(const XcdBarrier& b) {
    asm volatile("s_waitcnt vmcnt(0)" ::: "memory");
    __syncthreads();
    if (xb_leader(b.wid)) {
        unsigned* bar = b.bar;
        __builtin_amdgcn_s_waitcnt(0);
        unsigned nloc = b.st[0], nx = b.st[1];
        if (nloc == 0u) { xcd_barrier_complete(bar, b.x, nloc, nx); b.st[0] = nloc; b.st[1] = nx; }
        const unsigned old = xb_add(&bar[XB_XSUB(b.x)], 1u);
        const unsigned gen = old / nloc;
        if (old + 1u == (gen + 1u) * nloc) {
            __builtin_amdgcn_fence(__ATOMIC_RELEASE, "agent");
            asm volatile("s_waitcnt vmcnt(0)" ::: "memory");
            const unsigned og = xb_add(&bar[XB_TOP], 1u);
            const unsigned tg = og / nx;
            if (og + 1u == (tg + 1u) * nx) xb_add(&bar[XB_TOPGEN], 1u);
            else XB_SPIN(xb_ld(&bar[XB_TOPGEN]) == tg, bar);
            __builtin_amdgcn_fence(__ATOMIC_ACQUIRE, "agent");
            xb_add(&bar[XB_XGEN(b.x)], 1u);
            asm volatile("s_waitcnt vmcnt(0)" ::: "memory");
        } else {
            XB_SPIN(xb_ld(&bar[XB_XGEN(b.x)]) == gen, bar);
            __builtin_amdgcn_fence(__ATOMIC_ACQUIRE, "agent");
            asm volatile("s_waitcnt vmcnt(0)" ::: "memory");
        }
    }
    __syncthreads();
}

struct Frame {
    const __attribute__((address_space(4))) Params* pp; unsigned char* wsb; LAS char* lds; int tid, lane, wid, G, bid;
    unsigned* ctl;
    __device__ __forceinline__ const float* in(int i) const { return pp->in[i]; }
    __device__ __forceinline__ float* outp() const { return pp->out; }
    template <class T> __device__ __forceinline__ T* ws(size_t off) const { return (T*)(wsb + off); }
};

template <class RowMap>
__device__ __forceinline__ void transpose_tile(const Frame& F, const float* __restrict__ src, int ldn, int k0, int n0, bf16_t* dst, int ldk, int kdst0, const RowMap& rm) {
    LAS float* tile = (LAS float*)F.lds;
    const int t = F.tid;
    f32x4 v[8];
#pragma unroll
    for (int i = 0; i < 8; ++i) { const int idx = t + 512 * i, k = idx >> 6, c4 = idx & 63; v[i] = *(const f32x4*)(src + (size_t)(k0 + k) * ldn + n0 + 4 * c4); }
#pragma unroll
    for (int i = 0; i < 8; ++i) { const int idx = t + 512 * i, k = idx >> 6, c4 = idx & 63; *(LAS f32x4*)(tile + k * 260 + 4 * c4) = v[i]; }
    __syncthreads();
    { const int n = t >> 1, kh = t & 1; bf16_t* d = dst + (size_t)rm(n0 + n) * ldk + kdst0 + 32 * kh;
#pragma unroll
      for (int q = 0; q < 4; ++q) { float a[8];
#pragma unroll
          for (int j = 0; j < 8; ++j) a[j] = tile[(32 * kh + 8 * q + j) * 260 + n];
          u32x4 w = {pk2(a[0], a[1]), pk2(a[2], a[3]), pk2(a[4], a[5]), pk2(a[6], a[7])}; *(u32x4*)(d + 8 * q) = w; } }
    __syncthreads();
}
struct RowId { __device__ __forceinline__ int operator()(int n) const { return n; } };
struct RowGU { __device__ __forceinline__ int operator()(int n) const { const int ri = n >> 10, j = n & 1023; return 64 * (j >> 5) + 32 * ri + (j & 31); } };

constexpr int P0_GEMV = 192, P0_FOLD = 128, P0_TAB = 16;
constexpr int P0_TWIN = 2 * 16 * 8, P0_TWOUT = 2 * 12 * 4, P0_TWGU = 2 * 32 * 16 * 8, P0_TWDN = 2 * 32 * 16 * 4;
constexpr int P0_ITEMS = P0_GEMV + P0_FOLD + P0_TAB + P0_TWIN + P0_TWOUT + P0_TWGU + P0_TWDN;

__device__ __forceinline__ void p0_gemv(const Frame& F, int item) {
    const int l = item / 96, cc = item % 96, t = F.tid, lane = F.lane, w = F.wid;
    LAS float* sc = (LAS float*)F.lds;
    LAS float* red = sc + 2048;
    const float* c = F.in(I_C); const float* cx = F.in(I_CCTX);
#pragma unroll
    for (int i = 0; i < 2; ++i) { const int k = t + 512 * i; const float a = c[k], b = cx[k]; sc[k] = a / (1.f + __expf(-a)); sc[1024 + k] = b / (1.f + __expf(-b)); }
    __syncthreads();
    const int col = 64 * cc + lane; const float* wm = F.in(I_WMOD) + (size_t)l * 1024 * 6144 + col;
    float a1 = 0.f, a2 = 0.f;
#pragma unroll 8
    for (int k = 128 * w; k < 128 * w + 128; ++k) { const float wv = wm[(size_t)k * 6144]; a1 += sc[k] * wv; a2 += sc[1024 + k] * wv; }
    red[w * 64 + lane] = a1; red[512 + w * 64 + lane] = a2;
    __syncthreads();
    if (w == 0) { float s1 = 0.f, s2 = 0.f;
#pragma unroll
        for (int j = 0; j < 8; ++j) { s1 += red[j * 64 + lane]; s2 += red[512 + j * 64 + lane]; }
        const float b = F.in(I_BMOD)[l * 6144 + col]; float* mod = F.ws<float>(WS_MOD) + (size_t)l * 2 * 6144;
        mod[col] = s1 + b; mod[6144 + col] = s2 + b; }
    __syncthreads();
}
__device__ __forceinline__ void p0_fold(const Frame& F, int item) {
    const int nch = item & 7, g = (item >> 3) & 3, ri = (item >> 5) & 1, l = item >> 6, t = F.tid;
    LAS float* Mx = (LAS float*)F.lds;
    LAS float* wf = Mx + 64 * 65;
    const float* wfn = F.in(I_WFNET) + (size_t)(l * 4 + g) * 4096;
    for (int i = t; i < 4096; i += 512) wf[(i >> 6) * 65 + (i & 63)] = wfn[i];
    __syncthreads();
    for (int i = t; i < 4096; i += 512) { const int c = i >> 6, e = i & 63; float s = 0.f;
        for (int m = 0; m < 64; ++m) { float sn, cs; sincospif(2.f * (float)((m * c) & 63) / 64.f, &sn, &cs); s += (ri ? sn : cs) * wf[m * 65 + e]; }
        Mx[c * 65 + e] = s; }
    __syncthreads();
    const float* wo = F.in(I_WOUT) + (size_t)l * 1024 * 1024 + (size_t)(64 * g) * 1024;
    bf16_t* dst = F.ws<bf16_t>(WS_WOUT) + (size_t)l * DM * MIXK;
    { const int n = nch * 128 + (t & 127), c0 = (t >> 7) * 16; float acc[16];
#pragma unroll
      for (int j = 0; j < 16; ++j) acc[j] = 0.f;
      for (int e = 0; e < 64; ++e) { const float wv = wo[(size_t)e * 1024 + n];
#pragma unroll
          for (int j = 0; j < 16; ++j) acc[j] += Mx[(c0 + j) * 65 + e] * wv; }
      u32x4 w0 = {pk2(acc[0], acc[1]), pk2(acc[2], acc[3]), pk2(acc[4], acc[5]), pk2(acc[6], acc[7])};
      u32x4 w1 = {pk2(acc[8], acc[9]), pk2(acc[10], acc[11]), pk2(acc[12], acc[13]), pk2(acc[14], acc[15])};
      bf16_t* d = dst + (size_t)n * MIXK + 256 * ri + 64 * g + c0; *(u32x4*)d = w0; *(u32x4*)(d + 8) = w1; }
    __syncthreads();
}
__device__ __forceinline__ void p0_tables(const Frame& F, int item) {
    constexpr int N0 = ROPE_N, N1 = N0 + 16384, N2 = N1 + 32768, N3 = N2 + 65536, N4 = N3 + 131072;
    float* rope = F.ws<float>(WS_ROPE); f32x2* tw = F.ws<f32x2>(WS_TW);
    bf16_t* a1 = F.ws<bf16_t>(WS_A1F); bf16_t* a2 = F.ws<bf16_t>(WS_A2F); bf16_t* ac = F.ws<bf16_t>(WS_ACF);
    for (int idx = item * 512 + F.tid; idx < N4; idx += P0_TAB * 512) {
        if (idx < N0) {
            int i = idx; bool isg = false; if (i >= RG_RC) { isg = true; i -= RG_RC; }
            const int n = isg ? 16 : 8, rowsz = 256 * n, colsz = 64 * n;
            int which, pos, fi;
            if (i < rowsz) { which = 0; pos = i / n; fi = i % n; } else if (i < 2 * rowsz) { which = 1; i -= rowsz; pos = i / n; fi = i % n; }
            else if (i < 2 * rowsz + colsz) { which = 2; i -= 2 * rowsz; pos = i / n; fi = i % n; } else { which = 3; i -= 2 * rowsz + colsz; pos = i / n; fi = i % n; }
            const float inv = powf(10000.f, -(float)fi / (float)n); const float ang = (float)pos * inv;
            rope[idx] = (which & 1) ? sinf(ang) : cosf(ang);
        } else if (idx < N1) { const int j = idx - N0; float sn, cs; sincospif(2.f * (float)j / 16384.f, &sn, &cs); tw[j] = (f32x2){cs, sn};
        } else if (idx < N2) { const int e = idx - N1; const int j = e & 7, ln = (e >> 3) & 63, s = (e >> 9) & 7, fb = (e >> 12) & 1, rg = e >> 13;
            const int k1 = 32 * rg + (ln & 31), l1 = 16 * s + 8 * (ln >> 5) + j; float sn, cs; sincospif(2.f * (float)((k1 * l1) & 127) / 128.f, &sn, &cs);
            a1[e] = (bf16_t)(pk2(fb ? -sn : cs, 0.f) & 0xffff);
        } else if (idx < N3) { const int e = idx - N2; const int j = e & 7, ln = (e >> 3) & 63, s = (e >> 9) & 15, fb = (e >> 13) & 1, rg = e >> 14;
            const int k2 = 32 * rg + (ln & 31), kk = 16 * s + 8 * (ln >> 5) + j, l2 = kk >> 1, rip = kk & 1; float sn, cs; sincospif(2.f * (float)((k2 * l2) & 127) / 128.f, &sn, &cs);
            const float v = fb == 0 ? (rip == 0 ? cs : sn) : (rip == 0 ? -sn : cs);
            a2[e] = (bf16_t)(pk2(v, 0.f) & 0xffff);
        } else { const int e = idx - N3; const int j = e & 7, ln = (e >> 3) & 63, s = (e >> 9) & 15, fb = (e >> 13) & 1, rg = (e >> 14) & 3, pa = e >> 16;
            const int k = 128 * pa + 32 * rg + (ln & 31), li = 16 * s + 8 * (ln >> 5) + j; float sn, cs; sincospif(2.f * (float)((k * li) & 255) / 256.f, &sn, &cs);
            ac[e] = (bf16_t)(pk2(fb ? -sn : cs, 0.f) & 0xffff); }
    }
}
__device__ __forceinline__ void phase_prologue(const Frame& F) {
    LAS unsigned* qw = (LAS unsigned*)(F.lds + LDS_CTL + 64);
    unsigned nxt = 0u; if (F.tid == 0) nxt = xb_add(F.ctl + CW_QH + 32, 1u);
    for (;;) {
        __syncthreads();
        if (F.tid == 0) *qw = nxt;
        __syncthreads();
        const int it = (int)*qw; if (it >= P0_ITEMS) break;
        if (F.tid == 0) nxt = xb_add(F.ctl + CW_QH + 32, 1u);
        int i = it;
        if (i < P0_GEMV) { p0_gemv(F, i); continue; } i -= P0_GEMV;
        if (i < P0_FOLD) { p0_fold(F, i); continue; } i -= P0_FOLD;
        if (i < P0_TAB) { p0_tables(F, i); continue; } i -= P0_TAB;
        if (i < P0_TWIN) { const int l = i / 128, r = i % 128, kt = r / 8, nt = r % 8;
            transpose_tile(F, F.in(I_WIN) + (size_t)l * DM * INW, INW, 64 * kt, 256 * nt, F.ws<bf16_t>(WS_WIN) + (size_t)l * INW * DM, DM, 64 * kt, RowId()); continue; } i -= P0_TWIN;
        if (i < P0_TWOUT) { const int l = i / 48, r = i % 48, kt = r / 4, nt = r % 4;
            transpose_tile(F, F.in(I_WOUT) + (size_t)l * DM * DM, DM, 256 + 64 * kt, 256 * nt, F.ws<bf16_t>(WS_WOUT) + (size_t)l * DM * MIXK, MIXK, 512 + 64 * kt, RowId()); continue; } i -= P0_TWOUT;
        if (i < P0_TWGU) { const int le = i / 128, r = i % 128, kt = r / 8, nt = r % 8;
            transpose_tile(F, F.in(I_WGU) + (size_t)le * DM * 2048, 2048, 64 * kt, 256 * nt, F.ws<bf16_t>(WS_WGU) + (size_t)le * 2048 * DM, DM, 64 * kt, RowGU()); continue; } i -= P0_TWGU;
        { const int le = i / 64, r = i % 64, kt = r / 4, nt = r % 4;
            transpose_tile(F, F.in(I_WDN) + (size_t)le * FFD * DM, DM, 64 * kt, 256 * nt, F.ws<bf16_t>(WS_WDN) + (size_t)le * DM * FFD, FFD, 64 * kt, RowId()); }
    }
}

__device__ __forceinline__ void load_row(const float* row, int lane, f32x4 (&x)[4]) {
#pragma unroll
    for (int q = 0; q < 4; ++q) x[q] = *(const f32x4*)(row + 256 * q + 4 * lane);
}
__device__ __forceinline__ float row_rstd(const f32x4 (&x)[4], float eps) {
    float ss = 0.f;
#pragma unroll
    for (int q = 0; q < 4; ++q) ss += x[q][0] * x[q][0] + x[q][1] * x[q][1] + x[q][2] * x[q][2] + x[q][3] * x[q][3];
    ss = wave_sum(ss); return rsqrtf(ss * (1.f / 1024.f) + eps);
}
__device__ __forceinline__ void mod_store_bf16(const f32x4 (&x)[4], float rstd, const float* g, const float* shift, const float* scale, bf16_t* dst, int lane, f32x4 (*hout)[4] = nullptr) {
#pragma unroll
    for (int q = 0; q < 4; ++q) { const int k = 256 * q + 4 * lane;
        const f32x4 gv = *(const f32x4*)(g + k), sh = *(const f32x4*)(shift + k), sc = *(const f32x4*)(scale + k);
        f32x4 hv;
#pragma unroll
        for (int i = 0; i < 4; ++i) hv[i] = (x[q][i] * rstd * gv[i]) * (1.f + sc[i]) + sh[i];
        u32x2 w = {pk2(hv[0], hv[1]), pk2(hv[2], hv[3])}; *(u32x2*)(dst + k) = w;
        if (hout) (*hout)[q] = hv; }
}
__device__ __forceinline__ void phase_norm0(const Frame& F) {
    const float* mod = F.ws<float>(WS_MOD); bf16_t* hb = F.ws<bf16_t>(WS_HB); const float* g1 = F.in(I_GN1);
    const float* xc = F.in(I_CTX); const float* xl = F.in(I_X);
    for (int R = F.bid * 8 + F.wid; R < NT; R += F.G * 8) {
        const float* row = R < NCTX ? xc + (size_t)R * DM : xl + (size_t)(R - NCTX) * DM;
        const float* m = mod + (R < NCTX ? 6144 : 0);
        f32x4 x[4]; load_row(row, F.lane, x); const float rstd = row_rstd(x, 1e-6f);
        mod_store_bf16(x, rstd, g1, m, m + 1024, hb + (size_t)R * DM, F.lane);
    }
}

#define MFMA16(a, b, c) __builtin_amdgcn_mfma_f32_16x16x32_bf16((a), (b), (c), 0, 0, 0)
__device__ __forceinline__ int lds_byte(int r, int c) { const int st = (r >> 4) * 2 + (c >> 5), rr = r & 15, cc = c & 31, ob = rr * 64 + cc * 2; return st * 1024 + (ob ^ (((ob >> 9) & 1) << 5)); }
__device__ __forceinline__ void stage_rc(int b, int& R, int& C) { const int st = b / 1024, sb = b % 1024, swz = sb ^ (((sb >> 9) & 1) << 5); R = (st >> 1) * 16 + swz / 64; C = (st & 1) * 32 + (swz % 64) / 2; }
struct EpiC { f32x4 c[4]; };
struct EpiT { f32x4 t[4]; };
template <class XRow, class Epi>
__device__ __forceinline__ void gemm8(const Frame& F, const bf16_t* __restrict__ A, int K, int brow, const XRow& xrow, const Epi& epi) {
    constexpr int HTB = 16384;
    LAS char* shm = F.lds;
    const int tz = F.tid, wid = F.wid, lane = tz & 63, wr = wid >> 2, wc = wid & 3, fr = lane & 15, fq = lane >> 4;
    unsigned aoff[2]; const bf16_t* xp[2][2];
#pragma unroll
    for (int i = 0; i < 2; ++i) { int r, c; stage_rc(tz * 16 + i * 8192, r, c); aoff[i] = (unsigned)(r * K + c); xp[0][i] = xrow(r) + c; xp[1][i] = xrow(128 + r) + c; }
    const bf16_t* Ab = A + (size_t)brow * K; const size_t hstepA = (size_t)128 * K;
    const int ldsw = wid * 1024;
    const int aoffl = lds_byte(wr * 64 + fr, fq * 8), boffl = lds_byte(wc * 32 + fr, fq * 8);
#define SA(b, h) (shm + ((b) * 2 + (h)) * HTB)
#define SB(b, h) (shm + (4 + (b) * 2 + (h)) * HTB)
#define STAGE_A(b, h, kt) do { _Pragma("unroll") for (int i_ = 0; i_ < 2; ++i_) dma16(Ab + (h) * hstepA + aoff[i_] + (size_t)(kt) * 64, SA(b, h) + ldsw + i_ * 8192); } while (0)
#define STAGE_B(b, h, kt) do { _Pragma("unroll") for (int i_ = 0; i_ < 2; ++i_) dma16(xp[h][i_] + (size_t)(kt) * 64, SB(b, h) + ldsw + i_ * 8192); } while (0)
#define LDA(dst, b, h) do { _Pragma("unroll") for (int m = 0; m < 4; ++m) _Pragma("unroll") for (int k = 0; k < 2; ++k) dst[m][k] = *(LAS const bf16x8*)(SA(b, h) + aoffl + m * 2048 + k * 1024); } while (0)
#define LDB(dst, b, h) do { _Pragma("unroll") for (int n = 0; n < 2; ++n) _Pragma("unroll") for (int k = 0; k < 2; ++k) dst[n][k] = *(LAS const bf16x8*)(SB(b, h) + boffl + n * 2048 + k * 1024); } while (0)
#define MMA(ai, bj, At_, Bt_) do { __builtin_amdgcn_s_setprio(1); _Pragma("unroll") for (int m = 0; m < 4; ++m) _Pragma("unroll") for (int n = 0; n < 2; ++n) _Pragma("unroll") for (int k = 0; k < 2; ++k) \
        acc[ai][bj][m][n] = MFMA16(At_[m][k], Bt_[n][k], acc[ai][bj][m][n]); __builtin_amdgcn_s_setprio(0); } while (0)
#define WAIT_V(n) asm volatile("s_waitcnt vmcnt(" #n ")" ::: "memory")
#define WAIT_L(n) asm volatile("s_waitcnt lgkmcnt(" #n ")" ::: "memory")
#define BAR __builtin_amdgcn_s_barrier()
#define SCHED __builtin_amdgcn_sched_barrier(0)
    f32x4 acc[2][2][4][2];
#pragma unroll
    for (int a = 0; a < 2; ++a)
#pragma unroll
        for (int b = 0; b < 2; ++b)
#pragma unroll
            for (int m = 0; m < 4; ++m)
#pragma unroll
                for (int n = 0; n < 2; ++n) acc[a][b][m][n] = (f32x4){0.f, 0.f, 0.f, 0.f};
    bf16x8 At[4][2], B0[2][2], B1[2][2];
    const int nt = K / 64;
    WAIT_L(0); BAR;
    STAGE_B(0, 0, 0); STAGE_B(0, 1, 0); STAGE_A(0, 0, 0); STAGE_A(0, 1, 0);
    if (wr == 1) BAR;
    WAIT_V(2); BAR;
    STAGE_B(1, 0, 1); STAGE_A(1, 0, 1); STAGE_B(1, 1, 1);
    WAIT_V(6); BAR;
#pragma unroll 1
    for (int t = 0; t < nt; t += 2) {
        const int k2 = (t == nt - 2) ? 0 : t + 2;
        LDB(B0, 0, 0); LDB(B1, 0, 1); SCHED; LDA(At, 0, 0); STAGE_A(1, 1, t + 1);
        WAIT_V(8); WAIT_L(0); BAR; MMA(0, 0, At, B0); MMA(0, 1, At, B1); BAR; SCHED;
        LDA(At, 0, 1); STAGE_B(0, 0, k2); STAGE_B(0, 1, k2); STAGE_A(0, 0, k2);
        WAIT_V(8); WAIT_L(0); BAR; MMA(1, 0, At, B0); MMA(1, 1, At, B1); BAR; SCHED;
        LDB(B0, 1, 0); LDB(B1, 1, 1); SCHED; LDA(At, 1, 0); STAGE_A(0, 1, k2);
        WAIT_V(8); WAIT_L(0); BAR; MMA(0, 0, At, B0); MMA(0, 1, At, B1); BAR; SCHED;
        LDA(At, 1, 1); STAGE_B(1, 0, k2 + 1); STAGE_B(1, 1, k2 + 1); STAGE_A(1, 0, k2 + 1);
        WAIT_V(8); WAIT_L(0); BAR; MMA(1, 0, At, B0); MMA(1, 1, At, B1); BAR; SCHED;
    }
    WAIT_V(0);
    if (wr == 0) BAR;
    BAR;
#undef SA
#undef SB
#undef STAGE_A
#undef STAGE_B
#undef LDA
#undef LDB
#undef MMA
#undef WAIT_V
#undef WAIT_L
#undef BAR
#undef SCHED
    int tq = F.tid; asm volatile("" : "+v"(tq)); const int fr2 = tq & 15, fq2 = (tq >> 4) & 3;
#pragma unroll
    for (int ai = 0; ai < 2; ++ai) { const int cg = (brow >> 6) + 2 * ai + wr;
        const EpiC C = epi.load_c(cg, fq2);
        EpiT T = epi.load_t(cg, wc * 32 + fr2, fq2);
#pragma unroll
        for (int c = 0; c < 4; ++c) { const int bj = c >> 1, n = c & 1; const int tok = bj * 128 + wc * 32 + n * 16 + fr2;
            EpiT Tn = T; if (c < 3) Tn = epi.load_t(cg, ((c + 1) >> 1) * 128 + wc * 32 + ((c + 1) & 1) * 16 + fr2, fq2);
            f32x4 v[4] = {acc[ai][bj][0][n], acc[ai][bj][1][n], acc[ai][bj][2][n], acc[ai][bj][3][n]};
            epi.apply(v, cg, tok, fq2, C, T); T = Tn; } }
}

__device__ __forceinline__ u32x2 pk4(const f32x4& v) { return (u32x2){pk2(v[0], v[1]), pk2(v[2], v[3])}; }
struct EpiInProj {
    const Frame& F; int l, t0;
    __device__ __forceinline__ EpiC load_c(int cg, int fq) const { EpiC C;
#pragma unroll
        for (int m = 0; m < 4; ++m) C.c[m] = (f32x4){0.f, 0.f, 0.f, 0.f};
        if (cg >= 22 && cg < 30) { const float* gw = (cg < 28 ? F.in(I_GQ) : F.in(I_GK)) + 64 * l;
#pragma unroll
            for (int m = 0; m < 4; ++m) C.c[m] = *(const f32x4*)(gw + 16 * m + 4 * fq); }
        return C; }
    __device__ __forceinline__ EpiT load_t(int cg, int tok, int fq) const { EpiT T;
#pragma unroll
        for (int m = 0; m < 4; ++m) T.t[m] = (f32x4){0.f, 0.f, 0.f, 0.f};
        const int R = t0 + tok; const int t = R - NCTX; const int prow = (t >> 6) & 255, pcol = t & 63; const float* const rope = F.ws<float>(WS_ROPE);
        if (R >= NCTX) {
            if (cg >= 4 && cg < 16) { const int ti = fq < 2 ? RD_RC + prow * 8 + 4 * fq : RD_CC + pcol * 8 + 4 * (fq - 2), si = fq < 2 ? RD_RS + prow * 8 + 4 * fq : RD_CS + pcol * 8 + 4 * (fq - 2);
                T.t[0] = *(const f32x4*)(rope + ti); T.t[1] = *(const f32x4*)(rope + si); }
            else if (cg >= 22 && cg < 30) { T.t[0] = *(const f32x4*)(rope + RG_RC + prow * 16 + 4 * fq); T.t[1] = *(const f32x4*)(rope + RG_RS + prow * 16 + 4 * fq);
                T.t[2] = *(const f32x4*)(rope + RG_CC + pcol * 16 + 4 * fq); T.t[3] = *(const f32x4*)(rope + RG_CS + pcol * 16 + 4 * fq); } }
        return T; }
    __device__ __forceinline__ void apply(f32x4 (&v)[4], int cg, int tok, int fq, const EpiC& C, const EpiT& T) const {
        bf16_t* const ft = F.ws<bf16_t>(WS_FT); bf16_t* const fc = F.ws<bf16_t>(WS_FC); bf16_t* const qd = F.ws<bf16_t>(WS_QD); bf16_t* const kd = F.ws<bf16_t>(WS_KD); bf16_t* const vd = F.ws<bf16_t>(WS_VD);
        bf16_t* const qg = F.ws<bf16_t>(WS_QG); bf16_t* const kg = F.ws<bf16_t>(WS_KG); bf16_t* const vg = F.ws<bf16_t>(WS_VG);
        unsigned* const kmax = F.ctl + CW_KMAX + 16 * l;
        const float QSD = 0.17677669529663687f * LOG2E, QSG = 0.125f * LOG2E;
        const int R = t0 + tok; const bool isctx = R < NCTX; const int t = R - NCTX;
        if (cg < 4) {
#pragma unroll
            for (int m = 0; m < 4; ++m) { const int ch = 64 * cg + 16 * m + 4 * fq; const u32x2 w = pk4(v[m]);
                if (isctx) { const size_t a = (size_t)(((ch >> 7) * 4 + ((ch >> 5) & 3)) * 8192 + (R >> 3) * 256 + (R & 7) * 32 + (ch & 31)); *(u32x2*)(fc + a) = w; }
                else { const int l1 = t >> 7, l2 = t & 127; const size_t a = (size_t)((l2 * 2 + (ch >> 7)) * 4 + ((ch >> 5) & 3)) * 4096 + (l1 >> 3) * 256 + (l1 & 7) * 32 + (ch & 31); *(u32x2*)(ft + a) = w; } }
        } else if (cg < 16) {
            const bool isq = cg < 10; const int head = isq ? cg - 4 : cg - 10;
            if (!isctx) { const f32x4 cc = T.t[0], sn = T.t[1];
#pragma unroll
                for (int mp = 0; mp < 2; ++mp)
#pragma unroll
                    for (int j = 0; j < 4; ++j) { const float a = v[2 * mp][j], b = v[2 * mp + 1][j]; v[2 * mp][j] = a * cc[j] - b * sn[j]; v[2 * mp + 1][j] = b * cc[j] + a * sn[j]; } }
            if (isq) {
#pragma unroll
                for (int m = 0; m < 4; ++m) { const f32x4 s = v[m] * QSD;
                    const size_t a = ((((size_t)(head * NQB + (R >> 5)) * 2 + (m >> 1)) * 4 + 2 * (m & 1) + (fq >> 1)) * 32 + (R & 31)) * 8 + 4 * (fq & 1); *(u32x2*)(qd + a) = pk4(s); }
            } else {
                float ss0 = 0.f, ss1 = 0.f;
#pragma unroll
                for (int j = 0; j < 4; ++j) { ss0 += v[0][j] * v[0][j] + v[1][j] * v[1][j]; ss1 += v[2][j] * v[2][j] + v[3][j] * v[3][j]; }
                ss0 += shxc<16>(ss0); ss1 += shxc<16>(ss1); ss0 = add32(ss0); ss1 = add32(ss1);
                ss0 = fmaxf(ss0, shxc<8>(ss0)); ss1 = fmaxf(ss1, shxc<8>(ss1)); ss0 = fmaxf(ss0, shxc<4>(ss0)); ss1 = fmaxf(ss1, shxc<4>(ss1));
                ss0 = fmaxf(ss0, shxc<2>(ss0)); ss1 = fmaxf(ss1, shxc<2>(ss1)); ss0 = fmaxf(ss0, shxc<1>(ss0)); ss1 = fmaxf(ss1, shxc<1>(ss1));
                if ((tok & 15) == 0 && fq == 0) { float* kp = F.ws<float>(WS_KP) + ((size_t)(l * 12 + 2 * head) * 64 + ((t0 >> 8) - 1)) * 16 + (tok >> 4); kp[0] = ss0; kp[1024] = ss1; }
#pragma unroll
                for (int m = 0; m < 4; ++m) {
                    const size_t a = ((((size_t)(head * NKT + (R >> 6)) * 2 + (m >> 1)) * 4 + 2 * (m & 1) + (fq >> 1)) * 64 + (R & 63)) * 8 + 4 * (fq & 1); *(u32x2*)(kd + a) = pk4(v[m]); }
            }
        } else if (cg < 22 || cg >= 30) {
            const bool isd = cg < 22; const int head = isd ? cg - 16 : cg - 30; bf16_t* vb = isd ? vd : vg;
#pragma unroll
            for (int m = 0; m < 4; ++m) {
                const size_t a = ((size_t)(head * NKT + (R >> 6)) * 2 + (m >> 1)) * 2048 + ((R & 63) >> 3) * 256 + (R & 7) * 32 + 16 * (m & 1) + 4 * fq; *(u32x2*)(vb + a) = pk4(v[m]); }
        } else {
            const bool isq = cg < 28; const int head = isq ? cg - 22 : cg - 28;
            float ss = 0.f;
#pragma unroll
            for (int m = 0; m < 4; ++m)
#pragma unroll
                for (int j = 0; j < 4; ++j) ss += v[m][j] * v[m][j];
            ss += shxc<16>(ss); ss = add32(ss); const float rs = rsqrtf(ss * (1.f / 64.f) + 1e-6f);
#pragma unroll
            for (int m = 0; m < 4; ++m) v[m] = v[m] * C.c[m] * rs;
            if (!isctx) { const f32x4 cr = T.t[0], sr = T.t[1], cc = T.t[2], sc = T.t[3];
#pragma unroll
                for (int j = 0; j < 4; ++j) { { const float a = v[0][j], b = v[2][j]; v[0][j] = a * cr[j] - b * sr[j]; v[2][j] = b * cr[j] + a * sr[j]; }
                    { const float a = v[1][j], b = v[3][j]; v[1][j] = a * cc[j] - b * sc[j]; v[3][j] = b * cc[j] + a * sc[j]; } } }
#pragma unroll
            for (int m = 0; m < 4; ++m) { const f32x4 s = isq ? v[m] * QSG : v[m]; const int c = 2 * m + (fq >> 1);
                if (isq) { const size_t a = (((size_t)(head * NQB + (R >> 5)) * 8 + c) * 32 + (R & 31)) * 8 + 4 * (fq & 1); *(u32x2*)(qg + a) = pk4(s); }
                else { const size_t a = (((size_t)(head * NKT + (R >> 6)) * 8 + c) * 64 + (R & 63)) * 8 + 4 * (fq & 1); *(u32x2*)(kg + a) = pk4(s); } }
        }
    }
};
struct EpiOutProj {
    const Frame& F; int l, t0;
    __device__ __forceinline__ const float* src_row(int R) const { return l == 0 ? (R < NCTX ? F.in(I_CTX) + (size_t)R * DM : F.in(I_X) + (size_t)(R - NCTX) * DM) : F.ws<float>(WS_XS) + (size_t)R * DM; }
    __device__ __forceinline__ EpiC load_c(int cg, int fq) const { EpiC C; const float* gt = F.ws<float>(WS_MOD) + (size_t)l * 2 * 6144 + (t0 < NCTX ? 6144 : 0) + 2048;
#pragma unroll
        for (int m = 0; m < 4; ++m) C.c[m] = *(const f32x4*)(gt + 64 * cg + 16 * m + 4 * fq);
        return C; }
    __device__ __forceinline__ EpiT load_t(int cg, int tok, int fq) const { EpiT T; const float* src = src_row(t0 + tok);
#pragma unroll
        for (int m = 0; m < 4; ++m) T.t[m] = *(const f32x4*)(src + 64 * cg + 16 * m + 4 * fq);
        return T; }
    __device__ __forceinline__ void apply(f32x4 (&v)[4], int cg, int tok, int fq, const EpiC& C, const EpiT& T) const {
        float* xs = F.ws<float>(WS_XS) + (size_t)(t0 + tok) * DM;
#pragma unroll
        for (int m = 0; m < 4; ++m) *(f32x4*)(xs + 64 * cg + 16 * m + 4 * fq) = T.t[m] + C.c[m] * v[m];
    }
};
struct EpiGateUp {
    const Frame& F; int le, m0, cnt, offs;
    __device__ __forceinline__ EpiC load_c(int cg, int fq) const { EpiC C; const float* bias = F.in(I_BGU) + (size_t)le * 2048 + 32 * cg + 4 * fq;
        C.c[0] = *(const f32x4*)(bias); C.c[1] = *(const f32x4*)(bias + 16); C.c[2] = *(const f32x4*)(bias + 1024); C.c[3] = *(const f32x4*)(bias + 1024 + 16); return C; }
    __device__ __forceinline__ EpiT load_t(int, int, int) const { EpiT T;
#pragma unroll
        for (int m = 0; m < 4; ++m) T.t[m] = (f32x4){0.f, 0.f, 0.f, 0.f};
        return T; }
    __device__ __forceinline__ void apply(f32x4 (&v)[4], int cg, int tok, int fq, const EpiC& C, const EpiT&) const {
        const int mt = m0 + tok; if (mt >= cnt) return;
        bf16_t* dst = F.ws<bf16_t>(WS_ACT) + (size_t)(offs + mt) * FFD;
#pragma unroll
        for (int m = 0; m < 2; ++m) { const int jj = 32 * cg + 16 * m + 4 * fq; f32x4 o;
#pragma unroll
            for (int j = 0; j < 4; ++j) { float gl = v[m][j] + C.c[m][j], li = v[m + 2][j] + C.c[2 + m][j]; gl = fminf(gl, 7.f); li = fminf(fmaxf(li, -7.f), 7.f);
                o[j] = gl * (1.f / (1.f + __expf(-1.702f * gl))) * (li + 1.f); }
            *(u32x2*)(dst + jj) = pk4(o); }
    }
};
struct EpiDown {
    const Frame& F; int le, m0, cnt, offs;
    __device__ __forceinline__ EpiC load_c(int cg, int fq) const { EpiC C; const float* bias = F.in(I_BDN) + (size_t)le * DM + 64 * cg + 4 * fq;
#pragma unroll
        for (int m = 0; m < 4; ++m) C.c[m] = *(const f32x4*)(bias + 16 * m);
        return C; }
    __device__ __forceinline__ EpiT load_t(int, int, int) const { EpiT T;
#pragma unroll
        for (int m = 0; m < 4; ++m) T.t[m] = (f32x4){0.f, 0.f, 0.f, 0.f};
        return T; }
    __device__ __forceinline__ void apply(f32x4 (&v)[4], int cg, int tok, int fq, const EpiC& C, const EpiT&) const {
        const int mt = m0 + tok; if (mt >= cnt) return;
        bf16_t* dst = F.ws<bf16_t>(WS_YB) + (size_t)(offs + mt) * DM;
#pragma unroll
        for (int m = 0; m < 4; ++m) *(u32x2*)(dst + 64 * cg + 16 * m + 4 * fq) = pk4(v[m] + C.c[m]);
    }
};
struct XDense { const bf16_t* X; int ld; int t0; __device__ __forceinline__ const bf16_t* operator()(int row) const { return X + (size_t)(t0 + row) * ld; } };
struct XGather { const bf16_t* X; const unsigned* list; int m0, cnt; __device__ __forceinline__ const bf16_t* operator()(int row) const { int m = m0 + row; m = m < cnt ? m : cnt - 1; return X + (size_t)list[m] * DM; } };
struct XAct { const bf16_t* X; int base, m0, cnt; __device__ __forceinline__ const bf16_t* operator()(int row) const { int m = m0 + row; m = m < cnt ? m : cnt - 1; return X + (size_t)(base + m) * FFD; } };

template <class Epi>
__device__ __forceinline__ void mini_unit(const Frame& F, const bf16_t* W, int ldw, int f0, const bf16_t* X, int ldx, int t0, int K, const Epi& epi) {
    const int lane = F.lane, wid = F.wid, r = lane & 31, h = lane >> 5; const int kw = K >> 3;
    const bf16_t* wp = W + (size_t)(f0 + r) * ldw + wid * kw + 8 * h; const bf16_t* xp = X + (size_t)(t0 + r) * ldx + wid * kw + 8 * h;
    f32x16 acc0, acc1;
#pragma unroll
    for (int i = 0; i < 16; ++i) { acc0[i] = 0.f; acc1[i] = 0.f; }
#pragma unroll 2
    for (int s = 0; s < (kw >> 4); ++s) { const bf16x8 w0 = *(const bf16x8*)(wp + 16 * s), w1 = *(const bf16x8*)(wp + (size_t)32 * ldw + 16 * s), xv = *(const bf16x8*)(xp + 16 * s);
        acc0 = MFMA(w0, xv, acc0); acc1 = MFMA(w1, xv, acc1); }
    BAR_SYNC();
    LAS float* red = (LAS float*)F.lds;
#pragma unroll
    for (int i = 0; i < 16; ++i) { red[(wid * 32 + i) * 64 + lane] = acc0[i]; red[(wid * 32 + 16 + i) * 64 + lane] = acc1[i]; }
    __syncthreads();
    LAS float* out = red + 8 * 32 * 64;
#pragma unroll
    for (int j = 0; j < 4; ++j) { const int rg = 4 * wid + j; float s = 0.f;
#pragma unroll
        for (int w = 0; w < 8; ++w) s += red[(w * 32 + rg) * 64 + lane];
        out[rg * 64 + lane] = s; }
    __syncthreads();
    if (wid == 0) {
#pragma unroll
        for (int i = 0; i < 16; ++i) { acc0[i] = out[i * 64 + lane]; acc1[i] = out[(16 + i) * 64 + lane]; }
        epi(acc0, acc1, f0 >> 6, t0 + r, h);
    }
}
struct EpiInProjCtx {
    const Frame& F; int l;
    __device__ __forceinline__ void operator()(f32x16& v0, f32x16& v1, int cg, int R, int h) const {
        const float QSD = 0.17677669529663687f * LOG2E, QSG = 0.125f * LOG2E;
        if (cg < 4) { bf16_t* fc = F.ws<bf16_t>(WS_FC);
#pragma unroll
            for (int fb = 0; fb < 2; ++fb)
#pragma unroll
                for (int g = 0; g < 4; ++g) { const f32x16& v = fb ? v1 : v0; const int ch = 64 * cg + 32 * fb + 8 * g + 4 * h;
                    const size_t a = (size_t)(((ch >> 7) * 4 + ((ch >> 5) & 3)) * 8192 + (R >> 3) * 256 + (R & 7) * 32 + (ch & 31)); *(u32x2*)(fc + a) = (u32x2){pk2(v[4 * g], v[4 * g + 1]), pk2(v[4 * g + 2], v[4 * g + 3])}; }
        } else if (cg < 16) { const bool isq = cg < 10; const int head = isq ? cg - 4 : cg - 10;
            if (isq) { bf16_t* qd = F.ws<bf16_t>(WS_QD);
#pragma unroll
                for (int fb = 0; fb < 2; ++fb)
#pragma unroll
                    for (int g = 0; g < 4; ++g) { const f32x16& v = fb ? v1 : v0;
                        const size_t a = ((((size_t)(head * NQB + (R >> 5)) * 2 + fb) * 4 + g) * 32 + (R & 31)) * 8 + 4 * h;
                        *(u32x2*)(qd + a) = (u32x2){pk2(v[4 * g] * QSD, v[4 * g + 1] * QSD), pk2(v[4 * g + 2] * QSD, v[4 * g + 3] * QSD)}; }
            } else { bf16_t* kd = F.ws<bf16_t>(WS_KD); unsigned* kmax = F.ctl + CW_KMAX + 16 * l;
                float ss0 = 0.f, ss1 = 0.f;
#pragma unroll
                for (int i = 0; i < 16; ++i) { ss0 += v0[i] * v0[i]; ss1 += v1[i] * v1[i]; }
                ss0 = add32(ss0); ss1 = add32(ss1); ss0 = wave_max(ss0); ss1 = wave_max(ss1);
                if (F.lane == 0) { atomicMax(kmax + 2 * head, __float_as_uint(ss0)); atomicMax(kmax + 2 * head + 1, __float_as_uint(ss1)); }
#pragma unroll
                for (int fb = 0; fb < 2; ++fb)
#pragma unroll
                    for (int g = 0; g < 4; ++g) { const f32x16& v = fb ? v1 : v0;
                        const size_t a = ((((size_t)(head * NKT + (R >> 6)) * 2 + fb) * 4 + g) * 64 + (R & 63)) * 8 + 4 * h;
                        *(u32x2*)(kd + a) = (u32x2){pk2(v[4 * g], v[4 * g + 1]), pk2(v[4 * g + 2], v[4 * g + 3])}; } }
        } else if (cg < 22 || cg >= 30) { const bool isd = cg < 22; const int head = isd ? cg - 16 : cg - 30; bf16_t* vb = isd ? F.ws<bf16_t>(WS_VD) : F.ws<bf16_t>(WS_VG);
#pragma unroll
            for (int fb = 0; fb < 2; ++fb)
#pragma unroll
                for (int g = 0; g < 4; ++g) { const f32x16& v = fb ? v1 : v0;
                    const size_t a = ((size_t)(head * NKT + (R >> 6)) * 2 + fb) * 2048 + ((R & 63) >> 3) * 256 + (R & 7) * 32 + 8 * g + 4 * h;
                    *(u32x2*)(vb + a) = (u32x2){pk2(v[4 * g], v[4 * g + 1]), pk2(v[4 * g + 2], v[4 * g + 3])}; }
        } else { const bool isq = cg < 28; const int head = isq ? cg - 22 : cg - 28; const float* gw = (isq ? F.in(I_GQ) : F.in(I_GK)) + 64 * l;
            float ss = 0.f;
#pragma unroll
            for (int i = 0; i < 16; ++i) ss += v0[i] * v0[i] + v1[i] * v1[i];
            ss = add32(ss); const float rs = rsqrtf(ss * (1.f / 64.f) + 1e-6f) * (isq ? QSG : 1.f);
#pragma unroll
            for (int fb = 0; fb < 2; ++fb)
#pragma unroll
                for (int g = 0; g < 4; ++g) { const f32x16& v = fb ? v1 : v0; const f32x4 gv = *(const f32x4*)(gw + 32 * fb + 8 * g + 4 * h);
                    const u32x2 w = {pk2(v[4 * g] * rs * gv[0], v[4 * g + 1] * rs * gv[1]), pk2(v[4 * g + 2] * rs * gv[2], v[4 * g + 3] * rs * gv[3])};
                    if (isq) { const size_t a = (((size_t)(head * NQB + (R >> 5)) * 8 + 4 * fb + g) * 32 + (R & 31)) * 8 + 4 * h; *(u32x2*)(F.ws<bf16_t>(WS_QG) + a) = w; }
                    else { const size_t a = (((size_t)(head * NKT + (R >> 6)) * 8 + 4 * fb + g) * 64 + (R & 63)) * 8 + 4 * h; *(u32x2*)(F.ws<bf16_t>(WS_KG) + a) = w; } }
        }
    }
};
struct EpiOutProjCtx {
    const Frame& F;
    __device__ __forceinline__ void operator()(f32x16& v0, f32x16& v1, int cg, int R, int h) const {
        const float* src = F.in(I_CTX) + (size_t)R * DM; const float* gt = F.ws<float>(WS_MOD) + 6144 + 2048; float* xs = F.ws<float>(WS_XS) + (size_t)R * DM;
#pragma unroll
        for (int fb = 0; fb < 2; ++fb)
#pragma unroll
            for (int g = 0; g < 4; ++g) { const f32x16& v = fb ? v1 : v0; const int n = 64 * cg + 32 * fb + 8 * g + 4 * h;
                const f32x4 x = *(const f32x4*)(src + n), gv = *(const f32x4*)(gt + n);
                *(f32x4*)(xs + n) = (f32x4){x[0] + gv[0] * v[4 * g], x[1] + gv[1] * v[4 * g + 1], x[2] + gv[2] * v[4 * g + 2], x[3] + gv[3] * v[4 * g + 3]}; }
    }
};
__device__ __forceinline__ void phase_inproj(const Frame& F, int l) {
    const bf16_t* Wt = F.ws<bf16_t>(WS_WIN) + (size_t)l * INW * DM; const bf16_t* hb = F.ws<bf16_t>(WS_HB);
    const bool xcd = F.G == 256; const int x = F.bid & 7;
    const int first = xcd ? (F.bid >> 3) : F.bid, stride = xcd ? 32 : F.G, total = xcd ? 64 : 8 * 64;
    for (int i = first; i < total; i += stride) { const int ft = xcd ? 4 * (x & 1) + (i & 3) : (i & 7), tt = 1 + (xcd ? 4 * (i >> 2) + (x >> 1) : (i >> 3));
        EpiInProj E{F, l, 256 * tt}; XDense X{hb, DM, 256 * tt}; gemm8(F, Wt, DM, 256 * ft, X, E); }
    EpiInProjCtx EC{F, l};
    for (int u = F.bid; u < 256; u += F.G) { const int cg = u & 31, tb = u >> 5;
        if (l == 1 && !((cg >= 10 && cg < 22) || cg >= 28)) continue;
        mini_unit(F, Wt, DM, 64 * cg, hb, DM, 32 * tb, DM, EC); }
}
__device__ __forceinline__ void phase_outproj(const Frame& F, int l) {
    const bf16_t* Wt = F.ws<bf16_t>(WS_WOUT) + (size_t)l * DM * MIXK; const bf16_t* mix = F.ws<bf16_t>(WS_MIX);
    const bool xcd = F.G == 256; const int x = F.bid & 7;
    const int first = xcd ? (F.bid >> 3) : F.bid, stride = xcd ? 32 : F.G, total = xcd ? 32 : 4 * 64;
    for (int i = first; i < total; i += stride) { const int ft = i & 3, tt = 1 + (xcd ? 8 * (i >> 2) + x : (i >> 2));
        EpiOutProj E{F, l, 256 * tt}; XDense X{mix, MIXK, 256 * tt}; gemm8(F, Wt, MIXK, 256 * ft, X, E); }
    if (l == 0) { EpiOutProjCtx EC{F};
        for (int u = F.bid; u < 128; u += F.G) { const int cg = u & 15, tb = u >> 4; mini_unit(F, Wt, MIXK, 64 * cg, mix, MIXK, 32 * tb, MIXK, EC); } }
}
__device__ __forceinline__ void moe_tables(const Frame& F, int l, int nf, bool xcd, LAS int*& s_cnt, LAS int*& s_offs, LAS int*& s_t0) {
    LAS int* base = (LAS int*)(F.lds + LDS_CTL + 256); s_cnt = base; s_offs = base + 32; s_t0 = base + 72;
    __syncthreads();
    if (F.tid < NEXP) s_cnt[F.tid] = (int)__hip_atomic_load(F.ctl + CW_CNT + 64 * l + F.tid, __ATOMIC_RELAXED, __HIP_MEMORY_SCOPE_AGENT);
    __syncthreads();
    if (F.tid == 0) { const int g = (F.bid & 7) >> 1; int o = 0, t = 0; for (int e = 0; e < NEXP; ++e) { const int c = s_cnt[e];
            const int ntt = (c + 255) >> 8; int nu = ntt * nf;
            if (xcd) { const int fst = (g - e) & 3; nu = (fst < ntt ? (ntt - fst + 3) >> 2 : 0) * (nf >> 1); }
            s_cnt[e] = c; s_offs[e] = o; s_t0[e] = t; o += c; t += nu; } s_offs[32] = o; s_t0[32] = t; }
    __syncthreads();
}
__device__ __forceinline__ void moe_decode(const Frame& F, bool xcd, int nf, int i, LAS const int* s_t0, int& e, int& ft, int& tt) {
    e = 0; while (e < NEXP - 1 && i >= s_t0[e + 1]) ++e;
    const int j = i - s_t0[e];
    if (xcd) { const int x = F.bid & 7, hf = nf >> 1; ft = hf * (x & 1) + (j % hf); tt = (((x >> 1) - e) & 3) + 4 * (j / hf); }
    else { ft = j % nf; tt = j / nf; } }
__device__ __forceinline__ void phase_gateup(const Frame& F, int l) {
    const bool xcd = F.G == 256;
    LAS int *s_cnt, *s_offs, *s_t0; moe_tables(F, l, 8, xcd, s_cnt, s_offs, s_t0);
    const int first = xcd ? (F.bid >> 3) : F.bid, stride = xcd ? 32 : F.G, total = s_t0[32];
    for (int i = first; i < total; i += stride) { int e, ft, tt; moe_decode(F, xcd, 8, i, s_t0, e, ft, tt);
        EpiGateUp E{F, l * NEXP + e, 256 * tt, s_cnt[e], s_offs[e]};
        XGather X{F.ws<bf16_t>(WS_HB), F.ws<unsigned>(WS_LIST) + (size_t)e * NT, 256 * tt, s_cnt[e]};
        gemm8(F, F.ws<bf16_t>(WS_WGU) + (size_t)(l * NEXP + e) * 2048 * DM, DM, 256 * ft, X, E); }
}
__device__ __forceinline__ void phase_down(const Frame& F, int l) {
    const bool xcd = F.G == 256;
    LAS int *s_cnt, *s_offs, *s_t0; moe_tables(F, l, 4, xcd, s_cnt, s_offs, s_t0);
    const int first = xcd ? (F.bid >> 3) : F.bid, stride = xcd ? 32 : F.G, total = s_t0[32];
    for (int i = first; i < total; i += stride) { int e, ft, tt; moe_decode(F, xcd, 4, i, s_t0, e, ft, tt);
        EpiDown E{F, l * NEXP + e, 256 * tt, s_cnt[e], s_offs[e]};
        XAct X{F.ws<bf16_t>(WS_ACT), s_offs[e], 256 * tt, s_cnt[e]};
        gemm8(F, F.ws<bf16_t>(WS_WDN) + (size_t)(l * NEXP + e) * DM * FFD, FFD, 256 * ft, X, E); }
}

template <int KD, int MODE>
__device__ __forceinline__ void dft_unit(const Frame& F, const bf16_t* AF, const bf16_t* Bsrc, int p0, int colhalf, int pa) {
    constexpr int NS = KD / 16, TILE_B = 4 * KD * 64;
    const int lane = F.lane, wid = F.wid, r = lane & 31, h = lane >> 5, rg = wid & 3, cg2 = wid >> 2;
    LAS char* lds = F.lds;
    BAR_SYNC();
    for (int pc = wid; pc < TILE_B / 1024; pc += 8) dma16((const char*)Bsrc + (size_t)pc * 1024 + lane * 16, lds + pc * 1024);
    WAITV(0); BAR_SYNC();
    f32x16 acc[2][2];
#pragma unroll
    for (int a = 0; a < 2; ++a)
#pragma unroll
        for (int b = 0; b < 2; ++b)
#pragma unroll
            for (int i = 0; i < 16; ++i) acc[a][b][i] = 0.f;
    const bf16_t* af = AF + (size_t)(rg * 2) * NS * 512 + lane * 8;
    const int bl = h * 512 + ((lane & 15) >> 2) * 64 + ((lane >> 4) & 1) * 32 + (lane & 3) * 8;
#pragma unroll 4
    for (int s = 0; s < NS; ++s) {
        const bf16x8 a0 = *(const bf16x8*)(af + (size_t)s * 512), a1 = *(const bf16x8*)(af + (size_t)(NS + s) * 512);
#pragma unroll
        for (int cb = 0; cb < 2; ++cb) { LAS const char* bp = lds + (2 * cg2 + cb) * (KD * 64) + s * 1024 + bl;
            const s16x4 lo = vtr(bp), hi = vtr(bp + 256);
            const bf16x8 bf = {lo[0], lo[1], lo[2], lo[3], hi[0], hi[1], hi[2], hi[3]};
            acc[0][cb] = MFMA(a0, bf, acc[0][cb]); acc[1][cb] = MFMA(a1, bf, acc[1][cb]); }
    }
#pragma unroll
    for (int cb = 0; cb < 2; ++cb) { const int c = 128 * colhalf + 32 * (2 * cg2 + cb) + r;
#pragma unroll
        for (int rho = 0; rho < 16; ++rho) { const int kk = 32 * rg + (rho & 3) + 8 * (rho >> 2) + 4 * h; const float re = acc[0][cb][rho], im = acc[1][cb][rho];
            if (MODE == 0) { const int l2 = p0; const f32x2 tw = F.ws<f32x2>(WS_TW)[(kk * l2) & 16383]; const float o_re = re * tw[0] + im * tw[1], o_im = im * tw[0] - re * tw[1];
                bf16_t* T2 = F.ws<bf16_t>(WS_T2); const size_t a = ((size_t)(kk * 2 + (c >> 7)) * 4 + ((c >> 5) & 3)) * 8192 + (l2 >> 2) * 256 + (2 * (l2 & 3)) * 32 + (c & 31);
                T2[a] = (bf16_t)(pk2(o_re, 0.f) & 0xffff); T2[a + 32] = (bf16_t)(pk2(o_im, 0.f) & 0xffff);
            } else if (MODE == 1) { const int k1 = p0; bf16_t* mr = F.ws<bf16_t>(WS_MIX) + (size_t)(NCTX + k1 + 128 * kk) * MIXK;
                mr[c] = (bf16_t)(pk2(re * (1.f / 1024.f), 0.f) & 0xffff); mr[256 + c] = (bf16_t)(pk2(im * (1.f / 1024.f), 0.f) & 0xffff);
            } else { bf16_t* mr = F.ws<bf16_t>(WS_MIX) + (size_t)(128 * pa + kk) * MIXK;
                mr[c] = (bf16_t)(pk2(re * (1.f / 128.f), 0.f) & 0xffff); mr[256 + c] = (bf16_t)(pk2(im * (1.f / 128.f), 0.f) & 0xffff); } } }
}

constexpr int A_SLOT = 16384;
constexpr int N_PSLOT = 18;
constexpr int A_KRING = 0, A_VRING = 32768;
template <int NQ, int NKS, bool SEPK, bool BIAS>
__device__ __forceinline__ void attn_sweep(const Frame& F, const bf16x8 (&qf)[NQ][NKS], const bf16_t* Kt, const bf16_t* Vt, int ntiles, const f32x16& negm, f32x16 (&o)[NQ][2], float (&lsum)[NQ]) {
    constexpr int NKF = (SEPK ? NQ : 1) * NKS;
    const int lane = F.lane, wid = F.wid, r = lane & 31, h = lane >> 5;
    LAS char* lds = F.lds; const unsigned lds0 = (unsigned)(size_t)F.lds;
    const bf16_t* ksrc = Kt + wid * 512 + lane * 8; const bf16_t* vsrc = Vt + wid * 512 + lane * 8;
#define A_K(t) glds16(ksrc + (size_t)(t) * 4096, (unsigned)__builtin_amdgcn_readfirstlane((int)(lds0 + A_KRING + ((t) & 3) * 8192 + wid * 1024)))
#define A_V(t) glds16(vsrc + (size_t)(t) * 4096, (unsigned)__builtin_amdgcn_readfirstlane((int)(lds0 + A_VRING + ((t) & 3) * 8192 + wid * 1024)))
#define SB() __builtin_amdgcn_sched_barrier(0)
    BAR_SYNC();
    A_K(0); A_V(0); A_K(1); A_K(2); A_V(1);
    float l0[NQ]; f32x16 scA[NQ], scB[NQ]; bf16x8 kf[NKF], vf[4], pa[NQ][2];
#pragma unroll
    for (int qi = 0; qi < NQ; ++qi) { l0[qi] = 0.f;
#pragma unroll
        for (int i = 0; i < 16; ++i) { o[qi][0][i] = 0.f; o[qi][1][i] = 0.f; scB[qi][i] = 0.f; } }
    const int vb = ((lane >> 4) & 1) * 32 + (lane & 3) * 8 + (4 * h + ((lane & 15) >> 2)) * 64;
    const int kbo = h * 1024 + r * 16;
#define LOADK(tile, kb) do { LAS const char* kp_ = lds + A_KRING + ((tile) & 3) * 8192 + kbo + (kb) * 512; \
        _Pragma("unroll") for (int f_ = 0; f_ < NKF; ++f_) kf[f_] = *(LAS const bf16x8*)(kp_ + (SEPK ? (f_ / NKS) * 4096 : 0) + (f_ % NKS) * 2048); } while (0)
#define LOADV(tile, kb) do { LAS const char* vp_ = lds + A_VRING + ((tile) & 3) * 8192 + vb + (kb) * 2048; \
        _Pragma("unroll") for (int j_ = 0; j_ < 2; ++j_) _Pragma("unroll") for (int d_ = 0; d_ < 2; ++d_) { const s16x4 lo_ = vtr(vp_ + d_ * 4096 + j_ * 1024), hi_ = vtr(vp_ + d_ * 4096 + j_ * 1024 + 512); \
            vf[j_ * 2 + d_] = (bf16x8){lo_[0], lo_[1], lo_[2], lo_[3], hi_[0], hi_[1], hi_[2], hi_[3]}; } } while (0)
#define HALF(SN, SO, vtile, vkb, DOK, ktile, kkb) do { \
        LOADV(vtile, vkb); SB(); \
          \
        _Pragma("unroll") for (int m_ = 0; m_ < NQ * NKS; ++m_) { const int qi_ = m_ / NKS, s_ = m_ % NKS; \
            if (s_ == 0) { if (BIAS) SN[qi_] = MFMA(kf[(SEPK ? qi_ : 0) * NKS], qf[qi_][0], negm); else { f32x16 z_; _Pragma("unroll") for (int i_ = 0; i_ < 16; ++i_) z_[i_] = 0.f; SN[qi_] = MFMA(kf[(SEPK ? qi_ : 0) * NKS], qf[qi_][0], z_); } } \
            else SN[qi_] = MFMA(kf[(SEPK ? qi_ : 0) * NKS + s_], qf[qi_][s_], SN[qi_]); \
              \
            _Pragma("unroll") for (int g_ = m_ * 4 / NKS; g_ < (m_ + 1) * 4 / NKS; ++g_) { const int fq_ = g_ >> 2, gg_ = g_ & 3; \
                l0[fq_] += SO[fq_][4 * gg_]; l0[fq_] += SO[fq_][4 * gg_ + 1]; l0[fq_] += SO[fq_][4 * gg_ + 2]; l0[fq_] += SO[fq_][4 * gg_ + 3]; \
                { u32x4 w_ = __builtin_bit_cast(u32x4, pa[fq_][gg_ >> 1]); w_[(gg_ & 1) * 2] = pk2(SO[fq_][4 * gg_], SO[fq_][4 * gg_ + 1]); w_[(gg_ & 1) * 2 + 1] = pk2(SO[fq_][4 * gg_ + 2], SO[fq_][4 * gg_ + 3]); pa[fq_][gg_ >> 1] = __builtin_bit_cast(bf16x8, w_); } } \
            SB(); } \
          \
        _Pragma("unroll") for (int m_ = 0; m_ < NQ * 4; ++m_) { const int j_ = m_ / (2 * NQ), d_ = (m_ / NQ) & 1, qi_ = m_ % NQ; \
            o[qi_][d_] = MFMA(vf[j_ * 2 + d_], pa[qi_][j_], o[qi_][d_]); \
            { const int eq_ = m_ >> 2, eg_ = m_ & 3; \
              SN[eq_][4 * eg_] = __builtin_amdgcn_exp2f(SN[eq_][4 * eg_]); SN[eq_][4 * eg_ + 1] = __builtin_amdgcn_exp2f(SN[eq_][4 * eg_ + 1]); \
              SN[eq_][4 * eg_ + 2] = __builtin_amdgcn_exp2f(SN[eq_][4 * eg_ + 2]); SN[eq_][4 * eg_ + 3] = __builtin_amdgcn_exp2f(SN[eq_][4 * eg_ + 3]); } \
            if (m_ == 0) { if (DOK) LOADK(ktile, kkb); }   \
            SB(); } \
    } while (0)
    WAITV(2); BAR_SYNC();
    A_K(3); if (ntiles > 2) A_V(2);
    LOADK(0, 0);
    for (int t = 0; t < ntiles; ++t) {
        if (t > 0) {
            if (t + 2 < ntiles) { WAITV(2); } else if (t + 1 < ntiles) { WAITV(1); } else { WAITV(0); }
            BAR_SYNC();
            if (t + 3 < ntiles) A_K(t + 3);
            if (t + 2 < ntiles) A_V(t + 2);
        }
        HALF(scA, scB, (t > 0 ? t - 1 : 0), 1, true, t, 1);
        HALF(scB, scA, t, 0, (t + 1 < ntiles), t + 1, 0);
    }
    LOADV(ntiles - 1, 1);
#pragma unroll
    for (int qi = 0; qi < NQ; ++qi) {
#pragma unroll
        for (int i = 0; i < 16; ++i) l0[qi] += scB[qi][i];
        pa[qi][0] = pack8(scB[qi][0], scB[qi][1], scB[qi][2], scB[qi][3], scB[qi][4], scB[qi][5], scB[qi][6], scB[qi][7]);
        pa[qi][1] = pack8(scB[qi][8], scB[qi][9], scB[qi][10], scB[qi][11], scB[qi][12], scB[qi][13], scB[qi][14], scB[qi][15]); }
#pragma unroll
    for (int j = 0; j < 2; ++j)
#pragma unroll
        for (int d0 = 0; d0 < 2; ++d0)
#pragma unroll
            for (int qi = 0; qi < NQ; ++qi) o[qi][d0] = MFMA(vf[j * 2 + d0], pa[qi][j], o[qi][d0]);
#undef A_K
#undef A_V
#undef SB
#undef LOADK
#undef LOADV
#undef HALF
#pragma unroll
    for (int qi = 0; qi < NQ; ++qi) lsum[qi] = add32(l0[qi]);
}
constexpr int PREC = 1152;
__device__ __forceinline__ void store_partial(const Frame& F, int kh, int slot, int R, const f32x16 (&o)[2], float l, int r, int h) {
    bf16_t* rec = F.ws<bf16_t>(WS_PART) + ((size_t)R * 2 + kh) * PREC; const float inv = 1.f / l;
#pragma unroll
    for (int d0 = 0; d0 < 2; ++d0)
#pragma unroll
        for (int g = 0; g < 4; ++g) { u32x2 w = {pk2(o[d0][4 * g] * inv, o[d0][4 * g + 1] * inv), pk2(o[d0][4 * g + 2] * inv, o[d0][4 * g + 3] * inv)};
            const int off = slot < 12 ? (((slot >> 1) * 8 + 4 * d0 + g) * 2 + (slot & 1)) * 8 + 4 * h : 768 + (slot - 12) * 64 + 32 * d0 + 8 * g + 4 * h;
            *(u32x2*)(rec + off) = w; }
    if (h == 0) F.ws<float>(WS_PL)[((size_t)R * 2 + kh) * N_PSLOT + slot] = l;
}
__device__ __forceinline__ void attn_diff_unit(const Frame& F, int l, int head, int R0, int t0, int ntiles, int khalf) {
    const int lane = F.lane, wid = F.wid, r = lane & 31, h = lane >> 5;
    const bf16_t* qp = F.ws<bf16_t>(WS_QD) + (size_t)(head * NQB + (R0 >> 5) + wid) * 2048;
    bf16x8 qf[2][2]; float mi[2];
#pragma unroll
    for (int mp = 0; mp < 2; ++mp) {
#pragma unroll
        for (int s = 0; s < 2; ++s) qf[mp][s] = *(const bf16x8*)(qp + ((4 * mp + 2 * s + h) * 32 + r) * 8);
        float qq = 0.f;
#pragma unroll
        for (int j = 0; j < 8; ++j) { const float a = bf2f((unsigned short)qf[mp][0][j]), b = bf2f((unsigned short)qf[mp][1][j]); qq += a * a + b * b; }
        qq = add32(qq);
        const float km = ((LAS const float*)(F.lds + LDS_CTL + 1024))[2 * head + mp];
        mi[mp] = -sqrtf(qq * km) * 1.01f; }
    f32x16 negm; { const float mm = fminf(mi[0], mi[1]);
#pragma unroll
        for (int i = 0; i < 16; ++i) negm[i] = mm; asm volatile("" : "+v"(negm)); }
    f32x16 o[2][2]; float ls[2];
    attn_sweep<2, 2, true, true>(F, qf, F.ws<bf16_t>(WS_KD) + (size_t)(head * NKT + t0) * 4096, F.ws<bf16_t>(WS_VD) + (size_t)(head * NKT + t0) * 4096, ntiles, negm, o, ls);
    { const int ln = lane_now(), r2 = ln & 31, h2 = ln >> 5, R = R0 + 32 * wid + r2;
#pragma unroll
      for (int mp = 0; mp < 2; ++mp) store_partial(F, khalf, 2 * head + mp, R, o[mp], ls[mp], r2, h2); }
}
template <int NH>
__device__ __forceinline__ void attn_gqa_unit(const Frame& F, int qh0, int kvh, int R0, int t0, int ntiles, int khalf, float bound) {
    const int lane = F.lane, wid = F.wid, r = lane & 31, h = lane >> 5;
    bf16x8 qf[NH][4];
#pragma unroll
    for (int hh = 0; hh < NH; ++hh) { const bf16_t* qp = F.ws<bf16_t>(WS_QG) + (size_t)((qh0 + hh) * NQB + (R0 >> 5) + wid) * 2048;
#pragma unroll
        for (int s = 0; s < 4; ++s) qf[hh][s] = *(const bf16x8*)(qp + ((2 * s + h) * 32 + r) * 8); }
    f32x16 o[NH][2]; float ls[NH]; f32x16 negm;
#pragma unroll
    for (int i = 0; i < 16; ++i) negm[i] = 0.f;
    attn_sweep<NH, 4, false, false>(F, qf, F.ws<bf16_t>(WS_KG) + (size_t)(kvh * NKT + t0) * 4096, F.ws<bf16_t>(WS_VG) + (size_t)(kvh * NKT + t0) * 4096, ntiles, negm, o, ls);
    { const int ln = lane_now(), r2 = ln & 31, h2 = ln >> 5, R = R0 + 32 * wid + r2;
#pragma unroll
      for (int hh = 0; hh < NH; ++hh) store_partial(F, khalf, 12 + qh0 + hh, R, o[hh], ls[hh], r2, h2); }
}

__device__ __forceinline__ void phase_attn(const Frame& F, int l, int rep) {
    if (F.wid >= 4) __builtin_amdgcn_s_setprio(1);
    float gqm = 0.f, gkm = 0.f; { const float* gq = F.in(I_GQ) + 64 * l; const float* gk = F.in(I_GK) + 64 * l; for (int i = 0; i < 64; ++i) { gqm = fmaxf(gqm, fabsf(gq[i])); gkm = fmaxf(gkm, fabsf(gk[i])); } }
    const float bg = fminf(8.f * gqm * gkm * LOG2E * 1.01f, 100.f);
    for (int mp = F.wid; mp < 12; mp += 8) { const float* kp = F.ws<float>(WS_KP) + (size_t)(l * 12 + mp) * 1024; float mx = 0.f;
#pragma unroll
        for (int q = 0; q < 4; ++q) { const f32x4 v = *(const f32x4*)(kp + 256 * q + 4 * F.lane); mx = fmaxf(fmaxf(mx, fmaxf(v[0], v[1])), fmaxf(v[2], v[3])); }
        mx = wave_max(mx); mx = fmaxf(mx, __uint_as_float(__hip_atomic_load(F.ctl + CW_KMAX + 16 * l + mp, __ATOMIC_RELAXED, __HIP_MEMORY_SCOPE_AGENT)));
        if (F.lane == 0) ((LAS float*)(F.lds + LDS_CTL + 1024))[mp] = mx; }
    __syncthreads();
    constexpr int HT = NKT / 2;
    for (int u = F.bid; u < 256; u += F.G) { const int cb = (u & 7) >> 1, rb = ((u >> 3) << 1) | (u & 1), R0 = NCTX + 256 * rb; const int kvh = cb >> 1, kh = cb & 1;
        attn_gqa_unit<2>(F, 3 * kvh, kvh, R0, kh * HT, HT, kh, bg); }
    for (int u = F.bid; u < 768; u += F.G) { const int j = u >> 8, v = u & 255, cb = 4 * j + ((v & 7) >> 1), rb = ((v >> 3) << 1) | (v & 1), R0 = NCTX + 256 * rb; const int head = cb >> 1, kh = cb & 1;
        attn_diff_unit(F, l, head, R0, kh * HT, HT, kh); }
    for (int u = F.bid; u < 256; u += F.G) { const int cb = (u & 7) >> 1, rb = ((u >> 3) << 1) | (u & 1), R0 = NCTX + 256 * rb; const int kvh = cb >> 1, kh = cb & 1;
        attn_gqa_unit<1>(F, 3 * kvh + 2, kvh, R0, kh * HT, HT, kh, bg); }
    for (int u = F.bid; u < 256; u += F.G) { const int l2 = u >> 1, ch = u & 1;
        dft_unit<128, 0>(F, F.ws<bf16_t>(WS_A1F), F.ws<bf16_t>(WS_FT) + (size_t)(l2 * 2 + ch) * 4 * 4096, l2, ch, 0); }
    if (l == 0) {
        for (int u = F.bid; u < 14; u += F.G) {
            if (u < 4) { const int pa = u >> 1, ch = u & 1; dft_unit<256, 2>(F, F.ws<bf16_t>(WS_ACF) + (size_t)pa * 65536, F.ws<bf16_t>(WS_FC) + (size_t)ch * 4 * 8192, 0, ch, pa); }
            else if (u < 10) attn_diff_unit(F, l, u - 4, 0, 0, NCTX / 64, 0);
            else if (u < 12) attn_gqa_unit<2>(F, 3 * (u - 10), u - 10, 0, 0, NCTX / 64, 0, bg);
            else attn_gqa_unit<1>(F, 3 * (u - 12) + 2, u - 12, 0, 0, NCTX / 64, 0, bg);
        }
    }
    __builtin_amdgcn_s_setprio(0);
}
__device__ __forceinline__ void unpack8(const u32x4& w, float (&f)[8]) { f[0] = bflo(w[0]); f[1] = bfhi(w[0]); f[2] = bflo(w[1]); f[3] = bfhi(w[1]); f[4] = bflo(w[2]); f[5] = bfhi(w[2]); f[6] = bflo(w[3]); f[7] = bfhi(w[3]); }
__device__ __forceinline__ void attn_merge(const Frame& F, int l) {
    const int lane = F.lane, un = lane >> 3, dc = lane & 7; const bool act = lane < 48;
    const float* lq1 = F.in(I_LQ1) + 32 * l; const float* lk1 = F.in(I_LK1) + 32 * l; const float* lq2 = F.in(I_LQ2) + 32 * l; const float* lk2 = F.in(I_LK2) + 32 * l;
    float d1 = 0.f, d2 = 0.f; for (int i = 0; i < 32; ++i) { d1 += lq1[i] * lk1[i]; d2 += lq2[i] * lk2[i]; }
    const float lam_init = 0.8f - 0.6f * expf(-0.3f * (float)l); const float lam = expf(d1) - expf(d2) + lam_init, post = 1.f - lam_init;
    float gs[8]; { const float* g = F.in(I_GSUB) + 64 * l + 8 * dc; for (int j = 0; j < 8; ++j) gs[j] = g[j]; }
    const bf16_t* part = F.ws<bf16_t>(WS_PART); const float* pl = F.ws<float>(WS_PL); bf16_t* mix = F.ws<bf16_t>(WS_MIX);
    const int Rbeg = l == 0 ? 0 : NCTX; const int u6 = act ? un : 0;
    for (int R = Rbeg + F.bid * 8 + F.wid; R < NT; R += F.G * 8) {
        const bool two = R >= NCTX; bf16_t* mr = mix + (size_t)R * MIXK;
        const bf16_t* ra = part + (size_t)R * 2 * PREC; const bf16_t* rb = ra + PREC; const float* la = pl + (size_t)R * 2 * N_PSLOT; const float* lb = la + N_PSLOT;
        { const u32x4 a0 = *(const u32x4*)(ra + (u6 * 8 + dc) * 16), a1 = *(const u32x4*)(ra + (u6 * 8 + dc) * 16 + 8);
          u32x4 b0 = {0u, 0u, 0u, 0u}, b1 = b0; float lb0 = 0.f, lb1 = 0.f;
          if (two) { b0 = *(const u32x4*)(rb + (u6 * 8 + dc) * 16); b1 = *(const u32x4*)(rb + (u6 * 8 + dc) * 16 + 8); lb0 = lb[2 * u6]; lb1 = lb[2 * u6 + 1]; }
          const float la0 = la[2 * u6], la1 = la[2 * u6 + 1]; const float i0 = 1.f / (la0 + lb0), i1 = lam / (la1 + lb1);
          float fa0[8], fa1[8], fb0[8], fb1[8], v[8]; unpack8(a0, fa0); unpack8(a1, fa1); unpack8(b0, fb0); unpack8(b1, fb1);
          float ss = 0.f;
#pragma unroll
          for (int j = 0; j < 8; ++j) { v[j] = (la0 * fa0[j] + lb0 * fb0[j]) * i0 - (la1 * fa1[j] + lb1 * fb1[j]) * i1; ss += v[j] * v[j]; }
          ss += shxc<1>(ss); ss += shxc<2>(ss); ss += shxc<4>(ss);
          const float rs = rsqrtf(ss * (1.f / 64.f) + 1e-5f) * post;
          if (act) { u32x4 w = {pk2(v[0] * rs * gs[0], v[1] * rs * gs[1]), pk2(v[2] * rs * gs[2], v[3] * rs * gs[3]), pk2(v[4] * rs * gs[4], v[5] * rs * gs[5]), pk2(v[6] * rs * gs[6], v[7] * rs * gs[7])};
              *(u32x4*)(mr + 512 + 64 * un + 8 * dc) = w; } }
        { const u32x4 a0 = *(const u32x4*)(ra + 768 + u6 * 64 + dc * 8); u32x4 b0 = {0u, 0u, 0u, 0u}; float lbq = 0.f;
          if (two) { b0 = *(const u32x4*)(rb + 768 + u6 * 64 + dc * 8); lbq = lb[12 + u6]; }
          const float laq = la[12 + u6], iq = 1.f / (laq + lbq); float fa[8], fb[8]; unpack8(a0, fa); unpack8(b0, fb);
          if (act) { float o[8];
#pragma unroll
              for (int j = 0; j < 8; ++j) o[j] = (laq * fa[j] + lbq * fb[j]) * iq;
              u32x4 w = {pk2(o[0], o[1]), pk2(o[2], o[3]), pk2(o[4], o[5]), pk2(o[6], o[7])}; *(u32x4*)(mr + 896 + 64 * un + 8 * dc) = w; } }
    }
}
__device__ __forceinline__ void phase_fft2(const Frame& F, int l) {
    for (int u = F.bid; u < 256; u += F.G) { const int k1 = u >> 1, ch = u & 1;
        dft_unit<256, 1>(F, F.ws<bf16_t>(WS_A2F), F.ws<bf16_t>(WS_T2) + (size_t)(k1 * 2 + ch) * 4 * 8192, k1, ch, 0); }
    attn_merge(F, l);
}

__device__ __forceinline__ void phase_router(const Frame& F, int l) {
    LAS float* wl = (LAS float*)F.lds;
    LAS unsigned* hist = (LAS unsigned*)(F.lds + 131072);
    LAS unsigned* recs = hist + 64;
    const int lane = F.lane, wid = F.wid, t = F.tid;
    const float* wr = F.in(I_WR) + (size_t)l * 1024 * 32;
    __syncthreads();
    for (int i = t; i < 8192; i += 512) { const int k = i >> 3, c = i & 7; const f32x4 v = *(const f32x4*)(wr + k * 32 + 4 * c); *(LAS f32x4*)(wl + k * 32 + 4 * (c ^ ((k >> 2) & 7))) = v; }
    if (t < 64) hist[t] = 0u;
    __syncthreads();
    const int Rbeg = l == 0 ? 0 : NCTX, ntok = NT - Rbeg, per = (ntok + F.G - 1) / F.G;
    const int r0 = Rbeg + F.bid * per, r1 = min(r0 + per, NT);
    const float* mod = F.ws<float>(WS_MOD) + (size_t)l * 2 * 6144; const float* g2 = F.in(I_GN2) + 1024 * l; const float* br = F.in(I_BR) + 32 * l;
    const float* xs = F.ws<float>(WS_XS); bf16_t* hb = F.ws<bf16_t>(WS_HB);
    unsigned* slot = F.ws<unsigned>(WS_SLOT); float* gate = F.ws<float>(WS_GATE);
    const float bre = br[lane >> 1];
    for (int R = r0 + wid; R < r1; R += 16) {
        const int R2 = R + 8; const bool two = R2 < r1; const int Rb = two ? R2 : R;
        f32x4 hv[2][4];
        { f32x4 xa[4], xb[4]; load_row(xs + (size_t)R * DM, lane, xa); load_row(xs + (size_t)Rb * DM, lane, xb);
          const float* ma = mod + (R < NCTX ? 6144 : 0); const float* mb = mod + (Rb < NCTX ? 6144 : 0);
          const float rsa = row_rstd(xa, 1e-6f), rsb = row_rstd(xb, 1e-6f);
          mod_store_bf16(xa, rsa, g2, ma + 3072, ma + 4096, hb + (size_t)R * DM, lane, &hv[0]);
          mod_store_bf16(xb, rsb, g2, mb + 3072, mb + 4096, hb + (size_t)Rb * DM, lane, &hv[1]); }
        f32x2 accp[32];
#pragma unroll
        for (int e = 0; e < 32; ++e) accp[e] = (f32x2){0.f, 0.f};
#pragma unroll
        for (int q = 0; q < 4; ++q)
#pragma unroll
            for (int i = 0; i < 4; ++i) { const int k = 256 * q + 4 * lane + i; const f32x2 hx = {hv[0][q][i], hv[1][q][i]}; const int sw = (k >> 2) & 7;
#pragma unroll
                for (int c = 0; c < 8; ++c) { const f32x4 w = *(LAS const f32x4*)(wl + k * 32 + 4 * (c ^ sw));
#pragma unroll
                    for (int j = 0; j < 4; ++j) accp[4 * c + j] = __builtin_elementwise_fma(hx, (f32x2){w[j], w[j]}, accp[4 * c + j]); } }
        f32x2 a16[16], a8[8], a4[4], a2[2], a1;
        { const bool b = lane & 32;
#pragma unroll
          for (int j = 0; j < 16; ++j) { const f32x2 keep = b ? accp[16 + j] : accp[j], send = b ? accp[j] : accp[16 + j]; a16[j] = (f32x2){keep[0] + partner32(send[0], b), keep[1] + partner32(send[1], b)}; } }
        { const bool b = lane & 16;
#pragma unroll
          for (int j = 0; j < 8; ++j) { const f32x2 keep = b ? a16[8 + j] : a16[j], send = b ? a16[j] : a16[8 + j]; a8[j] = (f32x2){keep[0] + shxc<16>(send[0]), keep[1] + shxc<16>(send[1])}; } }
        { const bool b = lane & 8;
#pragma unroll
          for (int j = 0; j < 4; ++j) { const f32x2 keep = b ? a8[4 + j] : a8[j], send = b ? a8[j] : a8[4 + j]; a4[j] = (f32x2){keep[0] + shxc<8>(send[0]), keep[1] + shxc<8>(send[1])}; } }
        { const bool b = lane & 4;
#pragma unroll
          for (int j = 0; j < 2; ++j) { const f32x2 keep = b ? a4[2 + j] : a4[j], send = b ? a4[j] : a4[2 + j]; a2[j] = (f32x2){keep[0] + shxc<4>(send[0]), keep[1] + shxc<4>(send[1])}; } }
        { const bool b = lane & 2; const f32x2 keep = b ? a2[1] : a2[0], send = b ? a2[0] : a2[1]; a1 = (f32x2){keep[0] + shxc<2>(send[0]), keep[1] + shxc<2>(send[1])}; }
        a1 = (f32x2){a1[0] + shxc<1>(a1[0]), a1[1] + shxc<1>(a1[1])};
        const int e = lane >> 1; float v0 = a1[0] + bre, v1 = a1[1] + bre;
        float tv0[4], tv1[4]; int te0[4], te1[4];
#pragma unroll
        for (int kk = 0; kk < 4; ++kk) { const float m0 = wave_max(v0), m1 = wave_max(v1);
            const unsigned long long b0 = __ballot(v0 == m0), b1 = __ballot(v1 == m1); const int l0 = __ffsll((long long)b0) - 1, l1 = __ffsll((long long)b1) - 1;
            te0[kk] = l0 >> 1; tv0[kk] = m0; if (e == te0[kk]) v0 = -INFINITY; te1[kk] = l1 >> 1; tv1[kk] = m1; if (e == te1[kk]) v1 = -INFINITY; }
#pragma unroll
        for (int tk = 0; tk < 2; ++tk) { const float* tv = tk ? tv1 : tv0; const int* te = tk ? te1 : te0; const int Rt = tk ? R2 : R;
            const float e1 = __expf(tv[1] - tv[0]), e2 = __expf(tv[2] - tv[0]), e3 = __expf(tv[3] - tv[0]); const float inv = 1.f / (1.f + e1 + e2 + e3);
            if (lane < 4 && (tk == 0 || two)) { const int ee = lane == 0 ? te[0] : lane == 1 ? te[1] : lane == 2 ? te[2] : te[3]; const float gg = (lane == 0 ? 1.f : lane == 1 ? e1 : lane == 2 ? e2 : e3) * inv;
                const unsigned lr = atomicAdd((unsigned*)(hist + ee), 1u);
                const int ti = Rt - r0; recs[ti * 4 + lane] = ((unsigned)ee << 24) | lr; gate[(size_t)Rt * 4 + lane] = gg; } }
    }
    __syncthreads();
    if (t < 32) { const unsigned c = hist[t]; hist[32 + t] = c ? xb_add(F.ctl + CW_CNT + 64 * l + t, c) : 0u; }
    __syncthreads();
    unsigned* list = F.ws<unsigned>(WS_LIST);
    for (int i = t; i < (r1 - r0) * 4; i += 512) { const unsigned rec = recs[i]; const unsigned ee = rec >> 24, rk = (rec & 0xffffffu) + hist[32 + ee]; const int R = r0 + (i >> 2);
        slot[(size_t)R * 4 + (i & 3)] = (ee << 24) | rk; list[(size_t)ee * NT + rk] = (unsigned)R; }
    __syncthreads();
}

__device__ __forceinline__ void phase_combine(const Frame& F, int l) {
    const int lane = F.lane; const float* mod = F.ws<float>(WS_MOD) + (size_t)l * 2 * 6144; const float* modn = F.ws<float>(WS_MOD) + (size_t)(l + 1) * 2 * 6144;
    float* xs = F.ws<float>(WS_XS); const bf16_t* yb = F.ws<bf16_t>(WS_YB); const unsigned* slot = F.ws<unsigned>(WS_SLOT); const float* gate = F.ws<float>(WS_GATE); bf16_t* hb = F.ws<bf16_t>(WS_HB);
    int offs = 0;
    { const int ce = lane < NEXP ? (int)__hip_atomic_load(F.ctl + CW_CNT + 64 * l + lane, __ATOMIC_RELAXED, __HIP_MEMORY_SCOPE_AGENT) : 0;
      int inc = ce;
#pragma unroll
      for (int d = 1; d < 32; d <<= 1) { const int up = __builtin_amdgcn_ds_bpermute(((lane - d) & 63) << 2, inc); if (lane >= d) inc += up; }
      offs = inc - ce; }
    const int Rbeg = l == 0 ? 0 : NCTX; float* outb = F.outp(); const float* gn1 = F.in(I_GN1) + 1024; const float* gf = F.in(I_GFIN);
    for (int R = Rbeg + F.bid * 8 + F.wid; R < NT; R += F.G * 8) {
        const float* m = mod + (R < NCTX ? 6144 : 0);
        f32x4 x[4], a[4]; load_row(xs + (size_t)R * DM, lane, x);
#pragma unroll
        for (int q = 0; q < 4; ++q) a[q] = (f32x4){0.f, 0.f, 0.f, 0.f};
#pragma unroll
        for (int s = 0; s < 4; ++s) { const unsigned rec = slot[(size_t)R * 4 + s]; const float g = gate[(size_t)R * 4 + s]; const int pos = __builtin_amdgcn_ds_bpermute((int)((rec >> 24) << 2), offs) + (int)(rec & 0xffffffu);
            const bf16_t* yr = yb + (size_t)pos * DM;
#pragma unroll
            for (int q = 0; q < 4; ++q) { const u32x2 w = *(const u32x2*)(yr + 256 * q + 4 * lane); a[q][0] += g * bflo(w[0]); a[q][1] += g * bfhi(w[0]); a[q][2] += g * bflo(w[1]); a[q][3] += g * bfhi(w[1]); } }
#pragma unroll
        for (int q = 0; q < 4; ++q) { const f32x4 gt = *(const f32x4*)(m + 5120 + 256 * q + 4 * lane);
#pragma unroll
            for (int i = 0; i < 4; ++i) x[q][i] += gt[i] * a[q][i]; }
        const float rstd = row_rstd(x, 1e-6f);
        if (l == 0) {
#pragma unroll
            for (int q = 0; q < 4; ++q) *(f32x4*)(xs + (size_t)R * DM + 256 * q + 4 * lane) = x[q];
            const float* mn = modn + (R < NCTX ? 6144 : 0);
            mod_store_bf16(x, rstd, gn1, mn, mn + 1024, hb + (size_t)R * DM, lane);
        } else {
            float* orow = outb + (size_t)(R - NCTX) * DM;
#pragma unroll
            for (int q = 0; q < 4; ++q) { const f32x4 gv = *(const f32x4*)(gf + 256 * q + 4 * lane); f32x4 o;
#pragma unroll
                for (int i = 0; i < 4; ++i) o[i] = x[q][i] * rstd * gv[i];
                *(f32x4*)(orow + 256 * q + 4 * lane) = o; }
        }
    }
}

__device__ __forceinline__ int opaque_i32(int v) { asm volatile("" : "+s"(v)); return __builtin_amdgcn_readfirstlane(v); }
__device__ __forceinline__ unsigned long long opaque_u64(unsigned long long w) { int lo = (int)(unsigned)w, hi = (int)(unsigned)(w >> 32); lo = opaque_i32(lo); hi = opaque_i32(hi);
    return ((unsigned long long)(unsigned)hi << 32) | (unsigned)lo; }
__device__ __forceinline__ Frame fresh(const Frame& F) { Frame G = F;
    G.wsb = (unsigned char*)opaque_u64((unsigned long long)F.wsb); G.ctl = (unsigned*)opaque_u64((unsigned long long)F.ctl);
    G.pp = (const __attribute__((address_space(4))) Params*)opaque_u64((unsigned long long)F.pp);
    G.wid = opaque_i32(F.wid); G.bid = opaque_i32(F.bid); G.G = opaque_i32(F.G);
    G.lane = lane_now(); G.tid = G.wid * 64 + G.lane; return G; }
constexpr int N_PHASES = 18;
__global__ void __launch_bounds__(NTHREADS, 2) mk_fwd(Params P, int ph_lo, int ph_hi, int probe) {
    extern __shared__ __attribute__((aligned(16))) unsigned char smem_raw[];
    Frame F; F.pp = (const __attribute__((address_space(4))) Params*)__builtin_amdgcn_kernarg_segment_ptr(); F.wsb = P.ws; F.lds = (LAS char*)smem_raw; F.tid = threadIdx.x; F.lane = F.tid & 63; F.wid = __builtin_amdgcn_readfirstlane(F.tid >> 6); F.G = gridDim.x; F.bid = blockIdx.x;
    F.ctl = (unsigned*)(P.ws + WS_CTL);
    LAS unsigned* bw = (LAS unsigned*)(F.lds + LDS_CTL);
    if (F.tid < 4) bw[F.tid] = 0u;
    __syncthreads();
    XcdBarrier bar;
    if (MK_ONE_LAUNCH) bar = xcd_barrier_post(F.ctl + CW_BAR, (volatile LAS unsigned*)bw, F.wid);
#ifndef PHASE_MASK
#define PHASE_MASK 0xFFFFFFFFu
#endif
#if MK_ONE_LAUNCH
#define IN(k) (((PHASE_MASK >> ((k) >= 10 ? (k) - 8 : (k))) & 1u) != 0u)
#else
#define IN(k) (((PHASE_MASK >> ((k) >= 10 ? (k) - 8 : (k))) & 1u) && ph_lo <= (k) && (k) < ph_hi)
#endif
#define SEAM(k) do { if (MK_ONE_LAUNCH && IN(k) && IN((k) + 1)) xcd_barrier(bar); } while (0)
#define RUN(k, code, body) do { if (IN(k)) { const int nr_ = (opaque_i32(probe) == (code)) ? 2 : 1; _Pragma("unroll 1") for (int rep = 0; rep < nr_; ++rep) { body; if (MK_ONE_LAUNCH && rep + 1 < nr_) xcd_barrier(bar); } } SEAM(k); } while (0)
    RUN(0, 100, phase_prologue(fresh(F)));
    RUN(1, 101, phase_norm0(fresh(F)));
#pragma unroll 1
    for (int l = 0; l < 2; ++l) {
        const int b = 2 + 8 * l;
        RUN(b + 0, 0, phase_inproj(fresh(F), l));
        RUN(b + 1, 1, phase_attn(fresh(F), l, rep));
        RUN(b + 2, 2, phase_fft2(fresh(F), l));
        RUN(b + 3, 3 + 10 * l, phase_outproj(fresh(F), l));
        RUN(b + 4, 104, phase_router(fresh(F), l));
        RUN(b + 5, 5, phase_gateup(fresh(F), l));
        RUN(b + 6, 6, phase_down(fresh(F), l));
        RUN(b + 7, 17 - 10 * l, phase_combine(fresh(F), l));
    }
}

extern "C" void kernel_launch(void* const* d_in, const int* in_sizes, int n_in, void* d_out, int out_size, void* d_ws, size_t ws_size, hipStream_t stream) {
    static int grid = 0;
    if (!grid) {
        int dev = 0, cus = 0, per_cu = 0;
        hipGetDevice(&dev);
        hipDeviceGetAttribute(&cus, hipDeviceAttributeMultiprocessorCount, dev);
        hipFuncSetAttribute((const void*)mk_fwd, hipFuncAttributeMaxDynamicSharedMemorySize, LDS_BYTES);
        hipOccupancyMaxActiveBlocksPerMultiprocessor(&per_cu, (const void*)mk_fwd, NTHREADS, LDS_BYTES);
        if (per_cu < 1) { fprintf(stderr, "mk_fwd: occupancy query says %d blocks per CU\n", per_cu); per_cu = 1; }
        grid = cus * 1;
        if (ws_size < WS_END) fprintf(stderr, "mk_fwd: workspace too small (%zu < %zu)\n", ws_size, (size_t)WS_END);
    }
    hipMemsetAsync(d_ws, 0, CTL_BYTES, stream);
    Params p{};
    for (int i = 0; i < 25; ++i) p.in[i] = (const float*)d_in[i];
    p.out = (float*)d_out; p.ws = (unsigned char*)d_ws;
#if MK_ONE_LAUNCH
    hipLaunchKernelGGL(mk_fwd, dim3(grid), dim3(NTHREADS), LDS_BYTES, stream, p, 0, N_PHASES, MK_PROBE);
#else
    for (int k = 0; k < N_PHASES; ++k) hipLaunchKernelGGL(mk_fwd, dim3(grid), dim3(NTHREADS), LDS_BYTES, stream, p, k, k + 1, -1);
#endif
}
```

```cpp
#include <hip/hip_runtime.h>
#include <cstdio>
#include <cstdint>

#ifndef MK_PROBE
#define MK_PROBE -1
#endif
#ifndef MK_ONE_LAUNCH
#define MK_ONE_LAUNCH 1
#endif

#define LAS __attribute__((address_space(3)))
typedef unsigned short bf16_t;
typedef short bf16x8 __attribute__((ext_vector_type(8)));
typedef short s16x4 __attribute__((ext_vector_type(4)));
typedef float f32x16 __attribute__((ext_vector_type(16)));
typedef float f32x4 __attribute__((ext_vector_type(4)));
typedef float f32x2 __attribute__((ext_vector_type(2)));
typedef unsigned u32x4 __attribute__((ext_vector_type(4)));
typedef unsigned u32x2 __attribute__((ext_vector_type(2)));
typedef __bf16 bf16x2_t __attribute__((ext_vector_type(2)));
typedef short v4i16_t __attribute__((ext_vector_type(4)));

constexpr int DM = 1024, LSEQ = 16384, NCTX = 256, NT = LSEQ + NCTX, INW = 2048, NEXP = 32, FFD = 1024, MIXK = 1280;
constexpr int NKT = NT / 64;
constexpr int NQB = NT / 32;
constexpr float LOG2E = 1.4426950408889634f;
constexpr int NTHREADS = 512;
constexpr int LDS_BYTES = 155648;
constexpr int LDS_CTL = 151552;

constexpr size_t al256(size_t x) { return (x + 255) & ~(size_t)255; }
constexpr size_t WS_CTL = 0, CTL_BYTES = 1u << 20;
constexpr size_t WS_MOD = CTL_BYTES;
constexpr size_t WS_ROPE = WS_MOD + 131072;
constexpr size_t WS_TW = WS_ROPE + 65536;
constexpr size_t WS_A1F = WS_TW + 131072;
constexpr size_t WS_A2F = WS_A1F + 65536;
constexpr size_t WS_ACF = WS_A2F + 131072;
constexpr size_t WS_WIN = WS_ACF + 262144;
constexpr size_t WS_WOUT = WS_WIN + (size_t)2 * INW * DM * 2;
constexpr size_t WS_WGU = WS_WOUT + (size_t)2 * DM * MIXK * 2;
constexpr size_t WS_WDN = WS_WGU + (size_t)2 * NEXP * 2048 * DM * 2;
constexpr size_t WS_HB = WS_WDN + (size_t)2 * NEXP * DM * FFD * 2;
constexpr size_t WS_QD = WS_HB + (size_t)NT * DM * 2;
constexpr size_t WS_KD = WS_QD + (size_t)6 * NQB * 2048 * 2;
constexpr size_t WS_VD = WS_KD + (size_t)6 * NKT * 4096 * 2;
constexpr size_t WS_QG = WS_VD + (size_t)6 * NKT * 4096 * 2;
constexpr size_t WS_KG = WS_QG + (size_t)6 * NQB * 2048 * 2;
constexpr size_t WS_VG = WS_KG + (size_t)2 * NKT * 4096 * 2;
constexpr size_t WS_FT = WS_VG + (size_t)2 * NKT * 4096 * 2;
constexpr size_t WS_FC = WS_FT + (size_t)128 * 2 * 4 * 4096 * 2;
constexpr size_t WS_T2 = WS_FC + (size_t)2 * 4 * 8192 * 2;
constexpr size_t WS_MIX = WS_T2 + (size_t)128 * 2 * 4 * 8192 * 2;
constexpr size_t WS_XS = WS_MIX + (size_t)NT * MIXK * 2;
constexpr size_t WS_LIST = WS_XS + (size_t)NT * DM * 4;
constexpr size_t WS_SLOT = WS_LIST + (size_t)NEXP * NT * 4;
constexpr size_t WS_GATE = WS_SLOT + (size_t)NT * 16;
constexpr size_t WS_ACT = WS_GATE + (size_t)NT * 16;
constexpr size_t WS_YB = WS_ACT + (size_t)NT * 4 * FFD * 2;
constexpr size_t WS_PART = WS_YB + (size_t)NT * 4 * DM * 2;
constexpr size_t WS_PL = WS_PART + (size_t)36 * NT * 64 * 2;
constexpr size_t WS_KP = WS_PL + (size_t)36 * NT * 4;
constexpr size_t WS_END = WS_KP + (size_t)2 * 12 * 1024 * 4;

constexpr int CW_BAR = 4096;
constexpr int CW_CNT = 8192;
constexpr int CW_KMAX = 8320;
constexpr int CW_QH = 8448;

constexpr int RD_RC = 0, RD_RS = 2048, RD_CC = 4096, RD_CS = 4608, RG_RC = 5120, RG_RS = 9216, RG_CC = 13312, RG_CS = 14336, ROPE_N = 15360;

struct Params { const float* in[25]; float* out; unsigned char* ws; };
enum { I_X = 0, I_C, I_CTX, I_CCTX, I_WMOD, I_BMOD, I_GN1, I_GN2, I_WIN, I_WOUT, I_WFNET, I_LQ1, I_LK1, I_LQ2, I_LK2, I_GSUB, I_GQ, I_GK, I_WR, I_BR, I_WGU, I_BGU, I_WDN, I_BDN, I_GFIN };

__device__ __forceinline__ unsigned pk2(float lo, float hi) { f32x2 v = {lo, hi}; bf16x2_t b = __builtin_convertvector(v, bf16x2_t); return __builtin_bit_cast(unsigned, b); }
__device__ __forceinline__ float bf2f(unsigned short u) { return __builtin_bit_cast(float, (unsigned)u << 16); }
__device__ __forceinline__ float bflo(unsigned u) { return __builtin_bit_cast(float, u << 16); }
__device__ __forceinline__ float bfhi(unsigned u) { return __builtin_bit_cast(float, u & 0xffff0000u); }
#define WAITV(n) asm volatile("s_waitcnt vmcnt(" #n ")" ::: "memory")
#define BAR_SYNC() do { asm volatile("s_waitcnt lgkmcnt(0)" ::: "memory"); __builtin_amdgcn_s_barrier(); asm volatile("" ::: "memory"); } while (0)
__device__ __forceinline__ void dma16(const void* g, LAS void* l) { __builtin_amdgcn_global_load_lds((const unsigned*)g, (LAS unsigned*)l, 16, 0, 0); }
__device__ __forceinline__ void glds16(const void* gsrc, unsigned lds_dst) { unsigned keep;
    asm volatile("s_mov_b32 %0, m0\n\ts_mov_b32 m0, %2\n\ts_nop 0\n\tglobal_load_lds_dwordx4 %1, off\n\ts_mov_b32 m0, %0" : "=&s"(keep) : "v"(gsrc), "s"(lds_dst) : "memory"); }
__device__ __forceinline__ s16x4 vtr(LAS const char* p) { return __builtin_bit_cast(s16x4, __builtin_amdgcn_ds_read_tr16_b64_v4i16((LAS v4i16_t*)p)); }
__device__ __forceinline__ int lane_now() { unsigned z = 0u; asm volatile("" : "+v"(z)); return (int)__builtin_amdgcn_mbcnt_hi(~0u, __builtin_amdgcn_mbcnt_lo(~0u, z)); }
template <int M> __device__ __forceinline__ float shxc(float v) { return __builtin_bit_cast(float, __builtin_amdgcn_ds_bpermute((lane_now() ^ M) << 2, __builtin_bit_cast(int, v))); }
__device__ __forceinline__ float add32(float v) { return v + shxc<32>(v); }
__device__ __forceinline__ float max32(float v) { return fmaxf(v, shxc<32>(v)); }
__device__ __forceinline__ float partner32(float v, bool upper) { return shxc<32>(v); }
template <int CTRL, int ROWMASK, bool BC> __device__ __forceinline__ float dppf(float old, float src) {
    return __builtin_bit_cast(float, __builtin_amdgcn_update_dpp(__builtin_bit_cast(int, old), __builtin_bit_cast(int, src), CTRL, ROWMASK, 0xf, BC)); }
__device__ __forceinline__ float wave_sum(float v) {
    v += dppf<0x111, 0xf, true>(0.f, v); v += dppf<0x112, 0xf, true>(0.f, v); v += dppf<0x114, 0xf, true>(0.f, v); v += dppf<0x118, 0xf, true>(0.f, v);
    v += dppf<0x142, 0xa, false>(0.f, v); v += dppf<0x143, 0xc, false>(0.f, v);
    return __builtin_bit_cast(float, __builtin_amdgcn_readlane(__builtin_bit_cast(int, v), 63)); }
__device__ __forceinline__ float wave_max(float v) {
    v = fmaxf(v, dppf<0x111, 0xf, false>(v, v)); v = fmaxf(v, dppf<0x112, 0xf, false>(v, v)); v = fmaxf(v, dppf<0x114, 0xf, false>(v, v)); v = fmaxf(v, dppf<0x118, 0xf, false>(v, v));
    v = fmaxf(v, dppf<0x142, 0xa, false>(v, v)); v = fmaxf(v, dppf<0x143, 0xc, false>(v, v));
    return __builtin_bit_cast(float, __builtin_amdgcn_readlane(__builtin_bit_cast(int, v), 63)); }
__device__ __forceinline__ bf16x8 pack8(float a0, float a1, float a2, float a3, float a4, float a5, float a6, float a7) {
    u32x4 w = {pk2(a0, a1), pk2(a2, a3), pk2(a4, a5), pk2(a6, a7)}; return __builtin_bit_cast(bf16x8, w); }
#define MFMA(a, b, c) __builtin_amdgcn_mfma_f32_32x32x16_bf16((a), (b), (c), 0, 0, 0)

#define XB_TMO      128
#define XB_XCNT(j)  (256  + 64 * (j))
#define XB_XSUB(j)  (1280 + 64 * (j))
#define XB_XGEN(j)  (2304 + 64 * (j))
#define XB_TOP      3328
#define XB_TOPGEN   3392
#define XCD_BAR_WORDS 3456
#define XB_SPIN_CAP (1u << 22)
__device__ __forceinline__ unsigned xb_ld(unsigned* p)              { return __hip_atomic_load(p, __ATOMIC_RELAXED, __HIP_MEMORY_SCOPE_AGENT); }
__device__ __forceinline__ unsigned xb_add(unsigned* p, unsigned v) { return __hip_atomic_fetch_add(p, v, __ATOMIC_RELAXED, __HIP_MEMORY_SCOPE_AGENT); }
__device__ __forceinline__ unsigned xb_xcc_id() { return (unsigned)__builtin_amdgcn_s_getreg((3 << 11) | 20) & 0xFu; }
#define XB_SPIN(cond, bar) do { unsigned _sp = 0; while (cond) { __builtin_amdgcn_s_sleep(1); \
    if ((++_sp & 255u) == 0u) { if (xb_ld(&(bar)[XB_TMO])) break; if (_sp > XB_SPIN_CAP) { atomicAdd(&(bar)[XB_TMO], 1u); break; } } } } while (0)
struct XcdBarrier { unsigned* bar; unsigned x; volatile LAS unsigned* st; int wid; };
__device__ __forceinline__ bool xb_leader(int wid) { unsigned z = 0u; asm volatile("" : "+v"(z)); return wid == 0 && __builtin_amdgcn_mbcnt_hi(~0u, __builtin_amdgcn_mbcnt_lo(~0u, z)) == 0u; }
__device__ __forceinline__ XcdBarrier xcd_barrier_post(unsigned* bar, volatile LAS unsigned* st, int wid) {
    XcdBarrier b; b.bar = bar; b.x = xb_xcc_id(); b.st = st; b.wid = wid;
    if (xb_leader(wid)) (void)xb_add(&bar[XB_XCNT(b.x)], 1u);
    return b;
}
__device__ __forceinline__ void xcd_barrier_complete(unsigned* bar, unsigned x, unsigned& nloc, unsigned& nx) {
    const unsigned G = gridDim.x * gridDim.y * gridDim.z;
    unsigned sum, cnt, mine, sp = 0u;
    for (;;) {
        sum = 0u; cnt = 0u; mine = 0u;
#pragma unroll
        for (unsigned j = 0; j < 16; ++j) { const unsigned c = xb_ld(&bar[XB_XCNT(j)]); sum += c; cnt += (c > 0u) ? 1u : 0u; }
        mine = xb_ld(&bar[XB_XCNT(x)]);
        if (sum == G) break;
        __builtin_amdgcn_s_sleep(1);
        if ((++sp & 255u) == 0u) { if (xb_ld(&bar[XB_TMO])) break; if (sp > XB_SPIN_CAP) { atomicAdd(&bar[XB_TMO], 1u); break; } }
    }
    nloc = mine > 0u ? mine : 1u; nx = cnt > 0u ? cnt : 1u;
}
__device__ __forceinline__ void xcd_barrier(const XcdBarrier& b) {
    asm volatile("s_waitcnt vmcnt(0)" ::: "memory");
    __syncthreads();
    if (xb_leader(b.wid)) {
        unsigned* bar = b.bar;
        __builtin_amdgcn_s_waitcnt(0);
        unsigned nloc = b.st[0], nx = b.st[1];
        if (nloc == 0u) { xcd_barrier_complete(bar, b.x, nloc, nx); b.st[0] = nloc; b.st[1] = nx; }
        const unsigned old = xb_add(&bar[XB_XSUB(b.x)], 1u);
        const unsigned gen = old / nloc;
        if (old + 1u == (gen + 1u) * nloc) {
            __builtin_amdgcn_fence(__ATOMIC_RELEASE, "agent");
            asm volatile("s_waitcnt vmcnt(0)" ::: "memory");
            const unsigned og = xb_add(&bar[XB_TOP], 1u);
            const unsigned tg = og / nx;
            if (og + 1u == (tg + 1u) * nx) xb_add(&bar[XB_TOPGEN], 1u);
            else XB_SPIN(xb_ld(&bar[XB_TOPGEN]) == tg, bar);
            __builtin_amdgcn_fence(__ATOMIC_ACQUIRE, "agent");
            xb_add(&bar[XB_XGEN(b.x)], 1u);
            asm volatile("s_waitcnt vmcnt(0)" ::: "memory");
        } else {
            XB_SPIN(xb_ld(&bar[XB_XGEN(b.x)]) == gen, bar);
            __builtin_amdgcn_fence(__ATOMIC_ACQUIRE, "agent");
            asm volatile("s_waitcnt vmcnt(0)" ::: "memory");
        }
    }
    __syncthreads();
}

struct Frame {
    const __attribute__((address_space(4))) Params* pp; unsigned char* wsb; LAS char* lds; int tid, lane, wid, G, bid;
    unsigned* ctl;
    __device__ __forceinline__ const float* in(int i) const { return pp->in[i]; }
    __device__ __forceinline__ float* outp() const { return pp->out; }
    template <class T> __device__ __forceinline__ T* ws(size_t off) const { return (T*)(wsb + off); }
};

template <class RowMap>
__device__ __forceinline__ void transpose_tile(const Frame& F, const float* __restrict__ src, int ldn, int k0, int n0, bf16_t* dst, int ldk, int kdst0, const RowMap& rm) {
    LAS float* tile = (LAS float*)F.lds;
    const int t = F.tid;
    f32x4 v[8];
#pragma unroll
    for (int i = 0; i < 8; ++i) { const int idx = t + 512 * i, k = idx >> 6, c4 = idx & 63; v[i] = *(const f32x4*)(src + (size_t)(k0 + k) * ldn + n0 + 4 * c4); }
#pragma unroll
    for (int i = 0; i < 8; ++i) { const int idx = t + 512 * i, k = idx >> 6, c4 = idx & 63; *(LAS f32x4*)(tile + k * 260 + 4 * c4) = v[i]; }
    __syncthreads();
    { const int n = t >> 1, kh = t & 1; bf16_t* d = dst + (size_t)rm(n0 + n) * ldk + kdst0 + 32 * kh;
#pragma unroll
      for (int q = 0; q < 4; ++q) { float a[8];
#pragma unroll
          for (int j = 0; j < 8; ++j) a[j] = tile[(32 * kh + 8 * q + j) * 260 + n];
          u32x4 w = {pk2(a[0], a[1]), pk2(a[2], a[3]), pk2(a[4], a[5]), pk2(a[6], a[7])}; *(u32x4*)(d + 8 * q) = w; } }
    __syncthreads();
}
struct RowId { __device__ __forceinline__ int operator()(int n) const { return n; } };
struct RowGU { __device__ __forceinline__ int operator()(int n) const { const int ri = n >> 10, j = n & 1023; return 64 * (j >> 5) + 32 * ri + (j & 31); } };

constexpr int P0_GEMV = 192, P0_FOLD = 128, P0_TAB = 16;
constexpr int P0_TWIN = 2 * 16 * 8, P0_TWOUT = 2 * 12 * 4, P0_TWGU = 2 * 32 * 16 * 8, P0_TWDN = 2 * 32 * 16 * 4;
constexpr int P0_ITEMS = P0_GEMV + P0_FOLD + P0_TAB + P0_TWIN + P0_TWOUT + P0_TWGU + P0_TWDN;

__device__ __forceinline__ void p0_gemv(const Frame& F, int item) {
    const int l = item / 96, cc = item % 96, t = F.tid, lane = F.lane, w = F.wid;
    LAS float* sc = (LAS float*)F.lds;
    LAS float* red = sc + 2048;
    const float* c = F.in(I_C); const float* cx = F.in(I_CCTX);
#pragma unroll
    for (int i = 0; i < 2; ++i) { const int k = t + 512 * i; const float a = c[k], b = cx[k]; sc[k] = a / (1.f + __expf(-a)); sc[1024 + k] = b / (1.f + __expf(-b)); }
    __syncthreads();
    const int col = 64 * cc + lane; const float* wm = F.in(I_WMOD) + (size_t)l * 1024 * 6144 + col;
    float a1 = 0.f, a2 = 0.f;
#pragma unroll 8
    for (int k = 128 * w; k < 128 * w + 128; ++k) { const float wv = wm[(size_t)k * 6144]; a1 += sc[k] * wv; a2 += sc[1024 + k] * wv; }
    red[w * 64 + lane] = a1; red[512 + w * 64 + lane] = a2;
    __syncthreads();
    if (w == 0) { float s1 = 0.f, s2 = 0.f;
#pragma unroll
        for (int j = 0; j < 8; ++j) { s1 += red[j * 64 + lane]; s2 += red[512 + j * 64 + lane]; }
        const float b = F.in(I_BMOD)[l * 6144 + col]; float* mod = F.ws<float>(WS_MOD) + (size_t)l * 2 * 6144;
        mod[col] = s1 + b; mod[6144 + col] = s2 + b; }
    __syncthreads();
}
__device__ __forceinline__ void p0_fold(const Frame& F, int item) {
    const int nch = item & 7, g = (item >> 3) & 3, ri = (item >> 5) & 1, l = item >> 6, t = F.tid;
    LAS float* Mx = (LAS float*)F.lds;
    LAS float* wf = Mx + 64 * 65;
    const float* wfn = F.in(I_WFNET) + (size_t)(l * 4 + g) * 4096;
    for (int i = t; i < 4096; i += 512) wf[(i >> 6) * 65 + (i & 63)] = wfn[i];
    __syncthreads();
    for (int i = t; i < 4096; i += 512) { const int c = i >> 6, e = i & 63; float s = 0.f;
        for (int m = 0; m < 64; ++m) { float sn, cs; sincospif(2.f * (float)((m * c) & 63) / 64.f, &sn, &cs); s += (ri ? sn : cs) * wf[m * 65 + e]; }
        Mx[c * 65 + e] = s; }
    __syncthreads();
    const float* wo = F.in(I_WOUT) + (size_t)l * 1024 * 1024 + (size_t)(64 * g) * 1024;
    bf16_t* dst = F.ws<bf16_t>(WS_WOUT) + (size_t)l * DM * MIXK;
    { const int n = nch * 128 + (t & 127), c0 = (t >> 7) * 16; float acc[16];
#pragma unroll
      for (int j = 0; j < 16; ++j) acc[j] = 0.f;
      for (int e = 0; e < 64; ++e) { const float wv = wo[(size_t)e * 1024 + n];
#pragma unroll
          for (int j = 0; j < 16; ++j) acc[j] += Mx[(c0 + j) * 65 + e] * wv; }
      u32x4 w0 = {pk2(acc[0], acc[1]), pk2(acc[2], acc[3]), pk2(acc[4], acc[5]), pk2(acc[6], acc[7])};
      u32x4 w1 = {pk2(acc[8], acc[9]), pk2(acc[10], acc[11]), pk2(acc[12], acc[13]), pk2(acc[14], acc[15])};
      bf16_t* d = dst + (size_t)n * MIXK + 256 * ri + 64 * g + c0; *(u32x4*)d = w0; *(u32x4*)(d + 8) = w1; }
    __syncthreads();
}
__device__ __forceinline__ void p0_tables(const Frame& F, int item) {
    constexpr int N0 = ROPE_N, N1 = N0 + 16384, N2 = N1 + 32768, N3 = N2 + 65536, N4 = N3 + 131072;
    float* rope = F.ws<float>(WS_ROPE); f32x2* tw = F.ws<f32x2>(WS_TW);
    bf16_t* a1 = F.ws<bf16_t>(WS_A1F); bf16_t* a2 = F.ws<bf16_t>(WS_A2F); bf16_t* ac = F.ws<bf16_t>(WS_ACF);
    for (int idx = item * 512 + F.tid; idx < N4; idx += P0_TAB * 512) {
        if (idx < N0) {
            int i = idx; bool isg = false; if (i >= RG_RC) { isg = true; i -= RG_RC; }
            const int n = isg ? 16 : 8, rowsz = 256 * n, colsz = 64 * n;
            int which, pos, fi;
            if (i < rowsz) { which = 0; pos = i / n; fi = i % n; } else if (i < 2 * rowsz) { which = 1; i -= rowsz; pos = i / n; fi = i % n; }
            else if (i < 2 * rowsz + colsz) { which = 2; i -= 2 * rowsz; pos = i / n; fi = i % n; } else { which = 3; i -= 2 * rowsz + colsz; pos = i / n; fi = i % n; }
            const float inv = powf(10000.f, -(float)fi / (float)n); const float ang = (float)pos * inv;
            rope[idx] = (which & 1) ? sinf(ang) : cosf(ang);
        } else if (idx < N1) { const int j = idx - N0; float sn, cs; sincospif(2.f * (float)j / 16384.f, &sn, &cs); tw[j] = (f32x2){cs, sn};
        } else if (idx < N2) { const int e = idx - N1; const int j = e & 7, ln = (e >> 3) & 63, s = (e >> 9) & 7, fb = (e >> 12) & 1, rg = e >> 13;
            const int k1 = 32 * rg + (ln & 31), l1 = 16 * s + 8 * (ln >> 5) + j; float sn, cs; sincospif(2.f * (float)((k1 * l1) & 127) / 128.f, &sn, &cs);
            a1[e] = (bf16_t)(pk2(fb ? -sn : cs, 0.f) & 0xffff);
        } else if (idx < N3) { const int e = idx - N2; const int j = e & 7, ln = (e >> 3) & 63, s = (e >> 9) & 15, fb = (e >> 13) & 1, rg = e >> 14;
            const int k2 = 32 * rg + (ln & 31), kk = 16 * s + 8 * (ln >> 5) + j, l2 = kk >> 1, rip = kk & 1; float sn, cs; sincospif(2.f * (float)((k2 * l2) & 127) / 128.f, &sn, &cs);
            const float v = fb == 0 ? (rip == 0 ? cs : sn) : (rip == 0 ? -sn : cs);
            a2[e] = (bf16_t)(pk2(v, 0.f) & 0xffff);
        } else { const int e = idx - N3; const int j = e & 7, ln = (e >> 3) & 63, s = (e >> 9) & 15, fb = (e >> 13) & 1, rg = (e >> 14) & 3, pa = e >> 16;
            const int k = 128 * pa + 32 * rg + (ln & 31), li = 16 * s + 8 * (ln >> 5) + j; float sn, cs; sincospif(2.f * (float)((k * li) & 255) / 256.f, &sn, &cs);
            ac[e] = (bf16_t)(pk2(fb ? -sn : cs, 0.f) & 0xffff); }
    }
}
__device__ __forceinline__ void phase_prologue(const Frame& F) {
    LAS unsigned* qw = (LAS unsigned*)(F.lds + LDS_CTL + 64);
    unsigned nxt = 0u; if (F.tid == 0) nxt = xb_add(F.ctl + CW_QH + 32, 1u);
    for (;;) {
        __syncthreads();
        if (F.tid == 0) *qw = nxt;
        __syncthreads();
        const int it = (int)*qw; if (it >= P0_ITEMS) break;
        if (F.tid == 0) nxt = xb_add(F.ctl + CW_QH + 32, 1u);
        int i = it;
        if (i < P0_GEMV) { p0_gemv(F, i); continue; } i -= P0_GEMV;
        if (i < P0_FOLD) { p0_fold(F, i); continue; } i -= P0_FOLD;
        if (i < P0_TAB) { p0_tables(F, i); continue; } i -= P0_TAB;
        if (i < P0_TWIN) { const int l = i / 128, r = i % 128, kt = r / 8, nt = r % 8;
            transpose_tile(F, F.in(I_WIN) + (size_t)l * DM * INW, INW, 64 * kt, 256 * nt, F.ws<bf16_t>(WS_WIN) + (size_t)l * INW * DM, DM, 64 * kt, RowId()); continue; } i -= P0_TWIN;
        if (i < P0_TWOUT) { const int l = i / 48, r = i % 48, kt = r / 4, nt = r % 4;
            transpose_tile(F, F.in(I_WOUT) + (size_t)l * DM * DM, DM, 256 + 64 * kt, 256 * nt, F.ws<bf16_t>(WS_WOUT) + (size_t)l * DM * MIXK, MIXK, 512 + 64 * kt, RowId()); continue; } i -= P0_TWOUT;
        if (i < P0_TWGU) { const int le = i / 128, r = i % 128, kt = r / 8, nt = r % 8;
            transpose_tile(F, F.in(I_WGU) + (size_t)le * DM * 2048, 2048, 64 * kt, 256 * nt, F.ws<bf16_t>(WS_WGU) + (size_t)le * 2048 * DM, DM, 64 * kt, RowGU()); continue; } i -= P0_TWGU;
        { const int le = i / 64, r = i % 64, kt = r / 4, nt = r % 4;
            transpose_tile(F, F.in(I_WDN) + (size_t)le * FFD * DM, DM, 64 * kt, 256 * nt, F.ws<bf16_t>(WS_WDN) + (size_t)le * DM * FFD, FFD, 64 * kt, RowId()); }
    }
}

__device__ __forceinline__ void load_row(const float* row, int lane, f32x4 (&x)[4]) {
#pragma unroll
    for (int q = 0; q < 4; ++q) x[q] = *(const f32x4*)(row + 256 * q + 4 * lane);
}
__device__ __forceinline__ float row_rstd(const f32x4 (&x)[4], float eps) {
    float ss = 0.f;
#pragma unroll
    for (int q = 0; q < 4; ++q) ss += x[q][0] * x[q][0] + x[q][1] * x[q][1] + x[q][2] * x[q][2] + x[q][3] * x[q][3];
    ss = wave_sum(ss); return rsqrtf(ss * (1.f / 1024.f) + eps);
}
__device__ __forceinline__ void mod_store_bf16(const f32x4 (&x)[4], float rstd, const float* __restrict__ g, const float* __restrict__ shift, const float* __restrict__ scale, bf16_t* __restrict__ dst, int lane, f32x4 (*hout)[4] = nullptr) {
    f32x4 gv[4], sh[4], sc[4];
#pragma unroll
    for (int q = 0; q < 4; ++q) { const int k = 256 * q + 4 * lane; gv[q] = *(const f32x4*)(g + k); sh[q] = *(const f32x4*)(shift + k); sc[q] = *(const f32x4*)(scale + k); }
    __builtin_amdgcn_sched_barrier(0);
#pragma unroll
    for (int q = 0; q < 4; ++q) { const int k = 256 * q + 4 * lane;
        f32x4 hv;
#pragma unroll
        for (int i = 0; i < 4; ++i) hv[i] = (x[q][i] * rstd * gv[q][i]) * (1.f + sc[q][i]) + sh[q][i];
        u32x2 w = {pk2(hv[0], hv[1]), pk2(hv[2], hv[3])}; *(u32x2*)(dst + k) = w;
        if (hout) (*hout)[q] = hv; }
}
__device__ __forceinline__ void phase_norm0(const Frame& F) {
    const float* mod = F.ws<float>(WS_MOD); bf16_t* hb = F.ws<bf16_t>(WS_HB); const float* g1 = F.in(I_GN1);
    const float* xc = F.in(I_CTX); const float* xl = F.in(I_X);
    for (int R = F.bid * 8 + F.wid; R < NT; R += F.G * 8) {
        const float* row = R < NCTX ? xc + (size_t)R * DM : xl + (size_t)(R - NCTX) * DM;
        const float* m = mod + (R < NCTX ? 6144 : 0);
        f32x4 x[4]; load_row(row, F.lane, x); const float rstd = row_rstd(x, 1e-6f);
        mod_store_bf16(x, rstd, g1, m, m + 1024, hb + (size_t)R * DM, F.lane);
    }
}

#define MFMA16(a, b, c) __builtin_amdgcn_mfma_f32_16x16x32_bf16((a), (b), (c), 0, 0, 0)
__device__ __forceinline__ int lds_byte(int r, int c) { const int st = (r >> 4) * 2 + (c >> 5), rr = r & 15, cc = c & 31, ob = rr * 64 + cc * 2; return st * 1024 + (ob ^ (((ob >> 9) & 1) << 5)); }
__device__ __forceinline__ void stage_rc(int b, int& R, int& C) { const int st = b / 1024, sb = b % 1024, swz = sb ^ (((sb >> 9) & 1) << 5); R = (st >> 1) * 16 + swz / 64; C = (st & 1) * 32 + (swz % 64) / 2; }
struct EpiC { f32x4 c[4]; };
struct EpiT { f32x4 t[4]; };
template <class XRow, class Epi>
__device__ __forceinline__ void gemm8(const Frame& F, const bf16_t* __restrict__ A, int K, int brow, const XRow& xrow, const Epi& epi) {
    constexpr int HTB = 16384;
    LAS char* shm = F.lds;
    const int tz = F.tid, wid = F.wid, lane = tz & 63, wr = wid >> 2, wc = wid & 3, fr = lane & 15, fq = lane >> 4;
    unsigned aoff[2]; const bf16_t* xp[2][2];
#pragma unroll
    for (int i = 0; i < 2; ++i) { int r, c; stage_rc(tz * 16 + i * 8192, r, c); aoff[i] = (unsigned)(r * K + c); xp[0][i] = xrow(r) + c; xp[1][i] = xrow(128 + r) + c; }
    const bf16_t* Ab = A + (size_t)brow * K; const size_t hstepA = (size_t)128 * K;
    const int ldsw = wid * 1024;
    const int aoffl = lds_byte(wr * 64 + fr, fq * 8), boffl = lds_byte(wc * 32 + fr, fq * 8);
#define SA(b, h) (shm + ((b) * 2 + (h)) * HTB)
#define SB(b, h) (shm + (4 + (b) * 2 + (h)) * HTB)
#define STAGE_A(b, h, kt) do { _Pragma("unroll") for (int i_ = 0; i_ < 2; ++i_) dma16(Ab + (h) * hstepA + aoff[i_] + (size_t)(kt) * 64, SA(b, h) + ldsw + i_ * 8192); } while (0)
#define STAGE_B(b, h, kt) do { _Pragma("unroll") for (int i_ = 0; i_ < 2; ++i_) dma16(xp[h][i_] + (size_t)(kt) * 64, SB(b, h) + ldsw + i_ * 8192); } while (0)
#define LDA(dst, b, h) do { _Pragma("unroll") for (int m = 0; m < 4; ++m) _Pragma("unroll") for (int k = 0; k < 2; ++k) dst[m][k] = *(LAS const bf16x8*)(SA(b, h) + aoffl + m * 2048 + k * 1024); } while (0)
#define LDB(dst, b, h) do { _Pragma("unroll") for (int n = 0; n < 2; ++n) _Pragma("unroll") for (int k = 0; k < 2; ++k) dst[n][k] = *(LAS const bf16x8*)(SB(b, h) + boffl + n * 2048 + k * 1024); } while (0)
#define MMA(ai, bj, At_, Bt_) do { __builtin_amdgcn_s_setprio(1); _Pragma("unroll") for (int m = 0; m < 4; ++m) _Pragma("unroll") for (int n = 0; n < 2; ++n) _Pragma("unroll") for (int k = 0; k < 2; ++k) \
        acc[ai][bj][m][n] = MFMA16(At_[m][k], Bt_[n][k], acc[ai][bj][m][n]); __builtin_amdgcn_s_setprio(0); } while (0)
#define WAIT_V(n) asm volatile("s_waitcnt vmcnt(" #n ")" ::: "memory")
#define WAIT_L(n) asm volatile("s_waitcnt lgkmcnt(" #n ")" ::: "memory")
#define BAR __builtin_amdgcn_s_barrier()
#define SCHED __builtin_amdgcn_sched_barrier(0)
    f32x4 acc[2][2][4][2];
#pragma unroll
    for (int a = 0; a < 2; ++a)
#pragma unroll
        for (int b = 0; b < 2; ++b)
#pragma unroll
            for (int m = 0; m < 4; ++m)
#pragma unroll
                for (int n = 0; n < 2; ++n) acc[a][b][m][n] = (f32x4){0.f, 0.f, 0.f, 0.f};
    bf16x8 At[4][2], B0[2][2], B1[2][2];
    const int nt = K / 64;
    WAIT_L(0); BAR;
    STAGE_B(0, 0, 0); STAGE_B(0, 1, 0); STAGE_A(0, 0, 0); STAGE_A(0, 1, 0);
    if (wr == 1) BAR;
    WAIT_V(2); BAR;
    STAGE_B(1, 0, 1); STAGE_A(1, 0, 1); STAGE_B(1, 1, 1);
    WAIT_V(6); BAR;
#pragma unroll 1
    for (int t = 0; t < nt; t += 2) {
        const int k2 = (t == nt - 2) ? 0 : t + 2;
        LDB(B0, 0, 0); LDB(B1, 0, 1); SCHED; LDA(At, 0, 0); STAGE_A(1, 1, t + 1);
        WAIT_V(8); WAIT_L(0); BAR; MMA(0, 0, At, B0); MMA(0, 1, At, B1); BAR; SCHED;
        LDA(At, 0, 1); STAGE_B(0, 0, k2); STAGE_B(0, 1, k2); STAGE_A(0, 0, k2);
        WAIT_V(8); WAIT_L(0); BAR; MMA(1, 0, At, B0); MMA(1, 1, At, B1); BAR; SCHED;
        LDB(B0, 1, 0); LDB(B1, 1, 1); SCHED; LDA(At, 1, 0); STAGE_A(0, 1, k2);
        WAIT_V(8); WAIT_L(0); BAR; MMA(0, 0, At, B0); MMA(0, 1, At, B1); BAR; SCHED;
        LDA(At, 1, 1); STAGE_B(1, 0, k2 + 1); STAGE_B(1, 1, k2 + 1); STAGE_A(1, 0, k2 + 1);
        WAIT_V(8); WAIT_L(0); BAR; MMA(1, 0, At, B0); MMA(1, 1, At, B1); BAR; SCHED;
    }
    WAIT_V(0);
    if (wr == 0) BAR;
    BAR;
#undef SA
#undef SB
#undef STAGE_A
#undef STAGE_B
#undef LDA
#undef LDB
#undef MMA
#undef WAIT_V
#undef WAIT_L
#undef BAR
#undef SCHED
    int tq = F.tid; asm volatile("" : "+v"(tq)); const int fr2 = tq & 15, fq2 = (tq >> 4) & 3;
#pragma unroll
    for (int ai = 0; ai < 2; ++ai) { const int cg = (brow >> 6) + 2 * ai + wr;
        const EpiC C = epi.load_c(cg, fq2);
        EpiT T = epi.load_t(cg, wc * 32 + fr2, fq2);
#pragma unroll
        for (int c = 0; c < 4; ++c) { const int bj = c >> 1, n = c & 1; const int tok = bj * 128 + wc * 32 + n * 16 + fr2;
            EpiT Tn = T; if (c < 3) Tn = epi.load_t(cg, ((c + 1) >> 1) * 128 + wc * 32 + ((c + 1) & 1) * 16 + fr2, fq2);
            f32x4 v[4] = {acc[ai][bj][0][n], acc[ai][bj][1][n], acc[ai][bj][2][n], acc[ai][bj][3][n]};
            epi.apply(v, cg, tok, fq2, C, T); T = Tn; } }
}

__device__ __forceinline__ u32x2 pk4(const f32x4& v) { return (u32x2){pk2(v[0], v[1]), pk2(v[2], v[3])}; }
struct EpiInProj {
    const Frame& F; int l, t0;
    __device__ __forceinline__ EpiC load_c(int cg, int fq) const { EpiC C;
#pragma unroll
        for (int m = 0; m < 4; ++m) C.c[m] = (f32x4){0.f, 0.f, 0.f, 0.f};
        if (cg >= 22 && cg < 30) { const float* gw = (cg < 28 ? F.in(I_GQ) : F.in(I_GK)) + 64 * l;
#pragma unroll
            for (int m = 0; m < 4; ++m) C.c[m] = *(const f32x4*)(gw + 16 * m + 4 * fq); }
        return C; }
    __device__ __forceinline__ EpiT load_t(int cg, int tok, int fq) const { EpiT T;
#pragma unroll
        for (int m = 0; m < 4; ++m) T.t[m] = (f32x4){0.f, 0.f, 0.f, 0.f};
        const int R = t0 + tok; const int t = R - NCTX; const int prow = (t >> 6) & 255, pcol = t & 63; const float* const rope = F.ws<float>(WS_ROPE);
        if (R >= NCTX) {
            if (cg >= 4 && cg < 16) { const int ti = fq < 2 ? RD_RC + prow * 8 + 4 * fq : RD_CC + pcol * 8 + 4 * (fq - 2), si = fq < 2 ? RD_RS + prow * 8 + 4 * fq : RD_CS + pcol * 8 + 4 * (fq - 2);
                T.t[0] = *(const f32x4*)(rope + ti); T.t[1] = *(const f32x4*)(rope + si); }
            else if (cg >= 22 && cg < 30) { T.t[0] = *(const f32x4*)(rope + RG_RC + prow * 16 + 4 * fq); T.t[1] = *(const f32x4*)(rope + RG_RS + prow * 16 + 4 * fq);
                T.t[2] = *(const f32x4*)(rope + RG_CC + pcol * 16 + 4 * fq); T.t[3] = *(const f32x4*)(rope + RG_CS + pcol * 16 + 4 * fq); } }
        return T; }
    __device__ __forceinline__ void apply(f32x4 (&v)[4], int cg, int tok, int fq, const EpiC& C, const EpiT& T) const {
        bf16_t* const ft = F.ws<bf16_t>(WS_FT); bf16_t* const fc = F.ws<bf16_t>(WS_FC); bf16_t* const qd = F.ws<bf16_t>(WS_QD); bf16_t* const kd = F.ws<bf16_t>(WS_KD); bf16_t* const vd = F.ws<bf16_t>(WS_VD);
        bf16_t* const qg = F.ws<bf16_t>(WS_QG); bf16_t* const kg = F.ws<bf16_t>(WS_KG); bf16_t* const vg = F.ws<bf16_t>(WS_VG);
        unsigned* const kmax = F.ctl + CW_KMAX + 16 * l;
        const float QSD = 0.17677669529663687f * LOG2E, QSG = 0.125f * LOG2E;
        const int R = t0 + tok; const bool isctx = R < NCTX; const int t = R - NCTX;
        if (cg < 4) {
#pragma unroll
            for (int m = 0; m < 4; ++m) { const int ch = 64 * cg + 16 * m + 4 * fq; const u32x2 w = pk4(v[m]);
                if (isctx) { const size_t a = (size_t)(((ch >> 7) * 4 + ((ch >> 5) & 3)) * 8192 + (R >> 3) * 256 + (R & 7) * 32 + (ch & 31)); *(u32x2*)(fc + a) = w; }
                else { const int l1 = t >> 7, l2 = t & 127; const size_t a = (size_t)((l2 * 2 + (ch >> 7)) * 4 + ((ch >> 5) & 3)) * 4096 + (l1 >> 3) * 256 + (l1 & 7) * 32 + (ch & 31); *(u32x2*)(ft + a) = w; } }
        } else if (cg < 16) {
            const bool isq = cg < 10; const int head = isq ? cg - 4 : cg - 10;
            if (!isctx) { const f32x4 cc = T.t[0], sn = T.t[1];
#pragma unroll
                for (int mp = 0; mp < 2; ++mp)
#pragma unroll
                    for (int j = 0; j < 4; ++j) { const float a = v[2 * mp][j], b = v[2 * mp + 1][j]; v[2 * mp][j] = a * cc[j] - b * sn[j]; v[2 * mp + 1][j] = b * cc[j] + a * sn[j]; } }
            if (isq) {
#pragma unroll
                for (int m = 0; m < 4; ++m) { const f32x4 s = v[m] * QSD;
                    const size_t a = ((((size_t)(head * NQB + (R >> 5)) * 2 + (m >> 1)) * 4 + 2 * (m & 1) + (fq >> 1)) * 32 + (R & 31)) * 8 + 4 * (fq & 1); *(u32x2*)(qd + a) = pk4(s); }
            } else {
                float ss0 = 0.f, ss1 = 0.f;
#pragma unroll
                for (int j = 0; j < 4; ++j) { ss0 += v[0][j] * v[0][j] + v[1][j] * v[1][j]; ss1 += v[2][j] * v[2][j] + v[3][j] * v[3][j]; }
                ss0 += shxc<16>(ss0); ss1 += shxc<16>(ss1); ss0 = add32(ss0); ss1 = add32(ss1);
                ss0 = fmaxf(ss0, shxc<8>(ss0)); ss1 = fmaxf(ss1, shxc<8>(ss1)); ss0 = fmaxf(ss0, shxc<4>(ss0)); ss1 = fmaxf(ss1, shxc<4>(ss1));
                ss0 = fmaxf(ss0, shxc<2>(ss0)); ss1 = fmaxf(ss1, shxc<2>(ss1)); ss0 = fmaxf(ss0, shxc<1>(ss0)); ss1 = fmaxf(ss1, shxc<1>(ss1));
                if ((tok & 15) == 0 && fq == 0) { float* kp = F.ws<float>(WS_KP) + ((size_t)(l * 12 + 2 * head) * 64 + ((t0 >> 8) - 1)) * 16 + (tok >> 4); kp[0] = ss0; kp[1024] = ss1; }
#pragma unroll
                for (int m = 0; m < 4; ++m) {
                    const size_t a = ((((size_t)(head * NKT + (R >> 6)) * 2 + (m >> 1)) * 4 + 2 * (m & 1) + (fq >> 1)) * 64 + (R & 63)) * 8 + 4 * (fq & 1); *(u32x2*)(kd + a) = pk4(v[m]); }
            }
        } else if (cg < 22 || cg >= 30) {
            const bool isd = cg < 22; const int head = isd ? cg - 16 : cg - 30; bf16_t* vb = isd ? vd : vg;
#pragma unroll
            for (int m = 0; m < 4; ++m) {
                const size_t a = ((size_t)(head * NKT + (R >> 6)) * 2 + (m >> 1)) * 2048 + ((R & 63) >> 3) * 256 + (R & 7) * 32 + 16 * (m & 1) + 4 * fq; *(u32x2*)(vb + a) = pk4(v[m]); }
        } else {
            const bool isq = cg < 28; const int head = isq ? cg - 22 : cg - 28;
            float ss = 0.f;
#pragma unroll
            for (int m = 0; m < 4; ++m)
#pragma unroll
                for (int j = 0; j < 4; ++j) ss += v[m][j] * v[m][j];
            ss += shxc<16>(ss); ss = add32(ss); const float rs = rsqrtf(ss * (1.f / 64.f) + 1e-6f);
#pragma unroll
            for (int m = 0; m < 4; ++m) v[m] = v[m] * C.c[m] * rs;
            if (!isctx) { const f32x4 cr = T.t[0], sr = T.t[1], cc = T.t[2], sc = T.t[3];
#pragma unroll
                for (int j = 0; j < 4; ++j) { { const float a = v[0][j], b = v[2][j]; v[0][j] = a * cr[j] - b * sr[j]; v[2][j] = b * cr[j] + a * sr[j]; }
                    { const float a = v[1][j], b = v[3][j]; v[1][j] = a * cc[j] - b * sc[j]; v[3][j] = b * cc[j] + a * sc[j]; } } }
#pragma unroll
            for (int m = 0; m < 4; ++m) { const f32x4 s = isq ? v[m] * QSG : v[m]; const int c = 2 * m + (fq >> 1);
                if (isq) { const size_t a = (((size_t)(head * NQB + (R >> 5)) * 8 + c) * 32 + (R & 31)) * 8 + 4 * (fq & 1); *(u32x2*)(qg + a) = pk4(s); }
                else { const size_t a = (((size_t)(head * NKT + (R >> 6)) * 8 + c) * 64 + (R & 63)) * 8 + 4 * (fq & 1); *(u32x2*)(kg + a) = pk4(s); } }
        }
    }
};
struct EpiOutProj {
    const Frame& F; int l, t0;
    __device__ __forceinline__ const float* src_row(int R) const { return l == 0 ? (R < NCTX ? F.in(I_CTX) + (size_t)R * DM : F.in(I_X) + (size_t)(R - NCTX) * DM) : F.ws<float>(WS_XS) + (size_t)R * DM; }
    __device__ __forceinline__ EpiC load_c(int cg, int fq) const { EpiC C; const float* gt = F.ws<float>(WS_MOD) + (size_t)l * 2 * 6144 + (t0 < NCTX ? 6144 : 0) + 2048;
#pragma unroll
        for (int m = 0; m < 4; ++m) C.c[m] = *(const f32x4*)(gt + 64 * cg + 16 * m + 4 * fq);
        return C; }
    __device__ __forceinline__ EpiT load_t(int cg, int tok, int fq) const { EpiT T; const float* src = src_row(t0 + tok);
#pragma unroll
        for (int m = 0; m < 4; ++m) T.t[m] = *(const f32x4*)(src + 64 * cg + 16 * m + 4 * fq);
        return T; }
    __device__ __forceinline__ void apply(f32x4 (&v)[4], int cg, int tok, int fq, const EpiC& C, const EpiT& T) const {
        float* xs = F.ws<float>(WS_XS) + (size_t)(t0 + tok) * DM;
#pragma unroll
        for (int m = 0; m < 4; ++m) *(f32x4*)(xs + 64 * cg + 16 * m + 4 * fq) = T.t[m] + C.c[m] * v[m];
    }
};
struct EpiGateUp {
    const Frame& F; int le, m0, cnt, offs;
    __device__ __forceinline__ EpiC load_c(int cg, int fq) const { EpiC C; const float* bias = F.in(I_BGU) + (size_t)le * 2048 + 32 * cg + 4 * fq;
        C.c[0] = *(const f32x4*)(bias); C.c[1] = *(const f32x4*)(bias + 16); C.c[2] = *(const f32x4*)(bias + 1024); C.c[3] = *(const f32x4*)(bias + 1024 + 16); return C; }
    __device__ __forceinline__ EpiT load_t(int, int, int) const { EpiT T;
#pragma unroll
        for (int m = 0; m < 4; ++m) T.t[m] = (f32x4){0.f, 0.f, 0.f, 0.f};
        return T; }
    __device__ __forceinline__ void apply(f32x4 (&v)[4], int cg, int tok, int fq, const EpiC& C, const EpiT&) const {
        const int mt = m0 + tok; if (mt >= cnt) return;
        bf16_t* dst = F.ws<bf16_t>(WS_ACT) + (size_t)(offs + mt) * FFD;
#pragma unroll
        for (int m = 0; m < 2; ++m) { const int jj = 32 * cg + 16 * m + 4 * fq; f32x4 o;
#pragma unroll
            for (int j = 0; j < 4; ++j) { float gl = v[m][j] + C.c[m][j], li = v[m + 2][j] + C.c[2 + m][j]; gl = fminf(gl, 7.f); li = fminf(fmaxf(li, -7.f), 7.f);
                o[j] = gl * (1.f / (1.f + __expf(-1.702f * gl))) * (li + 1.f); }
            *(u32x2*)(dst + jj) = pk4(o); }
    }
};
struct EpiDown {
    const Frame& F; int le, m0, cnt, offs;
    __device__ __forceinline__ EpiC load_c(int cg, int fq) const { EpiC C; const float* bias = F.in(I_BDN) + (size_t)le * DM + 64 * cg + 4 * fq;
#pragma unroll
        for (int m = 0; m < 4; ++m) C.c[m] = *(const f32x4*)(bias + 16 * m);
        return C; }
    __device__ __forceinline__ EpiT load_t(int, int, int) const { EpiT T;
#pragma unroll
        for (int m = 0; m < 4; ++m) T.t[m] = (f32x4){0.f, 0.f, 0.f, 0.f};
        return T; }
    __device__ __forceinline__ void apply(f32x4 (&v)[4], int cg, int tok, int fq, const EpiC& C, const EpiT&) const {
        const int mt = m0 + tok; if (mt >= cnt) return;
        bf16_t* dst = F.ws<bf16_t>(WS_YB) + (size_t)(offs + mt) * DM;
#pragma unroll
        for (int m = 0; m < 4; ++m) *(u32x2*)(dst + 64 * cg + 16 * m + 4 * fq) = pk4(v[m] + C.c[m]);
    }
};
struct XDense { const bf16_t* X; int ld; int t0; __device__ __forceinline__ const bf16_t* operator()(int row) const { return X + (size_t)(t0 + row) * ld; } };
struct XGather { const bf16_t* X; const unsigned* list; int m0, cnt; __device__ __forceinline__ const bf16_t* operator()(int row) const { int m = m0 + row; m = m < cnt ? m : cnt - 1; return X + (size_t)list[m] * DM; } };
struct XAct { const bf16_t* X; int base, m0, cnt; __device__ __forceinline__ const bf16_t* operator()(int row) const { int m = m0 + row; m = m < cnt ? m : cnt - 1; return X + (size_t)(base + m) * FFD; } };

template <class Epi>
__device__ __forceinline__ void mini_unit(const Frame& F, const bf16_t* W, int ldw, int f0, const bf16_t* X, int ldx, int t0, int K, const Epi& epi) {
    const int lane = F.lane, wid = F.wid, r = lane & 31, h = lane >> 5; const int kw = K >> 3;
    const bf16_t* wp = W + (size_t)(f0 + r) * ldw + wid * kw + 8 * h; const bf16_t* xp = X + (size_t)(t0 + r) * ldx + wid * kw + 8 * h;
    f32x16 acc0, acc1;
#pragma unroll
    for (int i = 0; i < 16; ++i) { acc0[i] = 0.f; acc1[i] = 0.f; }
#pragma unroll 2
    for (int s = 0; s < (kw >> 4); ++s) { const bf16x8 w0 = *(const bf16x8*)(wp + 16 * s), w1 = *(const bf16x8*)(wp + (size_t)32 * ldw + 16 * s), xv = *(const bf16x8*)(xp + 16 * s);
        acc0 = MFMA(w0, xv, acc0); acc1 = MFMA(w1, xv, acc1); }
    BAR_SYNC();
    LAS float* red = (LAS float*)F.lds;
#pragma unroll
    for (int i = 0; i < 16; ++i) { red[(wid * 32 + i) * 64 + lane] = acc0[i]; red[(wid * 32 + 16 + i) * 64 + lane] = acc1[i]; }
    __syncthreads();
    LAS float* out = red + 8 * 32 * 64;
#pragma unroll
    for (int j = 0; j < 4; ++j) { const int rg = 4 * wid + j; float s = 0.f;
#pragma unroll
        for (int w = 0; w < 8; ++w) s += red[(w * 32 + rg) * 64 + lane];
        out[rg * 64 + lane] = s; }
    __syncthreads();
    if (wid == 0) {
#pragma unroll
        for (int i = 0; i < 16; ++i) { acc0[i] = out[i * 64 + lane]; acc1[i] = out[(16 + i) * 64 + lane]; }
        epi(acc0, acc1, f0 >> 6, t0 + r, h);
    }
}
struct EpiInProjCtx {
    const Frame& F; int l;
    __device__ __forceinline__ void operator()(f32x16& v0, f32x16& v1, int cg, int R, int h) const {
        const float QSD = 0.17677669529663687f * LOG2E, QSG = 0.125f * LOG2E;
        if (cg < 4) { bf16_t* fc = F.ws<bf16_t>(WS_FC);
#pragma unroll
            for (int fb = 0; fb < 2; ++fb)
#pragma unroll
                for (int g = 0; g < 4; ++g) { const f32x16& v = fb ? v1 : v0; const int ch = 64 * cg + 32 * fb + 8 * g + 4 * h;
                    const size_t a = (size_t)(((ch >> 7) * 4 + ((ch >> 5) & 3)) * 8192 + (R >> 3) * 256 + (R & 7) * 32 + (ch & 31)); *(u32x2*)(fc + a) = (u32x2){pk2(v[4 * g], v[4 * g + 1]), pk2(v[4 * g + 2], v[4 * g + 3])}; }
        } else if (cg < 16) { const bool isq = cg < 10; const int head = isq ? cg - 4 : cg - 10;
            if (isq) { bf16_t* qd = F.ws<bf16_t>(WS_QD);
#pragma unroll
                for (int fb = 0; fb < 2; ++fb)
#pragma unroll
                    for (int g = 0; g < 4; ++g) { const f32x16& v = fb ? v1 : v0;
                        const size_t a = ((((size_t)(head * NQB + (R >> 5)) * 2 + fb) * 4 + g) * 32 + (R & 31)) * 8 + 4 * h;
                        *(u32x2*)(qd + a) = (u32x2){pk2(v[4 * g] * QSD, v[4 * g + 1] * QSD), pk2(v[4 * g + 2] * QSD, v[4 * g + 3] * QSD)}; }
            } else { bf16_t* kd = F.ws<bf16_t>(WS_KD); unsigned* kmax = F.ctl + CW_KMAX + 16 * l;
                float ss0 = 0.f, ss1 = 0.f;
#pragma unroll
                for (int i = 0; i < 16; ++i) { ss0 += v0[i] * v0[i]; ss1 += v1[i] * v1[i]; }
                ss0 = add32(ss0); ss1 = add32(ss1); ss0 = wave_max(ss0); ss1 = wave_max(ss1);
                if (F.lane == 0) { atomicMax(kmax + 2 * head, __float_as_uint(ss0)); atomicMax(kmax + 2 * head + 1, __float_as_uint(ss1)); }
#pragma unroll
                for (int fb = 0; fb < 2; ++fb)
#pragma unroll
                    for (int g = 0; g < 4; ++g) { const f32x16& v = fb ? v1 : v0;
                        const size_t a = ((((size_t)(head * NKT + (R >> 6)) * 2 + fb) * 4 + g) * 64 + (R & 63)) * 8 + 4 * h;
                        *(u32x2*)(kd + a) = (u32x2){pk2(v[4 * g], v[4 * g + 1]), pk2(v[4 * g + 2], v[4 * g + 3])}; } }
        } else if (cg < 22 || cg >= 30) { const bool isd = cg < 22; const int head = isd ? cg - 16 : cg - 30; bf16_t* vb = isd ? F.ws<bf16_t>(WS_VD) : F.ws<bf16_t>(WS_VG);
#pragma unroll
            for (int fb = 0; fb < 2; ++fb)
#pragma unroll
                for (int g = 0; g < 4; ++g) { const f32x16& v = fb ? v1 : v0;
                    const size_t a = ((size_t)(head * NKT + (R >> 6)) * 2 + fb) * 2048 + ((R & 63) >> 3) * 256 + (R & 7) * 32 + 8 * g + 4 * h;
                    *(u32x2*)(vb + a) = (u32x2){pk2(v[4 * g], v[4 * g + 1]), pk2(v[4 * g + 2], v[4 * g + 3])}; }
        } else { const bool isq = cg < 28; const int head = isq ? cg - 22 : cg - 28; const float* gw = (isq ? F.in(I_GQ) : F.in(I_GK)) + 64 * l;
            float ss = 0.f;
#pragma unroll
            for (int i = 0; i < 16; ++i) ss += v0[i] * v0[i] + v1[i] * v1[i];
            ss = add32(ss); const float rs = rsqrtf(ss * (1.f / 64.f) + 1e-6f) * (isq ? QSG : 1.f);
#pragma unroll
            for (int fb = 0; fb < 2; ++fb)
#pragma unroll
                for (int g = 0; g < 4; ++g) { const f32x16& v = fb ? v1 : v0; const f32x4 gv = *(const f32x4*)(gw + 32 * fb + 8 * g + 4 * h);
                    const u32x2 w = {pk2(v[4 * g] * rs * gv[0], v[4 * g + 1] * rs * gv[1]), pk2(v[4 * g + 2] * rs * gv[2], v[4 * g + 3] * rs * gv[3])};
                    if (isq) { const size_t a = (((size_t)(head * NQB + (R >> 5)) * 8 + 4 * fb + g) * 32 + (R & 31)) * 8 + 4 * h; *(u32x2*)(F.ws<bf16_t>(WS_QG) + a) = w; }
                    else { const size_t a = (((size_t)(head * NKT + (R >> 6)) * 8 + 4 * fb + g) * 64 + (R & 63)) * 8 + 4 * h; *(u32x2*)(F.ws<bf16_t>(WS_KG) + a) = w; } }
        }
    }
};
struct EpiOutProjCtx {
    const Frame& F;
    __device__ __forceinline__ void operator()(f32x16& v0, f32x16& v1, int cg, int R, int h) const {
        const float* src = F.in(I_CTX) + (size_t)R * DM; const float* gt = F.ws<float>(WS_MOD) + 6144 + 2048; float* xs = F.ws<float>(WS_XS) + (size_t)R * DM;
#pragma unroll
        for (int fb = 0; fb < 2; ++fb)
#pragma unroll
            for (int g = 0; g < 4; ++g) { const f32x16& v = fb ? v1 : v0; const int n = 64 * cg + 32 * fb + 8 * g + 4 * h;
                const f32x4 x = *(const f32x4*)(src + n), gv = *(const f32x4*)(gt + n);
                *(f32x4*)(xs + n) = (f32x4){x[0] + gv[0] * v[4 * g], x[1] + gv[1] * v[4 * g + 1], x[2] + gv[2] * v[4 * g + 2], x[3] + gv[3] * v[4 * g + 3]}; }
    }
};
__device__ __forceinline__ void phase_inproj(const Frame& F, int l) {
    const bf16_t* Wt = F.ws<bf16_t>(WS_WIN) + (size_t)l * INW * DM; const bf16_t* hb = F.ws<bf16_t>(WS_HB);
    const bool xcd = F.G == 256; const int x = F.bid & 7;
    const int first = xcd ? (F.bid >> 3) : F.bid, stride = xcd ? 32 : F.G, total = xcd ? 64 : 8 * 64;
    for (int i = first; i < total; i += stride) { const int ft = xcd ? 4 * (x & 1) + (i & 3) : (i & 7), tt = 1 + (xcd ? 4 * (i >> 2) + (x >> 1) : (i >> 3));
        EpiInProj E{F, l, 256 * tt}; XDense X{hb, DM, 256 * tt}; gemm8(F, Wt, DM, 256 * ft, X, E); }
    EpiInProjCtx EC{F, l};
    for (int u = F.bid; u < 256; u += F.G) { const int cg = u & 31, tb = u >> 5;
        if (l == 1 && !((cg >= 10 && cg < 22) || cg >= 28)) continue;
        mini_unit(F, Wt, DM, 64 * cg, hb, DM, 32 * tb, DM, EC); }
}
__device__ __forceinline__ void phase_outproj(const Frame& F, int l) {
    const bf16_t* Wt = F.ws<bf16_t>(WS_WOUT) + (size_t)l * DM * MIXK; const bf16_t* mix = F.ws<bf16_t>(WS_MIX);
    const bool xcd = F.G == 256; const int x = F.bid & 7;
    const int first = xcd ? (F.bid >> 3) : F.bid, stride = xcd ? 32 : F.G, total = xcd ? 32 : 4 * 64;
    for (int i = first; i < total; i += stride) { const int ft = i & 3, tt = 1 + (xcd ? 8 * (i >> 2) + x : (i >> 2));
        EpiOutProj E{F, l, 256 * tt}; XDense X{mix, MIXK, 256 * tt}; gemm8(F, Wt, MIXK, 256 * ft, X, E); }
    if (l == 0) { EpiOutProjCtx EC{F};
        for (int u = F.bid; u < 128; u += F.G) { const int cg = u & 15, tb = u >> 4; mini_unit(F, Wt, MIXK, 64 * cg, mix, MIXK, 32 * tb, MIXK, EC); } }
}
__device__ __forceinline__ void moe_tables(const Frame& F, int l, int nf, bool xcd, LAS int*& s_cnt, LAS int*& s_offs, LAS int*& s_t0) {
    LAS int* base = (LAS int*)(F.lds + LDS_CTL + 256); s_cnt = base; s_offs = base + 32; s_t0 = base + 72;
    __syncthreads();
    if (F.tid < NEXP) s_cnt[F.tid] = (int)__hip_atomic_load(F.ctl + CW_CNT + 64 * l + F.tid, __ATOMIC_RELAXED, __HIP_MEMORY_SCOPE_AGENT);
    __syncthreads();
    if (F.tid == 0) { const int g = (F.bid & 7) >> 1; int o = 0, t = 0; for (int e = 0; e < NEXP; ++e) { const int c = s_cnt[e];
            const int ntt = (c + 255) >> 8; int nu = ntt * nf;
            if (xcd) { const int fst = (g - e) & 3; nu = (fst < ntt ? (ntt - fst + 3) >> 2 : 0) * (nf >> 1); }
            s_cnt[e] = c; s_offs[e] = o; s_t0[e] = t; o += c; t += nu; } s_offs[32] = o; s_t0[32] = t; }
    __syncthreads();
}
__device__ __forceinline__ void moe_decode(const Frame& F, bool xcd, int nf, int i, LAS const int* s_t0, int& e, int& ft, int& tt) {
    e = 0; while (e < NEXP - 1 && i >= s_t0[e + 1]) ++e;
    const int j = i - s_t0[e];
    if (xcd) { const int x = F.bid & 7, hf = nf >> 1; ft = hf * (x & 1) + (j % hf); tt = (((x >> 1) - e) & 3) + 4 * (j / hf); }
    else { ft = j % nf; tt = j / nf; } }
__device__ __forceinline__ void phase_gateup(const Frame& F, int l) {
    const bool xcd = F.G == 256;
    LAS int *s_cnt, *s_offs, *s_t0; moe_tables(F, l, 8, xcd, s_cnt, s_offs, s_t0);
    const int first = xcd ? (F.bid >> 3) : F.bid, stride = xcd ? 32 : F.G, total = s_t0[32];
    for (int i = first; i < total; i += stride) { int e, ft, tt; moe_decode(F, xcd, 8, i, s_t0, e, ft, tt);
        EpiGateUp E{F, l * NEXP + e, 256 * tt, s_cnt[e], s_offs[e]};
        XGather X{F.ws<bf16_t>(WS_HB), F.ws<unsigned>(WS_LIST) + (size_t)e * NT, 256 * tt, s_cnt[e]};
        gemm8(F, F.ws<bf16_t>(WS_WGU) + (size_t)(l * NEXP + e) * 2048 * DM, DM, 256 * ft, X, E); }
}
__device__ __forceinline__ void phase_down(const Frame& F, int l) {
    const bool xcd = F.G == 256;
    LAS int *s_cnt, *s_offs, *s_t0; moe_tables(F, l, 4, xcd, s_cnt, s_offs, s_t0);
    const int first = xcd ? (F.bid >> 3) : F.bid, stride = xcd ? 32 : F.G, total = s_t0[32];
    for (int i = first; i < total; i += stride) { int e, ft, tt; moe_decode(F, xcd, 4, i, s_t0, e, ft, tt);
        EpiDown E{F, l * NEXP + e, 256 * tt, s_cnt[e], s_offs[e]};
        XAct X{F.ws<bf16_t>(WS_ACT), s_offs[e], 256 * tt, s_cnt[e]};
        gemm8(F, F.ws<bf16_t>(WS_WDN) + (size_t)(l * NEXP + e) * DM * FFD, FFD, 256 * ft, X, E); }
}

template <int KD, int MODE>
__device__ __forceinline__ void dft_unit(const Frame& F, const bf16_t* AF, const bf16_t* Bsrc, int p0, int colhalf, int pa) {
    constexpr int NS = KD / 16, TILE_B = 4 * KD * 64;
    const int lane = F.lane, wid = F.wid, r = lane & 31, h = lane >> 5, rg = wid & 3, cg2 = wid >> 2;
    LAS char* lds = F.lds;
    BAR_SYNC();
    for (int pc = wid; pc < TILE_B / 1024; pc += 8) dma16((const char*)Bsrc + (size_t)pc * 1024 + lane * 16, lds + pc * 1024);
    WAITV(0); BAR_SYNC();
    f32x16 acc[2][2];
#pragma unroll
    for (int a = 0; a < 2; ++a)
#pragma unroll
        for (int b = 0; b < 2; ++b)
#pragma unroll
            for (int i = 0; i < 16; ++i) acc[a][b][i] = 0.f;
    const bf16_t* af = AF + (size_t)(rg * 2) * NS * 512 + lane * 8;
    const int bl = h * 512 + ((lane & 15) >> 2) * 64 + ((lane >> 4) & 1) * 32 + (lane & 3) * 8;
#pragma unroll 4
    for (int s = 0; s < NS; ++s) {
        const bf16x8 a0 = *(const bf16x8*)(af + (size_t)s * 512), a1 = *(const bf16x8*)(af + (size_t)(NS + s) * 512);
#pragma unroll
        for (int cb = 0; cb < 2; ++cb) { LAS const char* bp = lds + (2 * cg2 + cb) * (KD * 64) + s * 1024 + bl;
            const s16x4 lo = vtr(bp), hi = vtr(bp + 256);
            const bf16x8 bf = {lo[0], lo[1], lo[2], lo[3], hi[0], hi[1], hi[2], hi[3]};
            acc[0][cb] = MFMA(a0, bf, acc[0][cb]); acc[1][cb] = MFMA(a1, bf, acc[1][cb]); }
    }
#pragma unroll
    for (int cb = 0; cb < 2; ++cb) { const int c = 128 * colhalf + 32 * (2 * cg2 + cb) + r;
#pragma unroll
        for (int rho = 0; rho < 16; ++rho) { const int kk = 32 * rg + (rho & 3) + 8 * (rho >> 2) + 4 * h; const float re = acc[0][cb][rho], im = acc[1][cb][rho];
            if (MODE == 0) { const int l2 = p0; const f32x2 tw = F.ws<f32x2>(WS_TW)[(kk * l2) & 16383]; const float o_re = re * tw[0] + im * tw[1], o_im = im * tw[0] - re * tw[1];
                bf16_t* T2 = F.ws<bf16_t>(WS_T2); const size_t a = ((size_t)(kk * 2 + (c >> 7)) * 4 + ((c >> 5) & 3)) * 8192 + (l2 >> 2) * 256 + (2 * (l2 & 3)) * 32 + (c & 31);
                T2[a] = (bf16_t)(pk2(o_re, 0.f) & 0xffff); T2[a + 32] = (bf16_t)(pk2(o_im, 0.f) & 0xffff);
            } else if (MODE == 1) { const int k1 = p0; bf16_t* mr = F.ws<bf16_t>(WS_MIX) + (size_t)(NCTX + k1 + 128 * kk) * MIXK;
                mr[c] = (bf16_t)(pk2(re * (1.f / 1024.f), 0.f) & 0xffff); mr[256 + c] = (bf16_t)(pk2(im * (1.f / 1024.f), 0.f) & 0xffff);
            } else { bf16_t* mr = F.ws<bf16_t>(WS_MIX) + (size_t)(128 * pa + kk) * MIXK;
                mr[c] = (bf16_t)(pk2(re * (1.f / 128.f), 0.f) & 0xffff); mr[256 + c] = (bf16_t)(pk2(im * (1.f / 128.f), 0.f) & 0xffff); } } }
}

constexpr int A_SLOT = 16384;
constexpr int N_PSLOT = 18;
constexpr int A_KRING = 0, A_VRING = 32768;
template <int NQ, int NKS, bool SEPK, bool BIAS>
__device__ __forceinline__ void attn_sweep(const Frame& F, const bf16x8 (&qf)[NQ][NKS], const bf16_t* Kt, const bf16_t* Vt, int ntiles, const f32x16& negm, f32x16 (&o)[NQ][2], float (&lsum)[NQ]) {
    constexpr int NKF = (SEPK ? NQ : 1) * NKS;
    const int lane = F.lane, wid = F.wid, r = lane & 31, h = lane >> 5;
    LAS char* lds = F.lds; const unsigned lds0 = (unsigned)(size_t)F.lds;
    const bf16_t* ksrc = Kt + wid * 512 + lane * 8; const bf16_t* vsrc = Vt + wid * 512 + lane * 8;
#define A_K(t) glds16(ksrc + (size_t)(t) * 4096, (unsigned)__builtin_amdgcn_readfirstlane((int)(lds0 + A_KRING + ((t) & 3) * 8192 + wid * 1024)))
#define A_V(t) glds16(vsrc + (size_t)(t) * 4096, (unsigned)__builtin_amdgcn_readfirstlane((int)(lds0 + A_VRING + ((t) & 3) * 8192 + wid * 1024)))
#define SB() __builtin_amdgcn_sched_barrier(0)
    BAR_SYNC();
    A_K(0); A_V(0); A_K(1); A_K(2); A_V(1);
    float l0[NQ]; f32x16 scA[NQ], scB[NQ]; bf16x8 kf[NKF], vf[4], pa[NQ][2];
#pragma unroll
    for (int qi = 0; qi < NQ; ++qi) { l0[qi] = 0.f;
#pragma unroll
        for (int i = 0; i < 16; ++i) { o[qi][0][i] = 0.f; o[qi][1][i] = 0.f; scB[qi][i] = 0.f; } }
    const int vb = ((lane >> 4) & 1) * 32 + (lane & 3) * 8 + (4 * h + ((lane & 15) >> 2)) * 64;
    const int kbo = h * 1024 + r * 16;
#define LOADK(tile, kb) do { LAS const char* kp_ = lds + A_KRING + ((tile) & 3) * 8192 + kbo + (kb) * 512; \
        _Pragma("unroll") for (int f_ = 0; f_ < NKF; ++f_) kf[f_] = *(LAS const bf16x8*)(kp_ + (SEPK ? (f_ / NKS) * 4096 : 0) + (f_ % NKS) * 2048); } while (0)
#define LOADV(tile, kb) do { LAS const char* vp_ = lds + A_VRING + ((tile) & 3) * 8192 + vb + (kb) * 2048; \
        _Pragma("unroll") for (int j_ = 0; j_ < 2; ++j_) _Pragma("unroll") for (int d_ = 0; d_ < 2; ++d_) { const s16x4 lo_ = vtr(vp_ + d_ * 4096 + j_ * 1024), hi_ = vtr(vp_ + d_ * 4096 + j_ * 1024 + 512); \
            vf[j_ * 2 + d_] = (bf16x8){lo_[0], lo_[1], lo_[2], lo_[3], hi_[0], hi_[1], hi_[2], hi_[3]}; } } while (0)
#define HALF(SN, SO, vtile, vkb, DOK, ktile, kkb) do { \
        LOADV(vtile, vkb); SB(); \
          \
        _Pragma("unroll") for (int m_ = 0; m_ < NQ * NKS; ++m_) { const int qi_ = m_ / NKS, s_ = m_ % NKS; \
            if (s_ == 0) { if (BIAS) SN[qi_] = MFMA(kf[(SEPK ? qi_ : 0) * NKS], qf[qi_][0], negm); else { f32x16 z_; _Pragma("unroll") for (int i_ = 0; i_ < 16; ++i_) z_[i_] = 0.f; SN[qi_] = MFMA(kf[(SEPK ? qi_ : 0) * NKS], qf[qi_][0], z_); } } \
            else SN[qi_] = MFMA(kf[(SEPK ? qi_ : 0) * NKS + s_], qf[qi_][s_], SN[qi_]); \
              \
            _Pragma("unroll") for (int g_ = m_ * 4 / NKS; g_ < (m_ + 1) * 4 / NKS; ++g_) { const int fq_ = g_ >> 2, gg_ = g_ & 3; \
                l0[fq_] += SO[fq_][4 * gg_]; l0[fq_] += SO[fq_][4 * gg_ + 1]; l0[fq_] += SO[fq_][4 * gg_ + 2]; l0[fq_] += SO[fq_][4 * gg_ + 3]; \
                { u32x4 w_ = __builtin_bit_cast(u32x4, pa[fq_][gg_ >> 1]); w_[(gg_ & 1) * 2] = pk2(SO[fq_][4 * gg_], SO[fq_][4 * gg_ + 1]); w_[(gg_ & 1) * 2 + 1] = pk2(SO[fq_][4 * gg_ + 2], SO[fq_][4 * gg_ + 3]); pa[fq_][gg_ >> 1] = __builtin_bit_cast(bf16x8, w_); } } \
            SB(); } \
          \
        _Pragma("unroll") for (int m_ = 0; m_ < NQ * 4; ++m_) { const int j_ = m_ / (2 * NQ), d_ = (m_ / NQ) & 1, qi_ = m_ % NQ; \
            o[qi_][d_] = MFMA(vf[j_ * 2 + d_], pa[qi_][j_], o[qi_][d_]); \
            { const int eq_ = m_ >> 2, eg_ = m_ & 3; \
              SN[eq_][4 * eg_] = __builtin_amdgcn_exp2f(SN[eq_][4 * eg_]); SN[eq_][4 * eg_ + 1] = __builtin_amdgcn_exp2f(SN[eq_][4 * eg_ + 1]); \
              SN[eq_][4 * eg_ + 2] = __builtin_amdgcn_exp2f(SN[eq_][4 * eg_ + 2]); SN[eq_][4 * eg_ + 3] = __builtin_amdgcn_exp2f(SN[eq_][4 * eg_ + 3]); } \
            if (m_ == 0) { if (DOK) LOADK(ktile, kkb); }   \
            SB(); } \
    } while (0)
    WAITV(2); BAR_SYNC();
    A_K(3); if (ntiles > 2) A_V(2);
    LOADK(0, 0);
    for (int t = 0; t < ntiles; ++t) {
        if (t > 0) {
            if (t + 2 < ntiles) { WAITV(2); } else if (t + 1 < ntiles) { WAITV(1); } else { WAITV(0); }
            BAR_SYNC();
            if (t + 3 < ntiles) A_K(t + 3);
            if (t + 2 < ntiles) A_V(t + 2);
        }
        HALF(scA, scB, (t > 0 ? t - 1 : 0), 1, true, t, 1);
        HALF(scB, scA, t, 0, (t + 1 < ntiles), t + 1, 0);
    }
    LOADV(ntiles - 1, 1);
#pragma unroll
    for (int qi = 0; qi < NQ; ++qi) {
#pragma unroll
        for (int i = 0; i < 16; ++i) l0[qi] += scB[qi][i];
        pa[qi][0] = pack8(scB[qi][0], scB[qi][1], scB[qi][2], scB[qi][3], scB[qi][4], scB[qi][5], scB[qi][6], scB[qi][7]);
        pa[qi][1] = pack8(scB[qi][8], scB[qi][9], scB[qi][10], scB[qi][11], scB[qi][12], scB[qi][13], scB[qi][14], scB[qi][15]); }
#pragma unroll
    for (int j = 0; j < 2; ++j)
#pragma unroll
        for (int d0 = 0; d0 < 2; ++d0)
#pragma unroll
            for (int qi = 0; qi < NQ; ++qi) o[qi][d0] = MFMA(vf[j * 2 + d0], pa[qi][j], o[qi][d0]);
#undef A_K
#undef A_V
#undef SB
#undef LOADK
#undef LOADV
#undef HALF
#pragma unroll
    for (int qi = 0; qi < NQ; ++qi) lsum[qi] = add32(l0[qi]);
}
constexpr int PREC = 1152;
__device__ __forceinline__ void store_partial(const Frame& F, int kh, int slot, int R, const f32x16 (&o)[2], float l, int r, int h) {
    bf16_t* rec = F.ws<bf16_t>(WS_PART) + ((size_t)R * 2 + kh) * PREC; const float inv = 1.f / l;
#pragma unroll
    for (int d0 = 0; d0 < 2; ++d0)
#pragma unroll
        for (int g = 0; g < 4; ++g) { u32x2 w = {pk2(o[d0][4 * g] * inv, o[d0][4 * g + 1] * inv), pk2(o[d0][4 * g + 2] * inv, o[d0][4 * g + 3] * inv)};
            const int off = slot < 12 ? (((slot >> 1) * 8 + 4 * d0 + g) * 2 + (slot & 1)) * 8 + 4 * h : 768 + (slot - 12) * 64 + 32 * d0 + 8 * g + 4 * h;
            *(u32x2*)(rec + off) = w; }
    if (h == 0) F.ws<float>(WS_PL)[((size_t)R * 2 + kh) * N_PSLOT + slot] = l;
}
__device__ __forceinline__ void attn_diff_unit(const Frame& F, int l, int head, int R0, int t0, int ntiles, int khalf) {
    const int lane = F.lane, wid = F.wid, r = lane & 31, h = lane >> 5;
    const bf16_t* qp = F.ws<bf16_t>(WS_QD) + (size_t)(head * NQB + (R0 >> 5) + wid) * 2048;
    bf16x8 qf[2][2]; float mi[2];
#pragma unroll
    for (int mp = 0; mp < 2; ++mp) {
#pragma unroll
        for (int s = 0; s < 2; ++s) qf[mp][s] = *(const bf16x8*)(qp + ((4 * mp + 2 * s + h) * 32 + r) * 8);
        float qq = 0.f;
#pragma unroll
        for (int j = 0; j < 8; ++j) { const float a = bf2f((unsigned short)qf[mp][0][j]), b = bf2f((unsigned short)qf[mp][1][j]); qq += a * a + b * b; }
        qq = add32(qq);
        const float km = ((LAS const float*)(F.lds + LDS_CTL + 1024))[2 * head + mp];
        mi[mp] = -sqrtf(qq * km) * 1.01f; }
    f32x16 negm; { const float mm = fminf(mi[0], mi[1]);
#pragma unroll
        for (int i = 0; i < 16; ++i) negm[i] = mm; asm volatile("" : "+v"(negm)); }
    f32x16 o[2][2]; float ls[2];
    attn_sweep<2, 2, true, true>(F, qf, F.ws<bf16_t>(WS_KD) + (size_t)(head * NKT + t0) * 4096, F.ws<bf16_t>(WS_VD) + (size_t)(head * NKT + t0) * 4096, ntiles, negm, o, ls);
    { const int ln = lane_now(), r2 = ln & 31, h2 = ln >> 5, R = R0 + 32 * wid + r2;
#pragma unroll
      for (int mp = 0; mp < 2; ++mp) store_partial(F, khalf, 2 * head + mp, R, o[mp], ls[mp], r2, h2); }
}
template <int NH>
__device__ __forceinline__ void attn_gqa_unit(const Frame& F, int qh0, int kvh, int R0, int t0, int ntiles, int khalf, float bound) {
    const int lane = F.lane, wid = F.wid, r = lane & 31, h = lane >> 5;
    bf16x8 qf[NH][4];
#pragma unroll
    for (int hh = 0; hh < NH; ++hh) { const bf16_t* qp = F.ws<bf16_t>(WS_QG) + (size_t)((qh0 + hh) * NQB + (R0 >> 5) + wid) * 2048;
#pragma unroll
        for (int s = 0; s < 4; ++s) qf[hh][s] = *(const bf16x8*)(qp + ((2 * s + h) * 32 + r) * 8); }
    f32x16 o[NH][2]; float ls[NH]; f32x16 negm;
#pragma unroll
    for (int i = 0; i < 16; ++i) negm[i] = 0.f;
    attn_sweep<NH, 4, false, false>(F, qf, F.ws<bf16_t>(WS_KG) + (size_t)(kvh * NKT + t0) * 4096, F.ws<bf16_t>(WS_VG) + (size_t)(kvh * NKT + t0) * 4096, ntiles, negm, o, ls);
    { const int ln = lane_now(), r2 = ln & 31, h2 = ln >> 5, R = R0 + 32 * wid + r2;
#pragma unroll
      for (int hh = 0; hh < NH; ++hh) store_partial(F, khalf, 12 + qh0 + hh, R, o[hh], ls[hh], r2, h2); }
}

__device__ __forceinline__ void phase_attn(const Frame& F, int l, int rep) {
    if (F.wid >= 4) __builtin_amdgcn_s_setprio(1);
    float gqm = 0.f, gkm = 0.f; { const float* gq = F.in(I_GQ) + 64 * l; const float* gk = F.in(I_GK) + 64 * l; for (int i = 0; i < 64; ++i) { gqm = fmaxf(gqm, fabsf(gq[i])); gkm = fmaxf(gkm, fabsf(gk[i])); } }
    const float bg = fminf(8.f * gqm * gkm * LOG2E * 1.01f, 100.f);
    for (int mp = F.wid; mp < 12; mp += 8) { const float* kp = F.ws<float>(WS_KP) + (size_t)(l * 12 + mp) * 1024; float mx = 0.f;
#pragma unroll
        for (int q = 0; q < 4; ++q) { const f32x4 v = *(const f32x4*)(kp + 256 * q + 4 * F.lane); mx = fmaxf(fmaxf(mx, fmaxf(v[0], v[1])), fmaxf(v[2], v[3])); }
        mx = wave_max(mx); mx = fmaxf(mx, __uint_as_float(__hip_atomic_load(F.ctl + CW_KMAX + 16 * l + mp, __ATOMIC_RELAXED, __HIP_MEMORY_SCOPE_AGENT)));
        if (F.lane == 0) ((LAS float*)(F.lds + LDS_CTL + 1024))[mp] = mx; }
    __syncthreads();
    constexpr int HT = NKT / 2;
    for (int u = F.bid; u < 256; u += F.G) { const int cb = (u & 7) >> 1, rb = ((u >> 3) << 1) | (u & 1), R0 = NCTX + 256 * rb; const int kvh = cb >> 1, kh = cb & 1;
        attn_gqa_unit<2>(F, 3 * kvh, kvh, R0, kh * HT, HT, kh, bg); }
    for (int u = F.bid; u < 768; u += F.G) { const int j = u >> 8, v = u & 255, cb = 4 * j + ((v & 7) >> 1), rb = ((v >> 3) << 1) | (v & 1), R0 = NCTX + 256 * rb; const int head = cb >> 1, kh = cb & 1;
        attn_diff_unit(F, l, head, R0, kh * HT, HT, kh); }
    for (int u = F.bid; u < 256; u += F.G) { const int cb = (u & 7) >> 1, rb = ((u >> 3) << 1) | (u & 1), R0 = NCTX + 256 * rb; const int kvh = cb >> 1, kh = cb & 1;
        attn_gqa_unit<1>(F, 3 * kvh + 2, kvh, R0, kh * HT, HT, kh, bg); }
    for (int u = F.bid; u < 256; u += F.G) { const int l2 = u >> 1, ch = u & 1;
        dft_unit<128, 0>(F, F.ws<bf16_t>(WS_A1F), F.ws<bf16_t>(WS_FT) + (size_t)(l2 * 2 + ch) * 4 * 4096, l2, ch, 0); }
    if (l == 0) {
        for (int u = F.bid; u < 14; u += F.G) {
            if (u < 4) { const int pa = u >> 1, ch = u & 1; dft_unit<256, 2>(F, F.ws<bf16_t>(WS_ACF) + (size_t)pa * 65536, F.ws<bf16_t>(WS_FC) + (size_t)ch * 4 * 8192, 0, ch, pa); }
            else if (u < 10) attn_diff_unit(F, l, u - 4, 0, 0, NCTX / 64, 0);
            else if (u < 12) attn_gqa_unit<2>(F, 3 * (u - 10), u - 10, 0, 0, NCTX / 64, 0, bg);
            else attn_gqa_unit<1>(F, 3 * (u - 12) + 2, u - 12, 0, 0, NCTX / 64, 0, bg);
        }
    }
    __builtin_amdgcn_s_setprio(0);
}
__device__ __forceinline__ void unpack8(const u32x4& w, float (&f)[8]) { f[0] = bflo(w[0]); f[1] = bfhi(w[0]); f[2] = bflo(w[1]); f[3] = bfhi(w[1]); f[4] = bflo(w[2]); f[5] = bfhi(w[2]); f[6] = bflo(w[3]); f[7] = bfhi(w[3]); }
__device__ __forceinline__ void attn_merge(const Frame& F, int l) {
    const int lane = F.lane, un = lane >> 3, dc = lane & 7; const bool act = lane < 48;
    const float* lq1 = F.in(I_LQ1) + 32 * l; const float* lk1 = F.in(I_LK1) + 32 * l; const float* lq2 = F.in(I_LQ2) + 32 * l; const float* lk2 = F.in(I_LK2) + 32 * l;
    float d1 = 0.f, d2 = 0.f; for (int i = 0; i < 32; ++i) { d1 += lq1[i] * lk1[i]; d2 += lq2[i] * lk2[i]; }
    const float lam_init = 0.8f - 0.6f * expf(-0.3f * (float)l); const float lam = expf(d1) - expf(d2) + lam_init, post = 1.f - lam_init;
    float gs[8]; { const float* g = F.in(I_GSUB) + 64 * l + 8 * dc; for (int j = 0; j < 8; ++j) gs[j] = g[j]; }
    const bf16_t* part = F.ws<bf16_t>(WS_PART); const float* pl = F.ws<float>(WS_PL); bf16_t* mix = F.ws<bf16_t>(WS_MIX);
    const int Rbeg = l == 0 ? 0 : NCTX; const int u6 = act ? un : 0;
    for (int R = Rbeg + F.bid * 8 + F.wid; R < NT; R += F.G * 8) {
        const bool two = R >= NCTX; bf16_t* mr = mix + (size_t)R * MIXK;
        const bf16_t* ra = part + (size_t)R * 2 * PREC; const bf16_t* rb = ra + PREC; const float* la = pl + (size_t)R * 2 * N_PSLOT; const float* lb = la + N_PSLOT;
        { const u32x4 a0 = *(const u32x4*)(ra + (u6 * 8 + dc) * 16), a1 = *(const u32x4*)(ra + (u6 * 8 + dc) * 16 + 8);
          u32x4 b0 = {0u, 0u, 0u, 0u}, b1 = b0; float lb0 = 0.f, lb1 = 0.f;
          if (two) { b0 = *(const u32x4*)(rb + (u6 * 8 + dc) * 16); b1 = *(const u32x4*)(rb + (u6 * 8 + dc) * 16 + 8); lb0 = lb[2 * u6]; lb1 = lb[2 * u6 + 1]; }
          const float la0 = la[2 * u6], la1 = la[2 * u6 + 1]; const float i0 = 1.f / (la0 + lb0), i1 = lam / (la1 + lb1);
          float fa0[8], fa1[8], fb0[8], fb1[8], v[8]; unpack8(a0, fa0); unpack8(a1, fa1); unpack8(b0, fb0); unpack8(b1, fb1);
          float ss = 0.f;
#pragma unroll
          for (int j = 0; j < 8; ++j) { v[j] = (la0 * fa0[j] + lb0 * fb0[j]) * i0 - (la1 * fa1[j] + lb1 * fb1[j]) * i1; ss += v[j] * v[j]; }
          ss += shxc<1>(ss); ss += shxc<2>(ss); ss += shxc<4>(ss);
          const float rs = rsqrtf(ss * (1.f / 64.f) + 1e-5f) * post;
          if (act) { u32x4 w = {pk2(v[0] * rs * gs[0], v[1] * rs * gs[1]), pk2(v[2] * rs * gs[2], v[3] * rs * gs[3]), pk2(v[4] * rs * gs[4], v[5] * rs * gs[5]), pk2(v[6] * rs * gs[6], v[7] * rs * gs[7])};
              *(u32x4*)(mr + 512 + 64 * un + 8 * dc) = w; } }
        { const u32x4 a0 = *(const u32x4*)(ra + 768 + u6 * 64 + dc * 8); u32x4 b0 = {0u, 0u, 0u, 0u}; float lbq = 0.f;
          if (two) { b0 = *(const u32x4*)(rb + 768 + u6 * 64 + dc * 8); lbq = lb[12 + u6]; }
          const float laq = la[12 + u6], iq = 1.f / (laq + lbq); float fa[8], fb[8]; unpack8(a0, fa); unpack8(b0, fb);
          if (act) { float o[8];
#pragma unroll
              for (int j = 0; j < 8; ++j) o[j] = (laq * fa[j] + lbq * fb[j]) * iq;
              u32x4 w = {pk2(o[0], o[1]), pk2(o[2], o[3]), pk2(o[4], o[5]), pk2(o[6], o[7])}; *(u32x4*)(mr + 896 + 64 * un + 8 * dc) = w; } }
    }
}
__device__ __forceinline__ void phase_fft2(const Frame& F, int l) {
    for (int u = F.bid; u < 256; u += F.G) { const int k1 = u >> 1, ch = u & 1;
        dft_unit<256, 1>(F, F.ws<bf16_t>(WS_A2F), F.ws<bf16_t>(WS_T2) + (size_t)(k1 * 2 + ch) * 4 * 8192, k1, ch, 0); }
    attn_merge(F, l);
}

__device__ __forceinline__ void phase_router(const Frame& F, int l) {
    LAS float* wl = (LAS float*)F.lds;
    LAS unsigned* hist = (LAS unsigned*)(F.lds + 131072);
    LAS unsigned* recs = hist + 64;
    const int lane = F.lane, wid = F.wid, t = F.tid;
    const float* wr = F.in(I_WR) + (size_t)l * 1024 * 32;
    __syncthreads();
    { f32x4 tv[16];
#pragma unroll
      for (int j = 0; j < 16; ++j) { const int i = t + 512 * j, k = i >> 3, c = i & 7; tv[j] = *(const f32x4*)(wr + k * 32 + 4 * c); }
#pragma unroll
      for (int j = 0; j < 16; ++j) { const int i = t + 512 * j, k = i >> 3, c = i & 7; *(LAS f32x4*)(wl + (k ^ ((k >> 5) & 1)) * 32 + 4 * (c ^ ((k >> 2) & 7))) = tv[j]; } }
    if (t < 64) hist[t] = 0u;
    __syncthreads();
    const int Rbeg = l == 0 ? 0 : NCTX, ntok = NT - Rbeg, per = (ntok + F.G - 1) / F.G;
    const int r0 = Rbeg + F.bid * per, r1 = min(r0 + per, NT);
    const float* mod = F.ws<float>(WS_MOD) + (size_t)l * 2 * 6144; const float* g2 = F.in(I_GN2) + 1024 * l; const float* br = F.in(I_BR) + 32 * l;
    const float* xs = F.ws<float>(WS_XS); bf16_t* hb = F.ws<bf16_t>(WS_HB);
    unsigned* slot = F.ws<unsigned>(WS_SLOT); float* gate = F.ws<float>(WS_GATE);
    const float bre = br[lane >> 1];
    f32x4 xna[4], xnb[4];
    { const int Ra = min(r0 + wid, NT - 1), Rc = min(r0 + wid + 8, NT - 1); load_row(xs + (size_t)Ra * DM, lane, xna); load_row(xs + (size_t)(Rc < r1 ? Rc : Ra) * DM, lane, xnb); }
    for (int R = r0 + wid; R < r1; R += 16) {
        const int R2 = R + 8; const bool two = R2 < r1; const int Rb = two ? R2 : R;
        f32x4 hv[2][4];
        { f32x4 xa[4], xb[4];
#pragma unroll
          for (int q = 0; q < 4; ++q) { xa[q] = xna[q]; xb[q] = xnb[q]; }
          { const int Rn = R + 16 < r1 ? R + 16 : R, Rm = R + 24 < r1 ? R + 24 : Rn; load_row(xs + (size_t)Rn * DM, lane, xna); load_row(xs + (size_t)Rm * DM, lane, xnb); }
          const float* ma = mod + (R < NCTX ? 6144 : 0); const float* mb = mod + (Rb < NCTX ? 6144 : 0);
          const float rsa = row_rstd(xa, 1e-6f), rsb = row_rstd(xb, 1e-6f);
          mod_store_bf16(xa, rsa, g2, ma + 3072, ma + 4096, hb + (size_t)R * DM, lane, &hv[0]);
          mod_store_bf16(xb, rsb, g2, mb + 3072, mb + 4096, hb + (size_t)Rb * DM, lane, &hv[1]); }
        f32x2 accp[32];
#pragma unroll
        for (int e = 0; e < 32; ++e) accp[e] = (f32x2){0.f, 0.f};
        f32x4 wq[2][8];
#define RT_LOAD(buf, s_) do { const int k_ = 256 * ((s_) >> 2) + 4 * lane + ((s_) & 3), sw_ = (k_ >> 2) & 7; LAS const float* row_ = wl + (k_ ^ ((k_ >> 5) & 1)) * 32; \
            _Pragma("unroll") for (int c = 0; c < 8; ++c) wq[buf][c] = *(LAS const f32x4*)(row_ + 4 * (c ^ sw_)); } while (0)
        RT_LOAD(0, 0);
#pragma unroll
        for (int s = 0; s < 16; ++s) { const int q = s >> 2, i = s & 3; const f32x2 hx = {hv[0][q][i], hv[1][q][i]};
            if (s + 1 < 16) RT_LOAD((s + 1) & 1, s + 1);
            __builtin_amdgcn_sched_barrier(0);
#pragma unroll
            for (int c = 0; c < 8; ++c)
#pragma unroll
                for (int j = 0; j < 4; ++j) accp[4 * c + j] = __builtin_elementwise_fma(hx, (f32x2){wq[s & 1][c][j], wq[s & 1][c][j]}, accp[4 * c + j]);
            __builtin_amdgcn_sched_barrier(0); }
#undef RT_LOAD
        f32x2 a16[16], a8[8], a4[4], a2[2], a1;
        { const bool b = lane & 32;
#pragma unroll
          for (int j = 0; j < 16; ++j) { const f32x2 keep = b ? accp[16 + j] : accp[j], send = b ? accp[j] : accp[16 + j]; a16[j] = (f32x2){keep[0] + partner32(send[0], b), keep[1] + partner32(send[1], b)}; } }
        { const bool b = lane & 16;
#pragma unroll
          for (int j = 0; j < 8; ++j) { const f32x2 keep = b ? a16[8 + j] : a16[j], send = b ? a16[j] : a16[8 + j]; a8[j] = (f32x2){keep[0] + shxc<16>(send[0]), keep[1] + shxc<16>(send[1])}; } }
        { const bool b = lane & 8;
#pragma unroll
          for (int j = 0; j < 4; ++j) { const f32x2 keep = b ? a8[4 + j] : a8[j], send = b ? a8[j] : a8[4 + j]; a4[j] = (f32x2){keep[0] + shxc<8>(send[0]), keep[1] + shxc<8>(send[1])}; } }
        { const bool b = lane & 4;
#pragma unroll
          for (int j = 0; j < 2; ++j) { const f32x2 keep = b ? a4[2 + j] : a4[j], send = b ? a4[j] : a4[2 + j]; a2[j] = (f32x2){keep[0] + shxc<4>(send[0]), keep[1] + shxc<4>(send[1])}; } }
        { const bool b = lane & 2; const f32x2 keep = b ? a2[1] : a2[0], send = b ? a2[0] : a2[1]; a1 = (f32x2){keep[0] + shxc<2>(send[0]), keep[1] + shxc<2>(send[1])}; }
        a1 = (f32x2){a1[0] + shxc<1>(a1[0]), a1[1] + shxc<1>(a1[1])};
        const int e = lane >> 1; float v0 = a1[0] + bre, v1 = a1[1] + bre;
        float tv0[4], tv1[4]; int te0[4], te1[4];
#pragma unroll
        for (int kk = 0; kk < 4; ++kk) { const float m0 = wave_max(v0), m1 = wave_max(v1);
            const unsigned long long b0 = __ballot(v0 == m0), b1 = __ballot(v1 == m1); const int l0 = __ffsll((long long)b0) - 1, l1 = __ffsll((long long)b1) - 1;
            te0[kk] = l0 >> 1; tv0[kk] = m0; if (e == te0[kk]) v0 = -INFINITY; te1[kk] = l1 >> 1; tv1[kk] = m1; if (e == te1[kk]) v1 = -INFINITY; }
#pragma unroll
        for (int tk = 0; tk < 2; ++tk) { const float* tv = tk ? tv1 : tv0; const int* te = tk ? te1 : te0; const int Rt = tk ? R2 : R;
            const float e1 = __expf(tv[1] - tv[0]), e2 = __expf(tv[2] - tv[0]), e3 = __expf(tv[3] - tv[0]); const float inv = 1.f / (1.f + e1 + e2 + e3);
            if (lane < 4 && (tk == 0 || two)) { const int ee = lane == 0 ? te[0] : lane == 1 ? te[1] : lane == 2 ? te[2] : te[3]; const float gg = (lane == 0 ? 1.f : lane == 1 ? e1 : lane == 2 ? e2 : e3) * inv;
                const unsigned lr = atomicAdd((unsigned*)(hist + ee), 1u);
                const int ti = Rt - r0; recs[ti * 4 + lane] = ((unsigned)ee << 24) | lr; gate[(size_t)Rt * 4 + lane] = gg; } }
    }
    __syncthreads();
    if (t < 32) { const unsigned c = hist[t]; hist[32 + t] = c ? xb_add(F.ctl + CW_CNT + 64 * l + t, c) : 0u; }
    __syncthreads();
    unsigned* list = F.ws<unsigned>(WS_LIST);
    for (int i = t; i < (r1 - r0) * 4; i += 512) { const unsigned rec = recs[i]; const unsigned ee = rec >> 24, rk = (rec & 0xffffffu) + hist[32 + ee]; const int R = r0 + (i >> 2);
        slot[(size_t)R * 4 + (i & 3)] = (ee << 24) | rk; list[(size_t)ee * NT + rk] = (unsigned)R; }
    __syncthreads();
}

__device__ __forceinline__ void phase_combine(const Frame& F, int l) {
    const int lane = F.lane; const float* mod = F.ws<float>(WS_MOD) + (size_t)l * 2 * 6144; const float* modn = F.ws<float>(WS_MOD) + (size_t)(l + 1) * 2 * 6144;
    float* xs = F.ws<float>(WS_XS); const bf16_t* yb = F.ws<bf16_t>(WS_YB); const unsigned* slot = F.ws<unsigned>(WS_SLOT); const float* gate = F.ws<float>(WS_GATE); bf16_t* hb = F.ws<bf16_t>(WS_HB);
    int offs = 0;
    { const int ce = lane < NEXP ? (int)__hip_atomic_load(F.ctl + CW_CNT + 64 * l + lane, __ATOMIC_RELAXED, __HIP_MEMORY_SCOPE_AGENT) : 0;
      int inc = ce;
#pragma unroll
      for (int d = 1; d < 32; d <<= 1) { const int up = __builtin_amdgcn_ds_bpermute(((lane - d) & 63) << 2, inc); if (lane >= d) inc += up; }
      offs = inc - ce; }
    const int Rbeg = l == 0 ? 0 : NCTX; float* outb = F.outp(); const float* gn1 = F.in(I_GN1) + 1024; const float* gf = F.in(I_GFIN);
    f32x4 gfv[4];
#pragma unroll
    for (int q = 0; q < 4; ++q) gfv[q] = *(const f32x4*)(gf + 256 * q + 4 * lane);
    for (int R = Rbeg + F.bid * 8 + F.wid; R < NT; R += F.G * 8) {
        const float* m = mod + (R < NCTX ? 6144 : 0);
        f32x4 x[4], a[4]; load_row(xs + (size_t)R * DM, lane, x);
#pragma unroll
        for (int q = 0; q < 4; ++q) a[q] = (f32x4){0.f, 0.f, 0.f, 0.f};
#pragma unroll
        for (int s = 0; s < 4; ++s) { const unsigned rec = slot[(size_t)R * 4 + s]; const float g = gate[(size_t)R * 4 + s]; const int pos = __builtin_amdgcn_ds_bpermute((int)((rec >> 24) << 2), offs) + (int)(rec & 0xffffffu);
            const bf16_t* yr = yb + (size_t)pos * DM;
#pragma unroll
            for (int q = 0; q < 4; ++q) { const u32x2 w = *(const u32x2*)(yr + 256 * q + 4 * lane); a[q][0] += g * bflo(w[0]); a[q][1] += g * bfhi(w[0]); a[q][2] += g * bflo(w[1]); a[q][3] += g * bfhi(w[1]); } }
#pragma unroll
        for (int q = 0; q < 4; ++q) { const f32x4 gt = *(const f32x4*)(m + 5120 + 256 * q + 4 * lane);
#pragma unroll
            for (int i = 0; i < 4; ++i) x[q][i] += gt[i] * a[q][i]; }
        const float rstd = row_rstd(x, 1e-6f);
        if (l == 0) {
#pragma unroll
            for (int q = 0; q < 4; ++q) *(f32x4*)(xs + (size_t)R * DM + 256 * q + 4 * lane) = x[q];
            const float* mn = modn + (R < NCTX ? 6144 : 0);
            mod_store_bf16(x, rstd, gn1, mn, mn + 1024, hb + (size_t)R * DM, lane);
        } else {
            float* orow = outb + (size_t)(R - NCTX) * DM;
#pragma unroll
            for (int q = 0; q < 4; ++q) { const f32x4 gv = gfv[q]; f32x4 o;
#pragma unroll
                for (int i = 0; i < 4; ++i) o[i] = x[q][i] * rstd * gv[i];
                *(f32x4*)(orow + 256 * q + 4 * lane) = o; }
        }
    }
}

__device__ __forceinline__ int opaque_i32(int v) { asm volatile("" : "+s"(v)); return __builtin_amdgcn_readfirstlane(v); }
__device__ __forceinline__ unsigned long long opaque_u64(unsigned long long w) { int lo = (int)(unsigned)w, hi = (int)(unsigned)(w >> 32); lo = opaque_i32(lo); hi = opaque_i32(hi);
    return ((unsigned long long)(unsigned)hi << 32) | (unsigned)lo; }
__device__ __forceinline__ Frame fresh(const Frame& F) { Frame G = F;
    G.wsb = (unsigned char*)opaque_u64((unsigned long long)F.wsb); G.ctl = (unsigned*)opaque_u64((unsigned long long)F.ctl);
    G.pp = (const __attribute__((address_space(4))) Params*)opaque_u64((unsigned long long)F.pp);
    G.wid = opaque_i32(F.wid); G.bid = opaque_i32(F.bid); G.G = opaque_i32(F.G);
    G.lane = lane_now(); G.tid = G.wid * 64 + G.lane; return G; }
constexpr int N_PHASES = 18;
__global__ void __launch_bounds__(NTHREADS, 2) mk_fwd(Params P, int ph_lo, int ph_hi, int probe) {
    extern __shared__ __attribute__((aligned(16))) unsigned char smem_raw[];
    Frame F; F.pp = (const __attribute__((address_space(4))) Params*)__builtin_amdgcn_kernarg_segment_ptr(); F.wsb = P.ws; F.lds = (LAS char*)smem_raw; F.tid = threadIdx.x; F.lane = F.tid & 63; F.wid = __builtin_amdgcn_readfirstlane(F.tid >> 6); F.G = gridDim.x; F.bid = blockIdx.x;
    F.ctl = (unsigned*)(P.ws + WS_CTL);
    LAS unsigned* bw = (LAS unsigned*)(F.lds + LDS_CTL);
    if (F.tid < 4) bw[F.tid] = 0u;
    __syncthreads();
    XcdBarrier bar;
    if (MK_ONE_LAUNCH) bar = xcd_barrier_post(F.ctl + CW_BAR, (volatile LAS unsigned*)bw, F.wid);
#ifndef PHASE_MASK
#define PHASE_MASK 0xFFFFFFFFu
#endif
#if MK_ONE_LAUNCH
#define IN(k) (((PHASE_MASK >> ((k) >= 10 ? (k) - 8 : (k))) & 1u) != 0u)
#else
#define IN(k) (((PHASE_MASK >> ((k) >= 10 ? (k) - 8 : (k))) & 1u) && ph_lo <= (k) && (k) < ph_hi)
#endif
#define SEAM(k) do { if (MK_ONE_LAUNCH && IN(k) && IN((k) + 1)) xcd_barrier(bar); } while (0)
#define RUN(k, code, body) do { if (IN(k)) { const int nr_ = (opaque_i32(probe) == (code)) ? 2 : 1; _Pragma("unroll 1") for (int rep = 0; rep < nr_; ++rep) { body; if (MK_ONE_LAUNCH && rep + 1 < nr_) xcd_barrier(bar); } } SEAM(k); } while (0)
    RUN(0, 100, phase_prologue(fresh(F)));
    RUN(1, 101, phase_norm0(fresh(F)));
#pragma unroll 1
    for (int l = 0; l < 2; ++l) {
        const int b = 2 + 8 * l;
        RUN(b + 0, 0, phase_inproj(fresh(F), l));
        RUN(b + 1, 1, phase_attn(fresh(F), l, rep));
        RUN(b + 2, 2, phase_fft2(fresh(F), l));
        RUN(b + 3, 3 + 10 * l, phase_outproj(fresh(F), l));
        RUN(b + 4, 104, phase_router(fresh(F), l));
        RUN(b + 5, 5, phase_gateup(fresh(F), l));
        RUN(b + 6, 6, phase_down(fresh(F), l));
        RUN(b + 7, 17 - 10 * l, phase_combine(fresh(F), l));
    }
}

extern "C" void kernel_launch(void* const* d_in, const int* in_sizes, int n_in, void* d_out, int out_size, void* d_ws, size_t ws_size, hipStream_t stream) {
    static int grid = 0;
    if (!grid) {
        int dev = 0, cus = 0, per_cu = 0;
        hipGetDevice(&dev);
        hipDeviceGetAttribute(&cus, hipDeviceAttributeMultiprocessorCount, dev);
        hipFuncSetAttribute((const void*)mk_fwd, hipFuncAttributeMaxDynamicSharedMemorySize, LDS_BYTES);
        hipOccupancyMaxActiveBlocksPerMultiprocessor(&per_cu, (const void*)mk_fwd, NTHREADS, LDS_BYTES);
        if (per_cu < 1) { fprintf(stderr, "mk_fwd: occupancy query says %d blocks per CU\n", per_cu); per_cu = 1; }
        grid = cus * 1;
        if (ws_size < WS_END) fprintf(stderr, "mk_fwd: workspace too small (%zu < %zu)\n", ws_size, (size_t)WS_END);
    }
    hipMemsetAsync(d_ws, 0, CTL_BYTES, stream);
    Params p{};
    for (int i = 0; i < 25; ++i) p.in[i] = (const float*)d_in[i];
    p.out = (float*)d_out; p.ws = (unsigned char*)d_ws;
#if MK_ONE_LAUNCH
    hipLaunchKernelGGL(mk_fwd, dim3(grid), dim3(NTHREADS), LDS_BYTES, stream, p, 0, N_PHASES, MK_PROBE);
#else
    for (int k = 0; k < N_PHASES; ++k) hipLaunchKernelGGL(mk_fwd, dim3(grid), dim3(NTHREADS), LDS_BYTES, stream, p, k, k + 1, -1);
#endif
}
```

```cpp
#include <hip/hip_runtime.h>
#include <cstdio>
#include <cstdint>

#ifndef MK_PROBE
#define MK_PROBE -1
#endif
#ifndef MK_ONE_LAUNCH
#define MK_ONE_LAUNCH 1
#endif

#define LAS __attribute__((address_space(3)))
typedef unsigned short bf16_t;
typedef short bf16x8 __attribute__((ext_vector_type(8)));
typedef short s16x4 __attribute__((ext_vector_type(4)));
typedef float f32x16 __attribute__((ext_vector_type(16)));
typedef float f32x4 __attribute__((ext_vector_type(4)));
typedef float f32x2 __attribute__((ext_vector_type(2)));
typedef unsigned u32x4 __attribute__((ext_vector_type(4)));
typedef unsigned u32x2 __attribute__((ext_vector_type(2)));
typedef __bf16 bf16x2_t __attribute__((ext_vector_type(2)));
typedef short v4i16_t __attribute__((ext_vector_type(4)));

constexpr int DM = 1024, LSEQ = 16384, NCTX = 256, NT = LSEQ + NCTX, INW = 2048, NEXP = 32, FFD = 1024, MIXK = 1280;
constexpr int NKT = NT / 64;
constexpr int NQB = NT / 32;
constexpr float LOG2E = 1.4426950408889634f;
constexpr int NTHREADS = 512;
constexpr int LDS_BYTES = 155648;
constexpr int LDS_CTL = 151552;

constexpr size_t al256(size_t x) { return (x + 255) & ~(size_t)255; }
constexpr size_t WS_CTL = 0, CTL_BYTES = 1u << 20;
constexpr size_t WS_MOD = CTL_BYTES;
constexpr size_t WS_ROPE = WS_MOD + 131072;
constexpr size_t WS_TW = WS_ROPE + 65536;
constexpr size_t WS_A1F = WS_TW + 131072;
constexpr size_t WS_A2F = WS_A1F + 65536;
constexpr size_t WS_ACF = WS_A2F + 131072;
constexpr size_t WS_WIN = WS_ACF + 262144;
constexpr size_t WS_WOUT = WS_WIN + (size_t)2 * INW * DM * 2;
constexpr size_t WS_WGU = WS_WOUT + (size_t)2 * DM * MIXK * 2;
constexpr size_t WS_WDN = WS_WGU + (size_t)2 * NEXP * 2048 * DM * 2;
constexpr size_t WS_HB = WS_WDN + (size_t)2 * NEXP * DM * FFD * 2;
constexpr size_t WS_QD = WS_HB + (size_t)NT * DM * 2;
constexpr size_t WS_KD = WS_QD + (size_t)6 * NQB * 2048 * 2;
constexpr size_t WS_VD = WS_KD + (size_t)6 * NKT * 4096 * 2;
constexpr size_t WS_QG = WS_VD + (size_t)6 * NKT * 4096 * 2;
constexpr size_t WS_KG = WS_QG + (size_t)6 * NQB * 2048 * 2;
constexpr size_t WS_VG = WS_KG + (size_t)2 * NKT * 4096 * 2;
constexpr size_t WS_FT = WS_VG + (size_t)2 * NKT * 4096 * 2;
constexpr size_t WS_FC = WS_FT + (size_t)128 * 2 * 4 * 4096 * 2;
constexpr size_t WS_T2 = WS_FC + (size_t)2 * 4 * 8192 * 2;
constexpr size_t WS_MIX = WS_T2 + (size_t)128 * 2 * 4 * 8192 * 2;
constexpr size_t WS_XS = WS_MIX + (size_t)NT * MIXK * 2;
constexpr size_t WS_LIST = WS_XS + (size_t)NT * DM * 4;
constexpr size_t WS_SLOT = WS_LIST + (size_t)NEXP * NT * 4;
constexpr size_t WS_GATE = WS_SLOT + (size_t)NT * 16;
constexpr size_t WS_ACT = WS_GATE + (size_t)NT * 16;
constexpr size_t WS_YB = WS_ACT + (size_t)NT * 4 * FFD * 2;
constexpr size_t WS_PART = WS_YB + (size_t)NT * 4 * DM * 2;
constexpr size_t WS_PL = WS_PART + (size_t)36 * NT * 64 * 2;
constexpr size_t WS_KP = WS_PL + (size_t)36 * NT * 4;
constexpr size_t WS_END = WS_KP + (size_t)2 * 12 * 1024 * 4;

constexpr int CW_BAR = 4096;
constexpr int CW_CNT = 8192;
constexpr int CW_KMAX = 8320;
constexpr int CW_QH = 8448;

constexpr int RD_RC = 0, RD_RS = 2048, RD_CC = 4096, RD_CS = 4608, RG_RC = 5120, RG_RS = 9216, RG_CC = 13312, RG_CS = 14336, ROPE_N = 15360;

struct Params { const float* in[25]; float* out; unsigned char* ws; };
enum { I_X = 0, I_C, I_CTX, I_CCTX, I_WMOD, I_BMOD, I_GN1, I_GN2, I_WIN, I_WOUT, I_WFNET, I_LQ1, I_LK1, I_LQ2, I_LK2, I_GSUB, I_GQ, I_GK, I_WR, I_BR, I_WGU, I_BGU, I_WDN, I_BDN, I_GFIN };

__device__ __forceinline__ unsigned pk2(float lo, float hi) { f32x2 v = {lo, hi}; bf16x2_t b = __builtin_convertvector(v, bf16x2_t); return __builtin_bit_cast(unsigned, b); }
__device__ __forceinline__ float bf2f(unsigned short u) { return __builtin_bit_cast(float, (unsigned)u << 16); }
__device__ __forceinline__ float bflo(unsigned u) { return __builtin_bit_cast(float, u << 16); }
__device__ __forceinline__ float bfhi(unsigned u) { return __builtin_bit_cast(float, u & 0xffff0000u); }
#define WAITV(n) asm volatile("s_waitcnt vmcnt(" #n ")" ::: "memory")
#define BAR_SYNC() do { asm volatile("s_waitcnt lgkmcnt(0)" ::: "memory"); __builtin_amdgcn_s_barrier(); asm volatile("" ::: "memory"); } while (0)
__device__ __forceinline__ void dma16(const void* g, LAS void* l) { __builtin_amdgcn_global_load_lds((const unsigned*)g, (LAS unsigned*)l, 16, 0, 0); }
__device__ __forceinline__ void glds16(const void* gsrc, unsigned lds_dst) { unsigned keep;
    asm volatile("s_mov_b32 %0, m0\n\ts_mov_b32 m0, %2\n\ts_nop 0\n\tglobal_load_lds_dwordx4 %1, off\n\ts_mov_b32 m0, %0" : "=&s"(keep) : "v"(gsrc), "s"(lds_dst) : "memory"); }
__device__ __forceinline__ s16x4 vtr(LAS const char* p) { return __builtin_bit_cast(s16x4, __builtin_amdgcn_ds_read_tr16_b64_v4i16((LAS v4i16_t*)p)); }
__device__ __forceinline__ int lane_now() { unsigned z = 0u; asm volatile("" : "+v"(z)); return (int)__builtin_amdgcn_mbcnt_hi(~0u, __builtin_amdgcn_mbcnt_lo(~0u, z)); }
template <int M> __device__ __forceinline__ float shxc(float v) { return __builtin_bit_cast(float, __builtin_amdgcn_ds_bpermute((lane_now() ^ M) << 2, __builtin_bit_cast(int, v))); }
__device__ __forceinline__ float add32(float v) { return v + shxc<32>(v); }
__device__ __forceinline__ float max32(float v) { return fmaxf(v, shxc<32>(v)); }
__device__ __forceinline__ float partner32(float v, bool upper) { return shxc<32>(v); }
template <int CTRL, int ROWMASK, bool BC> __device__ __forceinline__ float dppf(float old, float src) {
    return __builtin_bit_cast(float, __builtin_amdgcn_update_dpp(__builtin_bit_cast(int, old), __builtin_bit_cast(int, src), CTRL, ROWMASK, 0xf, BC)); }
__device__ __forceinline__ float wave_sum(float v) {
    v += dppf<0x111, 0xf, true>(0.f, v); v += dppf<0x112, 0xf, true>(0.f, v); v += dppf<0x114, 0xf, true>(0.f, v); v += dppf<0x118, 0xf, true>(0.f, v);
    v += dppf<0x142, 0xa, false>(0.f, v); v += dppf<0x143, 0xc, false>(0.f, v);
    return __builtin_bit_cast(float, __builtin_amdgcn_readlane(__builtin_bit_cast(int, v), 63)); }
__device__ __forceinline__ float wave_max(float v) {
    v = fmaxf(v, dppf<0x111, 0xf, false>(v, v)); v = fmaxf(v, dppf<0x112, 0xf, false>(v, v)); v = fmaxf(v, dppf<0x114, 0xf, false>(v, v)); v = fmaxf(v, dppf<0x118, 0xf, false>(v, v));
    v = fmaxf(v, dppf<0x142, 0xa, false>(v, v)); v = fmaxf(v, dppf<0x143, 0xc, false>(v, v));
    return __builtin_bit_cast(float, __builtin_amdgcn_readlane(__builtin_bit_cast(int, v), 63)); }
__device__ __forceinline__ bf16x8 pack8(float a0, float a1, float a2, float a3, float a4, float a5, float a6, float a7) {
    u32x4 w = {pk2(a0, a1), pk2(a2, a3), pk2(a4, a5), pk2(a6, a7)}; return __builtin_bit_cast(bf16x8, w); }
#define MFMA(a, b, c) __builtin_amdgcn_mfma_f32_32x32x16_bf16((a), (b), (c), 0, 0, 0)

#define XB_TMO      128
#define XB_XCNT(j)  (256  + 64 * (j))
#define XB_XSUB(j)  (1280 + 64 * (j))
#define XB_XGEN(j)  (2304 + 64 * (j))
#define XB_TOP      3328
#define XB_TOPGEN   3392
#define XCD_BAR_WORDS 3456
#define XB_SPIN_CAP (1u << 22)
__device__ __forceinline__ unsigned xb_ld(unsigned* p)              { return __hip_atomic_load(p, __ATOMIC_RELAXED, __HIP_MEMORY_SCOPE_AGENT); }
__device__ __forceinline__ unsigned xb_add(unsigned* p, unsigned v) { return __hip_atomic_fetch_add(p, v, __ATOMIC_RELAXED, __HIP_MEMORY_SCOPE_AGENT); }
__device__ __forceinline__ unsigned xb_xcc_id() { return (unsigned)__builtin_amdgcn_s_getreg((3 << 11) | 20) & 0xFu; }
#define XB_SPIN(cond, bar) do { unsigned _sp = 0; while (cond) { __builtin_amdgcn_s_sleep(1); \
    if ((++_sp & 255u) == 0u) { if (xb_ld(&(bar)[XB_TMO])) break; if (_sp > XB_SPIN_CAP) { atomicAdd(&(bar)[XB_TMO], 1u); break; } } } } while (0)
struct XcdBarrier { unsigned* bar; unsigned x; volatile LAS unsigned* st; int wid; };
__device__ __forceinline__ bool xb_leader(int wid) { unsigned z = 0u; asm volatile("" : "+v"(z)); return wid == 0 && __builtin_amdgcn_mbcnt_hi(~0u, __builtin_amdgcn_mbcnt_lo(~0u, z)) == 0u; }
__device__ __forceinline__ XcdBarrier xcd_barrier_post(unsigned* bar, volatile LAS unsigned* st, int wid) {
    XcdBarrier b; b.bar = bar; b.x = xb_xcc_id(); b.st = st; b.wid = wid;
    if (xb_leader(wid)) (void)xb_add(&bar[XB_XCNT(b.x)], 1u);
    return b;
}
__device__ __forceinline__ void xcd_barrier_complete(unsigned* bar, unsigned x, unsigned& nloc, unsigned& nx) {
    const unsigned G = gridDim.x * gridDim.y * gridDim.z;
    unsigned sum, cnt, mine, sp = 0u;
    for (;;) {
        sum = 0u; cnt = 0u; mine = 0u;
#pragma unroll
        for (unsigned j = 0; j < 16; ++j) { const unsigned c = xb_ld(&bar[XB_XCNT(j)]); sum += c; cnt += (c > 0u) ? 1u : 0u; }
        mine = xb_ld(&bar[XB_XCNT(x)]);
        if (sum == G) break;
        __builtin_amdgcn_s_sleep(1);
        if ((++sp & 255u) == 0u) { if (xb_ld(&bar[XB_TMO])) break; if (sp > XB_SPIN_CAP) { atomicAdd(&bar[XB_TMO], 1u); break; } }
    }
    nloc = mine > 0u ? mine : 1u; nx = cnt > 0u ? cnt : 1u;
}
__device__ __forceinline__ void xcd_barrier(const XcdBarrier& b) {
    asm volatile("s_waitcnt vmcnt(0)" ::: "memory");
    __syncthreads();
    if (xb_leader(b.wid)) {
        unsigned* bar = b.bar;
        __builtin_amdgcn_s_waitcnt(0);
        unsigned nloc = b.st[0], nx = b.st[1];
        if (nloc == 0u) { xcd_barrier_complete(bar, b.x, nloc, nx); b.st[0] = nloc; b.st[1] = nx; }
        const unsigned old = xb_add(&bar[XB_XSUB(b.x)], 1u);
        const unsigned gen = old / nloc;
        if (old + 1u == (gen + 1u) * nloc) {
            __builtin_amdgcn_fence(__ATOMIC_RELEASE, "agent");
            asm volatile("s_waitcnt vmcnt(0)" ::: "memory");
            const unsigned og = xb_add(&bar[XB_TOP], 1u);
            const unsigned tg = og / nx;
            if (og + 1u == (tg + 1u) * nx) xb_add(&bar[XB_TOPGEN], 1u);
            else XB_SPIN(xb_ld(&bar[XB_TOPGEN]) == tg, bar);
            __builtin_amdgcn_fence(__ATOMIC_ACQUIRE, "agent");
            xb_add(&bar[XB_XGEN(b.x)], 1u);
            asm volatile("s_waitcnt vmcnt(0)" ::: "memory");
        } else {
            XB_SPIN(xb_ld(&bar[XB_XGEN(b.x)]) == gen, bar);
            __builtin_amdgcn_fence(__ATOMIC_ACQUIRE, "agent");
            asm volatile("s_waitcnt vmcnt(0)" ::: "memory");
        }
    }
    __syncthreads();
}

struct Frame {
    const __attribute__((address_space(4))) Params* pp; unsigned char* wsb; LAS char* lds; int tid, lane, wid, G, bid;
    unsigned* ctl;
    __device__ __forceinline__ const float* in(int i) const { return pp->in[i]; }
    __device__ __forceinline__ float* outp() const { return pp->out; }
    template <class T> __device__ __forceinline__ T* ws(size_t off) const { return (T*)(wsb + off); }
};

template <class RowMap>
__device__ __forceinline__ void transpose_tile(const Frame& F, const float* __restrict__ src, int ldn, int k0, int n0, bf16_t* dst, int ldk, int kdst0, const RowMap& rm) {
    LAS float* tile = (LAS float*)F.lds;
    const int t = F.tid;
    f32x4 v[8];
#pragma unroll
    for (int i = 0; i < 8; ++i) { const int idx = t + 512 * i, k = idx >> 6, c4 = idx & 63; v[i] = *(const f32x4*)(src + (size_t)(k0 + k) * ldn + n0 + 4 * c4); }
#pragma unroll
    for (int i = 0; i < 8; ++i) { const int idx = t + 512 * i, k = idx >> 6, c4 = idx & 63; *(LAS f32x4*)(tile + k * 260 + 4 * c4) = v[i]; }
    __syncthreads();
    { const int n = t >> 1, kh = t & 1; bf16_t* d = dst + (size_t)rm(n0 + n) * ldk + kdst0 + 32 * kh;
#pragma unroll
      for (int q = 0; q < 4; ++q) { float a[8];
#pragma unroll
          for (int j = 0; j < 8; ++j) a[j] = tile[(32 * kh + 8 * q + j) * 260 + n];
          u32x4 w = {pk2(a[0], a[1]), pk2(a[2], a[3]), pk2(a[4], a[5]), pk2(a[6], a[7])}; *(u32x4*)(d + 8 * q) = w; } }
    __syncthreads();
}
struct RowId { __device__ __forceinline__ int operator()(int n) const { return n; } };
struct RowGU { __device__ __forceinline__ int operator()(int n) const { const int ri = n >> 10, j = n & 1023; return 64 * (j >> 5) + 32 * ri + (j & 31); } };

constexpr int P0_GEMV = 192, P0_FOLD = 128, P0_TAB = 16;
constexpr int P0_TWIN = 2 * 16 * 8, P0_TWOUT = 2 * 12 * 4, P0_TWGU = 2 * 32 * 16 * 8, P0_TWDN = 2 * 32 * 16 * 4;
constexpr int P0_ITEMS = P0_GEMV + P0_FOLD + P0_TAB + P0_TWIN + P0_TWOUT + P0_TWGU + P0_TWDN;

__device__ __forceinline__ void p0_gemv(const Frame& F, int item) {
    const int l = item / 96, cc = item % 96, t = F.tid, lane = F.lane, w = F.wid;
    LAS float* sc = (LAS float*)F.lds;
    LAS float* red = sc + 2048;
    const float* c = F.in(I_C); const float* cx = F.in(I_CCTX);
#pragma unroll
    for (int i = 0; i < 2; ++i) { const int k = t + 512 * i; const float a = c[k], b = cx[k]; sc[k] = a / (1.f + __expf(-a)); sc[1024 + k] = b / (1.f + __expf(-b)); }
    __syncthreads();
    const int col = 64 * cc + lane; const float* wm = F.in(I_WMOD) + (size_t)l * 1024 * 6144 + col;
    float a1 = 0.f, a2 = 0.f;
#pragma unroll 8
    for (int k = 128 * w; k < 128 * w + 128; ++k) { const float wv = wm[(size_t)k * 6144]; a1 += sc[k] * wv; a2 += sc[1024 + k] * wv; }
    red[w * 64 + lane] = a1; red[512 + w * 64 + lane] = a2;
    __syncthreads();
    if (w == 0) { float s1 = 0.f, s2 = 0.f;
#pragma unroll
        for (int j = 0; j < 8; ++j) { s1 += red[j * 64 + lane]; s2 += red[512 + j * 64 + lane]; }
        const float b = F.in(I_BMOD)[l * 6144 + col]; float* mod = F.ws<float>(WS_MOD) + (size_t)l * 2 * 6144;
        mod[col] = s1 + b; mod[6144 + col] = s2 + b; }
    __syncthreads();
}
__device__ __forceinline__ void p0_fold(const Frame& F, int item) {
    const int nch = item & 7, g = (item >> 3) & 3, ri = (item >> 5) & 1, l = item >> 6, t = F.tid;
    LAS float* Mx = (LAS float*)F.lds;
    LAS float* wf = Mx + 64 * 65;
    const float* wfn = F.in(I_WFNET) + (size_t)(l * 4 + g) * 4096;
    for (int i = t; i < 4096; i += 512) wf[(i >> 6) * 65 + (i & 63)] = wfn[i];
    __syncthreads();
    for (int i = t; i < 4096; i += 512) { const int c = i >> 6, e = i & 63; float s = 0.f;
        for (int m = 0; m < 64; ++m) { float sn, cs; sincospif(2.f * (float)((m * c) & 63) / 64.f, &sn, &cs); s += (ri ? sn : cs) * wf[m * 65 + e]; }
        Mx[c * 65 + e] = s; }
    __syncthreads();
    const float* wo = F.in(I_WOUT) + (size_t)l * 1024 * 1024 + (size_t)(64 * g) * 1024;
    bf16_t* dst = F.ws<bf16_t>(WS_WOUT) + (size_t)l * DM * MIXK;
    { const int n = nch * 128 + (t & 127), c0 = (t >> 7) * 16; float acc[16];
#pragma unroll
      for (int j = 0; j < 16; ++j) acc[j] = 0.f;
      for (int e = 0; e < 64; ++e) { const float wv = wo[(size_t)e * 1024 + n];
#pragma unroll
          for (int j = 0; j < 16; ++j) acc[j] += Mx[(c0 + j) * 65 + e] * wv; }
      u32x4 w0 = {pk2(acc[0], acc[1]), pk2(acc[2], acc[3]), pk2(acc[4], acc[5]), pk2(acc[6], acc[7])};
      u32x4 w1 = {pk2(acc[8], acc[9]), pk2(acc[10], acc[11]), pk2(acc[12], acc[13]), pk2(acc[14], acc[15])};
      bf16_t* d = dst + (size_t)n * MIXK + 256 * ri + 64 * g + c0; *(u32x4*)d = w0; *(u32x4*)(d + 8) = w1; }
    __syncthreads();
}
__device__ __forceinline__ void p0_tables(const Frame& F, int item) {
    constexpr int N0 = ROPE_N, N1 = N0 + 16384, N2 = N1 + 32768, N3 = N2 + 65536, N4 = N3 + 131072;
    float* rope = F.ws<float>(WS_ROPE); f32x2* tw = F.ws<f32x2>(WS_TW);
    bf16_t* a1 = F.ws<bf16_t>(WS_A1F); bf16_t* a2 = F.ws<bf16_t>(WS_A2F); bf16_t* ac = F.ws<bf16_t>(WS_ACF);
    for (int idx = item * 512 + F.tid; idx < N4; idx += P0_TAB * 512) {
        if (idx < N0) {
            int i = idx; bool isg = false; if (i >= RG_RC) { isg = true; i -= RG_RC; }
            const int n = isg ? 16 : 8, rowsz = 256 * n, colsz = 64 * n;
            int which, pos, fi;
            if (i < rowsz) { which = 0; pos = i / n; fi = i % n; } else if (i < 2 * rowsz) { which = 1; i -= rowsz; pos = i / n; fi = i % n; }
            else if (i < 2 * rowsz + colsz) { which = 2; i -= 2 * rowsz; pos = i / n; fi = i % n; } else { which = 3; i -= 2 * rowsz + colsz; pos = i / n; fi = i % n; }
            const float inv = powf(10000.f, -(float)fi / (float)n); const float ang = (float)pos * inv;
            rope[idx] = (which & 1) ? sinf(ang) : cosf(ang);
        } else if (idx < N1) { const int j = idx - N0; float sn, cs; sincospif(2.f * (float)j / 16384.f, &sn, &cs); tw[j] = (f32x2){cs, sn};
        } else if (idx < N2) { const int e = idx - N1; const int j = e & 7, ln = (e >> 3) & 63, s = (e >> 9) & 7, fb = (e >> 12) & 1, rg = e >> 13;
            const int k1 = 32 * rg + (ln & 31), l1 = 16 * s + 8 * (ln >> 5) + j; float sn, cs; sincospif(2.f * (float)((k1 * l1) & 127) / 128.f, &sn, &cs);
            a1[e] = (bf16_t)(pk2(fb ? -sn : cs, 0.f) & 0xffff);
        } else if (idx < N3) { const int e = idx - N2; const int j = e & 7, ln = (e >> 3) & 63, s = (e >> 9) & 15, fb = (e >> 13) & 1, rg = e >> 14;
            const int k2 = 32 * rg + (ln & 31), kk = 16 * s + 8 * (ln >> 5) + j, l2 = kk >> 1, rip = kk & 1; float sn, cs; sincospif(2.f * (float)((k2 * l2) & 127) / 128.f, &sn, &cs);
            const float v = fb == 0 ? (rip == 0 ? cs : sn) : (rip == 0 ? -sn : cs);
            a2[e] = (bf16_t)(pk2(v, 0.f) & 0xffff);
        } else { const int e = idx - N3; const int j = e & 7, ln = (e >> 3) & 63, s = (e >> 9) & 15, fb = (e >> 13) & 1, rg = (e >> 14) & 3, pa = e >> 16;
            const int k = 128 * pa + 32 * rg + (ln & 31), li = 16 * s + 8 * (ln >> 5) + j; float sn, cs; sincospif(2.f * (float)((k * li) & 255) / 256.f, &sn, &cs);
            ac[e] = (bf16_t)(pk2(fb ? -sn : cs, 0.f) & 0xffff); }
    }
}
__device__ __forceinline__ void phase_prologue(const Frame& F) {
    LAS unsigned* qw = (LAS unsigned*)(F.lds + LDS_CTL + 64);
    unsigned nxt = 0u; if (F.tid == 0) nxt = xb_add(F.ctl + CW_QH + 32, 1u);
    for (;;) {
        __syncthreads();
        if (F.tid == 0) *qw = nxt;
        __syncthreads();
        const int it = (int)*qw; if (it >= P0_ITEMS) break;
        if (F.tid == 0) nxt = xb_add(F.ctl + CW_QH + 32, 1u);
        int i = it;
        if (i < P0_GEMV) { p0_gemv(F, i); continue; } i -= P0_GEMV;
        if (i < P0_FOLD) { p0_fold(F, i); continue; } i -= P0_FOLD;
        if (i < P0_TAB) { p0_tables(F, i); continue; } i -= P0_TAB;
        if (i < P0_TWIN) { const int l = i / 128, r = i % 128, kt = r / 8, nt = r % 8;
            transpose_tile(F, F.in(I_WIN) + (size_t)l * DM * INW, INW, 64 * kt, 256 * nt, F.ws<bf16_t>(WS_WIN) + (size_t)l * INW * DM, DM, 64 * kt, RowId()); continue; } i -= P0_TWIN;
        if (i < P0_TWOUT) { const int l = i / 48, r = i % 48, kt = r / 4, nt = r % 4;
            transpose_tile(F, F.in(I_WOUT) + (size_t)l * DM * DM, DM, 256 + 64 * kt, 256 * nt, F.ws<bf16_t>(WS_WOUT) + (size_t)l * DM * MIXK, MIXK, 512 + 64 * kt, RowId()); continue; } i -= P0_TWOUT;
        if (i < P0_TWGU) { const int le = i / 128, r = i % 128, kt = r / 8, nt = r % 8;
            transpose_tile(F, F.in(I_WGU) + (size_t)le * DM * 2048, 2048, 64 * kt, 256 * nt, F.ws<bf16_t>(WS_WGU) + (size_t)le * 2048 * DM, DM, 64 * kt, RowGU()); continue; } i -= P0_TWGU;
        { const int le = i / 64, r = i % 64, kt = r / 4, nt = r % 4;
            transpose_tile(F, F.in(I_WDN) + (size_t)le * FFD * DM, DM, 64 * kt, 256 * nt, F.ws<bf16_t>(WS_WDN) + (size_t)le * DM * FFD, FFD, 64 * kt, RowId()); }
    }
}

__device__ __forceinline__ void load_row(const float* row, int lane, f32x4 (&x)[4]) {
#pragma unroll
    for (int q = 0; q < 4; ++q) x[q] = *(const f32x4*)(row + 256 * q + 4 * lane);
}
__device__ __forceinline__ float row_rstd(const f32x4 (&x)[4], float eps) {
    float ss = 0.f;
#pragma unroll
    for (int q = 0; q < 4; ++q) ss += x[q][0] * x[q][0] + x[q][1] * x[q][1] + x[q][2] * x[q][2] + x[q][3] * x[q][3];
    ss = wave_sum(ss); return rsqrtf(ss * (1.f / 1024.f) + eps);
}
__device__ __forceinline__ void mod_store_bf16(const f32x4 (&x)[4], float rstd, const float* __restrict__ g, const float* __restrict__ shift, const float* __restrict__ scale, bf16_t* __restrict__ dst, int lane, f32x4 (*hout)[4] = nullptr) {
    f32x4 gv[4], sh[4], sc[4];
#pragma unroll
    for (int q = 0; q < 4; ++q) { const int k = 256 * q + 4 * lane; gv[q] = *(const f32x4*)(g + k); sh[q] = *(const f32x4*)(shift + k); sc[q] = *(const f32x4*)(scale + k); }
    __builtin_amdgcn_sched_barrier(0);
#pragma unroll
    for (int q = 0; q < 4; ++q) { const int k = 256 * q + 4 * lane;
        f32x4 hv;
#pragma unroll
        for (int i = 0; i < 4; ++i) hv[i] = (x[q][i] * rstd * gv[q][i]) * (1.f + sc[q][i]) + sh[q][i];
        u32x2 w = {pk2(hv[0], hv[1]), pk2(hv[2], hv[3])}; *(u32x2*)(dst + k) = w;
        if (hout) (*hout)[q] = hv; }
}
__device__ __forceinline__ void phase_norm0(const Frame& F) {
    const float* mod = F.ws<float>(WS_MOD); bf16_t* hb = F.ws<bf16_t>(WS_HB); const float* g1 = F.in(I_GN1);
    const float* xc = F.in(I_CTX); const float* xl = F.in(I_X);
    for (int R = F.bid * 8 + F.wid; R < NT; R += F.G * 8) {
        const float* row = R < NCTX ? xc + (size_t)R * DM : xl + (size_t)(R - NCTX) * DM;
        const float* m = mod + (R < NCTX ? 6144 : 0);
        f32x4 x[4]; load_row(row, F.lane, x); const float rstd = row_rstd(x, 1e-6f);
        mod_store_bf16(x, rstd, g1, m, m + 1024, hb + (size_t)R * DM, F.lane);
    }
}

#define MFMA16(a, b, c) __builtin_amdgcn_mfma_f32_16x16x32_bf16((a), (b), (c), 0, 0, 0)
__device__ __forceinline__ int lds_byte(int r, int c) { const int st = (r >> 4) * 2 + (c >> 5), rr = r & 15, cc = c & 31, ob = rr * 64 + cc * 2; return st * 1024 + (ob ^ (((ob >> 9) & 1) << 5)); }
__device__ __forceinline__ void stage_rc(int b, int& R, int& C) { const int st = b / 1024, sb = b % 1024, swz = sb ^ (((sb >> 9) & 1) << 5); R = (st >> 1) * 16 + swz / 64; C = (st & 1) * 32 + (swz % 64) / 2; }
struct EpiC { f32x4 c[4]; };
struct EpiT { f32x4 t[4]; };
template <class XRow, class Epi>
__device__ __forceinline__ void gemm8(const Frame& F, const bf16_t* __restrict__ A, int K, int brow, const XRow& xrow, const Epi& epi) {
    constexpr int HTB = 16384;
    LAS char* shm = F.lds;
    const int tz = F.tid, wid = F.wid, lane = tz & 63, wr = wid >> 2, wc = wid & 3, fr = lane & 15, fq = lane >> 4;
    unsigned aoff[2]; const bf16_t* xp[2][2];
#pragma unroll
    for (int i = 0; i < 2; ++i) { int r, c; stage_rc(tz * 16 + i * 8192, r, c); aoff[i] = (unsigned)(r * K + c); xp[0][i] = xrow(r) + c; xp[1][i] = xrow(128 + r) + c; }
    const bf16_t* Ab = A + (size_t)brow * K; const size_t hstepA = (size_t)128 * K;
    const int ldsw = wid * 1024;
    const int aoffl = lds_byte(wr * 64 + fr, fq * 8), boffl = lds_byte(wc * 32 + fr, fq * 8);
#define SA(b, h) (shm + ((b) * 2 + (h)) * HTB)
#define SB(b, h) (shm + (4 + (b) * 2 + (h)) * HTB)
#define STAGE_A(b, h, kt) do { _Pragma("unroll") for (int i_ = 0; i_ < 2; ++i_) dma16(Ab + (h) * hstepA + aoff[i_] + (size_t)(kt) * 64, SA(b, h) + ldsw + i_ * 8192); } while (0)
#define STAGE_B(b, h, kt) do { _Pragma("unroll") for (int i_ = 0; i_ < 2; ++i_) dma16(xp[h][i_] + (size_t)(kt) * 64, SB(b, h) + ldsw + i_ * 8192); } while (0)
#define LDA(dst, b, h) do { _Pragma("unroll") for (int m = 0; m < 4; ++m) _Pragma("unroll") for (int k = 0; k < 2; ++k) dst[m][k] = *(LAS const bf16x8*)(SA(b, h) + aoffl + m * 2048 + k * 1024); } while (0)
#define LDB(dst, b, h) do { _Pragma("unroll") for (int n = 0; n < 2; ++n) _Pragma("unroll") for (int k = 0; k < 2; ++k) dst[n][k] = *(LAS const bf16x8*)(SB(b, h) + boffl + n * 2048 + k * 1024); } while (0)
#define MMA(ai, bj, At_, Bt_) do { __builtin_amdgcn_s_setprio(1); _Pragma("unroll") for (int m = 0; m < 4; ++m) _Pragma("unroll") for (int n = 0; n < 2; ++n) _Pragma("unroll") for (int k = 0; k < 2; ++k) \
        acc[ai][bj][m][n] = MFMA16(At_[m][k], Bt_[n][k], acc[ai][bj][m][n]); __builtin_amdgcn_s_setprio(0); } while (0)
#define WAIT_V(n) asm volatile("s_waitcnt vmcnt(" #n ")" ::: "memory")
#define WAIT_L(n) asm volatile("s_waitcnt lgkmcnt(" #n ")" ::: "memory")
#define BAR __builtin_amdgcn_s_barrier()
#define SCHED __builtin_amdgcn_sched_barrier(0)
    f32x4 acc[2][2][4][2];
#pragma unroll
    for (int a = 0; a < 2; ++a)
#pragma unroll
        for (int b = 0; b < 2; ++b)
#pragma unroll
            for (int m = 0; m < 4; ++m)
#pragma unroll
                for (int n = 0; n < 2; ++n) acc[a][b][m][n] = (f32x4){0.f, 0.f, 0.f, 0.f};
    bf16x8 At[4][2], B0[2][2], B1[2][2];
    const int nt = K / 64;
    WAIT_L(0); BAR;
    STAGE_B(0, 0, 0); STAGE_B(0, 1, 0); STAGE_A(0, 0, 0); STAGE_A(0, 1, 0);
    if (wr == 1) BAR;
    WAIT_V(2); BAR;
    STAGE_B(1, 0, 1); STAGE_A(1, 0, 1); STAGE_B(1, 1, 1);
    WAIT_V(6); BAR;
#pragma unroll 1
    for (int t = 0; t < nt; t += 2) {
        const int k2 = (t == nt - 2) ? 0 : t + 2;
        LDB(B0, 0, 0); LDB(B1, 0, 1); SCHED; LDA(At, 0, 0); STAGE_A(1, 1, t + 1);
        WAIT_V(8); WAIT_L(0); BAR; MMA(0, 0, At, B0); MMA(0, 1, At, B1); BAR; SCHED;
        LDA(At, 0, 1); STAGE_B(0, 0, k2); STAGE_B(0, 1, k2); STAGE_A(0, 0, k2);
        WAIT_V(8); WAIT_L(0); BAR; MMA(1, 0, At, B0); MMA(1, 1, At, B1); BAR; SCHED;
        LDB(B0, 1, 0); LDB(B1, 1, 1); SCHED; LDA(At, 1, 0); STAGE_A(0, 1, k2);
        WAIT_V(8); WAIT_L(0); BAR; MMA(0, 0, At, B0); MMA(0, 1, At, B1); BAR; SCHED;
        LDA(At, 1, 1); STAGE_B(1, 0, k2 + 1); STAGE_B(1, 1, k2 + 1); STAGE_A(1, 0, k2 + 1);
        WAIT_V(8); WAIT_L(0); BAR; MMA(1, 0, At, B0); MMA(1, 1, At, B1); BAR; SCHED;
    }
    WAIT_V(0);
    if (wr == 0) BAR;
    BAR;
#undef SA
#undef SB
#undef STAGE_A
#undef STAGE_B
#undef LDA
#undef LDB
#undef MMA
#undef WAIT_V
#undef WAIT_L
#undef BAR
#undef SCHED
    int tq = F.tid; asm volatile("" : "+v"(tq)); const int fr2 = tq & 15, fq2 = (tq >> 4) & 3;
#pragma unroll
    for (int ai = 0; ai < 2; ++ai) { const int cg = (brow >> 6) + 2 * ai + wr;
        const EpiC C = epi.load_c(cg, fq2);
        EpiT T = epi.load_t(cg, wc * 32 + fr2, fq2);
#pragma unroll
        for (int c = 0; c < 4; ++c) { const int bj = c >> 1, n = c & 1; const int tok = bj * 128 + wc * 32 + n * 16 + fr2;
            EpiT Tn = T; if (c < 3) Tn = epi.load_t(cg, ((c + 1) >> 1) * 128 + wc * 32 + ((c + 1) & 1) * 16 + fr2, fq2);
            f32x4 v[4] = {acc[ai][bj][0][n], acc[ai][bj][1][n], acc[ai][bj][2][n], acc[ai][bj][3][n]};
            epi.apply(v, cg, tok, fq2, C, T); T = Tn; } }
}

__device__ __forceinline__ u32x2 pk4(const f32x4& v) { return (u32x2){pk2(v[0], v[1]), pk2(v[2], v[3])}; }
struct EpiInProj {
    const Frame& F; int l, t0;
    __device__ __forceinline__ EpiC load_c(int cg, int fq) const { EpiC C;
#pragma unroll
        for (int m = 0; m < 4; ++m) C.c[m] = (f32x4){0.f, 0.f, 0.f, 0.f};
        if (cg >= 22 && cg < 30) { const float* gw = (cg < 28 ? F.in(I_GQ) : F.in(I_GK)) + 64 * l;
#pragma unroll
            for (int m = 0; m < 4; ++m) C.c[m] = *(const f32x4*)(gw + 16 * m + 4 * fq); }
        return C; }
    __device__ __forceinline__ EpiT load_t(int cg, int tok, int fq) const { EpiT T;
#pragma unroll
        for (int m = 0; m < 4; ++m) T.t[m] = (f32x4){0.f, 0.f, 0.f, 0.f};
        const int R = t0 + tok; const int t = R - NCTX; const int prow = (t >> 6) & 255, pcol = t & 63; const float* const rope = F.ws<float>(WS_ROPE);
        if (R >= NCTX) {
            if (cg >= 4 && cg < 16) { const int ti = fq < 2 ? RD_RC + prow * 8 + 4 * fq : RD_CC + pcol * 8 + 4 * (fq - 2), si = fq < 2 ? RD_RS + prow * 8 + 4 * fq : RD_CS + pcol * 8 + 4 * (fq - 2);
                T.t[0] = *(const f32x4*)(rope + ti); T.t[1] = *(const f32x4*)(rope + si); }
            else if (cg >= 22 && cg < 30) { T.t[0] = *(const f32x4*)(rope + RG_RC + prow * 16 + 4 * fq); T.t[1] = *(const f32x4*)(rope + RG_RS + prow * 16 + 4 * fq);
                T.t[2] = *(const f32x4*)(rope + RG_CC + pcol * 16 + 4 * fq); T.t[3] = *(const f32x4*)(rope + RG_CS + pcol * 16 + 4 * fq); } }
        return T; }
    __device__ __forceinline__ void apply(f32x4 (&v)[4], int cg, int tok, int fq, const EpiC& C, const EpiT& T) const {
        bf16_t* const ft = F.ws<bf16_t>(WS_FT); bf16_t* const fc = F.ws<bf16_t>(WS_FC); bf16_t* const qd = F.ws<bf16_t>(WS_QD); bf16_t* const kd = F.ws<bf16_t>(WS_KD); bf16_t* const vd = F.ws<bf16_t>(WS_VD);
        bf16_t* const qg = F.ws<bf16_t>(WS_QG); bf16_t* const kg = F.ws<bf16_t>(WS_KG); bf16_t* const vg = F.ws<bf16_t>(WS_VG);
        unsigned* const kmax = F.ctl + CW_KMAX + 16 * l;
        const float QSD = 0.17677669529663687f * LOG2E, QSG = 0.125f * LOG2E;
        const int R = t0 + tok; const bool isctx = R < NCTX; const int t = R - NCTX;
        if (cg < 4) {
#pragma unroll
            for (int m = 0; m < 4; ++m) { const int ch = 64 * cg + 16 * m + 4 * fq; const u32x2 w = pk4(v[m]);
                if (isctx) { const size_t a = (size_t)(((ch >> 7) * 4 + ((ch >> 5) & 3)) * 8192 + (R >> 3) * 256 + (R & 7) * 32 + (ch & 31)); *(u32x2*)(fc + a) = w; }
                else { const int l1 = t >> 7, l2 = t & 127; const size_t a = (size_t)((l2 * 2 + (ch >> 7)) * 4 + ((ch >> 5) & 3)) * 4096 + (l1 >> 3) * 256 + (l1 & 7) * 32 + (ch & 31); *(u32x2*)(ft + a) = w; } }
        } else if (cg < 16) {
            const bool isq = cg < 10; const int head = isq ? cg - 4 : cg - 10;
            if (!isctx) { const f32x4 cc = T.t[0], sn = T.t[1];
#pragma unroll
                for (int mp = 0; mp < 2; ++mp)
#pragma unroll
                    for (int j = 0; j < 4; ++j) { const float a = v[2 * mp][j], b = v[2 * mp + 1][j]; v[2 * mp][j] = a * cc[j] - b * sn[j]; v[2 * mp + 1][j] = b * cc[j] + a * sn[j]; } }
            if (isq) {
#pragma unroll
                for (int m = 0; m < 4; ++m) { const f32x4 s = v[m] * QSD;
                    const size_t a = ((((size_t)(head * NQB + (R >> 5)) * 2 + (m >> 1)) * 4 + 2 * (m & 1) + (fq >> 1)) * 32 + (R & 31)) * 8 + 4 * (fq & 1); *(u32x2*)(qd + a) = pk4(s); }
            } else {
                float ss0 = 0.f, ss1 = 0.f;
#pragma unroll
                for (int j = 0; j < 4; ++j) { ss0 += v[0][j] * v[0][j] + v[1][j] * v[1][j]; ss1 += v[2][j] * v[2][j] + v[3][j] * v[3][j]; }
                ss0 += shxc<16>(ss0); ss1 += shxc<16>(ss1); ss0 = add32(ss0); ss1 = add32(ss1);
                ss0 = fmaxf(ss0, shxc<8>(ss0)); ss1 = fmaxf(ss1, shxc<8>(ss1)); ss0 = fmaxf(ss0, shxc<4>(ss0)); ss1 = fmaxf(ss1, shxc<4>(ss1));
                ss0 = fmaxf(ss0, shxc<2>(ss0)); ss1 = fmaxf(ss1, shxc<2>(ss1)); ss0 = fmaxf(ss0, shxc<1>(ss0)); ss1 = fmaxf(ss1, shxc<1>(ss1));
                if ((tok & 15) == 0 && fq == 0) { float* kp = F.ws<float>(WS_KP) + ((size_t)(l * 12 + 2 * head) * 64 + ((t0 >> 8) - 1)) * 16 + (tok >> 4); kp[0] = ss0; kp[1024] = ss1; }
#pragma unroll
                for (int m = 0; m < 4; ++m) {
                    const size_t a = ((((size_t)(head * NKT + (R >> 6)) * 2 + (m >> 1)) * 4 + 2 * (m & 1) + (fq >> 1)) * 64 + (R & 63)) * 8 + 4 * (fq & 1); *(u32x2*)(kd + a) = pk4(v[m]); }
            }
        } else if (cg < 22 || cg >= 30) {
            const bool isd = cg < 22; const int head = isd ? cg - 16 : cg - 30; bf16_t* vb = isd ? vd : vg;
#pragma unroll
            for (int m = 0; m < 4; ++m) {
                const size_t a = ((size_t)(head * NKT + (R >> 6)) * 2 + (m >> 1)) * 2048 + ((R & 63) >> 3) * 256 + (R & 7) * 32 + 16 * (m & 1) + 4 * fq; *(u32x2*)(vb + a) = pk4(v[m]); }
        } else {
            const bool isq = cg < 28; const int head = isq ? cg - 22 : cg - 28;
            float ss = 0.f;
#pragma unroll
            for (int m = 0; m < 4; ++m)
#pragma unroll
                for (int j = 0; j < 4; ++j) ss += v[m][j] * v[m][j];
            ss += shxc<16>(ss); ss = add32(ss); const float rs = rsqrtf(ss * (1.f / 64.f) + 1e-6f);
#pragma unroll
            for (int m = 0; m < 4; ++m) v[m] = v[m] * C.c[m] * rs;
            if (!isctx) { const f32x4 cr = T.t[0], sr = T.t[1], cc = T.t[2], sc = T.t[3];
#pragma unroll
                for (int j = 0; j < 4; ++j) { { const float a = v[0][j], b = v[2][j]; v[0][j] = a * cr[j] - b * sr[j]; v[2][j] = b * cr[j] + a * sr[j]; }
                    { const float a = v[1][j], b = v[3][j]; v[1][j] = a * cc[j] - b * sc[j]; v[3][j] = b * cc[j] + a * sc[j]; } } }
#pragma unroll
            for (int m = 0; m < 4; ++m) { const f32x4 s = isq ? v[m] * QSG : v[m]; const int c = 2 * m + (fq >> 1);
                if (isq) { const size_t a = (((size_t)(head * NQB + (R >> 5)) * 8 + c) * 32 + (R & 31)) * 8 + 4 * (fq & 1); *(u32x2*)(qg + a) = pk4(s); }
                else { const size_t a = (((size_t)(head * NKT + (R >> 6)) * 8 + c) * 64 + (R & 63)) * 8 + 4 * (fq & 1); *(u32x2*)(kg + a) = pk4(s); } }
        }
    }
};
struct EpiOutProj {
    const Frame& F; int l, t0;
    __device__ __forceinline__ const float* src_row(int R) const { return l == 0 ? (R < NCTX ? F.in(I_CTX) + (size_t)R * DM : F.in(I_X) + (size_t)(R - NCTX) * DM) : F.ws<float>(WS_XS) + (size_t)R * DM; }
    __device__ __forceinline__ EpiC load_c(int cg, int fq) const { EpiC C; const float* gt = F.ws<float>(WS_MOD) + (size_t)l * 2 * 6144 + (t0 < NCTX ? 6144 : 0) + 2048;
#pragma unroll
        for (int m = 0; m < 4; ++m) C.c[m] = *(const f32x4*)(gt + 64 * cg + 16 * m + 4 * fq);
        return C; }
    __device__ __forceinline__ EpiT load_t(int cg, int tok, int fq) const { EpiT T; const float* src = src_row(t0 + tok);
#pragma unroll
        for (int m = 0; m < 4; ++m) T.t[m] = *(const f32x4*)(src + 64 * cg + 16 * m + 4 * fq);
        return T; }
    __device__ __forceinline__ void apply(f32x4 (&v)[4], int cg, int tok, int fq, const EpiC& C, const EpiT& T) const {
        float* xs = F.ws<float>(WS_XS) + (size_t)(t0 + tok) * DM;
#pragma unroll
        for (int m = 0; m < 4; ++m) *(f32x4*)(xs + 64 * cg + 16 * m + 4 * fq) = T.t[m] + C.c[m] * v[m];
    }
};
struct EpiGateUp {
    const Frame& F; int le, m0, cnt, offs;
    __device__ __forceinline__ EpiC load_c(int cg, int fq) const { EpiC C; const float* bias = F.in(I_BGU) + (size_t)le * 2048 + 32 * cg + 4 * fq;
        C.c[0] = *(const f32x4*)(bias); C.c[1] = *(const f32x4*)(bias + 16); C.c[2] = *(const f32x4*)(bias + 1024); C.c[3] = *(const f32x4*)(bias + 1024 + 16); return C; }
    __device__ __forceinline__ EpiT load_t(int, int, int) const { EpiT T;
#pragma unroll
        for (int m = 0; m < 4; ++m) T.t[m] = (f32x4){0.f, 0.f, 0.f, 0.f};
        return T; }
    __device__ __forceinline__ void apply(f32x4 (&v)[4], int cg, int tok, int fq, const EpiC& C, const EpiT&) const {
        const int mt = m0 + tok; if (mt >= cnt) return;
        bf16_t* dst = F.ws<bf16_t>(WS_ACT) + (size_t)(offs + mt) * FFD;
#pragma unroll
        for (int m = 0; m < 2; ++m) { const int jj = 32 * cg + 16 * m + 4 * fq; f32x4 o;
#pragma unroll
            for (int j = 0; j < 4; ++j) { float gl = v[m][j] + C.c[m][j], li = v[m + 2][j] + C.c[2 + m][j]; gl = fminf(gl, 7.f); li = fminf(fmaxf(li, -7.f), 7.f);
                o[j] = gl * (1.f / (1.f + __expf(-1.702f * gl))) * (li + 1.f); }
            *(u32x2*)(dst + jj) = pk4(o); }
    }
};
struct EpiDown {
    const Frame& F; int le, m0, cnt, offs;
    __device__ __forceinline__ EpiC load_c(int cg, int fq) const { EpiC C; const float* bias = F.in(I_BDN) + (size_t)le * DM + 64 * cg + 4 * fq;
#pragma unroll
        for (int m = 0; m < 4; ++m) C.c[m] = *(const f32x4*)(bias + 16 * m);
        return C; }
    __device__ __forceinline__ EpiT load_t(int, int, int) const { EpiT T;
#pragma unroll
        for (int m = 0; m < 4; ++m) T.t[m] = (f32x4){0.f, 0.f, 0.f, 0.f};
        return T; }
    __device__ __forceinline__ void apply(f32x4 (&v)[4], int cg, int tok, int fq, const EpiC& C, const EpiT&) const {
        const int mt = m0 + tok; if (mt >= cnt) return;
        bf16_t* dst = F.ws<bf16_t>(WS_YB) + (size_t)(offs + mt) * DM;
#pragma unroll
        for (int m = 0; m < 4; ++m) *(u32x2*)(dst + 64 * cg + 16 * m + 4 * fq) = pk4(v[m] + C.c[m]);
    }
};
struct XDense { const bf16_t* X; int ld; int t0; __device__ __forceinline__ const bf16_t* operator()(int row) const { return X + (size_t)(t0 + row) * ld; } };
struct XGather { const bf16_t* X; const unsigned* list; int m0, cnt; __device__ __forceinline__ const bf16_t* operator()(int row) const { int m = m0 + row; m = m < cnt ? m : cnt - 1; return X + (size_t)list[m] * DM; } };
struct XAct { const bf16_t* X; int base, m0, cnt; __device__ __forceinline__ const bf16_t* operator()(int row) const { int m = m0 + row; m = m < cnt ? m : cnt - 1; return X + (size_t)(base + m) * FFD; } };

template <class Epi>
__device__ __forceinline__ void mini_unit(const Frame& F, const bf16_t* W, int ldw, int f0, const bf16_t* X, int ldx, int t0, int K, const Epi& epi) {
    const int lane = F.lane, wid = F.wid, r = lane & 31, h = lane >> 5; const int kw = K >> 3;
    const bf16_t* wp = W + (size_t)(f0 + r) * ldw + wid * kw + 8 * h; const bf16_t* xp = X + (size_t)(t0 + r) * ldx + wid * kw + 8 * h;
    f32x16 acc0, acc1;
#pragma unroll
    for (int i = 0; i < 16; ++i) { acc0[i] = 0.f; acc1[i] = 0.f; }
#pragma unroll 2
    for (int s = 0; s < (kw >> 4); ++s) { const bf16x8 w0 = *(const bf16x8*)(wp + 16 * s), w1 = *(const bf16x8*)(wp + (size_t)32 * ldw + 16 * s), xv = *(const bf16x8*)(xp + 16 * s);
        acc0 = MFMA(w0, xv, acc0); acc1 = MFMA(w1, xv, acc1); }
    BAR_SYNC();
    LAS float* red = (LAS float*)F.lds;
#pragma unroll
    for (int i = 0; i < 16; ++i) { red[(wid * 32 + i) * 64 + lane] = acc0[i]; red[(wid * 32 + 16 + i) * 64 + lane] = acc1[i]; }
    __syncthreads();
    LAS float* out = red + 8 * 32 * 64;
#pragma unroll
    for (int j = 0; j < 4; ++j) { const int rg = 4 * wid + j; float s = 0.f;
#pragma unroll
        for (int w = 0; w < 8; ++w) s += red[(w * 32 + rg) * 64 + lane];
        out[rg * 64 + lane] = s; }
    __syncthreads();
    if (wid == 0) {
#pragma unroll
        for (int i = 0; i < 16; ++i) { acc0[i] = out[i * 64 + lane]; acc1[i] = out[(16 + i) * 64 + lane]; }
        epi(acc0, acc1, f0 >> 6, t0 + r, h);
    }
}
struct EpiInProjCtx {
    const Frame& F; int l;
    __device__ __forceinline__ void operator()(f32x16& v0, f32x16& v1, int cg, int R, int h) const {
        const float QSD = 0.17677669529663687f * LOG2E, QSG = 0.125f * LOG2E;
        if (cg < 4) { bf16_t* fc = F.ws<bf16_t>(WS_FC);
#pragma unroll
            for (int fb = 0; fb < 2; ++fb)
#pragma unroll
                for (int g = 0; g < 4; ++g) { const f32x16& v = fb ? v1 : v0; const int ch = 64 * cg + 32 * fb + 8 * g + 4 * h;
                    const size_t a = (size_t)(((ch >> 7) * 4 + ((ch >> 5) & 3)) * 8192 + (R >> 3) * 256 + (R & 7) * 32 + (ch & 31)); *(u32x2*)(fc + a) = (u32x2){pk2(v[4 * g], v[4 * g + 1]), pk2(v[4 * g + 2], v[4 * g + 3])}; }
        } else if (cg < 16) { const bool isq = cg < 10; const int head = isq ? cg - 4 : cg - 10;
            if (isq) { bf16_t* qd = F.ws<bf16_t>(WS_QD);
#pragma unroll
                for (int fb = 0; fb < 2; ++fb)
#pragma unroll
                    for (int g = 0; g < 4; ++g) { const f32x16& v = fb ? v1 : v0;
                        const size_t a = ((((size_t)(head * NQB + (R >> 5)) * 2 + fb) * 4 + g) * 32 + (R & 31)) * 8 + 4 * h;
                        *(u32x2*)(qd + a) = (u32x2){pk2(v[4 * g] * QSD, v[4 * g + 1] * QSD), pk2(v[4 * g + 2] * QSD, v[4 * g + 3] * QSD)}; }
            } else { bf16_t* kd = F.ws<bf16_t>(WS_KD); unsigned* kmax = F.ctl + CW_KMAX + 16 * l;
                float ss0 = 0.f, ss1 = 0.f;
#pragma unroll
                for (int i = 0; i < 16; ++i) { ss0 += v0[i] * v0[i]; ss1 += v1[i] * v1[i]; }
                ss0 = add32(ss0); ss1 = add32(ss1); ss0 = wave_max(ss0); ss1 = wave_max(ss1);
                if (F.lane == 0) { atomicMax(kmax + 2 * head, __float_as_uint(ss0)); atomicMax(kmax + 2 * head + 1, __float_as_uint(ss1)); }
#pragma unroll
                for (int fb = 0; fb < 2; ++fb)
#pragma unroll
                    for (int g = 0; g < 4; ++g) { const f32x16& v = fb ? v1 : v0;
                        const size_t a = ((((size_t)(head * NKT + (R >> 6)) * 2 + fb) * 4 + g) * 64 + (R & 63)) * 8 + 4 * h;
                        *(u32x2*)(kd + a) = (u32x2){pk2(v[4 * g], v[4 * g + 1]), pk2(v[4 * g + 2], v[4 * g + 3])}; } }
        } else if (cg < 22 || cg >= 30) { const bool isd = cg < 22; const int head = isd ? cg - 16 : cg - 30; bf16_t* vb = isd ? F.ws<bf16_t>(WS_VD) : F.ws<bf16_t>(WS_VG);
#pragma unroll
            for (int fb = 0; fb < 2; ++fb)
#pragma unroll
                for (int g = 0; g < 4; ++g) { const f32x16& v = fb ? v1 : v0;
                    const size_t a = ((size_t)(head * NKT + (R >> 6)) * 2 + fb) * 2048 + ((R & 63) >> 3) * 256 + (R & 7) * 32 + 8 * g + 4 * h;
                    *(u32x2*)(vb + a) = (u32x2){pk2(v[4 * g], v[4 * g + 1]), pk2(v[4 * g + 2], v[4 * g + 3])}; }
        } else { const bool isq = cg < 28; const int head = isq ? cg - 22 : cg - 28; const float* gw = (isq ? F.in(I_GQ) : F.in(I_GK)) + 64 * l;
            float ss = 0.f;
#pragma unroll
            for (int i = 0; i < 16; ++i) ss += v0[i] * v0[i] + v1[i] * v1[i];
            ss = add32(ss); const float rs = rsqrtf(ss * (1.f / 64.f) + 1e-6f) * (isq ? QSG : 1.f);
#pragma unroll
            for (int fb = 0; fb < 2; ++fb)
#pragma unroll
                for (int g = 0; g < 4; ++g) { const f32x16& v = fb ? v1 : v0; const f32x4 gv = *(const f32x4*)(gw + 32 * fb + 8 * g + 4 * h);
                    const u32x2 w = {pk2(v[4 * g] * rs * gv[0], v[4 * g + 1] * rs * gv[1]), pk2(v[4 * g + 2] * rs * gv[2], v[4 * g + 3] * rs * gv[3])};
                    if (isq) { const size_t a = (((size_t)(head * NQB + (R >> 5)) * 8 + 4 * fb + g) * 32 + (R & 31)) * 8 + 4 * h; *(u32x2*)(F.ws<bf16_t>(WS_QG) + a) = w; }
                    else { const size_t a = (((size_t)(head * NKT + (R >> 6)) * 8 + 4 * fb + g) * 64 + (R & 63)) * 8 + 4 * h; *(u32x2*)(F.ws<bf16_t>(WS_KG) + a) = w; } }
        }
    }
};
struct EpiOutProjCtx {
    const Frame& F;
    __device__ __forceinline__ void operator()(f32x16& v0, f32x16& v1, int cg, int R, int h) const {
        const float* src = F.in(I_CTX) + (size_t)R * DM; const float* gt = F.ws<float>(WS_MOD) + 6144 + 2048; float* xs = F.ws<float>(WS_XS) + (size_t)R * DM;
#pragma unroll
        for (int fb = 0; fb < 2; ++fb)
#pragma unroll
            for (int g = 0; g < 4; ++g) { const f32x16& v = fb ? v1 : v0; const int n = 64 * cg + 32 * fb + 8 * g + 4 * h;
                const f32x4 x = *(const f32x4*)(src + n), gv = *(const f32x4*)(gt + n);
                *(f32x4*)(xs + n) = (f32x4){x[0] + gv[0] * v[4 * g], x[1] + gv[1] * v[4 * g + 1], x[2] + gv[2] * v[4 * g + 2], x[3] + gv[3] * v[4 * g + 3]}; }
    }
};
__device__ __forceinline__ void phase_inproj(const Frame& F, int l) {
    const bf16_t* Wt = F.ws<bf16_t>(WS_WIN) + (size_t)l * INW * DM; const bf16_t* hb = F.ws<bf16_t>(WS_HB);
    const bool xcd = F.G == 256; const int x = F.bid & 7;
    const int first = xcd ? (F.bid >> 3) : F.bid, stride = xcd ? 32 : F.G, total = xcd ? 64 : 8 * 64;
    for (int i = first; i < total; i += stride) { const int ft = xcd ? 4 * (x & 1) + (i & 3) : (i & 7), tt = 1 + (xcd ? 4 * (i >> 2) + (x >> 1) : (i >> 3));
        EpiInProj E{F, l, 256 * tt}; XDense X{hb, DM, 256 * tt}; gemm8(F, Wt, DM, 256 * ft, X, E); }
    EpiInProjCtx EC{F, l};
    for (int u = F.bid; u < 256; u += F.G) { const int cg = u & 31, tb = u >> 5;
        if (l == 1 && !((cg >= 10 && cg < 22) || cg >= 28)) continue;
        mini_unit(F, Wt, DM, 64 * cg, hb, DM, 32 * tb, DM, EC); }
}
__device__ __forceinline__ void phase_outproj(const Frame& F, int l) {
    const bf16_t* Wt = F.ws<bf16_t>(WS_WOUT) + (size_t)l * DM * MIXK; const bf16_t* mix = F.ws<bf16_t>(WS_MIX);
    const bool xcd = F.G == 256; const int x = F.bid & 7;
    const int first = xcd ? (F.bid >> 3) : F.bid, stride = xcd ? 32 : F.G, total = xcd ? 32 : 4 * 64;
    for (int i = first; i < total; i += stride) { const int ft = i & 3, tt = 1 + (xcd ? 8 * (i >> 2) + x : (i >> 2));
        EpiOutProj E{F, l, 256 * tt}; XDense X{mix, MIXK, 256 * tt}; gemm8(F, Wt, MIXK, 256 * ft, X, E); }
    if (l == 0) { EpiOutProjCtx EC{F};
        for (int u = F.bid; u < 128; u += F.G) { const int cg = u & 15, tb = u >> 4; mini_unit(F, Wt, MIXK, 64 * cg, mix, MIXK, 32 * tb, MIXK, EC); } }
}
__device__ __forceinline__ void moe_tables(const Frame& F, int l, int nf, bool xcd, LAS int*& s_cnt, LAS int*& s_offs, LAS int*& s_t0) {
    LAS int* base = (LAS int*)(F.lds + LDS_CTL + 256); s_cnt = base; s_offs = base + 32; s_t0 = base + 72;
    __syncthreads();
    if (F.tid < NEXP) s_cnt[F.tid] = (int)__hip_atomic_load(F.ctl + CW_CNT + 64 * l + F.tid, __ATOMIC_RELAXED, __HIP_MEMORY_SCOPE_AGENT);
    __syncthreads();
    if (F.tid == 0) { const int g = (F.bid & 7) >> 1; int o = 0, t = 0; for (int e = 0; e < NEXP; ++e) { const int c = s_cnt[e];
            const int ntt = (c + 255) >> 8; int nu = ntt * nf;
            if (xcd) { const int fst = (g - e) & 3; nu = (fst < ntt ? (ntt - fst + 3) >> 2 : 0) * (nf >> 1); }
            s_cnt[e] = c; s_offs[e] = o; s_t0[e] = t; o += c; t += nu; } s_offs[32] = o; s_t0[32] = t; }
    __syncthreads();
}
__device__ __forceinline__ void moe_decode(const Frame& F, bool xcd, int nf, int i, LAS const int* s_t0, int& e, int& ft, int& tt) {
    e = 0; while (e < NEXP - 1 && i >= s_t0[e + 1]) ++e;
    const int j = i - s_t0[e];
    if (xcd) { const int x = F.bid & 7, hf = nf >> 1; ft = hf * (x & 1) + (j % hf); tt = (((x >> 1) - e) & 3) + 4 * (j / hf); }
    else { ft = j % nf; tt = j / nf; } }
__device__ __forceinline__ void phase_gateup(const Frame& F, int l) {
    const bool xcd = F.G == 256;
    LAS int *s_cnt, *s_offs, *s_t0; moe_tables(F, l, 8, xcd, s_cnt, s_offs, s_t0);
    const int first = xcd ? (F.bid >> 3) : F.bid, stride = xcd ? 32 : F.G, total = s_t0[32];
    for (int i = first; i < total; i += stride) { int e, ft, tt; moe_decode(F, xcd, 8, i, s_t0, e, ft, tt);
        EpiGateUp E{F, l * NEXP + e, 256 * tt, s_cnt[e], s_offs[e]};
        XGather X{F.ws<bf16_t>(WS_HB), F.ws<unsigned>(WS_LIST) + (size_t)e * NT, 256 * tt, s_cnt[e]};
        gemm8(F, F.ws<bf16_t>(WS_WGU) + (size_t)(l * NEXP + e) * 2048 * DM, DM, 256 * ft, X, E); }
}
__device__ __forceinline__ void phase_down(const Frame& F, int l) {
    const bool xcd = F.G == 256;
    LAS int *s_cnt, *s_offs, *s_t0; moe_tables(F, l, 4, xcd, s_cnt, s_offs, s_t0);
    const int first = xcd ? (F.bid >> 3) : F.bid, stride = xcd ? 32 : F.G, total = s_t0[32];
    for (int i = first; i < total; i += stride) { int e, ft, tt; moe_decode(F, xcd, 4, i, s_t0, e, ft, tt);
        EpiDown E{F, l * NEXP + e, 256 * tt, s_cnt[e], s_offs[e]};
        XAct X{F.ws<bf16_t>(WS_ACT), s_offs[e], 256 * tt, s_cnt[e]};
        gemm8(F, F.ws<bf16_t>(WS_WDN) + (size_t)(l * NEXP + e) * DM * FFD, FFD, 256 * ft, X, E); }
}

template <int KD, int MODE>
__device__ __forceinline__ void dft_unit(const Frame& F, const bf16_t* AF, const bf16_t* Bsrc, int p0, int colhalf, int pa) {
    constexpr int NS = KD / 16, TILE_B = 4 * KD * 64;
    const int lane = F.lane, wid = F.wid, r = lane & 31, h = lane >> 5, rg = wid & 3, cg2 = wid >> 2;
    LAS char* lds = F.lds;
    BAR_SYNC();
    for (int pc = wid; pc < TILE_B / 1024; pc += 8) dma16((const char*)Bsrc + (size_t)pc * 1024 + lane * 16, lds + pc * 1024);
    WAITV(0); BAR_SYNC();
    f32x16 acc[2][2];
#pragma unroll
    for (int a = 0; a < 2; ++a)
#pragma unroll
        for (int b = 0; b < 2; ++b)
#pragma unroll
            for (int i = 0; i < 16; ++i) acc[a][b][i] = 0.f;
    const bf16_t* af = AF + (size_t)(rg * 2) * NS * 512 + lane * 8;
    const int bl = h * 512 + ((lane & 15) >> 2) * 64 + ((lane >> 4) & 1) * 32 + (lane & 3) * 8;
#pragma unroll 4
    for (int s = 0; s < NS; ++s) {
        const bf16x8 a0 = *(const bf16x8*)(af + (size_t)s * 512), a1 = *(const bf16x8*)(af + (size_t)(NS + s) * 512);
#pragma unroll
        for (int cb = 0; cb < 2; ++cb) { LAS const char* bp = lds + (2 * cg2 + cb) * (KD * 64) + s * 1024 + bl;
            const s16x4 lo = vtr(bp), hi = vtr(bp + 256);
            const bf16x8 bf = {lo[0], lo[1], lo[2], lo[3], hi[0], hi[1], hi[2], hi[3]};
            acc[0][cb] = MFMA(a0, bf, acc[0][cb]); acc[1][cb] = MFMA(a1, bf, acc[1][cb]); }
    }
#pragma unroll
    for (int cb = 0; cb < 2; ++cb) { const int c = 128 * colhalf + 32 * (2 * cg2 + cb) + r;
#pragma unroll
        for (int rho = 0; rho < 16; ++rho) { const int kk = 32 * rg + (rho & 3) + 8 * (rho >> 2) + 4 * h; const float re = acc[0][cb][rho], im = acc[1][cb][rho];
            if (MODE == 0) { const int l2 = p0; const f32x2 tw = F.ws<f32x2>(WS_TW)[(kk * l2) & 16383]; const float o_re = re * tw[0] + im * tw[1], o_im = im * tw[0] - re * tw[1];
                bf16_t* T2 = F.ws<bf16_t>(WS_T2); const size_t a = ((size_t)(kk * 2 + (c >> 7)) * 4 + ((c >> 5) & 3)) * 8192 + (l2 >> 2) * 256 + (2 * (l2 & 3)) * 32 + (c & 31);
                T2[a] = (bf16_t)(pk2(o_re, 0.f) & 0xffff); T2[a + 32] = (bf16_t)(pk2(o_im, 0.f) & 0xffff);
            } else if (MODE == 1) { const int k1 = p0; bf16_t* mr = F.ws<bf16_t>(WS_MIX) + (size_t)(NCTX + k1 + 128 * kk) * MIXK;
                mr[c] = (bf16_t)(pk2(re * (1.f / 1024.f), 0.f) & 0xffff); mr[256 + c] = (bf16_t)(pk2(im * (1.f / 1024.f), 0.f) & 0xffff);
            } else { bf16_t* mr = F.ws<bf16_t>(WS_MIX) + (size_t)(128 * pa + kk) * MIXK;
                mr[c] = (bf16_t)(pk2(re * (1.f / 128.f), 0.f) & 0xffff); mr[256 + c] = (bf16_t)(pk2(im * (1.f / 128.f), 0.f) & 0xffff); } } }
}

constexpr int A_SLOT = 16384;
constexpr int N_PSLOT = 18;
constexpr int A_KRING = 0, A_VRING = 32768;
template <int NQ, int NKS, bool SEPK, bool BIAS>
__device__ __forceinline__ void attn_sweep(const Frame& F, const bf16x8 (&qf)[NQ][NKS], const bf16_t* Kt, const bf16_t* Vt, int ntiles, const f32x16& negm, f32x16 (&o)[NQ][2], float (&lsum)[NQ]) {
    constexpr int NKF = (SEPK ? NQ : 1) * NKS;
    const int lane = F.lane, wid = F.wid, r = lane & 31, h = lane >> 5;
    LAS char* lds = F.lds; const unsigned lds0 = (unsigned)(size_t)F.lds;
    const bf16_t* ksrc = Kt + wid * 512 + lane * 8; const bf16_t* vsrc = Vt + wid * 512 + lane * 8;
#define A_K(t) glds16(ksrc + (size_t)(t) * 4096, (unsigned)__builtin_amdgcn_readfirstlane((int)(lds0 + A_KRING + ((t) & 3) * 8192 + wid * 1024)))
#define A_V(t) glds16(vsrc + (size_t)(t) * 4096, (unsigned)__builtin_amdgcn_readfirstlane((int)(lds0 + A_VRING + ((t) & 3) * 8192 + wid * 1024)))
#define SB() __builtin_amdgcn_sched_barrier(0)
    BAR_SYNC();
    A_K(0); A_V(0); A_K(1); A_K(2); A_V(1);
    float l0[NQ]; f32x16 scA[NQ], scB[NQ]; bf16x8 kf[NKF], vf[4], pa[NQ][2];
#pragma unroll
    for (int qi = 0; qi < NQ; ++qi) { l0[qi] = 0.f;
#pragma unroll
        for (int i = 0; i < 16; ++i) { o[qi][0][i] = 0.f; o[qi][1][i] = 0.f; scB[qi][i] = 0.f; } }
    const int vb = ((lane >> 4) & 1) * 32 + (lane & 3) * 8 + (4 * h + ((lane & 15) >> 2)) * 64;
    const int kbo = h * 1024 + r * 16;
#define LOADK(tile, kb) do { LAS const char* kp_ = lds + A_KRING + ((tile) & 3) * 8192 + kbo + (kb) * 512; \
        _Pragma("unroll") for (int f_ = 0; f_ < NKF; ++f_) kf[f_] = *(LAS const bf16x8*)(kp_ + (SEPK ? (f_ / NKS) * 4096 : 0) + (f_ % NKS) * 2048); } while (0)
#define LOADV(tile, kb) do { LAS const char* vp_ = lds + A_VRING + ((tile) & 3) * 8192 + vb + (kb) * 2048; \
        _Pragma("unroll") for (int j_ = 0; j_ < 2; ++j_) _Pragma("unroll") for (int d_ = 0; d_ < 2; ++d_) { const s16x4 lo_ = vtr(vp_ + d_ * 4096 + j_ * 1024), hi_ = vtr(vp_ + d_ * 4096 + j_ * 1024 + 512); \
            vf[j_ * 2 + d_] = (bf16x8){lo_[0], lo_[1], lo_[2], lo_[3], hi_[0], hi_[1], hi_[2], hi_[3]}; } } while (0)
#define HALF(SN, SO, vtile, vkb, DOK, ktile, kkb) do { \
        LOADV(vtile, vkb); SB(); \
          \
        _Pragma("unroll") for (int m_ = 0; m_ < NQ * NKS; ++m_) { const int qi_ = m_ / NKS, s_ = m_ % NKS; \
            if (s_ == 0) { if (BIAS) SN[qi_] = MFMA(kf[(SEPK ? qi_ : 0) * NKS], qf[qi_][0], negm); else { f32x16 z_; _Pragma("unroll") for (int i_ = 0; i_ < 16; ++i_) z_[i_] = 0.f; SN[qi_] = MFMA(kf[(SEPK ? qi_ : 0) * NKS], qf[qi_][0], z_); } } \
            else SN[qi_] = MFMA(kf[(SEPK ? qi_ : 0) * NKS + s_], qf[qi_][s_], SN[qi_]); \
              \
            _Pragma("unroll") for (int g_ = m_ * 4 / NKS; g_ < (m_ + 1) * 4 / NKS; ++g_) { const int fq_ = g_ >> 2, gg_ = g_ & 3; \
                l0[fq_] += SO[fq_][4 * gg_]; l0[fq_] += SO[fq_][4 * gg_ + 1]; l0[fq_] += SO[fq_][4 * gg_ + 2]; l0[fq_] += SO[fq_][4 * gg_ + 3]; \
                { u32x4 w_ = __builtin_bit_cast(u32x4, pa[fq_][gg_ >> 1]); w_[(gg_ & 1) * 2] = pk2(SO[fq_][4 * gg_], SO[fq_][4 * gg_ + 1]); w_[(gg_ & 1) * 2 + 1] = pk2(SO[fq_][4 * gg_ + 2], SO[fq_][4 * gg_ + 3]); pa[fq_][gg_ >> 1] = __builtin_bit_cast(bf16x8, w_); } } \
            SB(); } \
          \
        _Pragma("unroll") for (int m_ = 0; m_ < NQ * 4; ++m_) { const int j_ = m_ / (2 * NQ), d_ = (m_ / NQ) & 1, qi_ = m_ % NQ; \
            o[qi_][d_] = MFMA(vf[j_ * 2 + d_], pa[qi_][j_], o[qi_][d_]); \
            { const int eq_ = m_ >> 2, eg_ = m_ & 3; \
              SN[eq_][4 * eg_] = __builtin_amdgcn_exp2f(SN[eq_][4 * eg_]); SN[eq_][4 * eg_ + 1] = __builtin_amdgcn_exp2f(SN[eq_][4 * eg_ + 1]); \
              SN[eq_][4 * eg_ + 2] = __builtin_amdgcn_exp2f(SN[eq_][4 * eg_ + 2]); SN[eq_][4 * eg_ + 3] = __builtin_amdgcn_exp2f(SN[eq_][4 * eg_ + 3]); } \
            if (m_ == 0) { if (DOK) LOADK(ktile, kkb); }   \
            SB(); } \
    } while (0)
    WAITV(2); BAR_SYNC();
    A_K(3); if (ntiles > 2) A_V(2);
    LOADK(0, 0);
    for (int t = 0; t < ntiles; ++t) {
        if (t > 0) {
            if (t + 2 < ntiles) { WAITV(2); } else if (t + 1 < ntiles) { WAITV(1); } else { WAITV(0); }
            BAR_SYNC();
            if (t + 3 < ntiles) A_K(t + 3);
            if (t + 2 < ntiles) A_V(t + 2);
        }
        HALF(scA, scB, (t > 0 ? t - 1 : 0), 1, true, t, 1);
        HALF(scB, scA, t, 0, (t + 1 < ntiles), t + 1, 0);
    }
    LOADV(ntiles - 1, 1);
#pragma unroll
    for (int qi = 0; qi < NQ; ++qi) {
#pragma unroll
        for (int i = 0; i < 16; ++i) l0[qi] += scB[qi][i];
        pa[qi][0] = pack8(scB[qi][0], scB[qi][1], scB[qi][2], scB[qi][3], scB[qi][4], scB[qi][5], scB[qi][6], scB[qi][7]);
        pa[qi][1] = pack8(scB[qi][8], scB[qi][9], scB[qi][10], scB[qi][11], scB[qi][12], scB[qi][13], scB[qi][14], scB[qi][15]); }
#pragma unroll
    for (int j = 0; j < 2; ++j)
#pragma unroll
        for (int d0 = 0; d0 < 2; ++d0)
#pragma unroll
            for (int qi = 0; qi < NQ; ++qi) o[qi][d0] = MFMA(vf[j * 2 + d0], pa[qi][j], o[qi][d0]);
#undef A_K
#undef A_V
#undef SB
#undef LOADK
#undef LOADV
#undef HALF
#pragma unroll
    for (int qi = 0; qi < NQ; ++qi) lsum[qi] = add32(l0[qi]);
}
constexpr int PREC = 1152;
__device__ __forceinline__ void store_partial(const Frame& F, int kh, int slot, int R, const f32x16 (&o)[2], float l, int r, int h) {
    bf16_t* rec = F.ws<bf16_t>(WS_PART) + ((size_t)R * 2 + kh) * PREC; const float inv = 1.f / l;
#pragma unroll
    for (int d0 = 0; d0 < 2; ++d0)
#pragma unroll
        for (int g = 0; g < 4; ++g) { u32x2 w = {pk2(o[d0][4 * g] * inv, o[d0][4 * g + 1] * inv), pk2(o[d0][4 * g + 2] * inv, o[d0][4 * g + 3] * inv)};
            const int off = slot < 12 ? (((slot >> 1) * 8 + 4 * d0 + g) * 2 + (slot & 1)) * 8 + 4 * h : 768 + (slot - 12) * 64 + 32 * d0 + 8 * g + 4 * h;
            *(u32x2*)(rec + off) = w; }
    if (h == 0) F.ws<float>(WS_PL)[((size_t)R * 2 + kh) * N_PSLOT + slot] = l;
}
__device__ __forceinline__ void attn_diff_unit(const Frame& F, int l, int head, int R0, int t0, int ntiles, int khalf) {
    const int lane = F.lane, wid = F.wid, r = lane & 31, h = lane >> 5;
    const bf16_t* qp = F.ws<bf16_t>(WS_QD) + (size_t)(head * NQB + (R0 >> 5) + wid) * 2048;
    bf16x8 qf[2][2]; float mi[2];
#pragma unroll
    for (int mp = 0; mp < 2; ++mp) {
#pragma unroll
        for (int s = 0; s < 2; ++s) qf[mp][s] = *(const bf16x8*)(qp + ((4 * mp + 2 * s + h) * 32 + r) * 8);
        float qq = 0.f;
#pragma unroll
        for (int j = 0; j < 8; ++j) { const float a = bf2f((unsigned short)qf[mp][0][j]), b = bf2f((unsigned short)qf[mp][1][j]); qq += a * a + b * b; }
        qq = add32(qq);
        const float km = ((LAS const float*)(F.lds + LDS_CTL + 1024))[2 * head + mp];
        mi[mp] = -sqrtf(qq * km) * 1.01f; }
    f32x16 negm; { const float mm = fminf(mi[0], mi[1]);
#pragma unroll
        for (int i = 0; i < 16; ++i) negm[i] = mm; asm volatile("" : "+v"(negm)); }
    f32x16 o[2][2]; float ls[2];
    attn_sweep<2, 2, true, true>(F, qf, F.ws<bf16_t>(WS_KD) + (size_t)(head * NKT + t0) * 4096, F.ws<bf16_t>(WS_VD) + (size_t)(head * NKT + t0) * 4096, ntiles, negm, o, ls);
    { const int ln = lane_now(), r2 = ln & 31, h2 = ln >> 5, R = R0 + 32 * wid + r2;
#pragma unroll
      for (int mp = 0; mp < 2; ++mp) store_partial(F, khalf, 2 * head + mp, R, o[mp], ls[mp], r2, h2); }
}
template <int NH>
__device__ __forceinline__ void attn_gqa_unit(const Frame& F, int qh0, int kvh, int R0, int t0, int ntiles, int khalf, float bound) {
    const int lane = F.lane, wid = F.wid, r = lane & 31, h = lane >> 5;
    bf16x8 qf[NH][4];
#pragma unroll
    for (int hh = 0; hh < NH; ++hh) { const bf16_t* qp = F.ws<bf16_t>(WS_QG) + (size_t)((qh0 + hh) * NQB + (R0 >> 5) + wid) * 2048;
#pragma unroll
        for (int s = 0; s < 4; ++s) qf[hh][s] = *(const bf16x8*)(qp + ((2 * s + h) * 32 + r) * 8); }
    f32x16 o[NH][2]; float ls[NH]; f32x16 negm;
#pragma unroll
    for (int i = 0; i < 16; ++i) negm[i] = 0.f;
    attn_sweep<NH, 4, false, false>(F, qf, F.ws<bf16_t>(WS_KG) + (size_t)(kvh * NKT + t0) * 4096, F.ws<bf16_t>(WS_VG) + (size_t)(kvh * NKT + t0) * 4096, ntiles, negm, o, ls);
    { const int ln = lane_now(), r2 = ln & 31, h2 = ln >> 5, R = R0 + 32 * wid + r2;
#pragma unroll
      for (int hh = 0; hh < NH; ++hh) store_partial(F, khalf, 12 + qh0 + hh, R, o[hh], ls[hh], r2, h2); }
}

__device__ __forceinline__ void phase_attn(const Frame& F, int l, int rep) {
    if (F.wid >= 4) __builtin_amdgcn_s_setprio(1);
    float gqm = 0.f, gkm = 0.f; { const float* gq = F.in(I_GQ) + 64 * l; const float* gk = F.in(I_GK) + 64 * l; for (int i = 0; i < 64; ++i) { gqm = fmaxf(gqm, fabsf(gq[i])); gkm = fmaxf(gkm, fabsf(gk[i])); } }
    const float bg = fminf(8.f * gqm * gkm * LOG2E * 1.01f, 100.f);
    for (int mp = F.wid; mp < 12; mp += 8) { const float* kp = F.ws<float>(WS_KP) + (size_t)(l * 12 + mp) * 1024; float mx = 0.f;
#pragma unroll
        for (int q = 0; q < 4; ++q) { const f32x4 v = *(const f32x4*)(kp + 256 * q + 4 * F.lane); mx = fmaxf(fmaxf(mx, fmaxf(v[0], v[1])), fmaxf(v[2], v[3])); }
        mx = wave_max(mx); mx = fmaxf(mx, __uint_as_float(__hip_atomic_load(F.ctl + CW_KMAX + 16 * l + mp, __ATOMIC_RELAXED, __HIP_MEMORY_SCOPE_AGENT)));
        if (F.lane == 0) ((LAS float*)(F.lds + LDS_CTL + 1024))[mp] = mx; }
    __syncthreads();
    constexpr int HT = NKT / 2;
    for (int u = F.bid; u < 256; u += F.G) { const int cb = (u & 7) >> 1, rb = ((u >> 3) << 1) | (u & 1), R0 = NCTX + 256 * rb; const int kvh = cb >> 1, kh = cb & 1;
        attn_gqa_unit<2>(F, 3 * kvh, kvh, R0, kh * HT, HT, kh, bg); }
    for (int u = F.bid; u < 768; u += F.G) { const int j = u >> 8, v = u & 255, cb = 4 * j + ((v & 7) >> 1), rb = ((v >> 3) << 1) | (v & 1), R0 = NCTX + 256 * rb; const int head = cb >> 1, kh = cb & 1;
        attn_diff_unit(F, l, head, R0, kh * HT, HT, kh); }
    for (int u = F.bid; u < 256; u += F.G) { const int cb = (u & 7) >> 1, rb = ((u >> 3) << 1) | (u & 1), R0 = NCTX + 256 * rb; const int kvh = cb >> 1, kh = cb & 1;
        attn_gqa_unit<1>(F, 3 * kvh + 2, kvh, R0, kh * HT, HT, kh, bg); }
    for (int u = F.bid; u < 256; u += F.G) { const int l2 = u >> 1, ch = u & 1;
        dft_unit<128, 0>(F, F.ws<bf16_t>(WS_A1F), F.ws<bf16_t>(WS_FT) + (size_t)(l2 * 2 + ch) * 4 * 4096, l2, ch, 0); }
    if (l == 0) {
        for (int u = F.bid; u < 14; u += F.G) {
            if (u < 4) { const int pa = u >> 1, ch = u & 1; dft_unit<256, 2>(F, F.ws<bf16_t>(WS_ACF) + (size_t)pa * 65536, F.ws<bf16_t>(WS_FC) + (size_t)ch * 4 * 8192, 0, ch, pa); }
            else if (u < 10) attn_diff_unit(F, l, u - 4, 0, 0, NCTX / 64, 0);
            else if (u < 12) attn_gqa_unit<2>(F, 3 * (u - 10), u - 10, 0, 0, NCTX / 64, 0, bg);
            else attn_gqa_unit<1>(F, 3 * (u - 12) + 2, u - 12, 0, 0, NCTX / 64, 0, bg);
        }
    }
    __builtin_amdgcn_s_setprio(0);
}
__device__ __forceinline__ void unpack8(const u32x4& w, float (&f)[8]) { f[0] = bflo(w[0]); f[1] = bfhi(w[0]); f[2] = bflo(w[1]); f[3] = bfhi(w[1]); f[4] = bflo(w[2]); f[5] = bfhi(w[2]); f[6] = bflo(w[3]); f[7] = bfhi(w[3]); }
__device__ __forceinline__ void attn_merge(const Frame& F, int l) {
    const int lane = F.lane, un = lane >> 3, dc = lane & 7; const bool act = lane < 48;
    const float* lq1 = F.in(I_LQ1) + 32 * l; const float* lk1 = F.in(I_LK1) + 32 * l; const float* lq2 = F.in(I_LQ2) + 32 * l; const float* lk2 = F.in(I_LK2) + 32 * l;
    float d1 = 0.f, d2 = 0.f; for (int i = 0; i < 32; ++i) { d1 += lq1[i] * lk1[i]; d2 += lq2[i] * lk2[i]; }
    const float lam_init = 0.8f - 0.6f * expf(-0.3f * (float)l); const float lam = expf(d1) - expf(d2) + lam_init, post = 1.f - lam_init;
    float gs[8]; { const float* g = F.in(I_GSUB) + 64 * l + 8 * dc; for (int j = 0; j < 8; ++j) gs[j] = g[j]; }
    const bf16_t* part = F.ws<bf16_t>(WS_PART); const float* pl = F.ws<float>(WS_PL); bf16_t* mix = F.ws<bf16_t>(WS_MIX);
    const int Rbeg = l == 0 ? 0 : NCTX; const int u6 = act ? un : 0;
    for (int R = Rbeg + F.bid * 8 + F.wid; R < NT; R += F.G * 8) {
        const bool two = R >= NCTX; bf16_t* mr = mix + (size_t)R * MIXK;
        const bf16_t* ra = part + (size_t)R * 2 * PREC; const bf16_t* rb = ra + PREC; const float* la = pl + (size_t)R * 2 * N_PSLOT; const float* lb = la + N_PSLOT;
        { const u32x4 a0 = *(const u32x4*)(ra + (u6 * 8 + dc) * 16), a1 = *(const u32x4*)(ra + (u6 * 8 + dc) * 16 + 8);
          u32x4 b0 = {0u, 0u, 0u, 0u}, b1 = b0; float lb0 = 0.f, lb1 = 0.f;
          if (two) { b0 = *(const u32x4*)(rb + (u6 * 8 + dc) * 16); b1 = *(const u32x4*)(rb + (u6 * 8 + dc) * 16 + 8); lb0 = lb[2 * u6]; lb1 = lb[2 * u6 + 1]; }
          const float la0 = la[2 * u6], la1 = la[2 * u6 + 1]; const float i0 = 1.f / (la0 + lb0), i1 = lam / (la1 + lb1);
          float fa0[8], fa1[8], fb0[8], fb1[8], v[8]; unpack8(a0, fa0); unpack8(a1, fa1); unpack8(b0, fb0); unpack8(b1, fb1);
          float ss = 0.f;
#pragma unroll
          for (int j = 0; j < 8; ++j) { v[j] = (la0 * fa0[j] + lb0 * fb0[j]) * i0 - (la1 * fa1[j] + lb1 * fb1[j]) * i1; ss += v[j] * v[j]; }
          ss += shxc<1>(ss); ss += shxc<2>(ss); ss += shxc<4>(ss);
          const float rs = rsqrtf(ss * (1.f / 64.f) + 1e-5f) * post;
          if (act) { u32x4 w = {pk2(v[0] * rs * gs[0], v[1] * rs * gs[1]), pk2(v[2] * rs * gs[2], v[3] * rs * gs[3]), pk2(v[4] * rs * gs[4], v[5] * rs * gs[5]), pk2(v[6] * rs * gs[6], v[7] * rs * gs[7])};
              *(u32x4*)(mr + 512 + 64 * un + 8 * dc) = w; } }
        { const u32x4 a0 = *(const u32x4*)(ra + 768 + u6 * 64 + dc * 8); u32x4 b0 = {0u, 0u, 0u, 0u}; float lbq = 0.f;
          if (two) { b0 = *(const u32x4*)(rb + 768 + u6 * 64 + dc * 8); lbq = lb[12 + u6]; }
          const float laq = la[12 + u6], iq = 1.f / (laq + lbq); float fa[8], fb[8]; unpack8(a0, fa); unpack8(b0, fb);
          if (act) { float o[8];
#pragma unroll
              for (int j = 0; j < 8; ++j) o[j] = (laq * fa[j] + lbq * fb[j]) * iq;
              u32x4 w = {pk2(o[0], o[1]), pk2(o[2], o[3]), pk2(o[4], o[5]), pk2(o[6], o[7])}; *(u32x4*)(mr + 896 + 64 * un + 8 * dc) = w; } }
    }
}
__device__ __forceinline__ void phase_fft2(const Frame& F, int l) {
    for (int u = F.bid; u < 256; u += F.G) { const int k1 = u >> 1, ch = u & 1;
        dft_unit<256, 1>(F, F.ws<bf16_t>(WS_A2F), F.ws<bf16_t>(WS_T2) + (size_t)(k1 * 2 + ch) * 4 * 8192, k1, ch, 0); }
    attn_merge(F, l);
}

__device__ __forceinline__ void phase_router(const Frame& F, int l) {
    constexpr int HS = 2064;
    LAS char* hhi = F.lds; LAS char* hlo = F.lds + 32 * HS;
    LAS float* part = (LAS float*)F.lds;
    LAS unsigned* hist = (LAS unsigned*)(F.lds + 135168);
    LAS unsigned* recs = hist + 64;
    const int lane = F.lane, wid = F.wid, t = F.tid;
    const float* wr = F.in(I_WR) + (size_t)l * 1024 * 32;
    __syncthreads();
    if (t < 64) hist[t] = 0u;
    bf16x8 ahi[8], alo[8];
    { const int e = lane & 31, kk = lane >> 5;
#pragma unroll
      for (int s = 0; s < 8; ++s) { float w[8];
#pragma unroll
          for (int j = 0; j < 8; ++j) w[j] = wr[(size_t)(16 * (8 * wid + s) + 8 * kk + j) * 32 + e];
          unsigned hi[4], lo[4];
#pragma unroll
          for (int j = 0; j < 4; ++j) { hi[j] = pk2(w[2 * j], w[2 * j + 1]); lo[j] = pk2(w[2 * j] - bflo(hi[j]), w[2 * j + 1] - bfhi(hi[j])); }
          ahi[s] = __builtin_bit_cast(bf16x8, (u32x4){hi[0], hi[1], hi[2], hi[3]}); alo[s] = __builtin_bit_cast(bf16x8, (u32x4){lo[0], lo[1], lo[2], lo[3]}); } }
    const int Rbeg = l == 0 ? 0 : NCTX, ntok = NT - Rbeg, per = (ntok + F.G - 1) / F.G;
    const int r0 = Rbeg + F.bid * per, r1 = min(r0 + per, NT);
    const float* mod = F.ws<float>(WS_MOD) + (size_t)l * 2 * 6144; const float* g2 = F.in(I_GN2) + 1024 * l; const float* br = F.in(I_BR) + 32 * l;
    const float* xs = F.ws<float>(WS_XS); bf16_t* hb = F.ws<bf16_t>(WS_HB);
    unsigned* slot = F.ws<unsigned>(WS_SLOT); float* gate = F.ws<float>(WS_GATE);
    const float bre = br[lane & 31];
    for (int b0 = r0; b0 < r1; b0 += 32) {
        __syncthreads();
#pragma unroll 1
        for (int tt = wid; tt < 32; tt += 8) { const int R = min(b0 + tt, r1 - 1); const float* m = mod + (R < NCTX ? 6144 : 0);
            f32x4 x[4], hv[4]; load_row(xs + (size_t)R * DM, lane, x); const float rstd = row_rstd(x, 1e-6f);
            mod_store_bf16(x, rstd, g2, m + 3072, m + 4096, hb + (size_t)R * DM, lane, &hv);
#pragma unroll
            for (int q = 0; q < 4; ++q) { const unsigned h0 = pk2(hv[q][0], hv[q][1]), h1 = pk2(hv[q][2], hv[q][3]);
                const unsigned l0 = pk2(hv[q][0] - bflo(h0), hv[q][1] - bfhi(h0)), l1 = pk2(hv[q][2] - bflo(h1), hv[q][3] - bfhi(h1));
                *(LAS u32x2*)(hhi + tt * HS + (256 * q + 4 * lane) * 2) = (u32x2){h0, h1}; *(LAS u32x2*)(hlo + tt * HS + (256 * q + 4 * lane) * 2) = (u32x2){l0, l1}; } }
        __syncthreads();
        f32x16 acc;
#pragma unroll
        for (int i = 0; i < 16; ++i) acc[i] = 0.f;
        { const int n = lane & 31, kk = lane >> 5;
#pragma unroll
          for (int s = 0; s < 8; ++s) { const int off = n * HS + (16 * (8 * wid + s) + 8 * kk) * 2;
              const bf16x8 bh = *(LAS const bf16x8*)(hhi + off), bl = *(LAS const bf16x8*)(hlo + off);
              acc = MFMA(ahi[s], bh, acc); acc = MFMA(ahi[s], bl, acc); acc = MFMA(alo[s], bh, acc); } }
        __syncthreads();
#pragma unroll
        for (int i = 0; i < 16; ++i) part[(wid * 16 + i) * 64 + lane] = acc[i];
        __syncthreads();
#pragma unroll 1
        for (int tt = 0; tt < 4; ++tt) { const int tk = 4 * wid + tt, R = b0 + tk; const int e = lane & 31;
            const int rr = (e & 3) | ((e >> 3) << 2), ln = tk + 32 * ((e >> 2) & 1);
            float v = bre;
#pragma unroll
            for (int w = 0; w < 8; ++w) v += part[(w * 16 + rr) * 64 + ln];
            float tv[4]; int te[4];
#pragma unroll
            for (int kk = 0; kk < 4; ++kk) { const float mx = wave_max(v); const unsigned long long bal = __ballot(v == mx); const int lw = __ffsll((long long)bal) - 1; te[kk] = lw & 31; tv[kk] = mx; if (e == te[kk]) v = -INFINITY; }
            const float e1 = __expf(tv[1] - tv[0]), e2 = __expf(tv[2] - tv[0]), e3 = __expf(tv[3] - tv[0]); const float inv = 1.f / (1.f + e1 + e2 + e3);
            if (lane < 4 && R < r1) { const int ee = lane == 0 ? te[0] : lane == 1 ? te[1] : lane == 2 ? te[2] : te[3]; const float gg = (lane == 0 ? 1.f : lane == 1 ? e1 : lane == 2 ? e2 : e3) * inv;
                const unsigned lr = atomicAdd((unsigned*)(hist + ee), 1u);
                const int ti = R - r0; recs[ti * 4 + lane] = ((unsigned)ee << 24) | lr; gate[(size_t)R * 4 + lane] = gg; } }
    }
    __syncthreads();
    if (t < 32) { const unsigned c = hist[t]; hist[32 + t] = c ? xb_add(F.ctl + CW_CNT + 64 * l + t, c) : 0u; }
    __syncthreads();
    unsigned* list = F.ws<unsigned>(WS_LIST);
    for (int i = t; i < (r1 - r0) * 4; i += 512) { const unsigned rec = recs[i]; const unsigned ee = rec >> 24, rk = (rec & 0xffffffu) + hist[32 + ee]; const int R = r0 + (i >> 2);
        slot[(size_t)R * 4 + (i & 3)] = (ee << 24) | rk; list[(size_t)ee * NT + rk] = (unsigned)R; }
    __syncthreads();
}

__device__ __forceinline__ void phase_combine(const Frame& F, int l) {
    const int lane = F.lane; const float* mod = F.ws<float>(WS_MOD) + (size_t)l * 2 * 6144; const float* modn = F.ws<float>(WS_MOD) + (size_t)(l + 1) * 2 * 6144;
    float* xs = F.ws<float>(WS_XS); const bf16_t* yb = F.ws<bf16_t>(WS_YB); const unsigned* slot = F.ws<unsigned>(WS_SLOT); const float* gate = F.ws<float>(WS_GATE); bf16_t* hb = F.ws<bf16_t>(WS_HB);
    int offs = 0;
    { const int ce = lane < NEXP ? (int)__hip_atomic_load(F.ctl + CW_CNT + 64 * l + lane, __ATOMIC_RELAXED, __HIP_MEMORY_SCOPE_AGENT) : 0;
      int inc = ce;
#pragma unroll
      for (int d = 1; d < 32; d <<= 1) { const int up = __builtin_amdgcn_ds_bpermute(((lane - d) & 63) << 2, inc); if (lane >= d) inc += up; }
      offs = inc - ce; }
    const int Rbeg = l == 0 ? 0 : NCTX; float* outb = F.outp(); const float* gn1 = F.in(I_GN1) + 1024; const float* gf = F.in(I_GFIN);
    f32x4 gfv[4];
#pragma unroll
    for (int q = 0; q < 4; ++q) gfv[q] = *(const f32x4*)(gf + 256 * q + 4 * lane);
    for (int R = Rbeg + F.bid * 8 + F.wid; R < NT; R += F.G * 8) {
        const float* m = mod + (R < NCTX ? 6144 : 0);
        f32x4 x[4], a[4]; load_row(xs + (size_t)R * DM, lane, x);
#pragma unroll
        for (int q = 0; q < 4; ++q) a[q] = (f32x4){0.f, 0.f, 0.f, 0.f};
#pragma unroll
        for (int s = 0; s < 4; ++s) { const unsigned rec = slot[(size_t)R * 4 + s]; const float g = gate[(size_t)R * 4 + s]; const int pos = __builtin_amdgcn_ds_bpermute((int)((rec >> 24) << 2), offs) + (int)(rec & 0xffffffu);
            const bf16_t* yr = yb + (size_t)pos * DM;
#pragma unroll
            for (int q = 0; q < 4; ++q) { const u32x2 w = *(const u32x2*)(yr + 256 * q + 4 * lane); a[q][0] += g * bflo(w[0]); a[q][1] += g * bfhi(w[0]); a[q][2] += g * bflo(w[1]); a[q][3] += g * bfhi(w[1]); } }
#pragma unroll
        for (int q = 0; q < 4; ++q) { const f32x4 gt = *(const f32x4*)(m + 5120 + 256 * q + 4 * lane);
#pragma unroll
            for (int i = 0; i < 4; ++i) x[q][i] += gt[i] * a[q][i]; }
        const float rstd = row_rstd(x, 1e-6f);
        if (l == 0) {
#pragma unroll
            for (int q = 0; q < 4; ++q) *(f32x4*)(xs + (size_t)R * DM + 256 * q + 4 * lane) = x[q];
            const float* mn = modn + (R < NCTX ? 6144 : 0);
            mod_store_bf16(x, rstd, gn1, mn, mn + 1024, hb + (size_t)R * DM, lane);
        } else {
            float* orow = outb + (size_t)(R - NCTX) * DM;
#pragma unroll
            for (int q = 0; q < 4; ++q) { const f32x4 gv = gfv[q]; f32x4 o;
#pragma unroll
                for (int i = 0; i < 4; ++i) o[i] = x[q][i] * rstd * gv[i];
                *(f32x4*)(orow + 256 * q + 4 * lane) = o; }
        }
    }
}

__device__ __forceinline__ int opaque_i32(int v) { asm volatile("" : "+s"(v)); return __builtin_amdgcn_readfirstlane(v); }
__device__ __forceinline__ unsigned long long opaque_u64(unsigned long long w) { int lo = (int)(unsigned)w, hi = (int)(unsigned)(w >> 32); lo = opaque_i32(lo); hi = opaque_i32(hi);
    return ((unsigned long long)(unsigned)hi << 32) | (unsigned)lo; }
__device__ __forceinline__ Frame fresh(const Frame& F) { Frame G = F;
    G.wsb = (unsigned char*)opaque_u64((unsigned long long)F.wsb); G.ctl = (unsigned*)opaque_u64((unsigned long long)F.ctl);
    G.pp = (const __attribute__((address_space(4))) Params*)opaque_u64((unsigned long long)F.pp);
    G.wid = opaque_i32(F.wid); G.bid = opaque_i32(F.bid); G.G = opaque_i32(F.G);
    G.lane = lane_now(); G.tid = G.wid * 64 + G.lane; return G; }
constexpr int N_PHASES = 18;
__global__ void __launch_bounds__(NTHREADS, 2) mk_fwd(Params P, int ph_lo, int ph_hi, int probe) {
    extern __shared__ __attribute__((aligned(16))) unsigned char smem_raw[];
    Frame F; F.pp = (const __attribute__((address_space(4))) Params*)__builtin_amdgcn_kernarg_segment_ptr(); F.wsb = P.ws; F.lds = (LAS char*)smem_raw; F.tid = threadIdx.x; F.lane = F.tid & 63; F.wid = __builtin_amdgcn_readfirstlane(F.tid >> 6); F.G = gridDim.x; F.bid = blockIdx.x;
    F.ctl = (unsigned*)(P.ws + WS_CTL);
    LAS unsigned* bw = (LAS unsigned*)(F.lds + LDS_CTL);
    if (F.tid < 4) bw[F.tid] = 0u;
    __syncthreads();
    XcdBarrier bar;
    if (MK_ONE_LAUNCH) bar = xcd_barrier_post(F.ctl + CW_BAR, (volatile LAS unsigned*)bw, F.wid);
#ifndef PHASE_MASK
#define PHASE_MASK 0xFFFFFFFFu
#endif
#if MK_ONE_LAUNCH
#define IN(k) (((PHASE_MASK >> ((k) >= 10 ? (k) - 8 : (k))) & 1u) != 0u)
#else
#define IN(k) (((PHASE_MASK >> ((k) >= 10 ? (k) - 8 : (k))) & 1u) && ph_lo <= (k) && (k) < ph_hi)
#endif
#define SEAM(k) do { if (MK_ONE_LAUNCH && IN(k) && IN((k) + 1)) xcd_barrier(bar); } while (0)
#define RUN(k, code, body) do { if (IN(k)) { const int nr_ = (opaque_i32(probe) == (code)) ? 2 : 1; _Pragma("unroll 1") for (int rep = 0; rep < nr_; ++rep) { body; if (MK_ONE_LAUNCH && rep + 1 < nr_) xcd_barrier(bar); } } SEAM(k); } while (0)
    RUN(0, 100, phase_prologue(fresh(F)));
    RUN(1, 101, phase_norm0(fresh(F)));
#pragma unroll 1
    for (int l = 0; l < 2; ++l) {
        const int b = 2 + 8 * l;
        RUN(b + 0, 0, phase_inproj(fresh(F), l));
        RUN(b + 1, 1, phase_attn(fresh(F), l, rep));
        RUN(b + 2, 2, phase_fft2(fresh(F), l));
        RUN(b + 3, 3 + 10 * l, phase_outproj(fresh(F), l));
        RUN(b + 4, 104, phase_router(fresh(F), l));
        RUN(b + 5, 5, phase_gateup(fresh(F), l));
        RUN(b + 6, 6, phase_down(fresh(F), l));
        RUN(b + 7, 17 - 10 * l, phase_combine(fresh(F), l));
    }
}

extern "C" void kernel_launch(void* const* d_in, const int* in_sizes, int n_in, void* d_out, int out_size, void* d_ws, size_t ws_size, hipStream_t stream) {
    static int grid = 0;
    if (!grid) {
        int dev = 0, cus = 0, per_cu = 0;
        hipGetDevice(&dev);
        hipDeviceGetAttribute(&cus, hipDeviceAttributeMultiprocessorCount, dev);
        hipFuncSetAttribute((const void*)mk_fwd, hipFuncAttributeMaxDynamicSharedMemorySize, LDS_BYTES);
        hipOccupancyMaxActiveBlocksPerMultiprocessor(&per_cu, (const void*)mk_fwd, NTHREADS, LDS_BYTES);
        if (per_cu < 1) { fprintf(stderr, "mk_fwd: occupancy query says %d blocks per CU\n", per_cu); per_cu = 1; }
        grid = cus * 1;
        if (ws_size < WS_END) fprintf(stderr, "mk_fwd: workspace too small (%zu < %zu)\n", ws_size, (size_t)WS_END);
    }
    hipMemsetAsync(d_ws, 0, CTL_BYTES, stream);
    Params p{};
    for (int i = 0; i < 25; ++i) p.in[i] = (const float*)d_in[i];
    p.out = (float*)d_out; p.ws = (unsigned char*)d_ws;
#if MK_ONE_LAUNCH
    hipLaunchKernelGGL(mk_fwd, dim3(grid), dim3(NTHREADS), LDS_BYTES, stream, p, 0, N_PHASES, MK_PROBE);
#else
    for (int k = 0; k < N_PHASES; ++k) hipLaunchKernelGGL(mk_fwd, dim3(grid), dim3(NTHREADS), LDS_BYTES, stream, p, k, k + 1, -1);
#endif
}
```

```cpp
#include <hip/hip_runtime.h>
#include <cstdio>
#include <cstdint>

#ifndef MK_PROBE
#define MK_PROBE -1
#endif
#ifndef MK_ONE_LAUNCH
#define MK_ONE_LAUNCH 1
#endif

#define LAS __attribute__((address_space(3)))
typedef unsigned short bf16_t;
typedef short bf16x8 __attribute__((ext_vector_type(8)));
typedef short s16x4 __attribute__((ext_vector_type(4)));
typedef float f32x16 __attribute__((ext_vector_type(16)));
typedef float f32x4 __attribute__((ext_vector_type(4)));
typedef float f32x2 __attribute__((ext_vector_type(2)));
typedef unsigned u32x4 __attribute__((ext_vector_type(4)));
typedef unsigned u32x2 __attribute__((ext_vector_type(2)));
typedef __bf16 bf16x2_t __attribute__((ext_vector_type(2)));
typedef short v4i16_t __attribute__((ext_vector_type(4)));

constexpr int DM = 1024, LSEQ = 16384, NCTX = 256, NT = LSEQ + NCTX, INW = 2048, NEXP = 32, FFD = 1024, MIXK = 1280;
constexpr int NKT = NT / 64;
constexpr int NQB = NT / 32;
constexpr float LOG2E = 1.4426950408889634f;
constexpr int NTHREADS = 512;
constexpr int LDS_BYTES = 155648;
constexpr int LDS_CTL = 151552;

constexpr size_t al256(size_t x) { return (x + 255) & ~(size_t)255; }
constexpr size_t WS_CTL = 0, CTL_BYTES = 1u << 20;
constexpr size_t WS_MOD = CTL_BYTES;
constexpr size_t WS_ROPE = WS_MOD + 131072;
constexpr size_t WS_TW = WS_ROPE + 65536;
constexpr size_t WS_A1F = WS_TW + 131072;
constexpr size_t WS_A2F = WS_A1F + 65536;
constexpr size_t WS_ACF = WS_A2F + 131072;
constexpr size_t WS_WIN = WS_ACF + 262144;
constexpr size_t WS_WOUT = WS_WIN + (size_t)2 * INW * DM * 2;
constexpr size_t WS_WGU = WS_WOUT + (size_t)2 * DM * MIXK * 2;
constexpr size_t WS_WDN = WS_WGU + (size_t)2 * NEXP * 2048 * DM * 2;
constexpr size_t WS_HB = WS_WDN + (size_t)2 * NEXP * DM * FFD * 2;
constexpr size_t WS_QD = WS_HB + (size_t)NT * DM * 2;
constexpr size_t WS_KD = WS_QD + (size_t)6 * NQB * 2048 * 2;
constexpr size_t WS_VD = WS_KD + (size_t)6 * NKT * 4096 * 2;
constexpr size_t WS_QG = WS_VD + (size_t)6 * NKT * 4096 * 2;
constexpr size_t WS_KG = WS_QG + (size_t)6 * NQB * 2048 * 2;
constexpr size_t WS_VG = WS_KG + (size_t)2 * NKT * 4096 * 2;
constexpr size_t WS_FT = WS_VG + (size_t)2 * NKT * 4096 * 2;
constexpr size_t WS_FC = WS_FT + (size_t)128 * 2 * 4 * 4096 * 2;
constexpr size_t WS_T2 = WS_FC + (size_t)2 * 4 * 8192 * 2;
constexpr size_t WS_MIX = WS_T2 + (size_t)128 * 2 * 4 * 8192 * 2;
constexpr size_t WS_XS = WS_MIX + (size_t)NT * MIXK * 2;
constexpr size_t WS_LIST = WS_XS + (size_t)NT * DM * 4;
constexpr size_t WS_SLOT = WS_LIST + (size_t)NEXP * NT * 4;
constexpr size_t WS_GATE = WS_SLOT + (size_t)NT * 16;
constexpr size_t WS_ACT = WS_GATE + (size_t)NT * 16;
constexpr size_t WS_YB = WS_ACT + (size_t)NT * 4 * FFD * 2;
constexpr size_t WS_PART = WS_YB + (size_t)NT * 4 * DM * 2;
constexpr size_t WS_PL = WS_PART + (size_t)36 * NT * 64 * 2;
constexpr size_t WS_KP = WS_PL + (size_t)36 * NT * 4;
constexpr size_t WS_END = WS_KP + (size_t)2 * 12 * 1024 * 4;

constexpr int CW_BAR = 4096;
constexpr int CW_CNT = 8192;
constexpr int CW_KMAX = 8320;
constexpr int CW_QH = 8448;

constexpr int RD_RC = 0, RD_RS = 2048, RD_CC = 4096, RD_CS = 4608, RG_RC = 5120, RG_RS = 9216, RG_CC = 13312, RG_CS = 14336, ROPE_N = 15360;

struct Params { const float* in[25]; float* out; unsigned char* ws; };
enum { I_X = 0, I_C, I_CTX, I_CCTX, I_WMOD, I_BMOD, I_GN1, I_GN2, I_WIN, I_WOUT, I_WFNET, I_LQ1, I_LK1, I_LQ2, I_LK2, I_GSUB, I_GQ, I_GK, I_WR, I_BR, I_WGU, I_BGU, I_WDN, I_BDN, I_GFIN };

__device__ __forceinline__ unsigned pk2(float lo, float hi) { f32x2 v = {lo, hi}; bf16x2_t b = __builtin_convertvector(v, bf16x2_t); return __builtin_bit_cast(unsigned, b); }
__device__ __forceinline__ float bf2f(unsigned short u) { return __builtin_bit_cast(float, (unsigned)u << 16); }
__device__ __forceinline__ float bflo(unsigned u) { return __builtin_bit_cast(float, u << 16); }
__device__ __forceinline__ float bfhi(unsigned u) { return __builtin_bit_cast(float, u & 0xffff0000u); }
#define WAITV(n) asm volatile("s_waitcnt vmcnt(" #n ")" ::: "memory")
#define BAR_SYNC() do { asm volatile("s_waitcnt lgkmcnt(0)" ::: "memory"); __builtin_amdgcn_s_barrier(); asm volatile("" ::: "memory"); } while (0)
__device__ __forceinline__ void dma16(const void* g, LAS void* l) { __builtin_amdgcn_global_load_lds((const unsigned*)g, (LAS unsigned*)l, 16, 0, 0); }
__device__ __forceinline__ void glds16(const void* gsrc, unsigned lds_dst) { unsigned keep;
    asm volatile("s_mov_b32 %0, m0\n\ts_mov_b32 m0, %2\n\ts_nop 0\n\tglobal_load_lds_dwordx4 %1, off\n\ts_mov_b32 m0, %0" : "=&s"(keep) : "v"(gsrc), "s"(lds_dst) : "memory"); }
__device__ __forceinline__ s16x4 vtr(LAS const char* p) { return __builtin_bit_cast(s16x4, __builtin_amdgcn_ds_read_tr16_b64_v4i16((LAS v4i16_t*)p)); }
__device__ __forceinline__ int lane_now() { unsigned z = 0u; asm volatile("" : "+v"(z)); return (int)__builtin_amdgcn_mbcnt_hi(~0u, __builtin_amdgcn_mbcnt_lo(~0u, z)); }
template <int M> __device__ __forceinline__ float shxc(float v) { return __builtin_bit_cast(float, __builtin_amdgcn_ds_bpermute((lane_now() ^ M) << 2, __builtin_bit_cast(int, v))); }
__device__ __forceinline__ float add32(float v) { return v + shxc<32>(v); }
__device__ __forceinline__ float max32(float v) { return fmaxf(v, shxc<32>(v)); }
__device__ __forceinline__ float partner32(float v, bool upper) { return shxc<32>(v); }
template <int CTRL, int ROWMASK, bool BC> __device__ __forceinline__ float dppf(float old, float src) {
    return __builtin_bit_cast(float, __builtin_amdgcn_update_dpp(__builtin_bit_cast(int, old), __builtin_bit_cast(int, src), CTRL, ROWMASK, 0xf, BC)); }
__device__ __forceinline__ float wave_sum(float v) {
    v += dppf<0x111, 0xf, true>(0.f, v); v += dppf<0x112, 0xf, true>(0.f, v); v += dppf<0x114, 0xf, true>(0.f, v); v += dppf<0x118, 0xf, true>(0.f, v);
    v += dppf<0x142, 0xa, false>(0.f, v); v += dppf<0x143, 0xc, false>(0.f, v);
    return __builtin_bit_cast(float, __builtin_amdgcn_readlane(__builtin_bit_cast(int, v), 63)); }
__device__ __forceinline__ float wave_max(float v) {
    v = fmaxf(v, dppf<0x111, 0xf, false>(v, v)); v = fmaxf(v, dppf<0x112, 0xf, false>(v, v)); v = fmaxf(v, dppf<0x114, 0xf, false>(v, v)); v = fmaxf(v, dppf<0x118, 0xf, false>(v, v));
    v = fmaxf(v, dppf<0x142, 0xa, false>(v, v)); v = fmaxf(v, dppf<0x143, 0xc, false>(v, v));
    return __builtin_bit_cast(float, __builtin_amdgcn_readlane(__builtin_bit_cast(int, v), 63)); }
__device__ __forceinline__ bf16x8 pack8(float a0, float a1, float a2, float a3, float a4, float a5, float a6, float a7) {
    u32x4 w = {pk2(a0, a1), pk2(a2, a3), pk2(a4, a5), pk2(a6, a7)}; return __builtin_bit_cast(bf16x8, w); }
#define MFMA(a, b, c) __builtin_amdgcn_mfma_f32_32x32x16_bf16((a), (b), (c), 0, 0, 0)

#define XB_TMO      128
#define XB_XCNT(j)  (256  + 64 * (j))
#define XB_XSUB(j)  (1280 + 64 * (j))
#define XB_XGEN(j)  (2304 + 64 * (j))
#define XB_TOP      3328
#define XB_TOPGEN   3392
#define XCD_BAR_WORDS 3456
#define XB_SPIN_CAP (1u << 22)
__device__ __forceinline__ unsigned xb_ld(unsigned* p)              { return __hip_atomic_load(p, __ATOMIC_RELAXED, __HIP_MEMORY_SCOPE_AGENT); }
__device__ __forceinline__ unsigned xb_add(unsigned* p, unsigned v) { return __hip_atomic_fetch_add(p, v, __ATOMIC_RELAXED, __HIP_MEMORY_SCOPE_AGENT); }
__device__ __forceinline__ unsigned xb_xcc_id() { return (unsigned)__builtin_amdgcn_s_getreg((3 << 11) | 20) & 0xFu; }
#define XB_SPIN(cond, bar) do { unsigned _sp = 0; while (cond) { __builtin_amdgcn_s_sleep(1); \
    if ((++_sp & 255u) == 0u) { if (xb_ld(&(bar)[XB_TMO])) break; if (_sp > XB_SPIN_CAP) { atomicAdd(&(bar)[XB_TMO], 1u); break; } } } } while (0)
struct XcdBarrier { unsigned* bar; unsigned x; volatile LAS unsigned* st; int wid; };
__device__ __forceinline__ bool xb_leader(int wid) { unsigned z = 0u; asm volatile("" : "+v"(z)); return wid == 0 && __builtin_amdgcn_mbcnt_hi(~0u, __builtin_amdgcn_mbcnt_lo(~0u, z)) == 0u; }
__device__ __forceinline__ XcdBarrier xcd_barrier_post(unsigned* bar, volatile LAS unsigned* st, int wid) {
    XcdBarrier b; b.bar = bar; b.x = xb_xcc_id(); b.st = st; b.wid = wid;
    if (xb_leader(wid)) (void)xb_add(&bar[XB_XCNT(b.x)], 1u);
    return b;
}
__device__ __forceinline__ void xcd_barrier_complete(unsigned* bar, unsigned x, unsigned& nloc, unsigned& nx) {
    const unsigned G = gridDim.x * gridDim.y * gridDim.z;
    unsigned sum, cnt, mine, sp = 0u;
    for (;;) {
        sum = 0u; cnt = 0u; mine = 0u;
#pragma unroll
        for (unsigned j = 0; j < 16; ++j) { const unsigned c = xb_ld(&bar[XB_XCNT(j)]); sum += c; cnt += (c > 0u) ? 1u : 0u; }
        mine = xb_ld(&bar[XB_XCNT(x)]);
        if (sum == G) break;
        __builtin_amdgcn_s_sleep(1);
        if ((++sp & 255u) == 0u) { if (xb_ld(&bar[XB_TMO])) break; if (sp > XB_SPIN_CAP) { atomicAdd(&bar[XB_TMO], 1u); break; } }
    }
    nloc = mine > 0u ? mine : 1u; nx = cnt > 0u ? cnt : 1u;
}
__device__ __forceinline__ void xcd_barrier(const XcdBarrier& b) {
    asm volatile("s_waitcnt vmcnt(0)" ::: "memory");
    __syncthreads();
    if (xb_leader(b.wid)) {
        unsigned* bar = b.bar;
        __builtin_amdgcn_s_waitcnt(0);
        unsigned nloc = b.st[0], nx = b.st[1];
        if (nloc == 0u) { xcd_barrier_complete(bar, b.x, nloc, nx); b.st[0] = nloc; b.st[1] = nx; }
        const unsigned old = xb_add(&bar[XB_XSUB(b.x)], 1u);
        const unsigned gen = old / nloc;
        if (old + 1u == (gen + 1u) * nloc) {
            __builtin_amdgcn_fence(__ATOMIC_RELEASE, "agent");
            asm volatile("s_waitcnt vmcnt(0)" ::: "memory");
            const unsigned og = xb_add(&bar[XB_TOP], 1u);
            const unsigned tg = og / nx;
            if (og + 1u == (tg + 1u) * nx) xb_add(&bar[XB_TOPGEN], 1u);
            else XB_SPIN(xb_ld(&bar[XB_TOPGEN]) == tg, bar);
            __builtin_amdgcn_fence(__ATOMIC_ACQUIRE, "agent");
            xb_add(&bar[XB_XGEN(b.x)], 1u);
            asm volatile("s_waitcnt vmcnt(0)" ::: "memory");
        } else {
            XB_SPIN(xb_ld(&bar[XB_XGEN(b.x)]) == gen, bar);
            __builtin_amdgcn_fence(__ATOMIC_ACQUIRE, "agent");
            asm volatile("s_waitcnt vmcnt(0)" ::: "memory");
        }
    }
    __syncthreads();
}

struct Frame {
    const __attribute__((address_space(4))) Params* pp; unsigned char* wsb; LAS char* lds; int tid, lane, wid, G, bid;
    unsigned* ctl;
    __device__ __forceinline__ const float* in(int i) const { return pp->in[i]; }
    __device__ __forceinline__ float* outp() const { return pp->out; }
    template <class T> __device__ __forceinline__ T* ws(size_t off) const { return (T*)(wsb + off); }
};

template <class RowMap>
__device__ __forceinline__ void transpose_tile(const Frame& F, const float* __restrict__ src, int ldn, int k0, int n0, bf16_t* dst, int ldk, int kdst0, const RowMap& rm) {
    LAS float* tile = (LAS float*)F.lds;
    const int t = F.tid;
    f32x4 v[8];
#pragma unroll
    for (int i = 0; i < 8; ++i) { const int idx = t + 512 * i, k = idx >> 6, c4 = idx & 63; v[i] = *(const f32x4*)(src + (size_t)(k0 + k) * ldn + n0 + 4 * c4); }
#pragma unroll
    for (int i = 0; i < 8; ++i) { const int idx = t + 512 * i, k = idx >> 6, c4 = idx & 63; *(LAS f32x4*)(tile + k * 260 + 4 * c4) = v[i]; }
    __syncthreads();
    { const int n = t >> 1, kh = t & 1; bf16_t* d = dst + (size_t)rm(n0 + n) * ldk + kdst0 + 32 * kh;
#pragma unroll
      for (int q = 0; q < 4; ++q) { float a[8];
#pragma unroll
          for (int j = 0; j < 8; ++j) a[j] = tile[(32 * kh + 8 * q + j) * 260 + n];
          u32x4 w = {pk2(a[0], a[1]), pk2(a[2], a[3]), pk2(a[4], a[5]), pk2(a[6], a[7])}; *(u32x4*)(d + 8 * q) = w; } }
    __syncthreads();
}
struct RowId { __device__ __forceinline__ int operator()(int n) const { return n; } };
struct RowGU { __device__ __forceinline__ int operator()(int n) const { const int ri = n >> 10, j = n & 1023; return 64 * (j >> 5) + 32 * ri + (j & 31); } };

constexpr int P0_GEMV = 192, P0_FOLD = 128, P0_TAB = 16;
constexpr int P0_TWIN = 2 * 16 * 8, P0_TWOUT = 2 * 12 * 4, P0_TWGU = 2 * 32 * 16 * 8, P0_TWDN = 2 * 32 * 16 * 4;
constexpr int P0_ITEMS = P0_GEMV + P0_FOLD + P0_TAB + P0_TWIN + P0_TWOUT + P0_TWGU + P0_TWDN;

__device__ __forceinline__ void p0_gemv(const Frame& F, int item) {
    const int l = item / 96, cc = item % 96, t = F.tid, lane = F.lane, w = F.wid;
    LAS float* sc = (LAS float*)F.lds;
    LAS float* red = sc + 2048;
    const float* c = F.in(I_C); const float* cx = F.in(I_CCTX);
#pragma unroll
    for (int i = 0; i < 2; ++i) { const int k = t + 512 * i; const float a = c[k], b = cx[k]; sc[k] = a / (1.f + __expf(-a)); sc[1024 + k] = b / (1.f + __expf(-b)); }
    __syncthreads();
    const int col = 64 * cc + lane; const float* wm = F.in(I_WMOD) + (size_t)l * 1024 * 6144 + col;
    float a1 = 0.f, a2 = 0.f;
#pragma unroll 8
    for (int k = 128 * w; k < 128 * w + 128; ++k) { const float wv = wm[(size_t)k * 6144]; a1 += sc[k] * wv; a2 += sc[1024 + k] * wv; }
    red[w * 64 + lane] = a1; red[512 + w * 64 + lane] = a2;
    __syncthreads();
    if (w == 0) { float s1 = 0.f, s2 = 0.f;
#pragma unroll
        for (int j = 0; j < 8; ++j) { s1 += red[j * 64 + lane]; s2 += red[512 + j * 64 + lane]; }
        const float b = F.in(I_BMOD)[l * 6144 + col]; float* mod = F.ws<float>(WS_MOD) + (size_t)l * 2 * 6144;
        mod[col] = s1 + b; mod[6144 + col] = s2 + b; }
    __syncthreads();
}
__device__ __forceinline__ void p0_fold(const Frame& F, int item) {
    const int nch = item & 7, g = (item >> 3) & 3, ri = (item >> 5) & 1, l = item >> 6, t = F.tid;
    LAS float* Mx = (LAS float*)F.lds;
    LAS float* wf = Mx + 64 * 65;
    const float* wfn = F.in(I_WFNET) + (size_t)(l * 4 + g) * 4096;
    for (int i = t; i < 4096; i += 512) wf[(i >> 6) * 65 + (i & 63)] = wfn[i];
    __syncthreads();
    for (int i = t; i < 4096; i += 512) { const int c = i >> 6, e = i & 63; float s = 0.f;
        for (int m = 0; m < 64; ++m) { float sn, cs; sincospif(2.f * (float)((m * c) & 63) / 64.f, &sn, &cs); s += (ri ? sn : cs) * wf[m * 65 + e]; }
        Mx[c * 65 + e] = s; }
    __syncthreads();
    const float* wo = F.in(I_WOUT) + (size_t)l * 1024 * 1024 + (size_t)(64 * g) * 1024;
    bf16_t* dst = F.ws<bf16_t>(WS_WOUT) + (size_t)l * DM * MIXK;
    { const int n = nch * 128 + (t & 127), c0 = (t >> 7) * 16; float acc[16];
#pragma unroll
      for (int j = 0; j < 16; ++j) acc[j] = 0.f;
      for (int e = 0; e < 64; ++e) { const float wv = wo[(size_t)e * 1024 + n];
#pragma unroll
          for (int j = 0; j < 16; ++j) acc[j] += Mx[(c0 + j) * 65 + e] * wv; }
      u32x4 w0 = {pk2(acc[0], acc[1]), pk2(acc[2], acc[3]), pk2(acc[4], acc[5]), pk2(acc[6], acc[7])};
      u32x4 w1 = {pk2(acc[8], acc[9]), pk2(acc[10], acc[11]), pk2(acc[12], acc[13]), pk2(acc[14], acc[15])};
      bf16_t* d = dst + (size_t)n * MIXK + 256 * ri + 64 * g + c0; *(u32x4*)d = w0; *(u32x4*)(d + 8) = w1; }
    __syncthreads();
}
__device__ __forceinline__ void p0_tables(const Frame& F, int item) {
    constexpr int N0 = ROPE_N, N1 = N0 + 16384, N2 = N1 + 32768, N3 = N2 + 65536, N4 = N3 + 131072;
    float* rope = F.ws<float>(WS_ROPE); f32x2* tw = F.ws<f32x2>(WS_TW);
    bf16_t* a1 = F.ws<bf16_t>(WS_A1F); bf16_t* a2 = F.ws<bf16_t>(WS_A2F); bf16_t* ac = F.ws<bf16_t>(WS_ACF);
    for (int idx = item * 512 + F.tid; idx < N4; idx += P0_TAB * 512) {
        if (idx < N0) {
            int i = idx; bool isg = false; if (i >= RG_RC) { isg = true; i -= RG_RC; }
            const int n = isg ? 16 : 8, rowsz = 256 * n, colsz = 64 * n;
            int which, pos, fi;
            if (i < rowsz) { which = 0; pos = i / n; fi = i % n; } else if (i < 2 * rowsz) { which = 1; i -= rowsz; pos = i / n; fi = i % n; }
            else if (i < 2 * rowsz + colsz) { which = 2; i -= 2 * rowsz; pos = i / n; fi = i % n; } else { which = 3; i -= 2 * rowsz + colsz; pos = i / n; fi = i % n; }
            const float inv = powf(10000.f, -(float)fi / (float)n); const float ang = (float)pos * inv;
            rope[idx] = (which & 1) ? sinf(ang) : cosf(ang);
        } else if (idx < N1) { const int j = idx - N0; float sn, cs; sincospif(2.f * (float)j / 16384.f, &sn, &cs); tw[j] = (f32x2){cs, sn};
        } else if (idx < N2) { const int e = idx - N1; const int j = e & 7, ln = (e >> 3) & 63, s = (e >> 9) & 7, fb = (e >> 12) & 1, rg = e >> 13;
            const int k1 = 32 * rg + (ln & 31), l1 = 16 * s + 8 * (ln >> 5) + j; float sn, cs; sincospif(2.f * (float)((k1 * l1) & 127) / 128.f, &sn, &cs);
            a1[e] = (bf16_t)(pk2(fb ? -sn : cs, 0.f) & 0xffff);
        } else if (idx < N3) { const int e = idx - N2; const int j = e & 7, ln = (e >> 3) & 63, s = (e >> 9) & 15, fb = (e >> 13) & 1, rg = e >> 14;
            const int k2 = 32 * rg + (ln & 31), kk = 16 * s + 8 * (ln >> 5) + j, l2 = kk >> 1, rip = kk & 1; float sn, cs; sincospif(2.f * (float)((k2 * l2) & 127) / 128.f, &sn, &cs);
            const float v = fb == 0 ? (rip == 0 ? cs : sn) : (rip == 0 ? -sn : cs);
            a2[e] = (bf16_t)(pk2(v, 0.f) & 0xffff);
        } else { const int e = idx - N3; const int j = e & 7, ln = (e >> 3) & 63, s = (e >> 9) & 15, fb = (e >> 13) & 1, rg = (e >> 14) & 3, pa = e >> 16;
            const int k = 128 * pa + 32 * rg + (ln & 31), li = 16 * s + 8 * (ln >> 5) + j; float sn, cs; sincospif(2.f * (float)((k * li) & 255) / 256.f, &sn, &cs);
            ac[e] = (bf16_t)(pk2(fb ? -sn : cs, 0.f) & 0xffff); }
    }
}
__device__ __forceinline__ void phase_prologue(const Frame& F) {
    LAS unsigned* qw = (LAS unsigned*)(F.lds + LDS_CTL + 64);
    unsigned nxt = 0u; if (F.tid == 0) nxt = xb_add(F.ctl + CW_QH + 32, 1u);
    for (;;) {
        __syncthreads();
        if (F.tid == 0) *qw = nxt;
        __syncthreads();
        const int it = (int)*qw; if (it >= P0_ITEMS) break;
        if (F.tid == 0) nxt = xb_add(F.ctl + CW_QH + 32, 1u);
        int i = it;
        if (i < P0_GEMV) { p0_gemv(F, i); continue; } i -= P0_GEMV;
        if (i < P0_FOLD) { p0_fold(F, i); continue; } i -= P0_FOLD;
        if (i < P0_TAB) { p0_tables(F, i); continue; } i -= P0_TAB;
        if (i < P0_TWIN) { const int l = i / 128, r = i % 128, kt = r / 8, nt = r % 8;
            transpose_tile(F, F.in(I_WIN) + (size_t)l * DM * INW, INW, 64 * kt, 256 * nt, F.ws<bf16_t>(WS_WIN) + (size_t)l * INW * DM, DM, 64 * kt, RowId()); continue; } i -= P0_TWIN;
        if (i < P0_TWOUT) { const int l = i / 48, r = i % 48, kt = r / 4, nt = r % 4;
            transpose_tile(F, F.in(I_WOUT) + (size_t)l * DM * DM, DM, 256 + 64 * kt, 256 * nt, F.ws<bf16_t>(WS_WOUT) + (size_t)l * DM * MIXK, MIXK, 512 + 64 * kt, RowId()); continue; } i -= P0_TWOUT;
        if (i < P0_TWGU) { const int le = i / 128, r = i % 128, kt = r / 8, nt = r % 8;
            transpose_tile(F, F.in(I_WGU) + (size_t)le * DM * 2048, 2048, 64 * kt, 256 * nt, F.ws<bf16_t>(WS_WGU) + (size_t)le * 2048 * DM, DM, 64 * kt, RowGU()); continue; } i -= P0_TWGU;
        { const int le = i / 64, r = i % 64, kt = r / 4, nt = r % 4;
            transpose_tile(F, F.in(I_WDN) + (size_t)le * FFD * DM, DM, 64 * kt, 256 * nt, F.ws<bf16_t>(WS_WDN) + (size_t)le * DM * FFD, FFD, 64 * kt, RowId()); }
    }
}

__device__ __forceinline__ void load_row(const float* row, int lane, f32x4 (&x)[4]) {
#pragma unroll
    for (int q = 0; q < 4; ++q) x[q] = *(const f32x4*)(row + 256 * q + 4 * lane);
}
__device__ __forceinline__ float row_rstd(const f32x4 (&x)[4], float eps) {
    float ss = 0.f;
#pragma unroll
    for (int q = 0; q < 4; ++q) ss += x[q][0] * x[q][0] + x[q][1] * x[q][1] + x[q][2] * x[q][2] + x[q][3] * x[q][3];
    ss = wave_sum(ss); return rsqrtf(ss * (1.f / 1024.f) + eps);
}
__device__ __forceinline__ void mod_store_bf16(const f32x4 (&x)[4], float rstd, const float* __restrict__ g, const float* __restrict__ shift, const float* __restrict__ scale, bf16_t* __restrict__ dst, int lane, f32x4 (*hout)[4] = nullptr) {
    f32x4 gv[4], sh[4], sc[4];
#pragma unroll
    for (int q = 0; q < 4; ++q) { const int k = 256 * q + 4 * lane; gv[q] = *(const f32x4*)(g + k); sh[q] = *(const f32x4*)(shift + k); sc[q] = *(const f32x4*)(scale + k); }
    __builtin_amdgcn_sched_barrier(0);
#pragma unroll
    for (int q = 0; q < 4; ++q) { const int k = 256 * q + 4 * lane;
        f32x4 hv;
#pragma unroll
        for (int i = 0; i < 4; ++i) hv[i] = (x[q][i] * rstd * gv[q][i]) * (1.f + sc[q][i]) + sh[q][i];
        u32x2 w = {pk2(hv[0], hv[1]), pk2(hv[2], hv[3])}; *(u32x2*)(dst + k) = w;
        if (hout) (*hout)[q] = hv; }
}
__device__ __forceinline__ void phase_norm0(const Frame& F) {
    const float* mod = F.ws<float>(WS_MOD); bf16_t* hb = F.ws<bf16_t>(WS_HB); const float* g1 = F.in(I_GN1);
    const float* xc = F.in(I_CTX); const float* xl = F.in(I_X);
    for (int R = F.bid * 8 + F.wid; R < NT; R += F.G * 8) {
        const float* row = R < NCTX ? xc + (size_t)R * DM : xl + (size_t)(R - NCTX) * DM;
        const float* m = mod + (R < NCTX ? 6144 : 0);
        f32x4 x[4]; load_row(row, F.lane, x); const float rstd = row_rstd(x, 1e-6f);
        mod_store_bf16(x, rstd, g1, m, m + 1024, hb + (size_t)R * DM, F.lane);
    }
}

#define MFMA16(a, b, c) __builtin_amdgcn_mfma_f32_16x16x32_bf16((a), (b), (c), 0, 0, 0)
__device__ __forceinline__ int lds_byte(int r, int c) { const int st = (r >> 4) * 2 + (c >> 5), rr = r & 15, cc = c & 31, ob = rr * 64 + cc * 2; return st * 1024 + (ob ^ (((ob >> 9) & 1) << 5)); }
__device__ __forceinline__ void stage_rc(int b, int& R, int& C) { const int st = b / 1024, sb = b % 1024, swz = sb ^ (((sb >> 9) & 1) << 5); R = (st >> 1) * 16 + swz / 64; C = (st & 1) * 32 + (swz % 64) / 2; }
struct EpiC { f32x4 c[4]; };
struct EpiT { f32x4 t[4]; };
template <class XRow, class Epi>
__device__ __forceinline__ void gemm8(const Frame& F, const bf16_t* __restrict__ A, int K, int brow, const XRow& xrow, const Epi& epi) {
    constexpr int HTB = 16384;
    LAS char* shm = F.lds;
    const int tz = F.tid, wid = F.wid, lane = tz & 63, wr = wid >> 2, wc = wid & 3, fr = lane & 15, fq = lane >> 4;
    unsigned aoff[2]; const bf16_t* xp[2][2];
#pragma unroll
    for (int i = 0; i < 2; ++i) { int r, c; stage_rc(tz * 16 + i * 8192, r, c); aoff[i] = (unsigned)(r * K + c); xp[0][i] = xrow(r) + c; xp[1][i] = xrow(128 + r) + c; }
    const bf16_t* Ab = A + (size_t)brow * K; const size_t hstepA = (size_t)128 * K;
    const int ldsw = wid * 1024;
    const int aoffl = lds_byte(wr * 64 + fr, fq * 8), boffl = lds_byte(wc * 32 + fr, fq * 8);
#define SA(b, h) (shm + ((b) * 2 + (h)) * HTB)
#define SB(b, h) (shm + (4 + (b) * 2 + (h)) * HTB)
#define STAGE_A(b, h, kt) do { _Pragma("unroll") for (int i_ = 0; i_ < 2; ++i_) dma16(Ab + (h) * hstepA + aoff[i_] + (size_t)(kt) * 64, SA(b, h) + ldsw + i_ * 8192); } while (0)
#define STAGE_B(b, h, kt) do { _Pragma("unroll") for (int i_ = 0; i_ < 2; ++i_) dma16(xp[h][i_] + (size_t)(kt) * 64, SB(b, h) + ldsw + i_ * 8192); } while (0)
#define LDA(dst, b, h) do { _Pragma("unroll") for (int m = 0; m < 4; ++m) _Pragma("unroll") for (int k = 0; k < 2; ++k) dst[m][k] = *(LAS const bf16x8*)(SA(b, h) + aoffl + m * 2048 + k * 1024); } while (0)
#define LDB(dst, b, h) do { _Pragma("unroll") for (int n = 0; n < 2; ++n) _Pragma("unroll") for (int k = 0; k < 2; ++k) dst[n][k] = *(LAS const bf16x8*)(SB(b, h) + boffl + n * 2048 + k * 1024); } while (0)
#define MMA(ai, bj, At_, Bt_) do { __builtin_amdgcn_s_setprio(1); _Pragma("unroll") for (int m = 0; m < 4; ++m) _Pragma("unroll") for (int n = 0; n < 2; ++n) _Pragma("unroll") for (int k = 0; k < 2; ++k) \
        acc[ai][bj][m][n] = MFMA16(At_[m][k], Bt_[n][k], acc[ai][bj][m][n]); __builtin_amdgcn_s_setprio(0); } while (0)
#define WAIT_V(n) asm volatile("s_waitcnt vmcnt(" #n ")" ::: "memory")
#define WAIT_L(n) asm volatile("s_waitcnt lgkmcnt(" #n ")" ::: "memory")
#define BAR __builtin_amdgcn_s_barrier()
#define SCHED __builtin_amdgcn_sched_barrier(0)
    f32x4 acc[2][2][4][2];
#pragma unroll
    for (int a = 0; a < 2; ++a)
#pragma unroll
        for (int b = 0; b < 2; ++b)
#pragma unroll
            for (int m = 0; m < 4; ++m)
#pragma unroll
                for (int n = 0; n < 2; ++n) acc[a][b][m][n] = (f32x4){0.f, 0.f, 0.f, 0.f};
    bf16x8 At[4][2], B0[2][2], B1[2][2];
    const int nt = K / 64;
    WAIT_L(0); BAR;
    STAGE_B(0, 0, 0); STAGE_B(0, 1, 0); STAGE_A(0, 0, 0); STAGE_A(0, 1, 0);
    if (wr == 1) BAR;
    WAIT_V(2); BAR;
    STAGE_B(1, 0, 1); STAGE_A(1, 0, 1); STAGE_B(1, 1, 1);
    WAIT_V(6); BAR;
#pragma unroll 1
    for (int t = 0; t < nt; t += 2) {
        const int k2 = (t == nt - 2) ? 0 : t + 2;
        LDB(B0, 0, 0); LDB(B1, 0, 1); SCHED; LDA(At, 0, 0); STAGE_A(1, 1, t + 1);
        WAIT_V(8); WAIT_L(0); BAR; MMA(0, 0, At, B0); MMA(0, 1, At, B1); BAR; SCHED;
        LDA(At, 0, 1); STAGE_B(0, 0, k2); STAGE_B(0, 1, k2); STAGE_A(0, 0, k2);
        WAIT_V(8); WAIT_L(0); BAR; MMA(1, 0, At, B0); MMA(1, 1, At, B1); BAR; SCHED;
        LDB(B0, 1, 0); LDB(B1, 1, 1); SCHED; LDA(At, 1, 0); STAGE_A(0, 1, k2);
        WAIT_V(8); WAIT_L(0); BAR; MMA(0, 0, At, B0); MMA(0, 1, At, B1); BAR; SCHED;
        LDA(At, 1, 1); STAGE_B(1, 0, k2 + 1); STAGE_B(1, 1, k2 + 1); STAGE_A(1, 0, k2 + 1);
        WAIT_V(8); WAIT_L(0); BAR; MMA(1, 0, At, B0); MMA(1, 1, At, B1); BAR; SCHED;
    }
    WAIT_V(0);
    if (wr == 0) BAR;
    BAR;
#undef SA
#undef SB
#undef STAGE_A
#undef STAGE_B
#undef LDA
#undef LDB
#undef MMA
#undef WAIT_V
#undef WAIT_L
#undef BAR
#undef SCHED
    int tq = F.tid; asm volatile("" : "+v"(tq)); const int fr2 = tq & 15, fq2 = (tq >> 4) & 3;
#pragma unroll
    for (int ai = 0; ai < 2; ++ai) { const int cg = (brow >> 6) + 2 * ai + wr;
        const EpiC C = epi.load_c(cg, fq2);
        EpiT T = epi.load_t(cg, wc * 32 + fr2, fq2);
#pragma unroll
        for (int c = 0; c < 4; ++c) { const int bj = c >> 1, n = c & 1; const int tok = bj * 128 + wc * 32 + n * 16 + fr2;
            EpiT Tn = T; if (c < 3) Tn = epi.load_t(cg, ((c + 1) >> 1) * 128 + wc * 32 + ((c + 1) & 1) * 16 + fr2, fq2);
            f32x4 v[4] = {acc[ai][bj][0][n], acc[ai][bj][1][n], acc[ai][bj][2][n], acc[ai][bj][3][n]};
            epi.apply(v, cg, tok, fq2, C, T); T = Tn; } }
}

__device__ __forceinline__ u32x2 pk4(const f32x4& v) { return (u32x2){pk2(v[0], v[1]), pk2(v[2], v[3])}; }
struct EpiInProj {
    const Frame& F; int l, t0;
    __device__ __forceinline__ EpiC load_c(int cg, int fq) const { EpiC C;
#pragma unroll
        for (int m = 0; m < 4; ++m) C.c[m] = (f32x4){0.f, 0.f, 0.f, 0.f};
        if (cg >= 22 && cg < 30) { const float* gw = (cg < 28 ? F.in(I_GQ) : F.in(I_GK)) + 64 * l;
#pragma unroll
            for (int m = 0; m < 4; ++m) C.c[m] = *(const f32x4*)(gw + 16 * m + 4 * fq); }
        return C; }
    __device__ __forceinline__ EpiT load_t(int cg, int tok, int fq) const { EpiT T;
#pragma unroll
        for (int m = 0; m < 4; ++m) T.t[m] = (f32x4){0.f, 0.f, 0.f, 0.f};
        const int R = t0 + tok; const int t = R - NCTX; const int prow = (t >> 6) & 255, pcol = t & 63; const float* const rope = F.ws<float>(WS_ROPE);
        if (R >= NCTX) {
            if (cg >= 4 && cg < 16) { const int ti = fq < 2 ? RD_RC + prow * 8 + 4 * fq : RD_CC + pcol * 8 + 4 * (fq - 2), si = fq < 2 ? RD_RS + prow * 8 + 4 * fq : RD_CS + pcol * 8 + 4 * (fq - 2);
                T.t[0] = *(const f32x4*)(rope + ti); T.t[1] = *(const f32x4*)(rope + si); }
            else if (cg >= 22 && cg < 30) { T.t[0] = *(const f32x4*)(rope + RG_RC + prow * 16 + 4 * fq); T.t[1] = *(const f32x4*)(rope + RG_RS + prow * 16 + 4 * fq);
                T.t[2] = *(const f32x4*)(rope + RG_CC + pcol * 16 + 4 * fq); T.t[3] = *(const f32x4*)(rope + RG_CS + pcol * 16 + 4 * fq); } }
        return T; }
    __device__ __forceinline__ void apply(f32x4 (&v)[4], int cg, int tok, int fq, const EpiC& C, const EpiT& T) const {
        bf16_t* const ft = F.ws<bf16_t>(WS_FT); bf16_t* const fc = F.ws<bf16_t>(WS_FC); bf16_t* const qd = F.ws<bf16_t>(WS_QD); bf16_t* const kd = F.ws<bf16_t>(WS_KD); bf16_t* const vd = F.ws<bf16_t>(WS_VD);
        bf16_t* const qg = F.ws<bf16_t>(WS_QG); bf16_t* const kg = F.ws<bf16_t>(WS_KG); bf16_t* const vg = F.ws<bf16_t>(WS_VG);
        unsigned* const kmax = F.ctl + CW_KMAX + 16 * l;
        const float QSD = 0.17677669529663687f * LOG2E, QSG = 0.125f * LOG2E;
        const int R = t0 + tok; const bool isctx = R < NCTX; const int t = R - NCTX;
        if (cg < 4) {
#pragma unroll
            for (int m = 0; m < 4; ++m) { const int ch = 64 * cg + 16 * m + 4 * fq; const u32x2 w = pk4(v[m]);
                if (isctx) { const size_t a = (size_t)(((ch >> 7) * 4 + ((ch >> 5) & 3)) * 8192 + (R >> 3) * 256 + (R & 7) * 32 + (ch & 31)); *(u32x2*)(fc + a) = w; }
                else { const int l1 = t >> 7, l2 = t & 127; const size_t a = (size_t)((l2 * 2 + (ch >> 7)) * 4 + ((ch >> 5) & 3)) * 4096 + (l1 >> 3) * 256 + (l1 & 7) * 32 + (ch & 31); *(u32x2*)(ft + a) = w; } }
        } else if (cg < 16) {
            const bool isq = cg < 10; const int head = isq ? cg - 4 : cg - 10;
            if (!isctx) { const f32x4 cc = T.t[0], sn = T.t[1];
#pragma unroll
                for (int mp = 0; mp < 2; ++mp)
#pragma unroll
                    for (int j = 0; j < 4; ++j) { const float a = v[2 * mp][j], b = v[2 * mp + 1][j]; v[2 * mp][j] = a * cc[j] - b * sn[j]; v[2 * mp + 1][j] = b * cc[j] + a * sn[j]; } }
            if (isq) {
#pragma unroll
                for (int m = 0; m < 4; ++m) { const f32x4 s = v[m] * QSD;
                    const size_t a = ((((size_t)(head * NQB + (R >> 5)) * 2 + (m >> 1)) * 4 + 2 * (m & 1) + (fq >> 1)) * 32 + (R & 31)) * 8 + 4 * (fq & 1); *(u32x2*)(qd + a) = pk4(s); }
            } else {
                float ss0 = 0.f, ss1 = 0.f;
#pragma unroll
                for (int j = 0; j < 4; ++j) { ss0 += v[0][j] * v[0][j] + v[1][j] * v[1][j]; ss1 += v[2][j] * v[2][j] + v[3][j] * v[3][j]; }
                ss0 += shxc<16>(ss0); ss1 += shxc<16>(ss1); ss0 = add32(ss0); ss1 = add32(ss1);
                ss0 = fmaxf(ss0, shxc<8>(ss0)); ss1 = fmaxf(ss1, shxc<8>(ss1)); ss0 = fmaxf(ss0, shxc<4>(ss0)); ss1 = fmaxf(ss1, shxc<4>(ss1));
                ss0 = fmaxf(ss0, shxc<2>(ss0)); ss1 = fmaxf(ss1, shxc<2>(ss1)); ss0 = fmaxf(ss0, shxc<1>(ss0)); ss1 = fmaxf(ss1, shxc<1>(ss1));
                if ((tok & 15) == 0 && fq == 0) { float* kp = F.ws<float>(WS_KP) + ((size_t)(l * 12 + 2 * head) * 64 + ((t0 >> 8) - 1)) * 16 + (tok >> 4); kp[0] = ss0; kp[1024] = ss1; }
#pragma unroll
                for (int m = 0; m < 4; ++m) {
                    const size_t a = ((((size_t)(head * NKT + (R >> 6)) * 2 + (m >> 1)) * 4 + 2 * (m & 1) + (fq >> 1)) * 64 + (R & 63)) * 8 + 4 * (fq & 1); *(u32x2*)(kd + a) = pk4(v[m]); }
            }
        } else if (cg < 22 || cg >= 30) {
            const bool isd = cg < 22; const int head = isd ? cg - 16 : cg - 30; bf16_t* vb = isd ? vd : vg;
#pragma unroll
            for (int m = 0; m < 4; ++m) {
                const size_t a = ((size_t)(head * NKT + (R >> 6)) * 2 + (m >> 1)) * 2048 + ((R & 63) >> 3) * 256 + (R & 7) * 32 + 16 * (m & 1) + 4 * fq; *(u32x2*)(vb + a) = pk4(v[m]); }
        } else {
            const bool isq = cg < 28; const int head = isq ? cg - 22 : cg - 28;
            float ss = 0.f;
#pragma unroll
            for (int m = 0; m < 4; ++m)
#pragma unroll
                for (int j = 0; j < 4; ++j) ss += v[m][j] * v[m][j];
            ss += shxc<16>(ss); ss = add32(ss); const float rs = rsqrtf(ss * (1.f / 64.f) + 1e-6f);
#pragma unroll
            for (int m = 0; m < 4; ++m) v[m] = v[m] * C.c[m] * rs;
            if (!isctx) { const f32x4 cr = T.t[0], sr = T.t[1], cc = T.t[2], sc = T.t[3];
#pragma unroll
                for (int j = 0; j < 4; ++j) { { const float a = v[0][j], b = v[2][j]; v[0][j] = a * cr[j] - b * sr[j]; v[2][j] = b * cr[j] + a * sr[j]; }
                    { const float a = v[1][j], b = v[3][j]; v[1][j] = a * cc[j] - b * sc[j]; v[3][j] = b * cc[j] + a * sc[j]; } } }
#pragma unroll
            for (int m = 0; m < 4; ++m) { const f32x4 s = isq ? v[m] * QSG : v[m]; const int c = 2 * m + (fq >> 1);
                if (isq) { const size_t a = (((size_t)(head * NQB + (R >> 5)) * 8 + c) * 32 + (R & 31)) * 8 + 4 * (fq & 1); *(u32x2*)(qg + a) = pk4(s); }
                else { const size_t a = (((size_t)(head * NKT + (R >> 6)) * 8 + c) * 64 + (R & 63)) * 8 + 4 * (fq & 1); *(u32x2*)(kg + a) = pk4(s); } }
        }
    }
};
struct EpiOutProj {
    const Frame& F; int l, t0;
    __device__ __forceinline__ const float* src_row(int R) const { return l == 0 ? (R < NCTX ? F.in(I_CTX) + (size_t)R * DM : F.in(I_X) + (size_t)(R - NCTX) * DM) : F.ws<float>(WS_XS) + (size_t)R * DM; }
    __device__ __forceinline__ EpiC load_c(int cg, int fq) const { EpiC C; const float* gt = F.ws<float>(WS_MOD) + (size_t)l * 2 * 6144 + (t0 < NCTX ? 6144 : 0) + 2048;
#pragma unroll
        for (int m = 0; m < 4; ++m) C.c[m] = *(const f32x4*)(gt + 64 * cg + 16 * m + 4 * fq);
        return C; }
    __device__ __forceinline__ EpiT load_t(int cg, int tok, int fq) const { EpiT T; const float* src = src_row(t0 + tok);
#pragma unroll
        for (int m = 0; m < 4; ++m) T.t[m] = *(const f32x4*)(src + 64 * cg + 16 * m + 4 * fq);
        return T; }
    __device__ __forceinline__ void apply(f32x4 (&v)[4], int cg, int tok, int fq, const EpiC& C, const EpiT& T) const {
        float* xs = F.ws<float>(WS_XS) + (size_t)(t0 + tok) * DM;
#pragma unroll
        for (int m = 0; m < 4; ++m) *(f32x4*)(xs + 64 * cg + 16 * m + 4 * fq) = T.t[m] + C.c[m] * v[m];
    }
};
struct EpiGateUp {
    const Frame& F; int le, m0, cnt, offs;
    __device__ __forceinline__ EpiC load_c(int cg, int fq) const { EpiC C; const float* bias = F.in(I_BGU) + (size_t)le * 2048 + 32 * cg + 4 * fq;
        C.c[0] = *(const f32x4*)(bias); C.c[1] = *(const f32x4*)(bias + 16); C.c[2] = *(const f32x4*)(bias + 1024); C.c[3] = *(const f32x4*)(bias + 1024 + 16); return C; }
    __device__ __forceinline__ EpiT load_t(int, int, int) const { EpiT T;
#pragma unroll
        for (int m = 0; m < 4; ++m) T.t[m] = (f32x4){0.f, 0.f, 0.f, 0.f};
        return T; }
    __device__ __forceinline__ void apply(f32x4 (&v)[4], int cg, int tok, int fq, const EpiC& C, const EpiT&) const {
        const int mt = m0 + tok; if (mt >= cnt) return;
        bf16_t* dst = F.ws<bf16_t>(WS_ACT) + (size_t)(offs + mt) * FFD;
#pragma unroll
        for (int m = 0; m < 2; ++m) { const int jj = 32 * cg + 16 * m + 4 * fq; f32x4 o;
#pragma unroll
            for (int j = 0; j < 4; ++j) { float gl = v[m][j] + C.c[m][j], li = v[m + 2][j] + C.c[2 + m][j]; gl = fminf(gl, 7.f); li = fminf(fmaxf(li, -7.f), 7.f);
                o[j] = gl * (1.f / (1.f + __expf(-1.702f * gl))) * (li + 1.f); }
            *(u32x2*)(dst + jj) = pk4(o); }
    }
};
struct EpiDown {
    const Frame& F; int le, m0, cnt, offs;
    __device__ __forceinline__ EpiC load_c(int cg, int fq) const { EpiC C; const float* bias = F.in(I_BDN) + (size_t)le * DM + 64 * cg + 4 * fq;
#pragma unroll
        for (int m = 0; m < 4; ++m) C.c[m] = *(const f32x4*)(bias + 16 * m);
        return C; }
    __device__ __forceinline__ EpiT load_t(int, int, int) const { EpiT T;
#pragma unroll
        for (int m = 0; m < 4; ++m) T.t[m] = (f32x4){0.f, 0.f, 0.f, 0.f};
        return T; }
    __device__ __forceinline__ void apply(f32x4 (&v)[4], int cg, int tok, int fq, const EpiC& C, const EpiT&) const {
        const int mt = m0 + tok; if (mt >= cnt) return;
        bf16_t* dst = F.ws<bf16_t>(WS_YB) + (size_t)(offs + mt) * DM;
#pragma unroll
        for (int m = 0; m < 4; ++m) *(u32x2*)(dst + 64 * cg + 16 * m + 4 * fq) = pk4(v[m] + C.c[m]);
    }
};
struct XDense { const bf16_t* X; int ld; int t0; __device__ __forceinline__ const bf16_t* operator()(int row) const { return X + (size_t)(t0 + row) * ld; } };
struct XGather { const bf16_t* X; const unsigned* list; int m0, cnt; __device__ __forceinline__ const bf16_t* operator()(int row) const { int m = m0 + row; m = m < cnt ? m : cnt - 1; return X + (size_t)list[m] * DM; } };
struct XAct { const bf16_t* X; int base, m0, cnt; __device__ __forceinline__ const bf16_t* operator()(int row) const { int m = m0 + row; m = m < cnt ? m : cnt - 1; return X + (size_t)(base + m) * FFD; } };

template <class Epi>
__device__ __forceinline__ void mini_unit(const Frame& F, const bf16_t* W, int ldw, int f0, const bf16_t* X, int ldx, int t0, int K, const Epi& epi) {
    const int lane = F.lane, wid = F.wid, r = lane & 31, h = lane >> 5; const int kw = K >> 3;
    const bf16_t* wp = W + (size_t)(f0 + r) * ldw + wid * kw + 8 * h; const bf16_t* xp = X + (size_t)(t0 + r) * ldx + wid * kw + 8 * h;
    f32x16 acc0, acc1;
#pragma unroll
    for (int i = 0; i < 16; ++i) { acc0[i] = 0.f; acc1[i] = 0.f; }
#pragma unroll 2
    for (int s = 0; s < (kw >> 4); ++s) { const bf16x8 w0 = *(const bf16x8*)(wp + 16 * s), w1 = *(const bf16x8*)(wp + (size_t)32 * ldw + 16 * s), xv = *(const bf16x8*)(xp + 16 * s);
        acc0 = MFMA(w0, xv, acc0); acc1 = MFMA(w1, xv, acc1); }
    BAR_SYNC();
    LAS float* red = (LAS float*)F.lds;
#pragma unroll
    for (int i = 0; i < 16; ++i) { red[(wid * 32 + i) * 64 + lane] = acc0[i]; red[(wid * 32 + 16 + i) * 64 + lane] = acc1[i]; }
    __syncthreads();
    LAS float* out = red + 8 * 32 * 64;
#pragma unroll
    for (int j = 0; j < 4; ++j) { const int rg = 4 * wid + j; float s = 0.f;
#pragma unroll
        for (int w = 0; w < 8; ++w) s += red[(w * 32 + rg) * 64 + lane];
        out[rg * 64 + lane] = s; }
    __syncthreads();
    if (wid == 0) {
#pragma unroll
        for (int i = 0; i < 16; ++i) { acc0[i] = out[i * 64 + lane]; acc1[i] = out[(16 + i) * 64 + lane]; }
        epi(acc0, acc1, f0 >> 6, t0 + r, h);
    }
}
struct EpiInProjCtx {
    const Frame& F; int l;
    __device__ __forceinline__ void operator()(f32x16& v0, f32x16& v1, int cg, int R, int h) const {
        const float QSD = 0.17677669529663687f * LOG2E, QSG = 0.125f * LOG2E;
        if (cg < 4) { bf16_t* fc = F.ws<bf16_t>(WS_FC);
#pragma unroll
            for (int fb = 0; fb < 2; ++fb)
#pragma unroll
                for (int g = 0; g < 4; ++g) { const f32x16& v = fb ? v1 : v0; const int ch = 64 * cg + 32 * fb + 8 * g + 4 * h;
                    const size_t a = (size_t)(((ch >> 7) * 4 + ((ch >> 5) & 3)) * 8192 + (R >> 3) * 256 + (R & 7) * 32 + (ch & 31)); *(u32x2*)(fc + a) = (u32x2){pk2(v[4 * g], v[4 * g + 1]), pk2(v[4 * g + 2], v[4 * g + 3])}; }
        } else if (cg < 16) { const bool isq = cg < 10; const int head = isq ? cg - 4 : cg - 10;
            if (isq) { bf16_t* qd = F.ws<bf16_t>(WS_QD);
#pragma unroll
                for (int fb = 0; fb < 2; ++fb)
#pragma unroll
                    for (int g = 0; g < 4; ++g) { const f32x16& v = fb ? v1 : v0;
                        const size_t a = ((((size_t)(head * NQB + (R >> 5)) * 2 + fb) * 4 + g) * 32 + (R & 31)) * 8 + 4 * h;
                        *(u32x2*)(qd + a) = (u32x2){pk2(v[4 * g] * QSD, v[4 * g + 1] * QSD), pk2(v[4 * g + 2] * QSD, v[4 * g + 3] * QSD)}; }
            } else { bf16_t* kd = F.ws<bf16_t>(WS_KD); unsigned* kmax = F.ctl + CW_KMAX + 16 * l;
                float ss0 = 0.f, ss1 = 0.f;
#pragma unroll
                for (int i = 0; i < 16; ++i) { ss0 += v0[i] * v0[i]; ss1 += v1[i] * v1[i]; }
                ss0 = add32(ss0); ss1 = add32(ss1); ss0 = wave_max(ss0); ss1 = wave_max(ss1);
                if (F.lane == 0) { atomicMax(kmax + 2 * head, __float_as_uint(ss0)); atomicMax(kmax + 2 * head + 1, __float_as_uint(ss1)); }
#pragma unroll
                for (int fb = 0; fb < 2; ++fb)
#pragma unroll
                    for (int g = 0; g < 4; ++g) { const f32x16& v = fb ? v1 : v0;
                        const size_t a = ((((size_t)(head * NKT + (R >> 6)) * 2 + fb) * 4 + g) * 64 + (R & 63)) * 8 + 4 * h;
                        *(u32x2*)(kd + a) = (u32x2){pk2(v[4 * g], v[4 * g + 1]), pk2(v[4 * g + 2], v[4 * g + 3])}; } }
        } else if (cg < 22 || cg >= 30) { const bool isd = cg < 22; const int head = isd ? cg - 16 : cg - 30; bf16_t* vb = isd ? F.ws<bf16_t>(WS_VD) : F.ws<bf16_t>(WS_VG);
#pragma unroll
            for (int fb = 0; fb < 2; ++fb)
#pragma unroll
                for (int g = 0; g < 4; ++g) { const f32x16& v = fb ? v1 : v0;
                    const size_t a = ((size_t)(head * NKT + (R >> 6)) * 2 + fb) * 2048 + ((R & 63) >> 3) * 256 + (R & 7) * 32 + 8 * g + 4 * h;
                    *(u32x2*)(vb + a) = (u32x2){pk2(v[4 * g], v[4 * g + 1]), pk2(v[4 * g + 2], v[4 * g + 3])}; }
        } else { const bool isq = cg < 28; const int head = isq ? cg - 22 : cg - 28; const float* gw = (isq ? F.in(I_GQ) : F.in(I_GK)) + 64 * l;
            float ss = 0.f;
#pragma unroll
            for (int i = 0; i < 16; ++i) ss += v0[i] * v0[i] + v1[i] * v1[i];
            ss = add32(ss); const float rs = rsqrtf(ss * (1.f / 64.f) + 1e-6f) * (isq ? QSG : 1.f);
#pragma unroll
            for (int fb = 0; fb < 2; ++fb)
#pragma unroll
                for (int g = 0; g < 4; ++g) { const f32x16& v = fb ? v1 : v0; const f32x4 gv = *(const f32x4*)(gw + 32 * fb + 8 * g + 4 * h);
                    const u32x2 w = {pk2(v[4 * g] * rs * gv[0], v[4 * g + 1] * rs * gv[1]), pk2(v[4 * g + 2] * rs * gv[2], v[4 * g + 3] * rs * gv[3])};
                    if (isq) { const size_t a = (((size_t)(head * NQB + (R >> 5)) * 8 + 4 * fb + g) * 32 + (R & 31)) * 8 + 4 * h; *(u32x2*)(F.ws<bf16_t>(WS_QG) + a) = w; }
                    else { const size_t a = (((size_t)(head * NKT + (R >> 6)) * 8 + 4 * fb + g) * 64 + (R & 63)) * 8 + 4 * h; *(u32x2*)(F.ws<bf16_t>(WS_KG) + a) = w; } }
        }
    }
};
struct EpiOutProjCtx {
    const Frame& F;
    __device__ __forceinline__ void operator()(f32x16& v0, f32x16& v1, int cg, int R, int h) const {
        const float* src = F.in(I_CTX) + (size_t)R * DM; const float* gt = F.ws<float>(WS_MOD) + 6144 + 2048; float* xs = F.ws<float>(WS_XS) + (size_t)R * DM;
#pragma unroll
        for (int fb = 0; fb < 2; ++fb)
#pragma unroll
            for (int g = 0; g < 4; ++g) { const f32x16& v = fb ? v1 : v0; const int n = 64 * cg + 32 * fb + 8 * g + 4 * h;
                const f32x4 x = *(const f32x4*)(src + n), gv = *(const f32x4*)(gt + n);
                *(f32x4*)(xs + n) = (f32x4){x[0] + gv[0] * v[4 * g], x[1] + gv[1] * v[4 * g + 1], x[2] + gv[2] * v[4 * g + 2], x[3] + gv[3] * v[4 * g + 3]}; }
    }
};
__device__ __forceinline__ void phase_inproj(const Frame& F, int l) {
    const bf16_t* Wt = F.ws<bf16_t>(WS_WIN) + (size_t)l * INW * DM; const bf16_t* hb = F.ws<bf16_t>(WS_HB);
    const bool xcd = F.G == 256; const int x = F.bid & 7;
    const int first = xcd ? (F.bid >> 3) : F.bid, stride = xcd ? 32 : F.G, total = xcd ? 64 : 8 * 64;
    for (int i = first; i < total; i += stride) { const int ft = xcd ? 4 * (x & 1) + (i & 3) : (i & 7), tt = 1 + (xcd ? 4 * (i >> 2) + (x >> 1) : (i >> 3));
        EpiInProj E{F, l, 256 * tt}; XDense X{hb, DM, 256 * tt}; gemm8(F, Wt, DM, 256 * ft, X, E); }
    EpiInProjCtx EC{F, l};
    for (int u = F.bid; u < 256; u += F.G) { const int cg = u & 31, tb = u >> 5;
        if (l == 1 && !((cg >= 10 && cg < 22) || cg >= 28)) continue;
        mini_unit(F, Wt, DM, 64 * cg, hb, DM, 32 * tb, DM, EC); }
}
__device__ __forceinline__ void phase_outproj(const Frame& F, int l) {
    const bf16_t* Wt = F.ws<bf16_t>(WS_WOUT) + (size_t)l * DM * MIXK; const bf16_t* mix = F.ws<bf16_t>(WS_MIX);
    const bool xcd = F.G == 256; const int x = F.bid & 7;
    const int first = xcd ? (F.bid >> 3) : F.bid, stride = xcd ? 32 : F.G, total = xcd ? 32 : 4 * 64;
    for (int i = first; i < total; i += stride) { const int ft = i & 3, tt = 1 + (xcd ? 8 * (i >> 2) + x : (i >> 2));
        EpiOutProj E{F, l, 256 * tt}; XDense X{mix, MIXK, 256 * tt}; gemm8(F, Wt, MIXK, 256 * ft, X, E); }
    if (l == 0) { EpiOutProjCtx EC{F};
        for (int u = F.bid; u < 128; u += F.G) { const int cg = u & 15, tb = u >> 4; mini_unit(F, Wt, MIXK, 64 * cg, mix, MIXK, 32 * tb, MIXK, EC); } }
}
__device__ __forceinline__ void moe_tables(const Frame& F, int l, int nf, bool xcd, LAS int*& s_cnt, LAS int*& s_offs, LAS int*& s_t0) {
    LAS int* base = (LAS int*)(F.lds + LDS_CTL + 256); s_cnt = base; s_offs = base + 32; s_t0 = base + 72;
    __syncthreads();
    if (F.tid < NEXP) s_cnt[F.tid] = (int)__hip_atomic_load(F.ctl + CW_CNT + 64 * l + F.tid, __ATOMIC_RELAXED, __HIP_MEMORY_SCOPE_AGENT);
    __syncthreads();
    if (F.tid == 0) { const int g = (F.bid & 7) >> 1; int o = 0, t = 0; for (int e = 0; e < NEXP; ++e) { const int c = s_cnt[e];
            const int ntt = (c + 255) >> 8; int nu = ntt * nf;
            if (xcd) { const int fst = (g - e) & 3; nu = (fst < ntt ? (ntt - fst + 3) >> 2 : 0) * (nf >> 1); }
            s_cnt[e] = c; s_offs[e] = o; s_t0[e] = t; o += c; t += nu; } s_offs[32] = o; s_t0[32] = t; }
    __syncthreads();
}
__device__ __forceinline__ void moe_decode(const Frame& F, bool xcd, int nf, int i, LAS const int* s_t0, int& e, int& ft, int& tt) {
    e = 0; while (e < NEXP - 1 && i >= s_t0[e + 1]) ++e;
    const int j = i - s_t0[e];
    if (xcd) { const int x = F.bid & 7, hf = nf >> 1; ft = hf * (x & 1) + (j % hf); tt = (((x >> 1) - e) & 3) + 4 * (j / hf); }
    else { ft = j % nf; tt = j / nf; } }
__device__ __forceinline__ void phase_gateup(const Frame& F, int l) {
    const bool xcd = F.G == 256;
    LAS int *s_cnt, *s_offs, *s_t0; moe_tables(F, l, 8, xcd, s_cnt, s_offs, s_t0);
    const int first = xcd ? (F.bid >> 3) : F.bid, stride = xcd ? 32 : F.G, total = s_t0[32];
    for (int i = first; i < total; i += stride) { int e, ft, tt; moe_decode(F, xcd, 8, i, s_t0, e, ft, tt);
        EpiGateUp E{F, l * NEXP + e, 256 * tt, s_cnt[e], s_offs[e]};
        XGather X{F.ws<bf16_t>(WS_HB), F.ws<unsigned>(WS_LIST) + (size_t)e * NT, 256 * tt, s_cnt[e]};
        gemm8(F, F.ws<bf16_t>(WS_WGU) + (size_t)(l * NEXP + e) * 2048 * DM, DM, 256 * ft, X, E); }
}
__device__ __forceinline__ void phase_down(const Frame& F, int l) {
    const bool xcd = F.G == 256;
    LAS int *s_cnt, *s_offs, *s_t0; moe_tables(F, l, 4, xcd, s_cnt, s_offs, s_t0);
    const int first = xcd ? (F.bid >> 3) : F.bid, stride = xcd ? 32 : F.G, total = s_t0[32];
    for (int i = first; i < total; i += stride) { int e, ft, tt; moe_decode(F, xcd, 4, i, s_t0, e, ft, tt);
        EpiDown E{F, l * NEXP + e, 256 * tt, s_cnt[e], s_offs[e]};
        XAct X{F.ws<bf16_t>(WS_ACT), s_offs[e], 256 * tt, s_cnt[e]};
        gemm8(F, F.ws<bf16_t>(WS_WDN) + (size_t)(l * NEXP + e) * DM * FFD, FFD, 256 * ft, X, E); }
}

template <int KD, int MODE>
__device__ __forceinline__ void dft_unit(const Frame& F, const bf16_t* AF, const bf16_t* Bsrc, int p0, int colhalf, int pa) {
    constexpr int NS = KD / 16, TILE_B = 4 * KD * 64;
    const int lane = F.lane, wid = F.wid, r = lane & 31, h = lane >> 5, rg = wid & 3, cg2 = wid >> 2;
    LAS char* lds = F.lds;
    BAR_SYNC();
    for (int pc = wid; pc < TILE_B / 1024; pc += 8) dma16((const char*)Bsrc + (size_t)pc * 1024 + lane * 16, lds + pc * 1024);
    WAITV(0); BAR_SYNC();
    f32x16 acc[2][2];
#pragma unroll
    for (int a = 0; a < 2; ++a)
#pragma unroll
        for (int b = 0; b < 2; ++b)
#pragma unroll
            for (int i = 0; i < 16; ++i) acc[a][b][i] = 0.f;
    const bf16_t* af = AF + (size_t)(rg * 2) * NS * 512 + lane * 8;
    const int bl = h * 512 + ((lane & 15) >> 2) * 64 + ((lane >> 4) & 1) * 32 + (lane & 3) * 8;
#pragma unroll 4
    for (int s = 0; s < NS; ++s) {
        const bf16x8 a0 = *(const bf16x8*)(af + (size_t)s * 512), a1 = *(const bf16x8*)(af + (size_t)(NS + s) * 512);
#pragma unroll
        for (int cb = 0; cb < 2; ++cb) { LAS const char* bp = lds + (2 * cg2 + cb) * (KD * 64) + s * 1024 + bl;
            const s16x4 lo = vtr(bp), hi = vtr(bp + 256);
            const bf16x8 bf = {lo[0], lo[1], lo[2], lo[3], hi[0], hi[1], hi[2], hi[3]};
            acc[0][cb] = MFMA(a0, bf, acc[0][cb]); acc[1][cb] = MFMA(a1, bf, acc[1][cb]); }
    }
#pragma unroll
    for (int cb = 0; cb < 2; ++cb) { const int c = 128 * colhalf + 32 * (2 * cg2 + cb) + r;
#pragma unroll
        for (int rho = 0; rho < 16; ++rho) { const int kk = 32 * rg + (rho & 3) + 8 * (rho >> 2) + 4 * h; const float re = acc[0][cb][rho], im = acc[1][cb][rho];
            if (MODE == 0) { const int l2 = p0; const f32x2 tw = F.ws<f32x2>(WS_TW)[(kk * l2) & 16383]; const float o_re = re * tw[0] + im * tw[1], o_im = im * tw[0] - re * tw[1];
                bf16_t* T2 = F.ws<bf16_t>(WS_T2); const size_t a = ((size_t)(kk * 2 + (c >> 7)) * 4 + ((c >> 5) & 3)) * 8192 + (l2 >> 2) * 256 + (2 * (l2 & 3)) * 32 + (c & 31);
                T2[a] = (bf16_t)(pk2(o_re, 0.f) & 0xffff); T2[a + 32] = (bf16_t)(pk2(o_im, 0.f) & 0xffff);
            } else if (MODE == 1) { const int k1 = p0; bf16_t* mr = F.ws<bf16_t>(WS_MIX) + (size_t)(NCTX + k1 + 128 * kk) * MIXK;
                mr[c] = (bf16_t)(pk2(re * (1.f / 1024.f), 0.f) & 0xffff); mr[256 + c] = (bf16_t)(pk2(im * (1.f / 1024.f), 0.f) & 0xffff);
            } else { bf16_t* mr = F.ws<bf16_t>(WS_MIX) + (size_t)(128 * pa + kk) * MIXK;
                mr[c] = (bf16_t)(pk2(re * (1.f / 128.f), 0.f) & 0xffff); mr[256 + c] = (bf16_t)(pk2(im * (1.f / 128.f), 0.f) & 0xffff); } } }
}

constexpr int A_SLOT = 16384;
constexpr int N_PSLOT = 18;
constexpr int A_KRING = 0, A_VRING = 32768;
template <int NQ, int NKS, bool SEPK, bool BIAS>
__device__ __forceinline__ void attn_sweep(const Frame& F, const bf16x8 (&qf)[NQ][NKS], const bf16_t* Kt, const bf16_t* Vt, int ntiles, const f32x16& negm, f32x16 (&o)[NQ][2], float (&lsum)[NQ]) {
    constexpr int NKF = (SEPK ? NQ : 1) * NKS;
    const int lane = F.lane, wid = F.wid, r = lane & 31, h = lane >> 5;
    LAS char* lds = F.lds; const unsigned lds0 = (unsigned)(size_t)F.lds;
    const bf16_t* ksrc = Kt + wid * 512 + lane * 8; const bf16_t* vsrc = Vt + wid * 512 + lane * 8;
#define A_K(t) glds16(ksrc + (size_t)(t) * 4096, (unsigned)__builtin_amdgcn_readfirstlane((int)(lds0 + A_KRING + ((t) & 3) * 8192 + wid * 1024)))
#define A_V(t) glds16(vsrc + (size_t)(t) * 4096, (unsigned)__builtin_amdgcn_readfirstlane((int)(lds0 + A_VRING + ((t) & 3) * 8192 + wid * 1024)))
#define SB() __builtin_amdgcn_sched_barrier(0)
    BAR_SYNC();
    A_K(0); A_V(0); A_K(1); A_K(2); A_V(1);
    float l0[NQ]; f32x16 scA[NQ], scB[NQ]; bf16x8 kf[NKF], vf[4], pa[NQ][2];
#pragma unroll
    for (int qi = 0; qi < NQ; ++qi) { l0[qi] = 0.f;
#pragma unroll
        for (int i = 0; i < 16; ++i) { o[qi][0][i] = 0.f; o[qi][1][i] = 0.f; scB[qi][i] = 0.f; } }
    const int vb = ((lane >> 4) & 1) * 32 + (lane & 3) * 8 + (4 * h + ((lane & 15) >> 2)) * 64;
    const int kbo = h * 1024 + r * 16;
#define LOADK(tile, kb) do { LAS const char* kp_ = lds + A_KRING + ((tile) & 3) * 8192 + kbo + (kb) * 512; \
        _Pragma("unroll") for (int f_ = 0; f_ < NKF; ++f_) kf[f_] = *(LAS const bf16x8*)(kp_ + (SEPK ? (f_ / NKS) * 4096 : 0) + (f_ % NKS) * 2048); } while (0)
#define LOADV(tile, kb) do { LAS const char* vp_ = lds + A_VRING + ((tile) & 3) * 8192 + vb + (kb) * 2048; \
        _Pragma("unroll") for (int j_ = 0; j_ < 2; ++j_) _Pragma("unroll") for (int d_ = 0; d_ < 2; ++d_) { const s16x4 lo_ = vtr(vp_ + d_ * 4096 + j_ * 1024), hi_ = vtr(vp_ + d_ * 4096 + j_ * 1024 + 512); \
            vf[j_ * 2 + d_] = (bf16x8){lo_[0], lo_[1], lo_[2], lo_[3], hi_[0], hi_[1], hi_[2], hi_[3]}; } } while (0)
#define HALF(SN, SO, vtile, vkb, DOK, ktile, kkb) do { \
        LOADV(vtile, vkb); SB(); \
          \
        _Pragma("unroll") for (int m_ = 0; m_ < NQ * NKS; ++m_) { const int qi_ = m_ / NKS, s_ = m_ % NKS; \
            if (s_ == 0) { if (BIAS) SN[qi_] = MFMA(kf[(SEPK ? qi_ : 0) * NKS], qf[qi_][0], negm); else { f32x16 z_; _Pragma("unroll") for (int i_ = 0; i_ < 16; ++i_) z_[i_] = 0.f; SN[qi_] = MFMA(kf[(SEPK ? qi_ : 0) * NKS], qf[qi_][0], z_); } } \
            else SN[qi_] = MFMA(kf[(SEPK ? qi_ : 0) * NKS + s_], qf[qi_][s_], SN[qi_]); \
              \
            _Pragma("unroll") for (int g_ = m_ * 4 / NKS; g_ < (m_ + 1) * 4 / NKS; ++g_) { const int fq_ = g_ >> 2, gg_ = g_ & 3; \
                l0[fq_] += SO[fq_][4 * gg_]; l0[fq_] += SO[fq_][4 * gg_ + 1]; l0[fq_] += SO[fq_][4 * gg_ + 2]; l0[fq_] += SO[fq_][4 * gg_ + 3]; \
                { u32x4 w_ = __builtin_bit_cast(u32x4, pa[fq_][gg_ >> 1]); w_[(gg_ & 1) * 2] = pk2(SO[fq_][4 * gg_], SO[fq_][4 * gg_ + 1]); w_[(gg_ & 1) * 2 + 1] = pk2(SO[fq_][4 * gg_ + 2], SO[fq_][4 * gg_ + 3]); pa[fq_][gg_ >> 1] = __builtin_bit_cast(bf16x8, w_); } } \
            SB(); } \
          \
        _Pragma("unroll") for (int m_ = 0; m_ < NQ * 4; ++m_) { const int j_ = m_ / (2 * NQ), d_ = (m_ / NQ) & 1, qi_ = m_ % NQ; \
            o[qi_][d_] = MFMA(vf[j_ * 2 + d_], pa[qi_][j_], o[qi_][d_]); \
            { const int eq_ = m_ >> 2, eg_ = m_ & 3; \
              SN[eq_][4 * eg_] = __builtin_amdgcn_exp2f(SN[eq_][4 * eg_]); SN[eq_][4 * eg_ + 1] = __builtin_amdgcn_exp2f(SN[eq_][4 * eg_ + 1]); \
              SN[eq_][4 * eg_ + 2] = __builtin_amdgcn_exp2f(SN[eq_][4 * eg_ + 2]); SN[eq_][4 * eg_ + 3] = __builtin_amdgcn_exp2f(SN[eq_][4 * eg_ + 3]); } \
            if (m_ == 0) { if (DOK) LOADK(ktile, kkb); }   \
            SB(); } \
    } while (0)
    WAITV(2); BAR_SYNC();
    A_K(3); if (ntiles > 2) A_V(2);
    LOADK(0, 0);
    for (int t = 0; t < ntiles; ++t) {
        if (t > 0) {
            if (t + 2 < ntiles) { WAITV(2); } else if (t + 1 < ntiles) { WAITV(1); } else { WAITV(0); }
            BAR_SYNC();
            if (t + 3 < ntiles) A_K(t + 3);
            if (t + 2 < ntiles) A_V(t + 2);
        }
        HALF(scA, scB, (t > 0 ? t - 1 : 0), 1, true, t, 1);
        HALF(scB, scA, t, 0, (t + 1 < ntiles), t + 1, 0);
    }
    LOADV(ntiles - 1, 1);
#pragma unroll
    for (int qi = 0; qi < NQ; ++qi) {
#pragma unroll
        for (int i = 0; i < 16; ++i) l0[qi] += scB[qi][i];
        pa[qi][0] = pack8(scB[qi][0], scB[qi][1], scB[qi][2], scB[qi][3], scB[qi][4], scB[qi][5], scB[qi][6], scB[qi][7]);
        pa[qi][1] = pack8(scB[qi][8], scB[qi][9], scB[qi][10], scB[qi][11], scB[qi][12], scB[qi][13], scB[qi][14], scB[qi][15]); }
#pragma unroll
    for (int j = 0; j < 2; ++j)
#pragma unroll
        for (int d0 = 0; d0 < 2; ++d0)
#pragma unroll
            for (int qi = 0; qi < NQ; ++qi) o[qi][d0] = MFMA(vf[j * 2 + d0], pa[qi][j], o[qi][d0]);
#undef A_K
#undef A_V
#undef SB
#undef LOADK
#undef LOADV
#undef HALF
#pragma unroll
    for (int qi = 0; qi < NQ; ++qi) lsum[qi] = add32(l0[qi]);
}
constexpr int PREC = 1152;
__device__ __forceinline__ void store_partial(const Frame& F, int kh, int slot, int R, const f32x16 (&o)[2], float l, int r, int h) {
    bf16_t* rec = F.ws<bf16_t>(WS_PART) + ((size_t)R * 2 + kh) * PREC; const float inv = 1.f / l;
#pragma unroll
    for (int d0 = 0; d0 < 2; ++d0)
#pragma unroll
        for (int g = 0; g < 4; ++g) { u32x2 w = {pk2(o[d0][4 * g] * inv, o[d0][4 * g + 1] * inv), pk2(o[d0][4 * g + 2] * inv, o[d0][4 * g + 3] * inv)};
            const int off = slot < 12 ? (((slot >> 1) * 8 + 4 * d0 + g) * 2 + (slot & 1)) * 8 + 4 * h : 768 + (slot - 12) * 64 + 32 * d0 + 8 * g + 4 * h;
            *(u32x2*)(rec + off) = w; }
    if (h == 0) F.ws<float>(WS_PL)[((size_t)R * 2 + kh) * N_PSLOT + slot] = l;
}
__device__ __forceinline__ void attn_diff_unit(const Frame& F, int l, int head, int R0, int t0, int ntiles, int khalf) {
    const int lane = F.lane, wid = F.wid, r = lane & 31, h = lane >> 5;
    const bf16_t* qp = F.ws<bf16_t>(WS_QD) + (size_t)(head * NQB + (R0 >> 5) + wid) * 2048;
    bf16x8 qf[2][2]; float mi[2];
#pragma unroll
    for (int mp = 0; mp < 2; ++mp) {
#pragma unroll
        for (int s = 0; s < 2; ++s) qf[mp][s] = *(const bf16x8*)(qp + ((4 * mp + 2 * s + h) * 32 + r) * 8);
        float qq = 0.f;
#pragma unroll
        for (int j = 0; j < 8; ++j) { const float a = bf2f((unsigned short)qf[mp][0][j]), b = bf2f((unsigned short)qf[mp][1][j]); qq += a * a + b * b; }
        qq = add32(qq);
        const float km = ((LAS const float*)(F.lds + LDS_CTL + 1024))[2 * head + mp];
        mi[mp] = -sqrtf(qq * km) * 1.01f; }
    f32x16 negm; { const float mm = fminf(mi[0], mi[1]);
#pragma unroll
        for (int i = 0; i < 16; ++i) negm[i] = mm; asm volatile("" : "+v"(negm)); }
    f32x16 o[2][2]; float ls[2];
    attn_sweep<2, 2, true, true>(F, qf, F.ws<bf16_t>(WS_KD) + (size_t)(head * NKT + t0) * 4096, F.ws<bf16_t>(WS_VD) + (size_t)(head * NKT + t0) * 4096, ntiles, negm, o, ls);
    { const int ln = lane_now(), r2 = ln & 31, h2 = ln >> 5, R = R0 + 32 * wid + r2;
#pragma unroll
      for (int mp = 0; mp < 2; ++mp) store_partial(F, khalf, 2 * head + mp, R, o[mp], ls[mp], r2, h2); }
}
template <int NH>
__device__ __forceinline__ void attn_gqa_unit(const Frame& F, int qh0, int kvh, int R0, int t0, int ntiles, int khalf, float bound) {
    const int lane = F.lane, wid = F.wid, r = lane & 31, h = lane >> 5;
    bf16x8 qf[NH][4];
#pragma unroll
    for (int hh = 0; hh < NH; ++hh) { const bf16_t* qp = F.ws<bf16_t>(WS_QG) + (size_t)((qh0 + hh) * NQB + (R0 >> 5) + wid) * 2048;
#pragma unroll
        for (int s = 0; s < 4; ++s) qf[hh][s] = *(const bf16x8*)(qp + ((2 * s + h) * 32 + r) * 8); }
    f32x16 o[NH][2]; float ls[NH]; f32x16 negm;
#pragma unroll
    for (int i = 0; i < 16; ++i) negm[i] = 0.f;
    attn_sweep<NH, 4, false, false>(F, qf, F.ws<bf16_t>(WS_KG) + (size_t)(kvh * NKT + t0) * 4096, F.ws<bf16_t>(WS_VG) + (size_t)(kvh * NKT + t0) * 4096, ntiles, negm, o, ls);
    { const int ln = lane_now(), r2 = ln & 31, h2 = ln >> 5, R = R0 + 32 * wid + r2;
#pragma unroll
      for (int hh = 0; hh < NH; ++hh) store_partial(F, khalf, 12 + qh0 + hh, R, o[hh], ls[hh], r2, h2); }
}

__device__ __forceinline__ void phase_attn(const Frame& F, int l, int rep) {
    if (F.wid >= 4) __builtin_amdgcn_s_setprio(1);
    float gqm = 0.f, gkm = 0.f; { const float* gq = F.in(I_GQ) + 64 * l; const float* gk = F.in(I_GK) + 64 * l; for (int i = 0; i < 64; ++i) { gqm = fmaxf(gqm, fabsf(gq[i])); gkm = fmaxf(gkm, fabsf(gk[i])); } }
    const float bg = fminf(8.f * gqm * gkm * LOG2E * 1.01f, 100.f);
    for (int mp = F.wid; mp < 12; mp += 8) { const float* kp = F.ws<float>(WS_KP) + (size_t)(l * 12 + mp) * 1024; float mx = 0.f;
#pragma unroll
        for (int q = 0; q < 4; ++q) { const f32x4 v = *(const f32x4*)(kp + 256 * q + 4 * F.lane); mx = fmaxf(fmaxf(mx, fmaxf(v[0], v[1])), fmaxf(v[2], v[3])); }
        mx = wave_max(mx); mx = fmaxf(mx, __uint_as_float(__hip_atomic_load(F.ctl + CW_KMAX + 16 * l + mp, __ATOMIC_RELAXED, __HIP_MEMORY_SCOPE_AGENT)));
        if (F.lane == 0) ((LAS float*)(F.lds + LDS_CTL + 1024))[mp] = mx; }
    __syncthreads();
    constexpr int HT = NKT / 2;
    for (int u = F.bid; u < 256; u += F.G) { const int cb = (u & 7) >> 1, rb = ((u >> 3) << 1) | (u & 1), R0 = NCTX + 256 * rb; const int kvh = cb >> 1, kh = cb & 1;
        attn_gqa_unit<2>(F, 3 * kvh, kvh, R0, kh * HT, HT, kh, bg); }
    for (int u = F.bid; u < 768; u += F.G) { const int j = u >> 8, v = u & 255, cb = 4 * j + ((v & 7) >> 1), rb = ((v >> 3) << 1) | (v & 1), R0 = NCTX + 256 * rb; const int head = cb >> 1, kh = cb & 1;
        attn_diff_unit(F, l, head, R0, kh * HT, HT, kh); }
    for (int u = F.bid; u < 256; u += F.G) { const int cb = (u & 7) >> 1, rb = ((u >> 3) << 1) | (u & 1), R0 = NCTX + 256 * rb; const int kvh = cb >> 1, kh = cb & 1;
        attn_gqa_unit<1>(F, 3 * kvh + 2, kvh, R0, kh * HT, HT, kh, bg); }
    for (int u = F.bid; u < 256; u += F.G) { const int l2 = u >> 1, ch = u & 1;
        dft_unit<128, 0>(F, F.ws<bf16_t>(WS_A1F), F.ws<bf16_t>(WS_FT) + (size_t)(l2 * 2 + ch) * 4 * 4096, l2, ch, 0); }
    if (l == 0) {
        for (int u = F.bid; u < 14; u += F.G) {
            if (u < 4) { const int pa = u >> 1, ch = u & 1; dft_unit<256, 2>(F, F.ws<bf16_t>(WS_ACF) + (size_t)pa * 65536, F.ws<bf16_t>(WS_FC) + (size_t)ch * 4 * 8192, 0, ch, pa); }
            else if (u < 10) attn_diff_unit(F, l, u - 4, 0, 0, NCTX / 64, 0);
            else if (u < 12) attn_gqa_unit<2>(F, 3 * (u - 10), u - 10, 0, 0, NCTX / 64, 0, bg);
            else attn_gqa_unit<1>(F, 3 * (u - 12) + 2, u - 12, 0, 0, NCTX / 64, 0, bg);
        }
    }
    __builtin_amdgcn_s_setprio(0);
}
__device__ __forceinline__ void unpack8(const u32x4& w, float (&f)[8]) { f[0] = bflo(w[0]); f[1] = bfhi(w[0]); f[2] = bflo(w[1]); f[3] = bfhi(w[1]); f[4] = bflo(w[2]); f[5] = bfhi(w[2]); f[6] = bflo(w[3]); f[7] = bfhi(w[3]); }
__device__ __forceinline__ void attn_merge(const Frame& F, int l) {
    const int lane = F.lane, un = lane >> 3, dc = lane & 7; const bool act = lane < 48;
    const float* lq1 = F.in(I_LQ1) + 32 * l; const float* lk1 = F.in(I_LK1) + 32 * l; const float* lq2 = F.in(I_LQ2) + 32 * l; const float* lk2 = F.in(I_LK2) + 32 * l;
    float d1 = 0.f, d2 = 0.f; for (int i = 0; i < 32; ++i) { d1 += lq1[i] * lk1[i]; d2 += lq2[i] * lk2[i]; }
    const float lam_init = 0.8f - 0.6f * expf(-0.3f * (float)l); const float lam = expf(d1) - expf(d2) + lam_init, post = 1.f - lam_init;
    float gs[8]; { const float* g = F.in(I_GSUB) + 64 * l + 8 * dc; for (int j = 0; j < 8; ++j) gs[j] = g[j]; }
    const bf16_t* part = F.ws<bf16_t>(WS_PART); const float* pl = F.ws<float>(WS_PL); bf16_t* mix = F.ws<bf16_t>(WS_MIX);
    const int Rbeg = l == 0 ? 0 : NCTX; const int u6 = act ? un : 0;
    for (int R = Rbeg + F.bid * 8 + F.wid; R < NT; R += F.G * 8) {
        const bool two = R >= NCTX; bf16_t* mr = mix + (size_t)R * MIXK;
        const bf16_t* ra = part + (size_t)R * 2 * PREC; const bf16_t* rb = ra + PREC; const float* la = pl + (size_t)R * 2 * N_PSLOT; const float* lb = la + N_PSLOT;
        { const u32x4 a0 = *(const u32x4*)(ra + (u6 * 8 + dc) * 16), a1 = *(const u32x4*)(ra + (u6 * 8 + dc) * 16 + 8);
          u32x4 b0 = {0u, 0u, 0u, 0u}, b1 = b0; float lb0 = 0.f, lb1 = 0.f;
          if (two) { b0 = *(const u32x4*)(rb + (u6 * 8 + dc) * 16); b1 = *(const u32x4*)(rb + (u6 * 8 + dc) * 16 + 8); lb0 = lb[2 * u6]; lb1 = lb[2 * u6 + 1]; }
          const float la0 = la[2 * u6], la1 = la[2 * u6 + 1]; const float i0 = 1.f / (la0 + lb0), i1 = lam / (la1 + lb1);
          float fa0[8], fa1[8], fb0[8], fb1[8], v[8]; unpack8(a0, fa0); unpack8(a1, fa1); unpack8(b0, fb0); unpack8(b1, fb1);
          float ss = 0.f;
#pragma unroll
          for (int j = 0; j < 8; ++j) { v[j] = (la0 * fa0[j] + lb0 * fb0[j]) * i0 - (la1 * fa1[j] + lb1 * fb1[j]) * i1; ss += v[j] * v[j]; }
          ss += shxc<1>(ss); ss += shxc<2>(ss); ss += shxc<4>(ss);
          const float rs = rsqrtf(ss * (1.f / 64.f) + 1e-5f) * post;
          if (act) { u32x4 w = {pk2(v[0] * rs * gs[0], v[1] * rs * gs[1]), pk2(v[2] * rs * gs[2], v[3] * rs * gs[3]), pk2(v[4] * rs * gs[4], v[5] * rs * gs[5]), pk2(v[6] * rs * gs[6], v[7] * rs * gs[7])};
              *(u32x4*)(mr + 512 + 64 * un + 8 * dc) = w; } }
        { const u32x4 a0 = *(const u32x4*)(ra + 768 + u6 * 64 + dc * 8); u32x4 b0 = {0u, 0u, 0u, 0u}; float lbq = 0.f;
          if (two) { b0 = *(const u32x4*)(rb + 768 + u6 * 64 + dc * 8); lbq = lb[12 + u6]; }
          const float laq = la[12 + u6], iq = 1.f / (laq + lbq); float fa[8], fb[8]; unpack8(a0, fa); unpack8(b0, fb);
          if (act) { float o[8];
#pragma unroll
              for (int j = 0; j < 8; ++j) o[j] = (laq * fa[j] + lbq * fb[j]) * iq;
              u32x4 w = {pk2(o[0], o[1]), pk2(o[2], o[3]), pk2(o[4], o[5]), pk2(o[6], o[7])}; *(u32x4*)(mr + 896 + 64 * un + 8 * dc) = w; } }
    }
}
__device__ __forceinline__ void phase_fft2(const Frame& F, int l) {
    for (int u = F.bid; u < 256; u += F.G) { const int k1 = u >> 1, ch = u & 1;
        dft_unit<256, 1>(F, F.ws<bf16_t>(WS_A2F), F.ws<bf16_t>(WS_T2) + (size_t)(k1 * 2 + ch) * 4 * 8192, k1, ch, 0); }
    attn_merge(F, l);
}

__device__ __forceinline__ void phase_router(const Frame& F, int l) {
    constexpr int HS = 2064;
    LAS char* hhi = F.lds; LAS char* hlo = F.lds + 32 * HS;
    LAS float* part = (LAS float*)F.lds;
    LAS unsigned* hist = (LAS unsigned*)(F.lds + 135168);
    LAS unsigned* recs = hist + 64;
    const int lane = F.lane, wid = F.wid, t = F.tid;
    const float* wr = F.in(I_WR) + (size_t)l * 1024 * 32;
    __syncthreads();
    if (t < 64) hist[t] = 0u;
    bf16x8 ahi[8], alo[8];
    { const int e = lane & 31, kk = lane >> 5;
#pragma unroll
      for (int s = 0; s < 8; ++s) { float w[8];
#pragma unroll
          for (int j = 0; j < 8; ++j) w[j] = wr[(size_t)(16 * (8 * wid + s) + 8 * kk + j) * 32 + e];
          unsigned hi[4], lo[4];
#pragma unroll
          for (int j = 0; j < 4; ++j) { hi[j] = pk2(w[2 * j], w[2 * j + 1]); lo[j] = pk2(w[2 * j] - bflo(hi[j]), w[2 * j + 1] - bfhi(hi[j])); }
          ahi[s] = __builtin_bit_cast(bf16x8, (u32x4){hi[0], hi[1], hi[2], hi[3]}); alo[s] = __builtin_bit_cast(bf16x8, (u32x4){lo[0], lo[1], lo[2], lo[3]}); } }
    const int Rbeg = l == 0 ? 0 : NCTX, ntok = NT - Rbeg, per = (ntok + F.G - 1) / F.G;
    const int r0 = Rbeg + F.bid * per, r1 = min(r0 + per, NT);
    const float* mod = F.ws<float>(WS_MOD) + (size_t)l * 2 * 6144; const float* g2 = F.in(I_GN2) + 1024 * l; const float* br = F.in(I_BR) + 32 * l;
    const float* xs = F.ws<float>(WS_XS); bf16_t* hb = F.ws<bf16_t>(WS_HB);
    unsigned* slot = F.ws<unsigned>(WS_SLOT); float* gate = F.ws<float>(WS_GATE);
    const float bre = br[lane & 31];
    f32x4 gvv[4], shv[4], scv[4];
#pragma unroll
    for (int q = 0; q < 4; ++q) { const int k = 256 * q + 4 * lane; gvv[q] = *(const f32x4*)(g2 + k); shv[q] = *(const f32x4*)(mod + 3072 + k); scv[q] = *(const f32x4*)(mod + 4096 + k); }
    f32x4 xr[4][4];
    if (r0 < r1) {
#pragma unroll
        for (int j = 0; j < 4; ++j) load_row(xs + (size_t)min(r0 + wid + 8 * j, r1 - 1) * DM, lane, xr[j]); }
    for (int b0 = r0; b0 < r1; b0 += 32) {
        __syncthreads();
#pragma unroll
        for (int j = 0; j < 4; ++j) { const int tt = wid + 8 * j; const int R = min(b0 + tt, r1 - 1);
            f32x4 hv[4]; const float rstd = row_rstd(xr[j], 1e-6f);
            f32x4 sh[4], sc[4];
#pragma unroll
            for (int q = 0; q < 4; ++q) { sh[q] = shv[q]; sc[q] = scv[q]; }
            if (R < NCTX) {
#pragma unroll
                for (int q = 0; q < 4; ++q) { const int k = 256 * q + 4 * lane; sh[q] = *(const f32x4*)(mod + 6144 + 3072 + k); sc[q] = *(const f32x4*)(mod + 6144 + 4096 + k); } }
#pragma unroll
            for (int q = 0; q < 4; ++q) { const int k = 256 * q + 4 * lane;
#pragma unroll
                for (int i = 0; i < 4; ++i) hv[q][i] = (xr[j][q][i] * rstd * gvv[q][i]) * (1.f + sc[q][i]) + sh[q][i];
                *(u32x2*)(hb + (size_t)R * DM + k) = (u32x2){pk2(hv[q][0], hv[q][1]), pk2(hv[q][2], hv[q][3])}; }
#pragma unroll
            for (int q = 0; q < 4; ++q) { const unsigned h0 = pk2(hv[q][0], hv[q][1]), h1 = pk2(hv[q][2], hv[q][3]);
                const unsigned l0 = pk2(hv[q][0] - bflo(h0), hv[q][1] - bfhi(h0)), l1 = pk2(hv[q][2] - bflo(h1), hv[q][3] - bfhi(h1));
                *(LAS u32x2*)(hhi + tt * HS + (256 * q + 4 * lane) * 2) = (u32x2){h0, h1}; *(LAS u32x2*)(hlo + tt * HS + (256 * q + 4 * lane) * 2) = (u32x2){l0, l1}; } }
        if (b0 + 32 < r1) {
#pragma unroll
            for (int j = 0; j < 4; ++j) load_row(xs + (size_t)min(b0 + 32 + wid + 8 * j, r1 - 1) * DM, lane, xr[j]); }
        __syncthreads();
        f32x16 acc;
#pragma unroll
        for (int i = 0; i < 16; ++i) acc[i] = 0.f;
        { const int n = lane & 31, kk = lane >> 5;
#pragma unroll
          for (int s = 0; s < 8; ++s) { const int off = n * HS + (16 * (8 * wid + s) + 8 * kk) * 2;
              const bf16x8 bh = *(LAS const bf16x8*)(hhi + off), bl = *(LAS const bf16x8*)(hlo + off);
              acc = MFMA(ahi[s], bh, acc); acc = MFMA(ahi[s], bl, acc); acc = MFMA(alo[s], bh, acc); } }
        __syncthreads();
#pragma unroll
        for (int i = 0; i < 16; ++i) part[(wid * 16 + i) * 64 + lane] = acc[i];
        __syncthreads();
        { const int e = lane & 31; const int rr = (e & 3) | ((e >> 3) << 2), lh = 32 * ((e >> 2) & 1);
          float v[4];
#pragma unroll
          for (int tt = 0; tt < 4; ++tt) { v[tt] = bre;
#pragma unroll
              for (int w = 0; w < 8; ++w) v[tt] += part[(w * 16 + rr) * 64 + 4 * wid + tt + lh]; }
          float tv[4][4]; int te[4][4];
#pragma unroll
          for (int kk = 0; kk < 4; ++kk)
#pragma unroll
              for (int tt = 0; tt < 4; ++tt) { const float mx = wave_max(v[tt]); const unsigned long long bal = __ballot(v[tt] == mx); const int lw = __ffsll((long long)bal) - 1;
                  te[tt][kk] = lw & 31; tv[tt][kk] = mx; if (e == te[tt][kk]) v[tt] = -INFINITY; }
#pragma unroll
          for (int tt = 0; tt < 4; ++tt) { const int R = b0 + 4 * wid + tt;
            const float e1 = __expf(tv[tt][1] - tv[tt][0]), e2 = __expf(tv[tt][2] - tv[tt][0]), e3 = __expf(tv[tt][3] - tv[tt][0]); const float inv = 1.f / (1.f + e1 + e2 + e3);
            if (lane < 4 && R < r1) { const int ee = lane == 0 ? te[tt][0] : lane == 1 ? te[tt][1] : lane == 2 ? te[tt][2] : te[tt][3]; const float gg = (lane == 0 ? 1.f : lane == 1 ? e1 : lane == 2 ? e2 : e3) * inv;
                const unsigned lr = atomicAdd((unsigned*)(hist + ee), 1u);
                const int ti = R - r0; recs[ti * 4 + lane] = ((unsigned)ee << 24) | lr; gate[(size_t)R * 4 + lane] = gg; } } }
    }
    __syncthreads();
    if (t < 32) { const unsigned c = hist[t]; hist[32 + t] = c ? xb_add(F.ctl + CW_CNT + 64 * l + t, c) : 0u; }
    __syncthreads();
    unsigned* list = F.ws<unsigned>(WS_LIST);
    for (int i = t; i < (r1 - r0) * 4; i += 512) { const unsigned rec = recs[i]; const unsigned ee = rec >> 24, rk = (rec & 0xffffffu) + hist[32 + ee]; const int R = r0 + (i >> 2);
        slot[(size_t)R * 4 + (i & 3)] = (ee << 24) | rk; list[(size_t)ee * NT + rk] = (unsigned)R; }
    __syncthreads();
}

__device__ __forceinline__ void phase_combine(const Frame& F, int l) {
    const int lane = F.lane; const float* mod = F.ws<float>(WS_MOD) + (size_t)l * 2 * 6144; const float* modn = F.ws<float>(WS_MOD) + (size_t)(l + 1) * 2 * 6144;
    float* xs = F.ws<float>(WS_XS); const bf16_t* yb = F.ws<bf16_t>(WS_YB); const unsigned* slot = F.ws<unsigned>(WS_SLOT); const float* gate = F.ws<float>(WS_GATE); bf16_t* hb = F.ws<bf16_t>(WS_HB);
    int offs = 0;
    { const int ce = lane < NEXP ? (int)__hip_atomic_load(F.ctl + CW_CNT + 64 * l + lane, __ATOMIC_RELAXED, __HIP_MEMORY_SCOPE_AGENT) : 0;
      int inc = ce;
#pragma unroll
      for (int d = 1; d < 32; d <<= 1) { const int up = __builtin_amdgcn_ds_bpermute(((lane - d) & 63) << 2, inc); if (lane >= d) inc += up; }
      offs = inc - ce; }
    const int Rbeg = l == 0 ? 0 : NCTX; float* outb = F.outp(); const float* gn1 = F.in(I_GN1) + 1024; const float* gf = F.in(I_GFIN);
    f32x4 gfv[4];
#pragma unroll
    for (int q = 0; q < 4; ++q) gfv[q] = *(const f32x4*)(gf + 256 * q + 4 * lane);
    for (int R = Rbeg + F.bid * 8 + F.wid; R < NT; R += F.G * 8) {
        const float* m = mod + (R < NCTX ? 6144 : 0);
        f32x4 x[4], a[4]; load_row(xs + (size_t)R * DM, lane, x);
#pragma unroll
        for (int q = 0; q < 4; ++q) a[q] = (f32x4){0.f, 0.f, 0.f, 0.f};
#pragma unroll
        for (int s = 0; s < 4; ++s) { const unsigned rec = slot[(size_t)R * 4 + s]; const float g = gate[(size_t)R * 4 + s]; const int pos = __builtin_amdgcn_ds_bpermute((int)((rec >> 24) << 2), offs) + (int)(rec & 0xffffffu);
            const bf16_t* yr = yb + (size_t)pos * DM;
#pragma unroll
            for (int q = 0; q < 4; ++q) { const u32x2 w = *(const u32x2*)(yr + 256 * q + 4 * lane); a[q][0] += g * bflo(w[0]); a[q][1] += g * bfhi(w[0]); a[q][2] += g * bflo(w[1]); a[q][3] += g * bfhi(w[1]); } }
#pragma unroll
        for (int q = 0; q < 4; ++q) { const f32x4 gt = *(const f32x4*)(m + 5120 + 256 * q + 4 * lane);
#pragma unroll
            for (int i = 0; i < 4; ++i) x[q][i] += gt[i] * a[q][i]; }
        const float rstd = row_rstd(x, 1e-6f);
        if (l == 0) {
#pragma unroll
            for (int q = 0; q < 4; ++q) *(f32x4*)(xs + (size_t)R * DM + 256 * q + 4 * lane) = x[q];
            const float* mn = modn + (R < NCTX ? 6144 : 0);
            mod_store_bf16(x, rstd, gn1, mn, mn + 1024, hb + (size_t)R * DM, lane);
        } else {
            float* orow = outb + (size_t)(R - NCTX) * DM;
#pragma unroll
            for (int q = 0; q < 4; ++q) { const f32x4 gv = gfv[q]; f32x4 o;
#pragma unroll
                for (int i = 0; i < 4; ++i) o[i] = x[q][i] * rstd * gv[i];
                *(f32x4*)(orow + 256 * q + 4 * lane) = o; }
        }
    }
}

__device__ __forceinline__ int opaque_i32(int v) { asm volatile("" : "+s"(v)); return __builtin_amdgcn_readfirstlane(v); }
__device__ __forceinline__ unsigned long long opaque_u64(unsigned long long w) { int lo = (int)(unsigned)w, hi = (int)(unsigned)(w >> 32); lo = opaque_i32(lo); hi = opaque_i32(hi);
    return ((unsigned long long)(unsigned)hi << 32) | (unsigned)lo; }
__device__ __forceinline__ Frame fresh(const Frame& F) { Frame G = F;
    G.wsb = (unsigned char*)opaque_u64((unsigned long long)F.wsb); G.ctl = (unsigned*)opaque_u64((unsigned long long)F.ctl);
    G.pp = (const __attribute__((address_space(4))) Params*)opaque_u64((unsigned long long)F.pp);
    G.wid = opaque_i32(F.wid); G.bid = opaque_i32(F.bid); G.G = opaque_i32(F.G);
    G.lane = lane_now(); G.tid = G.wid * 64 + G.lane; return G; }
constexpr int N_PHASES = 18;
__global__ void __launch_bounds__(NTHREADS, 2) mk_fwd(Params P, int ph_lo, int ph_hi, int probe) {
    extern __shared__ __attribute__((aligned(16))) unsigned char smem_raw[];
    Frame F; F.pp = (const __attribute__((address_space(4))) Params*)__builtin_amdgcn_kernarg_segment_ptr(); F.wsb = P.ws; F.lds = (LAS char*)smem_raw; F.tid = threadIdx.x; F.lane = F.tid & 63; F.wid = __builtin_amdgcn_readfirstlane(F.tid >> 6); F.G = gridDim.x; F.bid = blockIdx.x;
    F.ctl = (unsigned*)(P.ws + WS_CTL);
    LAS unsigned* bw = (LAS unsigned*)(F.lds + LDS_CTL);
    if (F.tid < 4) bw[F.tid] = 0u;
    __syncthreads();
    XcdBarrier bar;
    if (MK_ONE_LAUNCH) bar = xcd_barrier_post(F.ctl + CW_BAR, (volatile LAS unsigned*)bw, F.wid);
#ifndef PHASE_MASK
#define PHASE_MASK 0xFFFFFFFFu
#endif
#if MK_ONE_LAUNCH
#define IN(k) (((PHASE_MASK >> ((k) >= 10 ? (k) - 8 : (k))) & 1u) != 0u)
#else
#define IN(k) (((PHASE_MASK >> ((k) >= 10 ? (k) - 8 : (k))) & 1u) && ph_lo <= (k) && (k) < ph_hi)
#endif
#define SEAM(k) do { if (MK_ONE_LAUNCH && IN(k) && IN((k) + 1)) xcd_barrier(bar); } while (0)
#define RUN(k, code, body) do { if (IN(k)) { const int nr_ = (opaque_i32(probe) == (code)) ? 2 : 1; _Pragma("unroll 1") for (int rep = 0; rep < nr_; ++rep) { body; if (MK_ONE_LAUNCH && rep + 1 < nr_) xcd_barrier(bar); } } SEAM(k); } while (0)
    RUN(0, 100, phase_prologue(fresh(F)));
    RUN(1, 101, phase_norm0(fresh(F)));
#pragma unroll 1
    for (int l = 0; l < 2; ++l) {
        const int b = 2 + 8 * l;
        RUN(b + 0, 0, phase_inproj(fresh(F), l));
        RUN(b + 1, 1, phase_attn(fresh(F), l, rep));
        RUN(b + 2, 2, phase_fft2(fresh(F), l));
        RUN(b + 3, 3 + 10 * l, phase_outproj(fresh(F), l));
        RUN(b + 4, 104, phase_router(fresh(F), l));
        RUN(b + 5, 5, phase_gateup(fresh(F), l));
        RUN(b + 6, 6, phase_down(fresh(F), l));
        RUN(b + 7, 17 - 10 * l, phase_combine(fresh(F), l));
    }
}

extern "C" void kernel_launch(void* const* d_in, const int* in_sizes, int n_in, void* d_out, int out_size, void* d_ws, size_t ws_size, hipStream_t stream) {
    static int grid = 0;
    if (!grid) {
        int dev = 0, cus = 0, per_cu = 0;
        hipGetDevice(&dev);
        hipDeviceGetAttribute(&cus, hipDeviceAttributeMultiprocessorCount, dev);
        hipFuncSetAttribute((const void*)mk_fwd, hipFuncAttributeMaxDynamicSharedMemorySize, LDS_BYTES);
        hipOccupancyMaxActiveBlocksPerMultiprocessor(&per_cu, (const void*)mk_fwd, NTHREADS, LDS_BYTES);
        if (per_cu < 1) { fprintf(stderr, "mk_fwd: occupancy query says %d blocks per CU\n", per_cu); per_cu = 1; }
        grid = cus * 1;
        if (ws_size < WS_END) fprintf(stderr, "mk_fwd: workspace too small (%zu < %zu)\n", ws_size, (size_t)WS_END);
    }
    hipMemsetAsync(d_ws, 0, CTL_BYTES, stream);
    Params p{};
    for (int i = 0; i < 25; ++i) p.in[i] = (const float*)d_in[i];
    p.out = (float*)d_out; p.ws = (unsigned char*)d_ws;
#if MK_ONE_LAUNCH
    hipLaunchKernelGGL(mk_fwd, dim3(grid), dim3(NTHREADS), LDS_BYTES, stream, p, 0, N_PHASES, MK_PROBE);
#else
    for (int k = 0; k < N_PHASES; ++k) hipLaunchKernelGGL(mk_fwd, dim3(grid), dim3(NTHREADS), LDS_BYTES, stream, p, k, k + 1, -1);
#endif
}
```

```cpp
#include <hip/hip_runtime.h>
#include <cstdio>
#include <cstdint>

#ifndef MK_PROBE
#define MK_PROBE -1
#endif
#ifndef MK_ONE_LAUNCH
#define MK_ONE_LAUNCH 1
#endif

#define LAS __attribute__((address_space(3)))
typedef unsigned short bf16_t;
typedef short bf16x8 __attribute__((ext_vector_type(8)));
typedef short s16x4 __attribute__((ext_vector_type(4)));
typedef float f32x16 __attribute__((ext_vector_type(16)));
typedef float f32x4 __attribute__((ext_vector_type(4)));
typedef float f32x2 __attribute__((ext_vector_type(2)));
typedef unsigned u32x4 __attribute__((ext_vector_type(4)));
typedef unsigned u32x2 __attribute__((ext_vector_type(2)));
typedef __bf16 bf16x2_t __attribute__((ext_vector_type(2)));
typedef short v4i16_t __attribute__((ext_vector_type(4)));

constexpr int DM = 1024, LSEQ = 16384, NCTX = 256, NT = LSEQ + NCTX, INW = 2048, NEXP = 32, FFD = 1024, MIXK = 1280;
constexpr int NKT = NT / 64;
constexpr int NQB = NT / 32;
constexpr float LOG2E = 1.4426950408889634f;
constexpr int NTHREADS = 512;
constexpr int LDS_BYTES = 155648;
constexpr int LDS_CTL = 151552;

constexpr size_t al256(size_t x) { return (x + 255) & ~(size_t)255; }
constexpr size_t WS_CTL = 0, CTL_BYTES = 1u << 20;
constexpr size_t WS_MOD = CTL_BYTES;
constexpr size_t WS_ROPE = WS_MOD + 131072;
constexpr size_t WS_TW = WS_ROPE + 65536;
constexpr size_t WS_A1F = WS_TW + 131072;
constexpr size_t WS_A2F = WS_A1F + 65536;
constexpr size_t WS_ACF = WS_A2F + 131072;
constexpr size_t WS_WIN = WS_ACF + 262144;
constexpr size_t WS_WOUT = WS_WIN + (size_t)2 * INW * DM * 2;
constexpr size_t WS_WGU = WS_WOUT + (size_t)2 * DM * MIXK * 2;
constexpr size_t WS_WDN = WS_WGU + (size_t)2 * NEXP * 2048 * DM * 2;
constexpr size_t WS_HB = WS_WDN + (size_t)2 * NEXP * DM * FFD * 2;
constexpr size_t WS_QD = WS_HB + (size_t)NT * DM * 2;
constexpr size_t WS_KD = WS_QD + (size_t)6 * NQB * 2048 * 2;
constexpr size_t WS_VD = WS_KD + (size_t)6 * NKT * 4096 * 2;
constexpr size_t WS_QG = WS_VD + (size_t)6 * NKT * 4096 * 2;
constexpr size_t WS_KG = WS_QG + (size_t)6 * NQB * 2048 * 2;
constexpr size_t WS_VG = WS_KG + (size_t)2 * NKT * 4096 * 2;
constexpr size_t WS_FT = WS_VG + (size_t)2 * NKT * 4096 * 2;
constexpr size_t WS_FC = WS_FT + (size_t)128 * 2 * 4 * 4096 * 2;
constexpr size_t WS_T2 = WS_FC + (size_t)2 * 4 * 8192 * 2;
constexpr size_t WS_MIX = WS_T2 + (size_t)128 * 2 * 4 * 8192 * 2;
constexpr size_t WS_XS = WS_MIX + (size_t)NT * MIXK * 2;
constexpr size_t WS_LIST = WS_XS + (size_t)NT * DM * 4;
constexpr size_t WS_SLOT = WS_LIST + (size_t)NEXP * NT * 4;
constexpr size_t WS_GATE = WS_SLOT + (size_t)NT * 16;
constexpr size_t WS_ACT = WS_GATE + (size_t)NT * 16;
constexpr size_t WS_YB = WS_ACT + (size_t)NT * 4 * FFD * 2;
constexpr size_t WS_PART = WS_YB + (size_t)NT * 4 * DM * 2;
constexpr size_t WS_PL = WS_PART + (size_t)36 * NT * 64 * 2;
constexpr size_t WS_KP = WS_PL + (size_t)36 * NT * 4;
constexpr size_t WS_END = WS_KP + (size_t)2 * 12 * 1024 * 4;

constexpr int CW_BAR = 4096;
constexpr int CW_CNT = 8192;
constexpr int CW_KMAX = 8320;
constexpr int CW_QH = 8448;

constexpr int RD_RC = 0, RD_RS = 2048, RD_CC = 4096, RD_CS = 4608, RG_RC = 5120, RG_RS = 9216, RG_CC = 13312, RG_CS = 14336, ROPE_N = 15360;

struct Params { const float* in[25]; float* out; unsigned char* ws; };
enum { I_X = 0, I_C, I_CTX, I_CCTX, I_WMOD, I_BMOD, I_GN1, I_GN2, I_WIN, I_WOUT, I_WFNET, I_LQ1, I_LK1, I_LQ2, I_LK2, I_GSUB, I_GQ, I_GK, I_WR, I_BR, I_WGU, I_BGU, I_WDN, I_BDN, I_GFIN };

__device__ __forceinline__ unsigned pk2(float lo, float hi) { f32x2 v = {lo, hi}; bf16x2_t b = __builtin_convertvector(v, bf16x2_t); return __builtin_bit_cast(unsigned, b); }
__device__ __forceinline__ float bf2f(unsigned short u) { return __builtin_bit_cast(float, (unsigned)u << 16); }
__device__ __forceinline__ float bflo(unsigned u) { return __builtin_bit_cast(float, u << 16); }
__device__ __forceinline__ float bfhi(unsigned u) { return __builtin_bit_cast(float, u & 0xffff0000u); }
#define WAITV(n) asm volatile("s_waitcnt vmcnt(" #n ")" ::: "memory")
#define BAR_SYNC() do { asm volatile("s_waitcnt lgkmcnt(0)" ::: "memory"); __builtin_amdgcn_s_barrier(); asm volatile("" ::: "memory"); } while (0)
__device__ __forceinline__ void dma16(const void* g, LAS void* l) { __builtin_amdgcn_global_load_lds((const unsigned*)g, (LAS unsigned*)l, 16, 0, 0); }
__device__ __forceinline__ void glds16(const void* gsrc, unsigned lds_dst) { unsigned keep;
    asm volatile("s_mov_b32 %0, m0\n\ts_mov_b32 m0, %2\n\ts_nop 0\n\tglobal_load_lds_dwordx4 %1, off\n\ts_mov_b32 m0, %0" : "=&s"(keep) : "v"(gsrc), "s"(lds_dst) : "memory"); }
__device__ __forceinline__ s16x4 vtr(LAS const char* p) { return __builtin_bit_cast(s16x4, __builtin_amdgcn_ds_read_tr16_b64_v4i16((LAS v4i16_t*)p)); }
__device__ __forceinline__ int lane_now() { unsigned z = 0u; asm volatile("" : "+v"(z)); return (int)__builtin_amdgcn_mbcnt_hi(~0u, __builtin_amdgcn_mbcnt_lo(~0u, z)); }
template <int M> __device__ __forceinline__ float shxc(float v) { return __builtin_bit_cast(float, __builtin_amdgcn_ds_bpermute((lane_now() ^ M) << 2, __builtin_bit_cast(int, v))); }
__device__ __forceinline__ float add32(float v) { return v + shxc<32>(v); }
__device__ __forceinline__ float max32(float v) { return fmaxf(v, shxc<32>(v)); }
__device__ __forceinline__ float partner32(float v, bool upper) { return shxc<32>(v); }
template <int CTRL, int ROWMASK, bool BC> __device__ __forceinline__ float dppf(float old, float src) {
    return __builtin_bit_cast(float, __builtin_amdgcn_update_dpp(__builtin_bit_cast(int, old), __builtin_bit_cast(int, src), CTRL, ROWMASK, 0xf, BC)); }
__device__ __forceinline__ float wave_sum(float v) {
    v += dppf<0x111, 0xf, true>(0.f, v); v += dppf<0x112, 0xf, true>(0.f, v); v += dppf<0x114, 0xf, true>(0.f, v); v += dppf<0x118, 0xf, true>(0.f, v);
    v += dppf<0x142, 0xa, false>(0.f, v); v += dppf<0x143, 0xc, false>(0.f, v);
    return __builtin_bit_cast(float, __builtin_amdgcn_readlane(__builtin_bit_cast(int, v), 63)); }
__device__ __forceinline__ float wave_max(float v) {
    v = fmaxf(v, dppf<0x111, 0xf, false>(v, v)); v = fmaxf(v, dppf<0x112, 0xf, false>(v, v)); v = fmaxf(v, dppf<0x114, 0xf, false>(v, v)); v = fmaxf(v, dppf<0x118, 0xf, false>(v, v));
    v = fmaxf(v, dppf<0x142, 0xa, false>(v, v)); v = fmaxf(v, dppf<0x143, 0xc, false>(v, v));
    return __builtin_bit_cast(float, __builtin_amdgcn_readlane(__builtin_bit_cast(int, v), 63)); }
__device__ __forceinline__ bf16x8 pack8(float a0, float a1, float a2, float a3, float a4, float a5, float a6, float a7) {
    u32x4 w = {pk2(a0, a1), pk2(a2, a3), pk2(a4, a5), pk2(a6, a7)}; return __builtin_bit_cast(bf16x8, w); }
#define MFMA(a, b, c) __builtin_amdgcn_mfma_f32_32x32x16_bf16((a), (b), (c), 0, 0, 0)

#define XB_TMO      128
#define XB_XCNT(j)  (256  + 64 * (j))
#define XB_XSUB(j)  (1280 + 64 * (j))
#define XB_XGEN(j)  (2304 + 64 * (j))
#define XB_TOP      3328
#define XB_TOPGEN   3392
#define XCD_BAR_WORDS 3456
#define XB_SPIN_CAP (1u << 22)
__device__ __forceinline__ unsigned xb_ld(unsigned* p)              { return __hip_atomic_load(p, __ATOMIC_RELAXED, __HIP_MEMORY_SCOPE_AGENT); }
__device__ __forceinline__ unsigned xb_add(unsigned* p, unsigned v) { return __hip_atomic_fetch_add(p, v, __ATOMIC_RELAXED, __HIP_MEMORY_SCOPE_AGENT); }
__device__ __forceinline__ unsigned xb_xcc_id() { return (unsigned)__builtin_amdgcn_s_getreg((3 << 11) | 20) & 0xFu; }
#define XB_SPIN(cond, bar) do { unsigned _sp = 0; while (cond) { __builtin_amdgcn_s_sleep(1); \
    if ((++_sp & 255u) == 0u) { if (xb_ld(&(bar)[XB_TMO])) break; if (_sp > XB_SPIN_CAP) { atomicAdd(&(bar)[XB_TMO], 1u); break; } } } } while (0)
struct XcdBarrier { unsigned* bar; unsigned x; volatile LAS unsigned* st; int wid; };
__device__ __forceinline__ bool xb_leader(int wid) { unsigned z = 0u; asm volatile("" : "+v"(z)); return wid == 0 && __builtin_amdgcn_mbcnt_hi(~0u, __builtin_amdgcn_mbcnt_lo(~0u, z)) == 0u; }
__device__ __forceinline__ XcdBarrier xcd_barrier_post(unsigned* bar, volatile LAS unsigned* st, int wid) {
    XcdBarrier b; b.bar = bar; b.x = xb_xcc_id(); b.st = st; b.wid = wid;
    if (xb_leader(wid)) (void)xb_add(&bar[XB_XCNT(b.x)], 1u);
    return b;
}
__device__ __forceinline__ void xcd_barrier_complete(unsigned* bar, unsigned x, unsigned& nloc, unsigned& nx) {
    const unsigned G = gridDim.x * gridDim.y * gridDim.z;
    unsigned sum, cnt, mine, sp = 0u;
    for (;;) {
        sum = 0u; cnt = 0u; mine = 0u;
#pragma unroll
        for (unsigned j = 0; j < 16; ++j) { const unsigned c = xb_ld(&bar[XB_XCNT(j)]); sum += c; cnt += (c > 0u) ? 1u : 0u; }
        mine = xb_ld(&bar[XB_XCNT(x)]);
        if (sum == G) break;
        __builtin_amdgcn_s_sleep(1);
        if ((++sp & 255u) == 0u) { if (xb_ld(&bar[XB_TMO])) break; if (sp > XB_SPIN_CAP) { atomicAdd(&bar[XB_TMO], 1u); break; } }
    }
    nloc = mine > 0u ? mine : 1u; nx = cnt > 0u ? cnt : 1u;
}
__device__ __forceinline__ void xcd_barrier(const XcdBarrier& b) {
    asm volatile("s_waitcnt vmcnt(0)" ::: "memory");
    __syncthreads();
    if (xb_leader(b.wid)) {
        unsigned* bar = b.bar;
        __builtin_amdgcn_s_waitcnt(0);
        unsigned nloc = b.st[0], nx = b.st[1];
        if (nloc == 0u) { xcd_barrier_complete(bar, b.x, nloc, nx); b.st[0] = nloc; b.st[1] = nx; }
        const unsigned old = xb_add(&bar[XB_XSUB(b.x)], 1u);
        const unsigned gen = old / nloc;
        if (old + 1u == (gen + 1u) * nloc) {
            __builtin_amdgcn_fence(__ATOMIC_RELEASE, "agent");
            asm volatile("s_waitcnt vmcnt(0)" ::: "memory");
            const unsigned og = xb_add(&bar[XB_TOP], 1u);
            const unsigned tg = og / nx;
            if (og + 1u == (tg + 1u) * nx) xb_add(&bar[XB_TOPGEN], 1u);
            else XB_SPIN(xb_ld(&bar[XB_TOPGEN]) == tg, bar);
            __builtin_amdgcn_fence(__ATOMIC_ACQUIRE, "agent");
            xb_add(&bar[XB_XGEN(b.x)], 1u);
            asm volatile("s_waitcnt vmcnt(0)" ::: "memory");
        } else {
            XB_SPIN(xb_ld(&bar[XB_XGEN(b.x)]) == gen, bar);
            __builtin_amdgcn_fence(__ATOMIC_ACQUIRE, "agent");
            asm volatile("s_waitcnt vmcnt(0)" ::: "memory");
        }
    }
    __syncthreads();
}

struct Frame {
    const __attribute__((address_space(4))) Params* pp; unsigned char* wsb; LAS char* lds; int tid, lane, wid, G, bid;
    unsigned* ctl;
    __device__ __forceinline__ const float* in(int i) const { return pp->in[i]; }
    __device__ __forceinline__ float* outp() const { return pp->out; }
    template <class T> __device__ __forceinline__ T* ws(size_t off) const { return (T*)(wsb + off); }
};
__device__ __forceinline__ Frame fresh(const Frame& F);

__device__ __forceinline__ int lds_byte(int r, int c) { const int st = (r >> 4) * 2 + (c >> 5), rr = r & 15, cc = c & 31, ob = rr * 64 + cc * 2; return st * 1024 + (ob ^ (((ob >> 9) & 1) << 5)); }
__device__ __forceinline__ size_t wblk(int n, int k, int nkt) { return ((size_t)((n >> 8) * nkt + (k >> 6)) * 32768) + (size_t)(((n >> 7) & 1) * 16384 + lds_byte(n & 127, k & 63)); }
template <class RowMap>
__device__ __forceinline__ void transpose_tile(const Frame& F, const float* __restrict__ src, int ldn, int k0, int n0, bf16_t* dst, int ldk, int kdst0, const RowMap& rm) {
    LAS float* tile = (LAS float*)F.lds;
    const int t = F.tid;
    f32x4 v[8];
#pragma unroll
    for (int i = 0; i < 8; ++i) { const int idx = t + 512 * i, k = idx >> 6, c4 = idx & 63; v[i] = *(const f32x4*)(src + (size_t)(k0 + k) * ldn + n0 + 4 * c4); }
#pragma unroll
    for (int i = 0; i < 8; ++i) { const int idx = t + 512 * i, k = idx >> 6, c4 = idx & 63; *(LAS f32x4*)(tile + k * 260 + 4 * c4) = v[i]; }
    __syncthreads();
    { const int n = t >> 1, kh = t & 1; const int drow = rm(n0 + n), nkt = ldk >> 6; char* const db = (char*)dst;
#pragma unroll
      for (int q = 0; q < 4; ++q) { float a[8];
#pragma unroll
          for (int j = 0; j < 8; ++j) a[j] = tile[(32 * kh + 8 * q + j) * 260 + n];
          u32x4 w = {pk2(a[0], a[1]), pk2(a[2], a[3]), pk2(a[4], a[5]), pk2(a[6], a[7])}; *(u32x4*)(db + wblk(drow, kdst0 + 32 * kh + 8 * q, nkt)) = w; } }
    __syncthreads();
}
struct RowId { __device__ __forceinline__ int operator()(int n) const { return n; } };
struct RowGU { __device__ __forceinline__ int operator()(int n) const { const int ri = n >> 10, j = n & 1023; return 64 * (j >> 5) + 32 * ri + (j & 31); } };

constexpr int P0_GEMV = 192, P0_FOLD = 128, P0_TAB = 16;
constexpr int P0_TWIN = 2 * 16 * 8, P0_TWOUT = 2 * 12 * 4, P0_TWGU = 2 * 32 * 16 * 8, P0_TWDN = 2 * 32 * 16 * 4;
constexpr int P0_ITEMS = P0_GEMV + P0_FOLD + P0_TAB + P0_TWIN + P0_TWOUT + P0_TWGU + P0_TWDN;

__device__ __forceinline__ void p0_gemv(const Frame& F, int item) {
    const int l = item / 96, cc = item % 96, t = F.tid, lane = F.lane, w = F.wid;
    LAS float* sc = (LAS float*)F.lds;
    LAS float* red = sc + 2048;
    const float* c = F.in(I_C); const float* cx = F.in(I_CCTX);
#pragma unroll
    for (int i = 0; i < 2; ++i) { const int k = t + 512 * i; const float a = c[k], b = cx[k]; sc[k] = a / (1.f + __expf(-a)); sc[1024 + k] = b / (1.f + __expf(-b)); }
    __syncthreads();
    const int col = 64 * cc + lane; const float* wm = F.in(I_WMOD) + (size_t)l * 1024 * 6144 + col;
    float a1 = 0.f, a2 = 0.f;
#pragma unroll 8
    for (int k = 128 * w; k < 128 * w + 128; ++k) { const float wv = wm[(size_t)k * 6144]; a1 += sc[k] * wv; a2 += sc[1024 + k] * wv; }
    red[w * 64 + lane] = a1; red[512 + w * 64 + lane] = a2;
    __syncthreads();
    if (w == 0) { float s1 = 0.f, s2 = 0.f;
#pragma unroll
        for (int j = 0; j < 8; ++j) { s1 += red[j * 64 + lane]; s2 += red[512 + j * 64 + lane]; }
        const float b = F.in(I_BMOD)[l * 6144 + col]; float* mod = F.ws<float>(WS_MOD) + (size_t)l * 2 * 6144;
        mod[col] = s1 + b; mod[6144 + col] = s2 + b; }
    __syncthreads();
}
__device__ __forceinline__ void p0_fold(const Frame& F, int item) {
    const int nch = item & 7, g = (item >> 3) & 3, ri = (item >> 5) & 1, l = item >> 6, t = F.tid;
    LAS float* Mx = (LAS float*)F.lds;
    LAS float* wf = Mx + 64 * 65;
    const float* wfn = F.in(I_WFNET) + (size_t)(l * 4 + g) * 4096;
    for (int i = t; i < 4096; i += 512) wf[(i >> 6) * 65 + (i & 63)] = wfn[i];
    __syncthreads();
    for (int i = t; i < 4096; i += 512) { const int c = i >> 6, e = i & 63; float s = 0.f;
        for (int m = 0; m < 64; ++m) { float sn, cs; sincospif(2.f * (float)((m * c) & 63) / 64.f, &sn, &cs); s += (ri ? sn : cs) * wf[m * 65 + e]; }
        Mx[c * 65 + e] = s; }
    __syncthreads();
    const float* wo = F.in(I_WOUT) + (size_t)l * 1024 * 1024 + (size_t)(64 * g) * 1024;
    bf16_t* dst = F.ws<bf16_t>(WS_WOUT) + (size_t)l * DM * MIXK;
    { const int n = nch * 128 + (t & 127), c0 = (t >> 7) * 16; float acc[16];
#pragma unroll
      for (int j = 0; j < 16; ++j) acc[j] = 0.f;
      for (int e = 0; e < 64; ++e) { const float wv = wo[(size_t)e * 1024 + n];
#pragma unroll
          for (int j = 0; j < 16; ++j) acc[j] += Mx[(c0 + j) * 65 + e] * wv; }
      u32x4 w0 = {pk2(acc[0], acc[1]), pk2(acc[2], acc[3]), pk2(acc[4], acc[5]), pk2(acc[6], acc[7])};
      u32x4 w1 = {pk2(acc[8], acc[9]), pk2(acc[10], acc[11]), pk2(acc[12], acc[13]), pk2(acc[14], acc[15])};
      char* const db = (char*)dst; const int k0 = 256 * ri + 64 * g + c0; *(u32x4*)(db + wblk(n, k0, MIXK >> 6)) = w0; *(u32x4*)(db + wblk(n, k0 + 8, MIXK >> 6)) = w1; }
    __syncthreads();
}
__device__ __forceinline__ void p0_tables(const Frame& F, int item) {
    constexpr int N0 = ROPE_N, N1 = N0 + 16384, N2 = N1 + 32768, N3 = N2 + 65536, N4 = N3 + 131072;
    float* rope = F.ws<float>(WS_ROPE); f32x2* tw = F.ws<f32x2>(WS_TW);
    bf16_t* a1 = F.ws<bf16_t>(WS_A1F); bf16_t* a2 = F.ws<bf16_t>(WS_A2F); bf16_t* ac = F.ws<bf16_t>(WS_ACF);
    for (int idx = item * 512 + F.tid; idx < N4; idx += P0_TAB * 512) {
        if (idx < N0) {
            int i = idx; bool isg = false; if (i >= RG_RC) { isg = true; i -= RG_RC; }
            const int n = isg ? 16 : 8, rowsz = 256 * n, colsz = 64 * n;
            int which, pos, fi;
            if (i < rowsz) { which = 0; pos = i / n; fi = i % n; } else if (i < 2 * rowsz) { which = 1; i -= rowsz; pos = i / n; fi = i % n; }
            else if (i < 2 * rowsz + colsz) { which = 2; i -= 2 * rowsz; pos = i / n; fi = i % n; } else { which = 3; i -= 2 * rowsz + colsz; pos = i / n; fi = i % n; }
            const float inv = powf(10000.f, -(float)fi / (float)n); const float ang = (float)pos * inv;
            rope[idx] = (which & 1) ? sinf(ang) : cosf(ang);
        } else if (idx < N1) { const int j = idx - N0; float sn, cs; sincospif(2.f * (float)j / 16384.f, &sn, &cs); tw[j] = (f32x2){cs, sn};
        } else if (idx < N2) { const int e = idx - N1; const int j = e & 7, ln = (e >> 3) & 63, s = (e >> 9) & 7, fb = (e >> 12) & 1, rg = e >> 13;
            const int k1 = 32 * rg + (ln & 31), l1 = 16 * s + 8 * (ln >> 5) + j; float sn, cs; sincospif(2.f * (float)((k1 * l1) & 127) / 128.f, &sn, &cs);
            a1[e] = (bf16_t)(pk2(fb ? -sn : cs, 0.f) & 0xffff);
        } else if (idx < N3) { const int e = idx - N2; const int j = e & 7, ln = (e >> 3) & 63, s = (e >> 9) & 15, fb = (e >> 13) & 1, rg = e >> 14;
            const int k2 = 32 * rg + (ln & 31), kk = 16 * s + 8 * (ln >> 5) + j, l2 = kk >> 1, rip = kk & 1; float sn, cs; sincospif(2.f * (float)((k2 * l2) & 127) / 128.f, &sn, &cs);
            const float v = fb == 0 ? (rip == 0 ? cs : sn) : (rip == 0 ? -sn : cs);
            a2[e] = (bf16_t)(pk2(v, 0.f) & 0xffff);
        } else { const int e = idx - N3; const int j = e & 7, ln = (e >> 3) & 63, s = (e >> 9) & 15, fb = (e >> 13) & 1, rg = (e >> 14) & 3, pa = e >> 16;
            const int k = 128 * pa + 32 * rg + (ln & 31), li = 16 * s + 8 * (ln >> 5) + j; float sn, cs; sincospif(2.f * (float)((k * li) & 255) / 256.f, &sn, &cs);
            ac[e] = (bf16_t)(pk2(fb ? -sn : cs, 0.f) & 0xffff); }
    }
}
__device__ __forceinline__ void phase_prologue(const Frame& F) {
    LAS unsigned* qw = (LAS unsigned*)(F.lds + LDS_CTL + 64);
    unsigned nxt = 0u; if (F.tid == 0) nxt = xb_add(F.ctl + CW_QH + 32, 1u);
    for (;;) {
        __syncthreads();
        if (F.tid == 0) *qw = nxt;
        __syncthreads();
        const int it = (int)*qw; if (it >= P0_ITEMS) break;
        if (F.tid == 0) nxt = xb_add(F.ctl + CW_QH + 32, 1u);
        int i = it;
        if (i < P0_GEMV) { p0_gemv(F, i); continue; } i -= P0_GEMV;
        if (i < P0_FOLD) { p0_fold(F, i); continue; } i -= P0_FOLD;
        if (i < P0_TAB) { p0_tables(F, i); continue; } i -= P0_TAB;
        if (i < P0_TWIN) { const int l = i / 128, r = i % 128, kt = r / 8, nt = r % 8;
            transpose_tile(F, F.in(I_WIN) + (size_t)l * DM * INW, INW, 64 * kt, 256 * nt, F.ws<bf16_t>(WS_WIN) + (size_t)l * INW * DM, DM, 64 * kt, RowId()); continue; } i -= P0_TWIN;
        if (i < P0_TWOUT) { const int l = i / 48, r = i % 48, kt = r / 4, nt = r % 4;
            transpose_tile(F, F.in(I_WOUT) + (size_t)l * DM * DM, DM, 256 + 64 * kt, 256 * nt, F.ws<bf16_t>(WS_WOUT) + (size_t)l * DM * MIXK, MIXK, 512 + 64 * kt, RowId()); continue; } i -= P0_TWOUT;
        if (i < P0_TWGU) { const int le = i / 128, r = i % 128, kt = r / 8, nt = r % 8;
            transpose_tile(F, F.in(I_WGU) + (size_t)le * DM * 2048, 2048, 64 * kt, 256 * nt, F.ws<bf16_t>(WS_WGU) + (size_t)le * 2048 * DM, DM, 64 * kt, RowGU()); continue; } i -= P0_TWGU;
        { const int le = i / 64, r = i % 64, kt = r / 4, nt = r % 4;
            transpose_tile(F, F.in(I_WDN) + (size_t)le * FFD * DM, DM, 64 * kt, 256 * nt, F.ws<bf16_t>(WS_WDN) + (size_t)le * DM * FFD, FFD, 64 * kt, RowId()); }
    }
}

__device__ __forceinline__ void load_row(const float* row, int lane, f32x4 (&x)[4]) {
#pragma unroll
    for (int q = 0; q < 4; ++q) x[q] = *(const f32x4*)(row + 256 * q + 4 * lane);
}
__device__ __forceinline__ float row_rstd(const f32x4 (&x)[4], float eps) {
    float ss = 0.f;
#pragma unroll
    for (int q = 0; q < 4; ++q) ss += x[q][0] * x[q][0] + x[q][1] * x[q][1] + x[q][2] * x[q][2] + x[q][3] * x[q][3];
    ss = wave_sum(ss); return rsqrtf(ss * (1.f / 1024.f) + eps);
}
__device__ __forceinline__ void mod_store_bf16(const f32x4 (&x)[4], float rstd, const float* __restrict__ g, const float* __restrict__ shift, const float* __restrict__ scale, bf16_t* __restrict__ dst, int lane, f32x4 (*hout)[4] = nullptr) {
    f32x4 gv[4], sh[4], sc[4];
#pragma unroll
    for (int q = 0; q < 4; ++q) { const int k = 256 * q + 4 * lane; gv[q] = *(const f32x4*)(g + k); sh[q] = *(const f32x4*)(shift + k); sc[q] = *(const f32x4*)(scale + k); }
    __builtin_amdgcn_sched_barrier(0);
#pragma unroll
    for (int q = 0; q < 4; ++q) { const int k = 256 * q + 4 * lane;
        f32x4 hv;
#pragma unroll
        for (int i = 0; i < 4; ++i) hv[i] = (x[q][i] * rstd * gv[q][i]) * (1.f + sc[q][i]) + sh[q][i];
        u32x2 w = {pk2(hv[0], hv[1]), pk2(hv[2], hv[3])}; *(u32x2*)(dst + k) = w;
        if (hout) (*hout)[q] = hv; }
}
__device__ __forceinline__ void phase_norm0(const Frame& F) {
    const float* mod = F.ws<float>(WS_MOD); bf16_t* hb = F.ws<bf16_t>(WS_HB); const float* g1 = F.in(I_GN1);
    const float* xc = F.in(I_CTX); const float* xl = F.in(I_X);
    const int step = F.G * 8;
    for (int R0 = F.bid * 8 + F.wid; R0 < NT; R0 += 4 * step) {
        f32x4 x[4][4];
#pragma unroll
        for (int j = 0; j < 4; ++j) { const int R = min(R0 + j * step, NT - 1); load_row(R < NCTX ? xc + (size_t)R * DM : xl + (size_t)(R - NCTX) * DM, F.lane, x[j]); }
#pragma unroll
        for (int j = 0; j < 4; ++j) { const int R = R0 + j * step; if (R < NT) { const float* m = mod + (R < NCTX ? 6144 : 0);
            const float rstd = row_rstd(x[j], 1e-6f); mod_store_bf16(x[j], rstd, g1, m, m + 1024, hb + (size_t)R * DM, F.lane); } }
    }
}

#define MFMA16(a, b, c) __builtin_amdgcn_mfma_f32_16x16x32_bf16((a), (b), (c), 0, 0, 0)
__device__ __forceinline__ void stage_rc(int b, int& R, int& C) { const int st = b / 1024, sb = b % 1024, swz = sb ^ (((sb >> 9) & 1) << 5); R = (st >> 1) * 16 + swz / 64; C = (st & 1) * 32 + (swz % 64) / 2; }
struct EpiC { f32x4 c[4]; };
struct EpiT { f32x4 t[4]; };
template <class XRow, class Epi>
__device__ __forceinline__ void gemm8(const Frame& F, const bf16_t* __restrict__ A, int K, int brow, const XRow& xrow, const Epi& epi) {
    constexpr int HTB = 16384;
    LAS char* shm = F.lds;
    const int tz = F.tid, wid = F.wid, lane = tz & 63, wr = wid >> 2, wc = wid & 3, fr = lane & 15, fq = lane >> 4;
    const bf16_t* xp[2][2];
#pragma unroll
    for (int i = 0; i < 2; ++i) { int r, c; stage_rc(tz * 16 + i * 8192, r, c); xp[0][i] = xrow(r) + c; xp[1][i] = xrow(128 + r) + c; }
    const char* Ab = (const char*)A + (size_t)(brow >> 8) * (K >> 6) * 32768 + tz * 16;
    const int ldsw = wid * 1024;
    const int aoffl = lds_byte(wr * 64 + fr, fq * 8), boffl = lds_byte(wc * 32 + fr, fq * 8);
#define SA(b, h) (shm + ((b) * 2 + (h)) * HTB)
#define SB(b, h) (shm + (4 + (b) * 2 + (h)) * HTB)
#define STAGE_A(b, h, kt) do { _Pragma("unroll") for (int i_ = 0; i_ < 2; ++i_) dma16(Ab + ((size_t)(kt) * 32768 + (h) * 16384 + i_ * 8192), SA(b, h) + ldsw + i_ * 8192); } while (0)
#define STAGE_B(b, h, kt) do { _Pragma("unroll") for (int i_ = 0; i_ < 2; ++i_) dma16(xp[h][i_] + (size_t)(kt) * 64, SB(b, h) + ldsw + i_ * 8192); } while (0)
#define LDA(dst, b, h) do { _Pragma("unroll") for (int m = 0; m < 4; ++m) _Pragma("unroll") for (int k = 0; k < 2; ++k) dst[m][k] = *(LAS const bf16x8*)(SA(b, h) + aoffl + m * 2048 + k * 1024); } while (0)
#define LDB(dst, b, h) do { _Pragma("unroll") for (int n = 0; n < 2; ++n) _Pragma("unroll") for (int k = 0; k < 2; ++k) dst[n][k] = *(LAS const bf16x8*)(SB(b, h) + boffl + n * 2048 + k * 1024); } while (0)
#define MMA(ai, bj, At_, Bt_) do { __builtin_amdgcn_s_setprio(1); _Pragma("unroll") for (int m = 0; m < 4; ++m) _Pragma("unroll") for (int n = 0; n < 2; ++n) _Pragma("unroll") for (int k = 0; k < 2; ++k) \
        acc[ai][bj][m][n] = MFMA16(At_[m][k], Bt_[n][k], acc[ai][bj][m][n]); __builtin_amdgcn_s_setprio(0); } while (0)
#define WAIT_V(n) asm volatile("s_waitcnt vmcnt(" #n ")" ::: "memory")
#define WAIT_L(n) asm volatile("s_waitcnt lgkmcnt(" #n ")" ::: "memory")
#define BAR __builtin_amdgcn_s_barrier()
#define SCHED __builtin_amdgcn_sched_barrier(0)
    f32x4 acc[2][2][4][2];
#pragma unroll
    for (int a = 0; a < 2; ++a)
#pragma unroll
        for (int b = 0; b < 2; ++b)
#pragma unroll
            for (int m = 0; m < 4; ++m)
#pragma unroll
                for (int n = 0; n < 2; ++n) acc[a][b][m][n] = (f32x4){0.f, 0.f, 0.f, 0.f};
    if constexpr (Epi::BIAS_INIT) {
#pragma unroll
        for (int a = 0; a < 2; ++a) { const EpiC Ci = epi.load_c((brow >> 6) + 2 * a + wr, fq);
#pragma unroll
            for (int b = 0; b < 2; ++b)
#pragma unroll
                for (int m = 0; m < 4; ++m)
#pragma unroll
                    for (int n = 0; n < 2; ++n) acc[a][b][m][n] = Ci.c[m]; } }
    bf16x8 At[4][2], B0[2][2], B1[2][2];
    const int nt = K / 64;
    WAIT_L(0); BAR;
    STAGE_B(0, 0, 0); STAGE_B(0, 1, 0); STAGE_A(0, 0, 0); STAGE_A(0, 1, 0); STAGE_B(1, 0, 1); STAGE_B(1, 1, 1);
    WAIT_V(6);
    if (wr == 1) BAR;
    BAR;
#pragma unroll 1
    for (int t = 0; t < nt; t += 2) {
        const int k2 = (t == nt - 2) ? 0 : t + 2;
        LDB(B0, 0, 0); LDB(B1, 0, 1); SCHED; LDA(At, 0, 0); STAGE_A(1, 0, t + 1); STAGE_A(1, 1, t + 1);
        WAIT_V(8); WAIT_L(0); BAR; MMA(0, 0, At, B0); MMA(0, 1, At, B1); BAR; SCHED;
        LDA(At, 0, 1); STAGE_B(0, 0, k2); STAGE_B(0, 1, k2);
        WAIT_V(6); WAIT_L(0); BAR; MMA(1, 0, At, B0); MMA(1, 1, At, B1); BAR; SCHED;
        LDB(B0, 1, 0); LDB(B1, 1, 1); SCHED; LDA(At, 1, 0); STAGE_A(0, 0, k2); STAGE_A(0, 1, k2);
        WAIT_V(8); WAIT_L(0); BAR; MMA(0, 0, At, B0); MMA(0, 1, At, B1); BAR; SCHED;
        LDA(At, 1, 1); STAGE_B(1, 0, k2 + 1); STAGE_B(1, 1, k2 + 1);
        WAIT_V(6); WAIT_L(0); BAR; MMA(1, 0, At, B0); MMA(1, 1, At, B1); BAR; SCHED;
    }
    int tq = F.tid; asm volatile("" : "+v"(tq)); const int fr2 = tq & 15, fq2 = (tq >> 4) & 3;
    const EpiC C0 = epi.load_c((brow >> 6) + wr, fq2);
    const EpiT T0 = epi.load_t((brow >> 6) + wr, wc * 32 + fr2, fq2);
    WAIT_V(0);
    if (wr == 0) BAR;
    BAR;
#undef SA
#undef SB
#undef STAGE_A
#undef STAGE_B
#undef LDA
#undef LDB
#undef MMA
#undef WAIT_V
#undef WAIT_L
#undef BAR
#undef SCHED
    EpiT T = T0;
#pragma unroll
    for (int ai = 0; ai < 2; ++ai) { const int cg = (brow >> 6) + 2 * ai + wr;
        const EpiC C = ai == 0 ? C0 : epi.load_c(cg, fq2);
#pragma unroll
        for (int c = 0; c < 4; ++c) { const int bj = c >> 1, n = c & 1; const int tok = bj * 128 + wc * 32 + n * 16 + fr2;
            EpiT Tn = T;
            if (c < 3) Tn = epi.load_t(cg, ((c + 1) >> 1) * 128 + wc * 32 + ((c + 1) & 1) * 16 + fr2, fq2); else if (ai == 0) Tn = epi.load_t(cg + 2, wc * 32 + fr2, fq2);
            f32x4 v[4] = {acc[ai][bj][0][n], acc[ai][bj][1][n], acc[ai][bj][2][n], acc[ai][bj][3][n]};
            epi.apply(v, cg, tok, fq2, C, T); T = Tn; } }
}

__device__ __forceinline__ u32x2 pk4(const f32x4& v) { return (u32x2){pk2(v[0], v[1]), pk2(v[2], v[3])}; }
struct EpiInProj {
    static constexpr bool BIAS_INIT = false;
    const Frame& F; int l, t0;
    __device__ __forceinline__ EpiC load_c(int cg, int fq) const { EpiC C;
#pragma unroll
        for (int m = 0; m < 4; ++m) C.c[m] = (f32x4){0.f, 0.f, 0.f, 0.f};
        if (cg >= 22 && cg < 30) { const float* gw = (cg < 28 ? F.in(I_GQ) : F.in(I_GK)) + 64 * l;
#pragma unroll
            for (int m = 0; m < 4; ++m) C.c[m] = *(const f32x4*)(gw + 16 * m + 4 * fq); }
        return C; }
    __device__ __forceinline__ EpiT load_t(int cg, int tok, int fq) const { EpiT T;
#pragma unroll
        for (int m = 0; m < 4; ++m) T.t[m] = (f32x4){0.f, 0.f, 0.f, 0.f};
        const int R = t0 + tok; const int t = R - NCTX; const int prow = (t >> 6) & 255, pcol = t & 63; const float* const rope = F.ws<float>(WS_ROPE);
        if (R >= NCTX) {
            if (cg >= 4 && cg < 16) { const int ti = fq < 2 ? RD_RC + prow * 8 + 4 * fq : RD_CC + pcol * 8 + 4 * (fq - 2), si = fq < 2 ? RD_RS + prow * 8 + 4 * fq : RD_CS + pcol * 8 + 4 * (fq - 2);
                T.t[0] = *(const f32x4*)(rope + ti); T.t[1] = *(const f32x4*)(rope + si); }
            else if (cg >= 22 && cg < 30) { T.t[0] = *(const f32x4*)(rope + RG_RC + prow * 16 + 4 * fq); T.t[1] = *(const f32x4*)(rope + RG_RS + prow * 16 + 4 * fq);
                T.t[2] = *(const f32x4*)(rope + RG_CC + pcol * 16 + 4 * fq); T.t[3] = *(const f32x4*)(rope + RG_CS + pcol * 16 + 4 * fq); } }
        return T; }
    __device__ __forceinline__ void apply(f32x4 (&v)[4], int cg, int tok, int fq, const EpiC& C, const EpiT& T) const {
        bf16_t* const ft = F.ws<bf16_t>(WS_FT); bf16_t* const fc = F.ws<bf16_t>(WS_FC); bf16_t* const qd = F.ws<bf16_t>(WS_QD); bf16_t* const kd = F.ws<bf16_t>(WS_KD); bf16_t* const vd = F.ws<bf16_t>(WS_VD);
        bf16_t* const qg = F.ws<bf16_t>(WS_QG); bf16_t* const kg = F.ws<bf16_t>(WS_KG); bf16_t* const vg = F.ws<bf16_t>(WS_VG);
        unsigned* const kmax = F.ctl + CW_KMAX + 16 * l;
        const float QSD = 0.17677669529663687f * LOG2E, QSG = 0.125f * LOG2E;
        const int R = t0 + tok; const bool isctx = R < NCTX; const int t = R - NCTX;
        if (cg < 4) {
#pragma unroll
            for (int m = 0; m < 4; ++m) { const int ch = 64 * cg + 16 * m + 4 * fq; const u32x2 w = pk4(v[m]);
                if (isctx) { const size_t a = (size_t)(((ch >> 7) * 4 + ((ch >> 5) & 3)) * 8192 + (R >> 3) * 256 + (R & 7) * 32 + (ch & 31)); *(u32x2*)(fc + a) = w; }
                else { const int l1 = t >> 7, l2 = t & 127; const size_t a = (size_t)((l2 * 2 + (ch >> 7)) * 4 + ((ch >> 5) & 3)) * 4096 + (l1 >> 3) * 256 + (l1 & 7) * 32 + (ch & 31); *(u32x2*)(ft + a) = w; } }
        } else if (cg < 16) {
            const bool isq = cg < 10; const int head = isq ? cg - 4 : cg - 10;
            if (!isctx) { const f32x4 cc = T.t[0], sn = T.t[1];
#pragma unroll
                for (int mp = 0; mp < 2; ++mp)
#pragma unroll
                    for (int j = 0; j < 4; ++j) { const float a = v[2 * mp][j], b = v[2 * mp + 1][j]; v[2 * mp][j] = a * cc[j] - b * sn[j]; v[2 * mp + 1][j] = b * cc[j] + a * sn[j]; } }
            if (isq) {
#pragma unroll
                for (int m = 0; m < 4; ++m) { const f32x4 s = v[m] * QSD;
                    const size_t a = ((((size_t)(head * NQB + (R >> 5)) * 2 + (m >> 1)) * 4 + 2 * (m & 1) + (fq >> 1)) * 32 + (R & 31)) * 8 + 4 * (fq & 1); *(u32x2*)(qd + a) = pk4(s); }
            } else {
                float ss0 = 0.f, ss1 = 0.f;
#pragma unroll
                for (int j = 0; j < 4; ++j) { ss0 += v[0][j] * v[0][j] + v[1][j] * v[1][j]; ss1 += v[2][j] * v[2][j] + v[3][j] * v[3][j]; }
                ss0 += shxc<16>(ss0); ss1 += shxc<16>(ss1); ss0 = add32(ss0); ss1 = add32(ss1);
                ss0 = fmaxf(ss0, shxc<8>(ss0)); ss1 = fmaxf(ss1, shxc<8>(ss1)); ss0 = fmaxf(ss0, shxc<4>(ss0)); ss1 = fmaxf(ss1, shxc<4>(ss1));
                ss0 = fmaxf(ss0, shxc<2>(ss0)); ss1 = fmaxf(ss1, shxc<2>(ss1)); ss0 = fmaxf(ss0, shxc<1>(ss0)); ss1 = fmaxf(ss1, shxc<1>(ss1));
                if ((tok & 15) == 0 && fq == 0) { float* kp = F.ws<float>(WS_KP) + ((size_t)(l * 12 + 2 * head) * 64 + ((t0 >> 8) - 1)) * 16 + (tok >> 4); kp[0] = ss0; kp[1024] = ss1; }
#pragma unroll
                for (int m = 0; m < 4; ++m) {
                    const size_t a = ((((size_t)(head * NKT + (R >> 6)) * 2 + (m >> 1)) * 4 + 2 * (m & 1) + (fq >> 1)) * 64 + (R & 63)) * 8 + 4 * (fq & 1); *(u32x2*)(kd + a) = pk4(v[m]); }
            }
        } else if (cg < 22 || cg >= 30) {
            const bool isd = cg < 22; const int head = isd ? cg - 16 : cg - 30; bf16_t* vb = isd ? vd : vg;
#pragma unroll
            for (int m = 0; m < 4; ++m) {
                const size_t a = (size_t)(head * NKT + (R >> 6)) * 4096 + m * 1024 + (R & 63) * 16 + 4 * fq; *(u32x2*)(vb + a) = pk4(v[m]); }
        } else {
            const bool isq = cg < 28; const int head = isq ? cg - 22 : cg - 28;
            float ss = 0.f;
#pragma unroll
            for (int m = 0; m < 4; ++m)
#pragma unroll
                for (int j = 0; j < 4; ++j) ss += v[m][j] * v[m][j];
            ss += shxc<16>(ss); ss = add32(ss); const float rs = rsqrtf(ss * (1.f / 64.f) + 1e-6f);
#pragma unroll
            for (int m = 0; m < 4; ++m) v[m] = v[m] * C.c[m] * rs;
            if (!isctx) { const f32x4 cr = T.t[0], sr = T.t[1], cc = T.t[2], sc = T.t[3];
#pragma unroll
                for (int j = 0; j < 4; ++j) { { const float a = v[0][j], b = v[2][j]; v[0][j] = a * cr[j] - b * sr[j]; v[2][j] = b * cr[j] + a * sr[j]; }
                    { const float a = v[1][j], b = v[3][j]; v[1][j] = a * cc[j] - b * sc[j]; v[3][j] = b * cc[j] + a * sc[j]; } } }
#pragma unroll
            for (int m = 0; m < 4; ++m) { const f32x4 s = isq ? v[m] * QSG : v[m]; const int c = 2 * m + (fq >> 1);
                if (isq) { const size_t a = (((size_t)(head * NQB + (R >> 5)) * 8 + c) * 32 + (R & 31)) * 8 + 4 * (fq & 1); *(u32x2*)(qg + a) = pk4(s); }
                else { const size_t a = (((size_t)(head * NKT + (R >> 6)) * 8 + c) * 64 + (R & 63)) * 8 + 4 * (fq & 1); *(u32x2*)(kg + a) = pk4(s); } }
        }
    }
};
struct EpiOutProj {
    static constexpr bool BIAS_INIT = false;
    const Frame& F; int l, t0;
    __device__ __forceinline__ const float* src_row(int R) const { return l == 0 ? (R < NCTX ? F.in(I_CTX) + (size_t)R * DM : F.in(I_X) + (size_t)(R - NCTX) * DM) : F.ws<float>(WS_XS) + (size_t)R * DM; }
    __device__ __forceinline__ EpiC load_c(int cg, int fq) const { EpiC C; const float* gt = F.ws<float>(WS_MOD) + (size_t)l * 2 * 6144 + (t0 < NCTX ? 6144 : 0) + 2048;
#pragma unroll
        for (int m = 0; m < 4; ++m) C.c[m] = *(const f32x4*)(gt + 64 * cg + 16 * m + 4 * fq);
        return C; }
    __device__ __forceinline__ EpiT load_t(int cg, int tok, int fq) const { EpiT T; const float* src = src_row(t0 + tok);
#pragma unroll
        for (int m = 0; m < 4; ++m) T.t[m] = *(const f32x4*)(src + 64 * cg + 16 * m + 4 * fq);
        return T; }
    __device__ __forceinline__ void apply(f32x4 (&v)[4], int cg, int tok, int fq, const EpiC& C, const EpiT& T) const {
        float* xs = F.ws<float>(WS_XS) + (size_t)(t0 + tok) * DM;
#pragma unroll
        for (int m = 0; m < 4; ++m) *(f32x4*)(xs + 64 * cg + 16 * m + 4 * fq) = T.t[m] + C.c[m] * v[m];
    }
};
struct EpiGateUp {
    static constexpr bool BIAS_INIT = true;
    const Frame& F; int le, m0, cnt, offs;
    __device__ __forceinline__ EpiC load_c(int cg, int fq) const { EpiC C; const float* bias = F.in(I_BGU) + (size_t)le * 2048 + 32 * cg + 4 * fq;
        C.c[0] = *(const f32x4*)(bias); C.c[1] = *(const f32x4*)(bias + 16); C.c[2] = *(const f32x4*)(bias + 1024) + 1.f; C.c[3] = *(const f32x4*)(bias + 1024 + 16) + 1.f; return C; }
    __device__ __forceinline__ EpiT load_t(int, int, int) const { EpiT T;
#pragma unroll
        for (int m = 0; m < 4; ++m) T.t[m] = (f32x4){0.f, 0.f, 0.f, 0.f};
        return T; }
    __device__ __forceinline__ void apply(f32x4 (&v)[4], int cg, int tok, int fq, const EpiC& C, const EpiT&) const {
        const int mt = m0 + tok; if (mt >= cnt) return;
        bf16_t* dst = F.ws<bf16_t>(WS_ACT) + (size_t)(offs + mt) * FFD;
#pragma unroll
        for (int m = 0; m < 2; ++m) { const int jj = 32 * cg + 16 * m + 4 * fq; f32x4 o;
#pragma unroll
            for (int j = 0; j < 4; ++j) { float gl = v[m][j], l1 = v[m + 2][j]; gl = fminf(gl, 7.f); l1 = fminf(fmaxf(l1, -6.f), 8.f);
                o[j] = gl * __builtin_amdgcn_rcpf(1.f + __builtin_amdgcn_exp2f(-1.702f * LOG2E * gl)) * l1; }
            *(u32x2*)(dst + jj) = pk4(o); }
    }
};
struct EpiDown {
    static constexpr bool BIAS_INIT = true;
    const Frame& F; int le, m0, cnt, offs;
    __device__ __forceinline__ EpiC load_c(int cg, int fq) const { EpiC C; const float* bias = F.in(I_BDN) + (size_t)le * DM + 64 * cg + 4 * fq;
#pragma unroll
        for (int m = 0; m < 4; ++m) C.c[m] = *(const f32x4*)(bias + 16 * m);
        return C; }
    __device__ __forceinline__ EpiT load_t(int, int, int) const { EpiT T;
#pragma unroll
        for (int m = 0; m < 4; ++m) T.t[m] = (f32x4){0.f, 0.f, 0.f, 0.f};
        return T; }
    __device__ __forceinline__ void apply(f32x4 (&v)[4], int cg, int tok, int fq, const EpiC& C, const EpiT&) const {
        const int mt = m0 + tok; if (mt >= cnt) return;
        bf16_t* dst = F.ws<bf16_t>(WS_YB) + (size_t)(offs + mt) * DM;
#pragma unroll
        for (int m = 0; m < 4; ++m) *(u32x2*)(dst + 64 * cg + 16 * m + 4 * fq) = pk4(v[m]);
    }
};
struct XDense { const bf16_t* X; int ld; int t0; __device__ __forceinline__ const bf16_t* operator()(int row) const { return X + (size_t)(t0 + row) * ld; } };
struct XGather { const bf16_t* X; const unsigned* list; int m0, cnt; __device__ __forceinline__ const bf16_t* operator()(int row) const { int m = m0 + row; m = m < cnt ? m : cnt - 1; return X + (size_t)list[m] * DM; } };
struct XAct { const bf16_t* X; int base, m0, cnt; __device__ __forceinline__ const bf16_t* operator()(int row) const { int m = m0 + row; m = m < cnt ? m : cnt - 1; return X + (size_t)(base + m) * FFD; } };

template <class Epi>
__device__ __forceinline__ void mini_unit(const Frame& F, const bf16_t* W, int ldw, int f0, const bf16_t* X, int ldx, int t0, int K, const Epi& epi) {
    const int lane = F.lane, wid = F.wid, r = lane & 31, h = lane >> 5; const int kw = K >> 3;
    const char* wb = (const char*)W; const int nkt = ldw >> 6, wk0 = wid * kw + 8 * h; const bf16_t* xp = X + (size_t)(t0 + r) * ldx + wid * kw + 8 * h;
    f32x16 acc0, acc1;
#pragma unroll
    for (int i = 0; i < 16; ++i) { acc0[i] = 0.f; acc1[i] = 0.f; }
#pragma unroll 2
    for (int s = 0; s < (kw >> 4); ++s) { const bf16x8 w0 = *(const bf16x8*)(wb + wblk(f0 + r, wk0 + 16 * s, nkt)), w1 = *(const bf16x8*)(wb + wblk(f0 + 32 + r, wk0 + 16 * s, nkt)), xv = *(const bf16x8*)(xp + 16 * s);
        acc0 = MFMA(w0, xv, acc0); acc1 = MFMA(w1, xv, acc1); }
    BAR_SYNC();
    LAS float* red = (LAS float*)F.lds;
#pragma unroll
    for (int i = 0; i < 16; ++i) { red[(wid * 32 + i) * 64 + lane] = acc0[i]; red[(wid * 32 + 16 + i) * 64 + lane] = acc1[i]; }
    __syncthreads();
    LAS float* out = red + 8 * 32 * 64;
#pragma unroll
    for (int j = 0; j < 4; ++j) { const int rg = 4 * wid + j; float s = 0.f;
#pragma unroll
        for (int w = 0; w < 8; ++w) s += red[(w * 32 + rg) * 64 + lane];
        out[rg * 64 + lane] = s; }
    __syncthreads();
    if (wid == 0) {
#pragma unroll
        for (int i = 0; i < 16; ++i) { acc0[i] = out[i * 64 + lane]; acc1[i] = out[(16 + i) * 64 + lane]; }
        epi(acc0, acc1, f0 >> 6, t0 + r, h);
    }
}
struct EpiInProjCtx {
    const Frame& F; int l;
    __device__ __forceinline__ void operator()(f32x16& v0, f32x16& v1, int cg, int R, int h) const {
        const float QSD = 0.17677669529663687f * LOG2E, QSG = 0.125f * LOG2E;
        if (cg < 4) { bf16_t* fc = F.ws<bf16_t>(WS_FC);
#pragma unroll
            for (int fb = 0; fb < 2; ++fb)
#pragma unroll
                for (int g = 0; g < 4; ++g) { const f32x16& v = fb ? v1 : v0; const int ch = 64 * cg + 32 * fb + 8 * g + 4 * h;
                    const size_t a = (size_t)(((ch >> 7) * 4 + ((ch >> 5) & 3)) * 8192 + (R >> 3) * 256 + (R & 7) * 32 + (ch & 31)); *(u32x2*)(fc + a) = (u32x2){pk2(v[4 * g], v[4 * g + 1]), pk2(v[4 * g + 2], v[4 * g + 3])}; }
        } else if (cg < 16) { const bool isq = cg < 10; const int head = isq ? cg - 4 : cg - 10;
            if (isq) { bf16_t* qd = F.ws<bf16_t>(WS_QD);
#pragma unroll
                for (int fb = 0; fb < 2; ++fb)
#pragma unroll
                    for (int g = 0; g < 4; ++g) { const f32x16& v = fb ? v1 : v0;
                        const size_t a = ((((size_t)(head * NQB + (R >> 5)) * 2 + fb) * 4 + g) * 32 + (R & 31)) * 8 + 4 * h;
                        *(u32x2*)(qd + a) = (u32x2){pk2(v[4 * g] * QSD, v[4 * g + 1] * QSD), pk2(v[4 * g + 2] * QSD, v[4 * g + 3] * QSD)}; }
            } else { bf16_t* kd = F.ws<bf16_t>(WS_KD); unsigned* kmax = F.ctl + CW_KMAX + 16 * l;
                float ss0 = 0.f, ss1 = 0.f;
#pragma unroll
                for (int i = 0; i < 16; ++i) { ss0 += v0[i] * v0[i]; ss1 += v1[i] * v1[i]; }
                ss0 = add32(ss0); ss1 = add32(ss1); ss0 = wave_max(ss0); ss1 = wave_max(ss1);
                if (F.lane == 0) { atomicMax(kmax + 2 * head, __float_as_uint(ss0)); atomicMax(kmax + 2 * head + 1, __float_as_uint(ss1)); }
#pragma unroll
                for (int fb = 0; fb < 2; ++fb)
#pragma unroll
                    for (int g = 0; g < 4; ++g) { const f32x16& v = fb ? v1 : v0;
                        const size_t a = ((((size_t)(head * NKT + (R >> 6)) * 2 + fb) * 4 + g) * 64 + (R & 63)) * 8 + 4 * h;
                        *(u32x2*)(kd + a) = (u32x2){pk2(v[4 * g], v[4 * g + 1]), pk2(v[4 * g + 2], v[4 * g + 3])}; } }
        } else if (cg < 22 || cg >= 30) { const bool isd = cg < 22; const int head = isd ? cg - 16 : cg - 30; bf16_t* vb = isd ? F.ws<bf16_t>(WS_VD) : F.ws<bf16_t>(WS_VG);
#pragma unroll
            for (int fb = 0; fb < 2; ++fb)
#pragma unroll
                for (int g = 0; g < 4; ++g) { const f32x16& v = fb ? v1 : v0;
                    const int dd = 32 * fb + 8 * g + 4 * h; const size_t a = (size_t)(head * NKT + (R >> 6)) * 4096 + (dd >> 4) * 1024 + (R & 63) * 16 + (dd & 15);
                    *(u32x2*)(vb + a) = (u32x2){pk2(v[4 * g], v[4 * g + 1]), pk2(v[4 * g + 2], v[4 * g + 3])}; }
        } else { const bool isq = cg < 28; const int head = isq ? cg - 22 : cg - 28; const float* gw = (isq ? F.in(I_GQ) : F.in(I_GK)) + 64 * l;
            float ss = 0.f;
#pragma unroll
            for (int i = 0; i < 16; ++i) ss += v0[i] * v0[i] + v1[i] * v1[i];
            ss = add32(ss); const float rs = rsqrtf(ss * (1.f / 64.f) + 1e-6f) * (isq ? QSG : 1.f);
#pragma unroll
            for (int fb = 0; fb < 2; ++fb)
#pragma unroll
                for (int g = 0; g < 4; ++g) { const f32x16& v = fb ? v1 : v0; const f32x4 gv = *(const f32x4*)(gw + 32 * fb + 8 * g + 4 * h);
                    const u32x2 w = {pk2(v[4 * g] * rs * gv[0], v[4 * g + 1] * rs * gv[1]), pk2(v[4 * g + 2] * rs * gv[2], v[4 * g + 3] * rs * gv[3])};
                    if (isq) { const size_t a = (((size_t)(head * NQB + (R >> 5)) * 8 + 4 * fb + g) * 32 + (R & 31)) * 8 + 4 * h; *(u32x2*)(F.ws<bf16_t>(WS_QG) + a) = w; }
                    else { const size_t a = (((size_t)(head * NKT + (R >> 6)) * 8 + 4 * fb + g) * 64 + (R & 63)) * 8 + 4 * h; *(u32x2*)(F.ws<bf16_t>(WS_KG) + a) = w; } }
        }
    }
};
struct EpiOutProjCtx {
    const Frame& F;
    __device__ __forceinline__ void operator()(f32x16& v0, f32x16& v1, int cg, int R, int h) const {
        const float* src = F.in(I_CTX) + (size_t)R * DM; const float* gt = F.ws<float>(WS_MOD) + 6144 + 2048; float* xs = F.ws<float>(WS_XS) + (size_t)R * DM;
#pragma unroll
        for (int fb = 0; fb < 2; ++fb)
#pragma unroll
            for (int g = 0; g < 4; ++g) { const f32x16& v = fb ? v1 : v0; const int n = 64 * cg + 32 * fb + 8 * g + 4 * h;
                const f32x4 x = *(const f32x4*)(src + n), gv = *(const f32x4*)(gt + n);
                *(f32x4*)(xs + n) = (f32x4){x[0] + gv[0] * v[4 * g], x[1] + gv[1] * v[4 * g + 1], x[2] + gv[2] * v[4 * g + 2], x[3] + gv[3] * v[4 * g + 3]}; }
    }
};
__device__ __forceinline__ void phase_inproj(const Frame& F, int l) {
    const bf16_t* Wt = F.ws<bf16_t>(WS_WIN) + (size_t)l * INW * DM; const bf16_t* hb = F.ws<bf16_t>(WS_HB);
    const bool xcd = F.G == 256; const int x = F.bid & 7;
    const int first = xcd ? (F.bid >> 3) : F.bid, stride = xcd ? 32 : F.G, total = xcd ? 64 : 8 * 64;
    for (int i = first; i < total; i += stride) { const int ft = xcd ? 4 * (x & 1) + (i & 3) : (i & 7), tt = 1 + (xcd ? 4 * (i >> 2) + (x >> 1) : (i >> 3));
        EpiInProj E{F, l, 256 * tt}; XDense X{hb, DM, 256 * tt}; gemm8(F, Wt, DM, 256 * ft, X, E); }
    EpiInProjCtx EC{F, l};
    for (int u = F.bid; u < 256; u += F.G) { const int cg = u & 31, tb = u >> 5;
        if (l == 1 && !((cg >= 10 && cg < 22) || cg >= 28)) continue;
        mini_unit(F, Wt, DM, 64 * cg, hb, DM, 32 * tb, DM, EC); }
}
__device__ __forceinline__ void phase_outproj(const Frame& F, int l) {
    const bf16_t* Wt = F.ws<bf16_t>(WS_WOUT) + (size_t)l * DM * MIXK; const bf16_t* mix = F.ws<bf16_t>(WS_MIX);
    const bool xcd = F.G == 256; const int x = F.bid & 7;
    const int first = xcd ? (F.bid >> 3) : F.bid, stride = xcd ? 32 : F.G, total = xcd ? 32 : 4 * 64;
    for (int i = first; i < total; i += stride) { const int ft = i & 3, tt = 1 + (xcd ? 8 * (i >> 2) + x : (i >> 2));
        EpiOutProj E{F, l, 256 * tt}; XDense X{mix, MIXK, 256 * tt}; gemm8(F, Wt, MIXK, 256 * ft, X, E); }
    if (l == 0) { EpiOutProjCtx EC{F};
        for (int u = F.bid; u < 128; u += F.G) { const int cg = u & 15, tb = u >> 4; mini_unit(F, Wt, MIXK, 64 * cg, mix, MIXK, 32 * tb, MIXK, EC); } }
}
__device__ __forceinline__ void moe_tables(const Frame& F, int l, int nf, bool xcd, LAS int*& s_cnt, LAS int*& s_offs, LAS int*& s_t0) {
    LAS int* base = (LAS int*)(F.lds + LDS_CTL + 256); s_cnt = base; s_offs = base + 32; s_t0 = base + 72;
    __syncthreads();
    if (F.wid == 0) { const int e = F.lane, g = (F.bid & 7) >> 1; const bool v = e < NEXP;
        const int c = v ? (int)__hip_atomic_load(F.ctl + CW_CNT + 64 * l + e, __ATOMIC_RELAXED, __HIP_MEMORY_SCOPE_AGENT) : 0;
        const int ntt = (c + 255) >> 8; int nu = ntt * nf;
        if (xcd) { const int fst = (g - e) & 3; nu = (fst < ntt ? (ntt - fst + 3) >> 2 : 0) * (nf >> 1); }
        if (!v) nu = 0;
        int ic = c, iu = nu;
#pragma unroll
        for (int d = 1; d < 32; d <<= 1) { const int uc = __builtin_amdgcn_ds_bpermute(((e - d) & 63) << 2, ic), uu = __builtin_amdgcn_ds_bpermute(((e - d) & 63) << 2, iu); if (e >= d) { ic += uc; iu += uu; } }
        if (v) { s_cnt[e] = c; s_offs[e] = ic - c; s_t0[e] = iu - nu; }
        if (e == NEXP - 1) { s_offs[32] = ic; s_t0[32] = iu; } }
    __syncthreads();
}
__device__ __forceinline__ void moe_decode(const Frame& F, bool xcd, int nf, int i, LAS const int* s_t0, int& e, int& ft, int& tt) {
    while (e < NEXP - 1 && i >= s_t0[e + 1]) ++e;
    const int j = i - s_t0[e];
    if (xcd) { const int x = F.bid & 7, hf = nf >> 1; ft = hf * (x & 1) + (j % hf); tt = (((x >> 1) - e) & 3) + 4 * (j / hf); }
    else { ft = j % nf; tt = j / nf; } }
__device__ __forceinline__ void phase_gateup(const Frame& F, int l) {
    const bool xcd = F.G == 256;
    LAS int *s_cnt, *s_offs, *s_t0; moe_tables(F, l, 8, xcd, s_cnt, s_offs, s_t0);
    const int first = xcd ? (F.bid >> 3) : F.bid, stride = xcd ? 32 : F.G, total = s_t0[32];
    int e = 0;
    for (int i = first; i < total; i += stride) { int ft, tt; moe_decode(F, xcd, 8, i, s_t0, e, ft, tt);
        EpiGateUp E{F, l * NEXP + e, 256 * tt, s_cnt[e], s_offs[e]};
        XGather X{F.ws<bf16_t>(WS_HB), F.ws<unsigned>(WS_LIST) + (size_t)e * NT, 256 * tt, s_cnt[e]};
        gemm8(F, F.ws<bf16_t>(WS_WGU) + (size_t)(l * NEXP + e) * 2048 * DM, DM, 256 * ft, X, E); }
}
__device__ __forceinline__ void phase_down(const Frame& F, int l) {
    const bool xcd = F.G == 256;
    LAS int *s_cnt, *s_offs, *s_t0; moe_tables(F, l, 4, xcd, s_cnt, s_offs, s_t0);
    const int first = xcd ? (F.bid >> 3) : F.bid, stride = xcd ? 32 : F.G, total = s_t0[32];
    int e = 0;
    for (int i = first; i < total; i += stride) { int ft, tt; moe_decode(F, xcd, 4, i, s_t0, e, ft, tt);
        EpiDown E{F, l * NEXP + e, 256 * tt, s_cnt[e], s_offs[e]};
        XAct X{F.ws<bf16_t>(WS_ACT), s_offs[e], 256 * tt, s_cnt[e]};
        gemm8(F, F.ws<bf16_t>(WS_WDN) + (size_t)(l * NEXP + e) * DM * FFD, FFD, 256 * ft, X, E); }
}

template <int KD, int MODE>
__device__ __forceinline__ void dft_unit(const Frame& F, const bf16_t* AF, const bf16_t* Bsrc, int p0, int colhalf, int pa) {
    constexpr int NS = KD / 16, TILE_B = 4 * KD * 64;
    const int lane = F.lane, wid = F.wid, r = lane & 31, h = lane >> 5, rg = wid & 3, cg2 = wid >> 2;
    LAS char* lds = F.lds;
    BAR_SYNC();
    for (int pc = wid; pc < TILE_B / 1024; pc += 8) dma16((const char*)Bsrc + (size_t)pc * 1024 + lane * 16, lds + pc * 1024);
    WAITV(0); BAR_SYNC();
    f32x16 acc[2][2];
#pragma unroll
    for (int a = 0; a < 2; ++a)
#pragma unroll
        for (int b = 0; b < 2; ++b)
#pragma unroll
            for (int i = 0; i < 16; ++i) acc[a][b][i] = 0.f;
    const bf16_t* af = AF + (size_t)(rg * 2) * NS * 512 + lane * 8;
    const int bl = h * 512 + ((lane & 15) >> 2) * 64 + ((lane >> 4) & 1) * 32 + (lane & 3) * 8;
#pragma unroll 4
    for (int s = 0; s < NS; ++s) {
        const bf16x8 a0 = *(const bf16x8*)(af + (size_t)s * 512), a1 = *(const bf16x8*)(af + (size_t)(NS + s) * 512);
#pragma unroll
        for (int cb = 0; cb < 2; ++cb) { LAS const char* bp = lds + (2 * cg2 + cb) * (KD * 64) + s * 1024 + bl;
            const s16x4 lo = vtr(bp), hi = vtr(bp + 256);
            const bf16x8 bf = {lo[0], lo[1], lo[2], lo[3], hi[0], hi[1], hi[2], hi[3]};
            acc[0][cb] = MFMA(a0, bf, acc[0][cb]); acc[1][cb] = MFMA(a1, bf, acc[1][cb]); }
    }
#pragma unroll
    for (int cb = 0; cb < 2; ++cb) { const int c = 128 * colhalf + 32 * (2 * cg2 + cb) + r;
#pragma unroll
        for (int rho = 0; rho < 16; ++rho) { const int kk = 32 * rg + (rho & 3) + 8 * (rho >> 2) + 4 * h; const float re = acc[0][cb][rho], im = acc[1][cb][rho];
            if (MODE == 0) { const int l2 = p0; const f32x2 tw = F.ws<f32x2>(WS_TW)[(kk * l2) & 16383]; const float o_re = re * tw[0] + im * tw[1], o_im = im * tw[0] - re * tw[1];
                bf16_t* T2 = F.ws<bf16_t>(WS_T2); const size_t a = ((size_t)(kk * 2 + (c >> 7)) * 4 + ((c >> 5) & 3)) * 8192 + (l2 >> 2) * 256 + (2 * (l2 & 3)) * 32 + (c & 31);
                T2[a] = (bf16_t)(pk2(o_re, 0.f) & 0xffff); T2[a + 32] = (bf16_t)(pk2(o_im, 0.f) & 0xffff);
            } else if (MODE == 1) { const int k1 = p0; bf16_t* mr = F.ws<bf16_t>(WS_MIX) + (size_t)(NCTX + k1 + 128 * kk) * MIXK;
                mr[c] = (bf16_t)(pk2(re * (1.f / 1024.f), 0.f) & 0xffff); mr[256 + c] = (bf16_t)(pk2(im * (1.f / 1024.f), 0.f) & 0xffff);
            } else { bf16_t* mr = F.ws<bf16_t>(WS_MIX) + (size_t)(128 * pa + kk) * MIXK;
                mr[c] = (bf16_t)(pk2(re * (1.f / 128.f), 0.f) & 0xffff); mr[256 + c] = (bf16_t)(pk2(im * (1.f / 128.f), 0.f) & 0xffff); } } }
}

constexpr int A_SLOT = 16384;
constexpr int N_PSLOT = 18;
constexpr int A_KRING = 0, A_VRING = 32768;
template <int NQ, int NKS, bool SEPK, bool BIAS>
__device__ __forceinline__ void attn_sweep(const Frame& F, const bf16x8 (&qf)[NQ][NKS], const bf16_t* Kt, const bf16_t* Vt, int ntiles, const f32x16& negm, f32x16 (&o)[NQ][2], float (&lsum)[NQ]) {
    constexpr int NKF = (SEPK ? NQ : 1) * NKS;
    const int lane = F.lane, wid = F.wid, r = lane & 31, h = lane >> 5;
    LAS char* lds = F.lds; const unsigned lds0 = (unsigned)(size_t)F.lds;
    const bf16_t* ksrc = Kt + wid * 512 + lane * 8; const bf16_t* vsrc = Vt + wid * 512 + lane * 8;
#define A_K(t) glds16(ksrc + (size_t)(t) * 4096, (unsigned)__builtin_amdgcn_readfirstlane((int)(lds0 + A_KRING + ((t) & 3) * 8192 + wid * 1024)))
#define A_V(t) glds16(vsrc + (size_t)(t) * 4096, (unsigned)__builtin_amdgcn_readfirstlane((int)(lds0 + A_VRING + ((t) & 3) * 8192 + wid * 1024)))
#define SB() __builtin_amdgcn_sched_barrier(0)
    BAR_SYNC();
    A_K(0); A_V(0); A_K(1); A_K(2); A_V(1);
    float l0[NQ]; f32x16 scA[NQ], scB[NQ]; bf16x8 kf[NKF], vf[4], pa[NQ][2];
#pragma unroll
    for (int qi = 0; qi < NQ; ++qi) { l0[qi] = 0.f;
#pragma unroll
        for (int i = 0; i < 16; ++i) { o[qi][0][i] = 0.f; o[qi][1][i] = 0.f; scB[qi][i] = 0.f; } }
    const int vb = ((lane >> 4) & 1) * 32 + (lane & 3) * 8 + (4 * h + ((lane & 15) >> 2)) * 64;
    const int kbo = h * 1024 + r * 16;
#define LOADK(tile, kb) do { LAS const char* kp_ = lds + A_KRING + ((tile) & 3) * 8192 + kbo + (kb) * 512; \
        _Pragma("unroll") for (int f_ = 0; f_ < NKF; ++f_) kf[f_] = *(LAS const bf16x8*)(kp_ + (SEPK ? (f_ / NKS) * 4096 : 0) + (f_ % NKS) * 2048); } while (0)
#define LOADV(tile, kb) do { LAS const char* vp_ = lds + A_VRING + ((tile) & 3) * 8192 + vb + (kb) * 2048; \
        _Pragma("unroll") for (int j_ = 0; j_ < 2; ++j_) _Pragma("unroll") for (int d_ = 0; d_ < 2; ++d_) { const s16x4 lo_ = vtr(vp_ + d_ * 4096 + j_ * 1024), hi_ = vtr(vp_ + d_ * 4096 + j_ * 1024 + 512); \
            vf[j_ * 2 + d_] = (bf16x8){lo_[0], lo_[1], lo_[2], lo_[3], hi_[0], hi_[1], hi_[2], hi_[3]}; } } while (0)
#define HALF(SN, SO, vtile, vkb, DOK, ktile, kkb) do { \
        LOADV(vtile, vkb); SB(); \
          \
        _Pragma("unroll") for (int m_ = 0; m_ < NQ * NKS; ++m_) { const int qi_ = m_ / NKS, s_ = m_ % NKS; \
            if (s_ == 0) { if (BIAS) SN[qi_] = MFMA(kf[(SEPK ? qi_ : 0) * NKS], qf[qi_][0], negm); else { f32x16 z_; _Pragma("unroll") for (int i_ = 0; i_ < 16; ++i_) z_[i_] = 0.f; SN[qi_] = MFMA(kf[(SEPK ? qi_ : 0) * NKS], qf[qi_][0], z_); } } \
            else SN[qi_] = MFMA(kf[(SEPK ? qi_ : 0) * NKS + s_], qf[qi_][s_], SN[qi_]); \
              \
            _Pragma("unroll") for (int g_ = m_ * 4 / NKS; g_ < (m_ + 1) * 4 / NKS; ++g_) { const int fq_ = g_ >> 2, gg_ = g_ & 3; \
                l0[fq_] += SO[fq_][4 * gg_]; l0[fq_] += SO[fq_][4 * gg_ + 1]; l0[fq_] += SO[fq_][4 * gg_ + 2]; l0[fq_] += SO[fq_][4 * gg_ + 3]; \
                { u32x4 w_ = __builtin_bit_cast(u32x4, pa[fq_][gg_ >> 1]); w_[(gg_ & 1) * 2] = pk2(SO[fq_][4 * gg_], SO[fq_][4 * gg_ + 1]); w_[(gg_ & 1) * 2 + 1] = pk2(SO[fq_][4 * gg_ + 2], SO[fq_][4 * gg_ + 3]); pa[fq_][gg_ >> 1] = __builtin_bit_cast(bf16x8, w_); } } \
            SB(); } \
          \
        _Pragma("unroll") for (int m_ = 0; m_ < NQ * 4; ++m_) { const int j_ = m_ / (2 * NQ), d_ = (m_ / NQ) & 1, qi_ = m_ % NQ; \
            o[qi_][d_] = MFMA(vf[j_ * 2 + d_], pa[qi_][j_], o[qi_][d_]); \
            { const int eq_ = m_ >> 2, eg_ = m_ & 3; \
              SN[eq_][4 * eg_] = __builtin_amdgcn_exp2f(SN[eq_][4 * eg_]); SN[eq_][4 * eg_ + 1] = __builtin_amdgcn_exp2f(SN[eq_][4 * eg_ + 1]); \
              SN[eq_][4 * eg_ + 2] = __builtin_amdgcn_exp2f(SN[eq_][4 * eg_ + 2]); SN[eq_][4 * eg_ + 3] = __builtin_amdgcn_exp2f(SN[eq_][4 * eg_ + 3]); } \
            if (m_ == 0) { if (DOK) LOADK(ktile, kkb); }   \
            SB(); } \
    } while (0)
    WAITV(2); BAR_SYNC();
    A_K(3); if (ntiles > 2) A_V(2);
    LOADK(0, 0);
    for (int t = 0; t < ntiles; ++t) {
        if (t > 0) {
            if (t + 2 < ntiles) { WAITV(2); } else if (t + 1 < ntiles) { WAITV(1); } else { WAITV(0); }
            BAR_SYNC();
            if (t + 3 < ntiles) A_K(t + 3);
            if (t + 2 < ntiles) A_V(t + 2);
        }
        HALF(scA, scB, (t > 0 ? t - 1 : 0), 1, true, t, 1);
        HALF(scB, scA, t, 0, (t + 1 < ntiles), t + 1, 0);
    }
    LOADV(ntiles - 1, 1);
#pragma unroll
    for (int qi = 0; qi < NQ; ++qi) {
#pragma unroll
        for (int i = 0; i < 16; ++i) l0[qi] += scB[qi][i];
        pa[qi][0] = pack8(scB[qi][0], scB[qi][1], scB[qi][2], scB[qi][3], scB[qi][4], scB[qi][5], scB[qi][6], scB[qi][7]);
        pa[qi][1] = pack8(scB[qi][8], scB[qi][9], scB[qi][10], scB[qi][11], scB[qi][12], scB[qi][13], scB[qi][14], scB[qi][15]); }
#pragma unroll
    for (int j = 0; j < 2; ++j)
#pragma unroll
        for (int d0 = 0; d0 < 2; ++d0)
#pragma unroll
            for (int qi = 0; qi < NQ; ++qi) o[qi][d0] = MFMA(vf[j * 2 + d0], pa[qi][j], o[qi][d0]);
#undef A_K
#undef A_V
#undef SB
#undef LOADK
#undef LOADV
#undef HALF
#pragma unroll
    for (int qi = 0; qi < NQ; ++qi) lsum[qi] = add32(l0[qi]);
}
constexpr int PREC = 1152;
__device__ __forceinline__ void store_partial(const Frame& F, int kh, int slot, int R, const f32x16 (&o)[2], float l, int r, int h) {
    bf16_t* rec = F.ws<bf16_t>(WS_PART) + ((size_t)R * 2 + kh) * PREC; const float inv = 1.f / l;
#pragma unroll
    for (int d0 = 0; d0 < 2; ++d0)
#pragma unroll
        for (int g = 0; g < 4; ++g) { u32x2 w = {pk2(o[d0][4 * g] * inv, o[d0][4 * g + 1] * inv), pk2(o[d0][4 * g + 2] * inv, o[d0][4 * g + 3] * inv)};
            const int off = slot < 12 ? (((slot >> 1) * 8 + 4 * d0 + g) * 2 + (slot & 1)) * 8 + 4 * h : 768 + (slot - 12) * 64 + 32 * d0 + 8 * g + 4 * h;
            *(u32x2*)(rec + off) = w; }
    if (h == 0) F.ws<float>(WS_PL)[((size_t)R * 2 + kh) * N_PSLOT + slot] = l;
}
template <int NQ, int NC, bool SEPK, bool BIAS>
__device__ __forceinline__ void attn_sweep16(const Frame& F, const bf16x8 (&qf)[NQ][2][NC], const bf16_t* Kt, const bf16_t* Vt, int ntiles, const float (&negm)[2], f32x4 (&o)[NQ][4][2], float (&lsum)[NQ][2]) {
    constexpr int NKS_ = (SEPK ? NQ : 1);
    const int lane = F.lane, wid = F.wid, m16 = lane & 15, g = lane >> 4;
    LAS char* lds = F.lds; const unsigned lds0 = (unsigned)(size_t)F.lds;
    const bf16_t* ksrc = Kt + wid * 512 + lane * 8; const bf16_t* vsrc = Vt + wid * 512 + lane * 8;
#define A_K(t) glds16(ksrc + (size_t)(t) * 4096, (unsigned)__builtin_amdgcn_readfirstlane((int)(lds0 + A_KRING + ((t) & 3) * 8192 + wid * 1024)))
#define A_V(t) glds16(vsrc + (size_t)(t) * 4096, (unsigned)__builtin_amdgcn_readfirstlane((int)(lds0 + A_VRING + ((t) & 3) * 8192 + wid * 1024)))
#define SB() __builtin_amdgcn_sched_barrier(0)
    BAR_SYNC();
    A_K(0); A_V(0); A_K(1); A_K(2); A_V(1);
    f32x4 lacc[NQ][2]; f32x4 scA[NQ][2][2], scB[NQ][2][2]; bf16x8 kf[NKS_][2][NC], vf[4], pb[NQ][2];
    bf16x8 ones; { const short one_ = (short)0x3F80;
#pragma unroll
        for (int i = 0; i < 8; ++i) ones[i] = one_; asm volatile("" : "+v"(ones)); }
#pragma unroll
    for (int qi = 0; qi < NQ; ++qi)
#pragma unroll
        for (int qb = 0; qb < 2; ++qb) { lacc[qi][qb] = (f32x4){0.f, 0.f, 0.f, 0.f};
#pragma unroll
            for (int d = 0; d < 4; ++d) o[qi][d][qb] = (f32x4){0.f, 0.f, 0.f, 0.f};
#pragma unroll
            for (int kk = 0; kk < 2; ++kk) scB[qi][kk][qb] = (f32x4){0.f, 0.f, 0.f, 0.f}; }
    const int kbo = g * 1024 + m16 * 16;
    const int vbo = (4 * g + (m16 >> 2)) * 32 + (m16 & 3) * 8;
#define LOADK(tile, kb) do { LAS const char* kp_ = lds + A_KRING + ((tile) & 3) * 8192 + kbo + (kb) * 512; \
        _Pragma("unroll") for (int s_ = 0; s_ < NKS_; ++s_) _Pragma("unroll") for (int kk_ = 0; kk_ < 2; ++kk_) _Pragma("unroll") for (int c_ = 0; c_ < NC; ++c_) \
            kf[s_][kk_][c_] = *(LAS const bf16x8*)(kp_ + s_ * 4096 + c_ * 4096 + kk_ * 256); } while (0)
#define LOADV(tile, kb) do { LAS const char* vp_ = lds + A_VRING + ((tile) & 3) * 8192 + vbo + (kb) * 1024; \
        _Pragma("unroll") for (int d_ = 0; d_ < 4; ++d_) { const s16x4 lo_ = vtr(vp_ + d_ * 2048), hi_ = vtr(vp_ + d_ * 2048 + 512); \
            vf[d_] = (bf16x8){lo_[0], lo_[1], lo_[2], lo_[3], hi_[0], hi_[1], hi_[2], hi_[3]}; } } while (0)
#define HALF(SN, SO, vtile, vkb, DOK, ktile, kkb) do { \
        LOADV(vtile, vkb); SB(); \
          \
        _Pragma("unroll") for (int m_ = 0; m_ < NQ * 4 * NC; ++m_) { const int qi_ = m_ / (4 * NC), t_ = (m_ / NC) & 3, kk_ = t_ >> 1, qb_ = t_ & 1, c_ = m_ % NC; \
            if (c_ == 0) { f32x4 z_ = {0.f, 0.f, 0.f, 0.f}; if (BIAS) z_ = (f32x4){negm[qb_], negm[qb_], negm[qb_], negm[qb_]}; SN[qi_][kk_][qb_] = MFMA16(kf[SEPK ? qi_ : 0][kk_][0], qf[qi_][qb_][0], z_); } \
            else SN[qi_][kk_][qb_] = MFMA16(kf[SEPK ? qi_ : 0][kk_][c_], qf[qi_][qb_][c_], SN[qi_][kk_][qb_]); \
            if (c_ == NC - 1) { const f32x4 so_ = SO[qi_][kk_][qb_]; \
                u32x4 w_ = __builtin_bit_cast(u32x4, pb[qi_][qb_]); w_[2 * kk_] = pk2(so_[0], so_[1]); w_[2 * kk_ + 1] = pk2(so_[2], so_[3]); pb[qi_][qb_] = __builtin_bit_cast(bf16x8, w_); } \
            SB(); } \
          \
        _Pragma("unroll") for (int m_ = 0; m_ < NQ * 8; ++m_) { const int qi_ = m_ >> 3, d_ = (m_ >> 1) & 3, qb_ = m_ & 1; \
            o[qi_][d_][qb_] = MFMA16(vf[d_], pb[qi_][qb_], o[qi_][d_][qb_]); if (d_ == 3) lacc[qi_][qb_] = MFMA16(ones, pb[qi_][qb_], lacc[qi_][qb_]); \
            { const int e_ = m_ & 7, kk_ = e_ >> 2, eb_ = (e_ >> 1) & 1, hh_ = e_ & 1; \
              SN[qi_][kk_][eb_][2 * hh_] = __builtin_amdgcn_exp2f(SN[qi_][kk_][eb_][2 * hh_]); SN[qi_][kk_][eb_][2 * hh_ + 1] = __builtin_amdgcn_exp2f(SN[qi_][kk_][eb_][2 * hh_ + 1]); } \
            if (m_ == NQ * 4) { if (DOK) LOADK(ktile, kkb); } \
            SB(); } \
    } while (0)
    WAITV(2); BAR_SYNC();
    A_K(3); if (ntiles > 2) A_V(2);
    LOADK(0, 0);
    for (int t = 0; t < ntiles; ++t) {
        if (t > 0) {
            if (t + 2 < ntiles) { WAITV(2); } else if (t + 1 < ntiles) { WAITV(1); } else { WAITV(0); }
            BAR_SYNC();
            if (t + 3 < ntiles) A_K(t + 3);
            if (t + 2 < ntiles) A_V(t + 2);
        }
        HALF(scA, scB, (t > 0 ? t - 1 : 0), 1, true, t, 1);
        HALF(scB, scA, t, 0, (t + 1 < ntiles), t + 1, 0);
    }
    LOADV(ntiles - 1, 1);
#pragma unroll
    for (int qi = 0; qi < NQ; ++qi)
#pragma unroll
        for (int qb = 0; qb < 2; ++qb) { const f32x4 s0 = scB[qi][0][qb], s1 = scB[qi][1][qb];
            pb[qi][qb] = pack8(s0[0], s0[1], s0[2], s0[3], s1[0], s1[1], s1[2], s1[3]); }
#pragma unroll
    for (int qi = 0; qi < NQ; ++qi)
#pragma unroll
        for (int d = 0; d < 4; ++d)
#pragma unroll
            for (int qb = 0; qb < 2; ++qb) { o[qi][d][qb] = MFMA16(vf[d], pb[qi][qb], o[qi][d][qb]); if (d == 3) lacc[qi][qb] = MFMA16(ones, pb[qi][qb], lacc[qi][qb]); }
#undef A_K
#undef A_V
#undef SB
#undef LOADK
#undef LOADV
#undef HALF
#pragma unroll
    for (int qi = 0; qi < NQ; ++qi)
#pragma unroll
        for (int qb = 0; qb < 2; ++qb) lsum[qi][qb] = lacc[qi][qb][0];
}
__device__ __forceinline__ void store_partial16(const Frame& F, int kh, int slot, int R, const f32x4 (&o)[4], float l, int g) {
    bf16_t* rec = F.ws<bf16_t>(WS_PART) + ((size_t)R * 2 + kh) * PREC; const float inv = 1.f / l;
#pragma unroll
    for (int db = 0; db < 4; ++db) { const u32x2 w = {pk2(o[db][0] * inv, o[db][1] * inv), pk2(o[db][2] * inv, o[db][3] * inv)};
        const int off = slot < 12 ? (((slot >> 1) * 8 + 2 * db + (g >> 1)) * 2 + (slot & 1)) * 8 + 4 * (g & 1) : 768 + (slot - 12) * 64 + 16 * db + 4 * g;
        *(u32x2*)(rec + off) = w; }
    if (g == 0) F.ws<float>(WS_PL)[((size_t)R * 2 + kh) * N_PSLOT + slot] = l;
}
__device__ __forceinline__ void attn_diff_unit(const Frame& F0, int l, int head, int R0, int t0, int ntiles, int khalf) {
    const Frame F = fresh(F0);
    const int lane = F.lane, wid = F.wid, n = lane & 15, g = lane >> 4;
    const bf16_t* qp = F.ws<bf16_t>(WS_QD) + (size_t)(head * NQB + (R0 >> 5) + wid) * 2048;
    bf16x8 qf[2][2][1]; float negm[2] = {0.f, 0.f};
#pragma unroll
    for (int qb = 0; qb < 2; ++qb) { float mi[2];
#pragma unroll
        for (int mp = 0; mp < 2; ++mp) { qf[mp][qb][0] = *(const bf16x8*)(qp + ((4 * mp + g) * 32 + 16 * qb + n) * 8);
            float qq = 0.f;
#pragma unroll
            for (int j = 0; j < 8; ++j) { const float a = bf2f((unsigned short)qf[mp][qb][0][j]); qq += a * a; }
            qq += shxc<16>(qq); qq += shxc<32>(qq);
            const float km = ((LAS const float*)(F.lds + LDS_CTL + 1024))[2 * head + mp];
            mi[mp] = -sqrtf(qq * km) * 1.01f; }
        negm[qb] = fminf(mi[0], mi[1]); }
    f32x4 o[2][4][2]; float ls[2][2];
    attn_sweep16<2, 1, true, true>(F, qf, F.ws<bf16_t>(WS_KD) + (size_t)(head * NKT + t0) * 4096, F.ws<bf16_t>(WS_VD) + (size_t)(head * NKT + t0) * 4096, ntiles, negm, o, ls);
    { const int ln = lane_now(), n2 = ln & 15, g2 = ln >> 4;
#pragma unroll
      for (int mp = 0; mp < 2; ++mp)
#pragma unroll
          for (int qb = 0; qb < 2; ++qb) { const f32x4 oo[4] = {o[mp][0][qb], o[mp][1][qb], o[mp][2][qb], o[mp][3][qb]};
              store_partial16(F, khalf, 2 * head + mp, R0 + 32 * wid + 16 * qb + n2, oo, ls[mp][qb], g2); } }
}
template <int NH>
__device__ __forceinline__ void attn_gqa_unit(const Frame& F0, int qh0, int kvh, int R0, int t0, int ntiles, int khalf, float bound) {
    const Frame F = fresh(F0);
    const int lane = F.lane, wid = F.wid, n = lane & 15, g = lane >> 4;
    bf16x8 qf[NH][2][2];
#pragma unroll
    for (int hh = 0; hh < NH; ++hh) { const bf16_t* qp = F.ws<bf16_t>(WS_QG) + (size_t)((qh0 + hh) * NQB + (R0 >> 5) + wid) * 2048;
#pragma unroll
        for (int qb = 0; qb < 2; ++qb)
#pragma unroll
            for (int c = 0; c < 2; ++c) qf[hh][qb][c] = *(const bf16x8*)(qp + ((4 * c + g) * 32 + 16 * qb + n) * 8); }
    f32x4 o[NH][4][2]; float ls[NH][2]; const float negm[2] = {0.f, 0.f};
    attn_sweep16<NH, 2, false, false>(F, qf, F.ws<bf16_t>(WS_KG) + (size_t)(kvh * NKT + t0) * 4096, F.ws<bf16_t>(WS_VG) + (size_t)(kvh * NKT + t0) * 4096, ntiles, negm, o, ls);
    { const int ln = lane_now(), n2 = ln & 15, g2 = ln >> 4;
#pragma unroll
      for (int hh = 0; hh < NH; ++hh)
#pragma unroll
          for (int qb = 0; qb < 2; ++qb) { const f32x4 oo[4] = {o[hh][0][qb], o[hh][1][qb], o[hh][2][qb], o[hh][3][qb]};
              store_partial16(F, khalf, 12 + qh0 + hh, R0 + 32 * wid + 16 * qb + n2, oo, ls[hh][qb], g2); } }
}

__device__ __forceinline__ void phase_attn(const Frame& F, int l, int rep) {

    float gqm = 0.f, gkm = 0.f; { const float* gq = F.in(I_GQ) + 64 * l; const float* gk = F.in(I_GK) + 64 * l; for (int i = 0; i < 64; ++i) { gqm = fmaxf(gqm, fabsf(gq[i])); gkm = fmaxf(gkm, fabsf(gk[i])); } }
    const float bg = fminf(8.f * gqm * gkm * LOG2E * 1.01f, 100.f);
    for (int mp = F.wid; mp < 12; mp += 8) { const float* kp = F.ws<float>(WS_KP) + (size_t)(l * 12 + mp) * 1024; float mx = 0.f;
#pragma unroll
        for (int q = 0; q < 4; ++q) { const f32x4 v = *(const f32x4*)(kp + 256 * q + 4 * F.lane); mx = fmaxf(fmaxf(mx, fmaxf(v[0], v[1])), fmaxf(v[2], v[3])); }
        mx = wave_max(mx); mx = fmaxf(mx, __uint_as_float(__hip_atomic_load(F.ctl + CW_KMAX + 16 * l + mp, __ATOMIC_RELAXED, __HIP_MEMORY_SCOPE_AGENT)));
        if (F.lane == 0) ((LAS float*)(F.lds + LDS_CTL + 1024))[mp] = mx; }
    __syncthreads();
    constexpr int HT = NKT / 2;
    for (int u = F.bid; u < 256; u += F.G) { const int cb = (u & 7) >> 1, rb = ((u >> 3) << 1) | (u & 1), R0 = NCTX + 256 * rb; const int kvh = cb >> 1, kh = cb & 1;
        attn_gqa_unit<2>(F, 3 * kvh, kvh, R0, kh * HT, HT, kh, bg); }
    for (int u = F.bid; u < 768; u += F.G) { const int j = u >> 8, v = u & 255, cb = 4 * j + ((v & 7) >> 1), rb = ((v >> 3) << 1) | (v & 1), R0 = NCTX + 256 * rb; const int head = cb >> 1, kh = cb & 1;
        attn_diff_unit(F, l, head, R0, kh * HT, HT, kh); }
    for (int u = F.bid; u < 256; u += F.G) { const int cb = (u & 7) >> 1, rb = ((u >> 3) << 1) | (u & 1), R0 = NCTX + 256 * rb; const int kvh = cb >> 1, kh = cb & 1;
        attn_gqa_unit<1>(F, 3 * kvh + 2, kvh, R0, kh * HT, HT, kh, bg); }
    for (int u = F.bid; u < 256; u += F.G) { const int l2 = u >> 1, ch = u & 1;
        dft_unit<128, 0>(F, F.ws<bf16_t>(WS_A1F), F.ws<bf16_t>(WS_FT) + (size_t)(l2 * 2 + ch) * 4 * 4096, l2, ch, 0); }
    if (l == 0) {
        for (int u = F.bid; u < 14; u += F.G) {
            if (u < 4) { const int pa = u >> 1, ch = u & 1; dft_unit<256, 2>(F, F.ws<bf16_t>(WS_ACF) + (size_t)pa * 65536, F.ws<bf16_t>(WS_FC) + (size_t)ch * 4 * 8192, 0, ch, pa); }
            else if (u < 10) attn_diff_unit(F, l, u - 4, 0, 0, NCTX / 64, 0);
            else if (u < 12) attn_gqa_unit<2>(F, 3 * (u - 10), u - 10, 0, 0, NCTX / 64, 0, bg);
            else attn_gqa_unit<1>(F, 3 * (u - 12) + 2, u - 12, 0, 0, NCTX / 64, 0, bg);
        }
    }
    __builtin_amdgcn_s_setprio(0);
}
__device__ __forceinline__ void unpack8(const u32x4& w, float (&f)[8]) { f[0] = bflo(w[0]); f[1] = bfhi(w[0]); f[2] = bflo(w[1]); f[3] = bfhi(w[1]); f[4] = bflo(w[2]); f[5] = bfhi(w[2]); f[6] = bflo(w[3]); f[7] = bfhi(w[3]); }
__device__ __forceinline__ void attn_merge(const Frame& F, int l) {
    const int lane = F.lane, un = lane >> 3, dc = lane & 7; const bool act = lane < 48;
    const float* lq1 = F.in(I_LQ1) + 32 * l; const float* lk1 = F.in(I_LK1) + 32 * l; const float* lq2 = F.in(I_LQ2) + 32 * l; const float* lk2 = F.in(I_LK2) + 32 * l;
    float d1 = 0.f, d2 = 0.f; for (int i = 0; i < 32; ++i) { d1 += lq1[i] * lk1[i]; d2 += lq2[i] * lk2[i]; }
    const float lam_init = 0.8f - 0.6f * expf(-0.3f * (float)l); const float lam = expf(d1) - expf(d2) + lam_init, post = 1.f - lam_init;
    float gs[8]; { const float* g = F.in(I_GSUB) + 64 * l + 8 * dc; for (int j = 0; j < 8; ++j) gs[j] = g[j]; }
    const bf16_t* part = F.ws<bf16_t>(WS_PART); const float* pl = F.ws<float>(WS_PL); bf16_t* mix = F.ws<bf16_t>(WS_MIX);
    const int Rbeg = l == 0 ? 0 : NCTX; const int u6 = act ? un : 0;
    for (int R = Rbeg + F.bid * 8 + F.wid; R < NT; R += F.G * 8) {
        const bool two = R >= NCTX; bf16_t* mr = mix + (size_t)R * MIXK;
        const bf16_t* ra = part + (size_t)R * 2 * PREC; const bf16_t* rb = ra + PREC; const float* la = pl + (size_t)R * 2 * N_PSLOT; const float* lb = la + N_PSLOT;
        { const u32x4 a0 = *(const u32x4*)(ra + (u6 * 8 + dc) * 16), a1 = *(const u32x4*)(ra + (u6 * 8 + dc) * 16 + 8);
          u32x4 b0 = {0u, 0u, 0u, 0u}, b1 = b0; float lb0 = 0.f, lb1 = 0.f;
          if (two) { b0 = *(const u32x4*)(rb + (u6 * 8 + dc) * 16); b1 = *(const u32x4*)(rb + (u6 * 8 + dc) * 16 + 8); lb0 = lb[2 * u6]; lb1 = lb[2 * u6 + 1]; }
          const float la0 = la[2 * u6], la1 = la[2 * u6 + 1]; const float i0 = 1.f / (la0 + lb0), i1 = lam / (la1 + lb1);
          float fa0[8], fa1[8], fb0[8], fb1[8], v[8]; unpack8(a0, fa0); unpack8(a1, fa1); unpack8(b0, fb0); unpack8(b1, fb1);
          float ss = 0.f;
#pragma unroll
          for (int j = 0; j < 8; ++j) { v[j] = (la0 * fa0[j] + lb0 * fb0[j]) * i0 - (la1 * fa1[j] + lb1 * fb1[j]) * i1; ss += v[j] * v[j]; }
          ss += shxc<1>(ss); ss += shxc<2>(ss); ss += shxc<4>(ss);
          const float rs = rsqrtf(ss * (1.f / 64.f) + 1e-5f) * post;
          if (act) { u32x4 w = {pk2(v[0] * rs * gs[0], v[1] * rs * gs[1]), pk2(v[2] * rs * gs[2], v[3] * rs * gs[3]), pk2(v[4] * rs * gs[4], v[5] * rs * gs[5]), pk2(v[6] * rs * gs[6], v[7] * rs * gs[7])};
              *(u32x4*)(mr + 512 + 64 * un + 8 * dc) = w; } }
        { const u32x4 a0 = *(const u32x4*)(ra + 768 + u6 * 64 + dc * 8); u32x4 b0 = {0u, 0u, 0u, 0u}; float lbq = 0.f;
          if (two) { b0 = *(const u32x4*)(rb + 768 + u6 * 64 + dc * 8); lbq = lb[12 + u6]; }
          const float laq = la[12 + u6], iq = 1.f / (laq + lbq); float fa[8], fb[8]; unpack8(a0, fa); unpack8(b0, fb);
          if (act) { float o[8];
#pragma unroll
              for (int j = 0; j < 8; ++j) o[j] = (laq * fa[j] + lbq * fb[j]) * iq;
              u32x4 w = {pk2(o[0], o[1]), pk2(o[2], o[3]), pk2(o[4], o[5]), pk2(o[6], o[7])}; *(u32x4*)(mr + 896 + 64 * un + 8 * dc) = w; } }
    }
}
__device__ __forceinline__ void phase_fft2(const Frame& F, int l) {
    for (int u = F.bid; u < 256; u += F.G) { const int k1 = u >> 1, ch = u & 1;
        dft_unit<256, 1>(F, F.ws<bf16_t>(WS_A2F), F.ws<bf16_t>(WS_T2) + (size_t)(k1 * 2 + ch) * 4 * 8192, k1, ch, 0); }
    attn_merge(F, l);
}

__device__ __forceinline__ void phase_router(const Frame& F, int l) {
    constexpr int HS = 2064;
    LAS char* hhi = F.lds; LAS char* hlo = F.lds + 32 * HS;
    LAS float* part = (LAS float*)F.lds;
    LAS unsigned* hist = (LAS unsigned*)(F.lds + 135168);
    LAS unsigned* recs = hist + 64;
    const int lane = F.lane, wid = F.wid, t = F.tid;
    const float* wr = F.in(I_WR) + (size_t)l * 1024 * 32;
    __syncthreads();
    if (t < 64) hist[t] = 0u;
    bf16x8 ahi[8], alo[8];
    { const int e = lane & 31, kk = lane >> 5;
#pragma unroll
      for (int s = 0; s < 8; ++s) { float w[8];
#pragma unroll
          for (int j = 0; j < 8; ++j) w[j] = wr[(size_t)(16 * (8 * wid + s) + 8 * kk + j) * 32 + e];
          unsigned hi[4], lo[4];
#pragma unroll
          for (int j = 0; j < 4; ++j) { hi[j] = pk2(w[2 * j], w[2 * j + 1]); lo[j] = pk2(w[2 * j] - bflo(hi[j]), w[2 * j + 1] - bfhi(hi[j])); }
          ahi[s] = __builtin_bit_cast(bf16x8, (u32x4){hi[0], hi[1], hi[2], hi[3]}); alo[s] = __builtin_bit_cast(bf16x8, (u32x4){lo[0], lo[1], lo[2], lo[3]}); } }
    const int Rbeg = l == 0 ? 0 : NCTX, ntok = NT - Rbeg, per = (ntok + F.G - 1) / F.G;
    const int r0 = Rbeg + F.bid * per, r1 = min(r0 + per, NT);
    const float* mod = F.ws<float>(WS_MOD) + (size_t)l * 2 * 6144; const float* g2 = F.in(I_GN2) + 1024 * l; const float* br = F.in(I_BR) + 32 * l;
    const float* xs = F.ws<float>(WS_XS); bf16_t* hb = F.ws<bf16_t>(WS_HB);
    unsigned* slot = F.ws<unsigned>(WS_SLOT); float* gate = F.ws<float>(WS_GATE);
    const float bre = br[lane & 31];
    f32x4 gvv[4], shv[4], scv[4];
#pragma unroll
    for (int q = 0; q < 4; ++q) { const int k = 256 * q + 4 * lane; gvv[q] = *(const f32x4*)(g2 + k); shv[q] = *(const f32x4*)(mod + 3072 + k); scv[q] = *(const f32x4*)(mod + 4096 + k); }
    f32x4 xr[4][4];
    if (r0 < r1) {
#pragma unroll
        for (int j = 0; j < 4; ++j) load_row(xs + (size_t)min(r0 + wid + 8 * j, r1 - 1) * DM, lane, xr[j]); }
    for (int b0 = r0; b0 < r1; b0 += 32) {
        __syncthreads();
#pragma unroll
        for (int j = 0; j < 4; ++j) { const int tt = wid + 8 * j; const int R = min(b0 + tt, r1 - 1);
            f32x4 hv[4]; const float rstd = row_rstd(xr[j], 1e-6f);
            f32x4 sh[4], sc[4];
#pragma unroll
            for (int q = 0; q < 4; ++q) { sh[q] = shv[q]; sc[q] = scv[q]; }
            if (R < NCTX) {
#pragma unroll
                for (int q = 0; q < 4; ++q) { const int k = 256 * q + 4 * lane; sh[q] = *(const f32x4*)(mod + 6144 + 3072 + k); sc[q] = *(const f32x4*)(mod + 6144 + 4096 + k); } }
#pragma unroll
            for (int q = 0; q < 4; ++q) { const int k = 256 * q + 4 * lane;
#pragma unroll
                for (int i = 0; i < 4; ++i) hv[q][i] = (xr[j][q][i] * rstd * gvv[q][i]) * (1.f + sc[q][i]) + sh[q][i];
                *(u32x2*)(hb + (size_t)R * DM + k) = (u32x2){pk2(hv[q][0], hv[q][1]), pk2(hv[q][2], hv[q][3])}; }
#pragma unroll
            for (int q = 0; q < 4; ++q) { const unsigned h0 = pk2(hv[q][0], hv[q][1]), h1 = pk2(hv[q][2], hv[q][3]);
                const unsigned l0 = pk2(hv[q][0] - bflo(h0), hv[q][1] - bfhi(h0)), l1 = pk2(hv[q][2] - bflo(h1), hv[q][3] - bfhi(h1));
                *(LAS u32x2*)(hhi + tt * HS + (256 * q + 4 * lane) * 2) = (u32x2){h0, h1}; *(LAS u32x2*)(hlo + tt * HS + (256 * q + 4 * lane) * 2) = (u32x2){l0, l1}; } }
        if (b0 + 32 < r1) {
#pragma unroll
            for (int j = 0; j < 4; ++j) load_row(xs + (size_t)min(b0 + 32 + wid + 8 * j, r1 - 1) * DM, lane, xr[j]); }
        __syncthreads();
        f32x16 acc;
#pragma unroll
        for (int i = 0; i < 16; ++i) acc[i] = 0.f;
        { const int n = lane & 31, kk = lane >> 5;
#pragma unroll
          for (int s = 0; s < 8; ++s) { const int off = n * HS + (16 * (8 * wid + s) + 8 * kk) * 2;
              const bf16x8 bh = *(LAS const bf16x8*)(hhi + off), bl = *(LAS const bf16x8*)(hlo + off);
              acc = MFMA(ahi[s], bh, acc); acc = MFMA(ahi[s], bl, acc); acc = MFMA(alo[s], bh, acc); } }
        __syncthreads();
#pragma unroll
        for (int i = 0; i < 16; ++i) part[(wid * 16 + i) * 64 + lane] = acc[i];
        __syncthreads();
        { const int e = lane & 31; const int rr = (e & 3) | ((e >> 3) << 2), lh = 32 * ((e >> 2) & 1);
          float v[4];
#pragma unroll
          for (int tt = 0; tt < 4; ++tt) { v[tt] = bre;
#pragma unroll
              for (int w = 0; w < 8; ++w) v[tt] += part[(w * 16 + rr) * 64 + 4 * wid + tt + lh]; }
          float tv[4][4]; int te[4][4];
#pragma unroll
          for (int kk = 0; kk < 4; ++kk)
#pragma unroll
              for (int tt = 0; tt < 4; ++tt) { const float mx = wave_max(v[tt]); const unsigned long long bal = __ballot(v[tt] == mx); const int lw = __ffsll((long long)bal) - 1;
                  te[tt][kk] = lw & 31; tv[tt][kk] = mx; if (e == te[tt][kk]) v[tt] = -INFINITY; }
#pragma unroll
          for (int tt = 0; tt < 4; ++tt) { const int R = b0 + 4 * wid + tt;
            const float e1 = __expf(tv[tt][1] - tv[tt][0]), e2 = __expf(tv[tt][2] - tv[tt][0]), e3 = __expf(tv[tt][3] - tv[tt][0]); const float inv = 1.f / (1.f + e1 + e2 + e3);
            if (lane < 4 && R < r1) { const int ee = lane == 0 ? te[tt][0] : lane == 1 ? te[tt][1] : lane == 2 ? te[tt][2] : te[tt][3]; const float gg = (lane == 0 ? 1.f : lane == 1 ? e1 : lane == 2 ? e2 : e3) * inv;
                const unsigned lr = atomicAdd((unsigned*)(hist + ee), 1u);
                const int ti = R - r0; recs[ti * 4 + lane] = ((unsigned)ee << 24) | lr; gate[(size_t)R * 4 + lane] = gg; } } }
    }
    __syncthreads();
    if (t < 32) { const unsigned c = hist[t]; hist[32 + t] = c ? xb_add(F.ctl + CW_CNT + 64 * l + t, c) : 0u; }
    __syncthreads();
    unsigned* list = F.ws<unsigned>(WS_LIST);
    for (int i = t; i < (r1 - r0) * 4; i += 512) { const unsigned rec = recs[i]; const unsigned ee = rec >> 24, rk = (rec & 0xffffffu) + hist[32 + ee]; const int R = r0 + (i >> 2);
        slot[(size_t)R * 4 + (i & 3)] = (ee << 24) | rk; list[(size_t)ee * NT + rk] = (unsigned)R; }
    __syncthreads();
}

__device__ __forceinline__ void phase_combine(const Frame& F, int l) {
    const int lane = F.lane; const float* mod = F.ws<float>(WS_MOD) + (size_t)l * 2 * 6144; const float* modn = F.ws<float>(WS_MOD) + (size_t)(l + 1) * 2 * 6144;
    float* xs = F.ws<float>(WS_XS); const bf16_t* yb = F.ws<bf16_t>(WS_YB); const unsigned* slot = F.ws<unsigned>(WS_SLOT); const float* gate = F.ws<float>(WS_GATE); bf16_t* hb = F.ws<bf16_t>(WS_HB);
    int offs = 0;
    { const int ce = lane < NEXP ? (int)__hip_atomic_load(F.ctl + CW_CNT + 64 * l + lane, __ATOMIC_RELAXED, __HIP_MEMORY_SCOPE_AGENT) : 0;
      int inc = ce;
#pragma unroll
      for (int d = 1; d < 32; d <<= 1) { const int up = __builtin_amdgcn_ds_bpermute(((lane - d) & 63) << 2, inc); if (lane >= d) inc += up; }
      offs = inc - ce; }
    const int Rbeg = l == 0 ? 0 : NCTX; float* outb = F.outp(); const float* gn1 = F.in(I_GN1) + 1024; const float* gf = F.in(I_GFIN);
    f32x4 gfv[4];
#pragma unroll
    for (int q = 0; q < 4; ++q) gfv[q] = *(const f32x4*)(gf + 256 * q + 4 * lane);
    const int step = F.G * 8;
    for (int R0 = Rbeg + F.bid * 8 + F.wid; R0 < NT; R0 += 2 * step) {
        const int R1 = R0 + step; const bool two = R1 < NT; const int Rr[2] = {R0, two ? R1 : R0};
        f32x4 x[2][4], a[2][4]; unsigned rec[2][4]; float gg[2][4];
#pragma unroll
        for (int j = 0; j < 2; ++j) { load_row(xs + (size_t)Rr[j] * DM, lane, x[j]);
#pragma unroll
            for (int s = 0; s < 4; ++s) { rec[j][s] = slot[(size_t)Rr[j] * 4 + s]; gg[j][s] = gate[(size_t)Rr[j] * 4 + s]; } }
        u32x2 w[2][4][4];
#pragma unroll
        for (int j = 0; j < 2; ++j)
#pragma unroll
            for (int s = 0; s < 4; ++s) { const int pos = __builtin_amdgcn_ds_bpermute((int)((rec[j][s] >> 24) << 2), offs) + (int)(rec[j][s] & 0xffffffu); const bf16_t* yr = yb + (size_t)pos * DM;
#pragma unroll
                for (int q = 0; q < 4; ++q) w[j][s][q] = *(const u32x2*)(yr + 256 * q + 4 * lane); }
#pragma unroll
        for (int j = 0; j < 2; ++j) {
#pragma unroll
            for (int q = 0; q < 4; ++q) a[j][q] = (f32x4){0.f, 0.f, 0.f, 0.f};
#pragma unroll
            for (int s = 0; s < 4; ++s)
#pragma unroll
                for (int q = 0; q < 4; ++q) { const float g = gg[j][s]; const u32x2 ww = w[j][s][q]; a[j][q][0] += g * bflo(ww[0]); a[j][q][1] += g * bfhi(ww[0]); a[j][q][2] += g * bflo(ww[1]); a[j][q][3] += g * bfhi(ww[1]); } }
#pragma unroll
        for (int j = 0; j < 2; ++j) { const int R = Rr[j]; if (j == 1 && !two) break;
            const float* m = mod + (R < NCTX ? 6144 : 0);
#pragma unroll
            for (int q = 0; q < 4; ++q) { const f32x4 gt = *(const f32x4*)(m + 5120 + 256 * q + 4 * lane);
#pragma unroll
                for (int i = 0; i < 4; ++i) x[j][q][i] += gt[i] * a[j][q][i]; }
            const float rstd = row_rstd(x[j], 1e-6f);
            if (l == 0) {
#pragma unroll
                for (int q = 0; q < 4; ++q) *(f32x4*)(xs + (size_t)R * DM + 256 * q + 4 * lane) = x[j][q];
                const float* mn = modn + (R < NCTX ? 6144 : 0);
                mod_store_bf16(x[j], rstd, gn1, mn, mn + 1024, hb + (size_t)R * DM, lane);
            } else {
                float* orow = outb + (size_t)(R - NCTX) * DM;
#pragma unroll
                for (int q = 0; q < 4; ++q) { const f32x4 gv = gfv[q]; f32x4 o;
#pragma unroll
                    for (int i = 0; i < 4; ++i) o[i] = x[j][q][i] * rstd * gv[i];
                    *(f32x4*)(orow + 256 * q + 4 * lane) = o; }
            }
        }
    }
}

__device__ __forceinline__ int opaque_i32(int v) { asm volatile("" : "+s"(v)); return __builtin_amdgcn_readfirstlane(v); }
__device__ __forceinline__ unsigned long long opaque_u64(unsigned long long w) { int lo = (int)(unsigned)w, hi = (int)(unsigned)(w >> 32); lo = opaque_i32(lo); hi = opaque_i32(hi);
    return ((unsigned long long)(unsigned)hi << 32) | (unsigned)lo; }
__device__ __forceinline__ Frame fresh(const Frame& F) { Frame G = F;
    G.wsb = (unsigned char*)opaque_u64((unsigned long long)F.wsb); G.ctl = (unsigned*)opaque_u64((unsigned long long)F.ctl);
    G.pp = (const __attribute__((address_space(4))) Params*)opaque_u64((unsigned long long)F.pp);
    G.wid = opaque_i32(F.wid); G.bid = opaque_i32(F.bid); G.G = opaque_i32(F.G);
    G.lane = lane_now(); G.tid = G.wid * 64 + G.lane; return G; }
constexpr int N_PHASES = 18;
__global__ void __launch_bounds__(NTHREADS, 2) mk_fwd(Params P, int ph_lo, int ph_hi, int probe) {
    extern __shared__ __attribute__((aligned(16))) unsigned char smem_raw[];
    Frame F; F.pp = (const __attribute__((address_space(4))) Params*)__builtin_amdgcn_kernarg_segment_ptr(); F.wsb = P.ws; F.lds = (LAS char*)smem_raw; F.tid = threadIdx.x; F.lane = F.tid & 63; F.wid = __builtin_amdgcn_readfirstlane(F.tid >> 6); F.G = gridDim.x; F.bid = blockIdx.x;
    F.ctl = (unsigned*)(P.ws + WS_CTL);
    LAS unsigned* bw = (LAS unsigned*)(F.lds + LDS_CTL);
    if (F.tid < 4) bw[F.tid] = 0u;
    __syncthreads();
    XcdBarrier bar;
    if (MK_ONE_LAUNCH) bar = xcd_barrier_post(F.ctl + CW_BAR, (volatile LAS unsigned*)bw, F.wid);
#ifndef PHASE_MASK
#define PHASE_MASK 0xFFFFFFFFu
#endif
#if MK_ONE_LAUNCH
#define IN(k) (((PHASE_MASK >> ((k) >= 10 ? (k) - 8 : (k))) & 1u) != 0u)
#else
#define IN(k) (((PHASE_MASK >> ((k) >= 10 ? (k) - 8 : (k))) & 1u) && ph_lo <= (k) && (k) < ph_hi)
#endif
#define SEAM(k) do { if (MK_ONE_LAUNCH && IN(k) && IN((k) + 1)) xcd_barrier(bar); } while (0)
#define RUN(k, code, body) do { if (IN(k)) { const int nr_ = (opaque_i32(probe) == (code)) ? 2 : 1; _Pragma("unroll 1") for (int rep = 0; rep < nr_; ++rep) { body; if (MK_ONE_LAUNCH && rep + 1 < nr_) xcd_barrier(bar); } } SEAM(k); } while (0)
    RUN(0, 100, phase_prologue(fresh(F)));
    RUN(1, 101, phase_norm0(fresh(F)));
#pragma unroll 1
    for (int l = 0; l < 2; ++l) {
        const int b = 2 + 8 * l;
        RUN(b + 0, 0, phase_inproj(fresh(F), l));
        RUN(b + 1, 1, phase_attn(fresh(F), l, rep));
        RUN(b + 2, 2, phase_fft2(fresh(F), l));
        RUN(b + 3, 3 + 10 * l, phase_outproj(fresh(F), l));
        RUN(b + 4, 104, phase_router(fresh(F), l));
        RUN(b + 5, 5, phase_gateup(fresh(F), l));
        RUN(b + 6, 6, phase_down(fresh(F), l));
        RUN(b + 7, 17 - 10 * l, phase_combine(fresh(F), l));
    }
}

extern "C" void kernel_launch(void* const* d_in, const int* in_sizes, int n_in, void* d_out, int out_size, void* d_ws, size_t ws_size, hipStream_t stream) {
    static int grid = 0;
    if (!grid) {
        int dev = 0, cus = 0, per_cu = 0;
        hipGetDevice(&dev);
        hipDeviceGetAttribute(&cus, hipDeviceAttributeMultiprocessorCount, dev);
        hipFuncSetAttribute((const void*)mk_fwd, hipFuncAttributeMaxDynamicSharedMemorySize, LDS_BYTES);
        hipOccupancyMaxActiveBlocksPerMultiprocessor(&per_cu, (const void*)mk_fwd, NTHREADS, LDS_BYTES);
        if (per_cu < 1) { fprintf(stderr, "mk_fwd: occupancy query says %d blocks per CU\n", per_cu); per_cu = 1; }
        grid = cus * 1;
        if (ws_size < WS_END) fprintf(stderr, "mk_fwd: workspace too small (%zu < %zu)\n", ws_size, (size_t)WS_END);
    }
    hipMemsetAsync(d_ws, 0, CTL_BYTES, stream);
    Params p{};
    for (int i = 0; i < 25; ++i) p.in[i] = (const float*)d_in[i];
    p.out = (float*)d_out; p.ws = (unsigned char*)d_ws;
#if MK_ONE_LAUNCH
    hipLaunchKernelGGL(mk_fwd, dim3(grid), dim3(NTHREADS), LDS_BYTES, stream, p, 0, N_PHASES, MK_PROBE);
#else
    for (int k = 0; k < N_PHASES; ++k) hipLaunchKernelGGL(mk_fwd, dim3(grid), dim3(NTHREADS), LDS_BYTES, stream, p, k, k + 1, -1);
#endif
}
```
